# Optimizing an MI355X kernel written in HIP

```python
import jax, jax.numpy as jnp
from jax import lax
import numpy as np

D_MODEL = 1024
BATCH = 8
SEQ = 4096
DEPTH = 1

CTX_LEN = 256
GRID_W = 64
NA_HEADS = 8
NA_HEAD_DIM = 64
NA_WIDTH = NA_HEADS * NA_HEAD_DIM
WIN_ROWS = 8
WIN_COLS = 16
GLA_HEADS = 4
GLA_DK = 128
GLA_DV = 256
GLA_QK_WIDTH = GLA_HEADS * GLA_DK
GLA_V_WIDTH = GLA_HEADS * GLA_DV
GLA_GATE_RANK = 16
GLA_TAU = 16.0
GLA_CHUNK = 64
ROPE_BASE = 10000.0
PROJ_SIZES = (NA_WIDTH, NA_WIDTH, NA_WIDTH, GLA_QK_WIDTH, GLA_QK_WIDTH, GLA_V_WIDTH, GLA_V_WIDTH, GLA_GATE_RANK, GLA_GATE_RANK, D_MODEL, D_MODEL)
PROJ_WIDTH = sum(PROJ_SIZES)
N_EXPERTS = 256
TOP_K = 8
N_GROUPS = 8
TOPK_GROUPS = 4
EXPERT_FF = 256
SHARED_FF = 256
ROUTED_SCALE = 2.5
MOE_BLOCK = 128
DEEPNORM_ALPHA = (2 * DEPTH) ** 0.25
DEEPNORM_BETA = (8 * DEPTH) ** -0.25
EPS = 1e-6

kernel_name = 'hybrid_natten_gla_moe_dit_layer'


def layer_norm(x, g, b):
    xf = x.astype(jnp.float32)
    mu = xf.mean(-1, keepdims=True)
    var = jnp.square(xf - mu).mean(-1, keepdims=True)
    return ((xf - mu) * lax.rsqrt(var + EPS)).astype(x.dtype) * g + b


def split_heads(t, n_heads):
    b, t_len, _ = t.shape
    return t.reshape(b, t_len, n_heads, -1).transpose(0, 2, 1, 3)


def merge_heads(t):
    b, h, t_len, d = t.shape
    return t.transpose(0, 2, 1, 3).reshape(b, t_len, h * d)


def swiglu(x, wg, wu, wd):
    return (jax.nn.silu(x @ wg) * (x @ wu)) @ wd


def rope_2d(x, row_pos, col_pos):
    half = x.shape[-1] // 2
    quarter = half // 2
    inv_freq = ROPE_BASE ** (-jnp.arange(quarter, dtype=jnp.float32) / quarter)

    def rotate(xh, pos):
        ang = pos[:, None] * inv_freq[None, :]
        cos = jnp.cos(ang).astype(x.dtype)
        sin = jnp.sin(ang).astype(x.dtype)
        x1, x2 = xh[..., :quarter], xh[..., quarter:]
        return jnp.concatenate([x1 * cos - x2 * sin, x2 * cos + x1 * sin], axis=-1)

    return jnp.concatenate([rotate(x[..., :half], row_pos), rotate(x[..., half:], col_pos)], axis=-1)


def neighbourhood_attention(q, k, v, k_ctx, v_ctx, rpb):
    b, h, rows, w, dh = q.shape
    wr = min(WIN_ROWS, rows)
    col_start = np.clip(np.arange(w) - WIN_COLS // 2, 0, w - WIN_COLS)
    col_idx = col_start[:, None] + np.arange(WIN_COLS)[None, :]
    col_rel = col_idx - np.arange(w)[:, None] + (WIN_COLS - 1)
    rpb_cols = rpb[:, :, col_rel]
    n_loc = wr * WIN_COLS

    def one_row(r):
        start = jnp.clip(r - wr // 2, 0, rows - wr)
        q_r = lax.dynamic_index_in_dim(q, r, axis=2, keepdims=False)
        k_win = lax.dynamic_slice_in_dim(k, start, wr, axis=2)[:, :, :, col_idx]
        v_win = lax.dynamic_slice_in_dim(v, start, wr, axis=2)[:, :, :, col_idx]
        row_rel = start + jnp.arange(wr) - r + (WIN_ROWS - 1)
        bias = jnp.take(rpb_cols, row_rel, axis=1).transpose(0, 2, 1, 3)
        s_loc = jnp.einsum('bhqd,bhrqcd->bhqrc', q_r, k_win) + bias[None]
        s_ctx = jnp.einsum('bhqd,bhkd->bhqk', q_r, k_ctx)
        s = jnp.concatenate([s_loc.reshape(b, h, w, n_loc), s_ctx], axis=-1)
        p = jax.nn.softmax(s.astype(jnp.float32), axis=-1).astype(q.dtype)
        p_loc = p[..., :n_loc].reshape(b, h, w, wr, WIN_COLS)
        return (jnp.einsum('bhqrc,bhrqcd->bhqd', p_loc, v_win)
                + jnp.einsum('bhqk,bhkd->bhqd', p[..., n_loc:], v_ctx))

    out = lax.map(one_row, jnp.arange(rows))
    return out.transpose(1, 0, 3, 2, 4).reshape(b, rows * w, h * dh)


def context_attention(q, k, v):
    s = jnp.einsum('bhqd,bhkd->bhqk', q, k)
    p = jax.nn.softmax(s.astype(jnp.float32), axis=-1).astype(q.dtype)
    return merge_heads(jnp.einsum('bhqk,bhkd->bhqd', p, v))


def gla_log_decay(lr, w2, b2):
    return split_heads(jax.nn.log_sigmoid((lr @ w2 + b2).astype(jnp.float32)) / GLA_TAU, GLA_HEADS)


def gla_chunked(q, k, v, log_a, s0):
    b, h, t_len, dk = q.shape
    dv = v.shape[-1]
    n_chunks = t_len // GLA_CHUNK

    def to_chunks(t):
        return t.astype(jnp.float32).reshape(b, h, n_chunks, GLA_CHUNK, t.shape[-1]).transpose(2, 0, 1, 3, 4)

    causal = jnp.tril(jnp.ones((GLA_CHUNK, GLA_CHUNK), dtype=bool))[:, :, None]

    def chunk_step(state, xs):
        qc, kc, vc, ac = xs
        cum = jnp.cumsum(ac, axis=-2)
        pair = jnp.exp(jnp.where(causal, cum[..., :, None, :] - cum[..., None, :, :], -jnp.inf))
        scores = jnp.einsum('bhid,bhjd,bhijd->bhij', qc, kc, pair)
        out = (jnp.einsum('bhij,bhje->bhie', scores, vc)
               + jnp.einsum('bhid,bhde->bhie', qc * jnp.exp(cum), state))
        total = cum[..., -1:, :]
        state = (jnp.exp(total)[..., 0, :, None] * state
                 + jnp.einsum('bhjd,bhje->bhde', kc * jnp.exp(total - cum), vc))
        return state, out

    state, out = lax.scan(chunk_step, s0, (to_chunks(q), to_chunks(k), to_chunks(v), to_chunks(log_a)))
    return out.transpose(1, 2, 0, 3, 4).reshape(b, h, t_len, dv).astype(v.dtype), state


def gla_final_state(k, v, log_a):
    cum = jnp.cumsum(log_a.astype(jnp.float32), axis=2)
    return jnp.einsum('bhtd,bhte->bhde', k.astype(jnp.float32) * jnp.exp(cum[:, :, -1:, :] - cum), v.astype(jnp.float32))


def gla_readout(o_f, o_b, g, norm_w):
    o = (o_f + o_b).transpose(0, 2, 1, 3).astype(jnp.float32)
    o = o * lax.rsqrt(jnp.mean(jnp.square(o), axis=-1, keepdims=True) + EPS)
    b, t_len = o.shape[:2]
    return o.reshape(b, t_len, -1).astype(g.dtype) * norm_w * jax.nn.silu(g)


def branch_merge(out_a, out_b, gate_a, gate_b, w_br_a, w_br_b, w_out):
    y = jax.nn.sigmoid(gate_a) * (out_a @ w_br_a) + jax.nn.sigmoid(gate_b) * (out_b @ w_br_b)
    return y @ w_out


def token_mixer(h_lat, h_ctx, w_in, rpb, w_dec_f, b_dec_f, w_dec_b, b_dec_b, norm_w, w_br_a, w_br_b, w_out, need_ctx):
    b, t_len, _ = h_lat.shape
    rows = t_len // GRID_W
    splits = np.cumsum(PROJ_SIZES)[:-1].tolist()
    qa, ka, va, qb, kb, vb, gb, lrf, lrb, gate_a, gate_b = jnp.split(h_lat @ w_in, splits, axis=-1)
    qa_c, ka_c, va_c, qb_c, kb_c, vb_c, gb_c, lrf_c, lrb_c, gate_a_c, gate_b_c = jnp.split(h_ctx @ w_in, splits, axis=-1)

    na_scale = NA_HEAD_DIM ** -0.5

    def to_grid(t):
        return split_heads(t, NA_HEADS).reshape(b, NA_HEADS, rows, GRID_W, NA_HEAD_DIM)

    ka_ch, va_ch = split_heads(ka_c, NA_HEADS), split_heads(va_c, NA_HEADS)
    out_a = neighbourhood_attention(to_grid(qa) * na_scale, to_grid(ka), to_grid(va), ka_ch, va_ch, rpb)

    pos = jnp.arange(t_len)
    row_pos = (pos // GRID_W).astype(jnp.float32)
    col_pos = (pos % GRID_W).astype(jnp.float32)
    gla_scale = GLA_DK ** -0.5
    qb_l = rope_2d(split_heads(qb, GLA_HEADS), row_pos, col_pos) * gla_scale
    kb_l = rope_2d(split_heads(kb, GLA_HEADS), row_pos, col_pos)
    vb_l = split_heads(vb, GLA_HEADS)
    lgf_l = gla_log_decay(lrf, w_dec_f, b_dec_f)
    lgb_l = gla_log_decay(lrb, w_dec_b, b_dec_b)
    kb_ch, vb_ch = split_heads(kb_c, GLA_HEADS), split_heads(vb_c, GLA_HEADS)
    lgf_c = gla_log_decay(lrf_c, w_dec_f, b_dec_f)
    lgb_c = gla_log_decay(lrb_c, w_dec_b, b_dec_b)

    def flip(t):
        return jnp.flip(t, axis=2)

    if need_ctx:
        qb_ch = split_heads(qb_c, GLA_HEADS) * gla_scale
        s0 = jnp.zeros((b, GLA_HEADS, GLA_DK, GLA_DV), jnp.float32)
        o_cf, s_f = gla_chunked(qb_ch, kb_ch, vb_ch, lgf_c, s0)
        o_cb, s_b = gla_chunked(flip(qb_ch), flip(kb_ch), flip(vb_ch), flip(lgb_c), s0)
    else:
        s_f = gla_final_state(kb_ch, vb_ch, lgf_c)
        s_b = gla_final_state(flip(kb_ch), flip(vb_ch), flip(lgb_c))
    o_lf, _ = gla_chunked(qb_l, kb_l, vb_l, lgf_l, s_f)
    o_lb, _ = gla_chunked(flip(qb_l), flip(kb_l), flip(vb_l), flip(lgb_l), s_b)
    out_b = gla_readout(o_lf, flip(o_lb), gb, norm_w)

    y_lat = branch_merge(out_a, out_b, gate_a, gate_b, w_br_a, w_br_b, w_out)
    if not need_ctx:
        return y_lat, None
    out_a_c = context_attention(split_heads(qa_c, NA_HEADS) * na_scale, ka_ch, va_ch)
    out_b_c = gla_readout(o_cf, flip(o_cb), gb_c, norm_w)
    y_ctx = branch_merge(out_a_c, out_b_c, gate_a_c, gate_b_c, w_br_a, w_br_b, w_out)
    return y_lat, y_ctx


def moe_ffn(h, router_w, router_bias, w_gate, w_up, w_down, sh_gate, sh_up, sh_down):
    n, d = h.shape
    n_exp = w_gate.shape[0]
    scores = jax.nn.sigmoid(h.astype(jnp.float32) @ router_w.astype(jnp.float32))
    biased = scores + router_bias.astype(jnp.float32)
    group_score = lax.top_k(biased.reshape(n, N_GROUPS, n_exp // N_GROUPS), 2)[0].sum(-1)
    _, top_groups = lax.top_k(group_score, TOPK_GROUPS)
    group_keep = jnp.any(top_groups[:, :, None] == jnp.arange(N_GROUPS)[None, None, :], axis=1)
    masked = jnp.where(jnp.repeat(group_keep, n_exp // N_GROUPS, axis=1), biased, -jnp.inf)
    _, top_e = lax.top_k(masked, TOP_K)
    top_s = jnp.take_along_axis(scores, top_e, axis=1)
    top_w = (top_s / top_s.sum(-1, keepdims=True) * ROUTED_SCALE).astype(h.dtype)

    nk = n * TOP_K
    n_blocks = -(-nk // MOE_BLOCK) + n_exp
    e_flat = top_e.reshape(-1)
    order = jnp.argsort(e_flat)
    e_sorted = e_flat[order]
    tok_sorted = (order // TOP_K).astype(jnp.int32)
    w_sorted = top_w.reshape(-1)[order]
    counts = jnp.bincount(e_flat, length=n_exp)
    padded = (counts + MOE_BLOCK - 1) // MOE_BLOCK * MOE_BLOCK
    start = jnp.cumsum(counts) - counts
    pad_end = jnp.cumsum(padded)
    pad_start = pad_end - padded
    dest = pad_start[e_sorted] + jnp.arange(nk) - start[e_sorted]
    slot_tok = jnp.full((n_blocks * MOE_BLOCK,), n, jnp.int32).at[dest].set(tok_sorted)
    slot_w = jnp.zeros((n_blocks * MOE_BLOCK,), h.dtype).at[dest].set(w_sorted)
    block_exp = jnp.clip(jnp.searchsorted(pad_end, jnp.arange(n_blocks) * MOE_BLOCK, side='right'), 0, n_exp - 1)
    h_pad = jnp.concatenate([h, jnp.zeros((1, d), h.dtype)], axis=0)

    def block_step(acc, blk):
        idx, wts, e = blk
        y = swiglu(h_pad[idx], w_gate[e], w_up[e], w_down[e]) * wts[:, None]
        return acc.at[idx].add(y), None

    routed, _ = lax.scan(block_step, jnp.zeros((n + 1, d), h.dtype),
                         (slot_tok.reshape(n_blocks, MOE_BLOCK), slot_w.reshape(n_blocks, MOE_BLOCK), block_exp))
    return swiglu(h, sh_gate, sh_up, sh_down) + routed[:n]


def setup_inputs(seed: int = 0) -> dict:
    key = jax.random.key(seed)
    ks = jax.random.split(key, 28)

    def nrm(k, shape, scale):
        return jax.random.normal(k, shape, jnp.float32) * scale

    L, D = DEPTH, D_MODEL
    return {
        'x': nrm(ks[0], (BATCH, SEQ, D), 1.0),
        'c': nrm(ks[1], (BATCH, D), 1.0),
        'ctx': nrm(ks[2], (BATCH, CTX_LEN, D), 1.0),
        'c_ctx': nrm(ks[3], (D,), 1.0),
        'w_mod': nrm(ks[4], (L, D, 6 * D), D ** -0.5),
        'b_mod': nrm(ks[5], (L, 6 * D), 0.02),
        'w_in': nrm(ks[6], (L, D, PROJ_WIDTH), D ** -0.5),
        'na_rpb': nrm(ks[7], (L, NA_HEADS, 2 * WIN_ROWS - 1, 2 * WIN_COLS - 1), 0.1),
        'gla_w_decay_f': nrm(ks[8], (L, GLA_GATE_RANK, GLA_QK_WIDTH), GLA_GATE_RANK ** -0.5),
        'gla_b_decay_f': nrm(ks[9], (L, GLA_QK_WIDTH), 0.1),
        'gla_w_decay_b': nrm(ks[10], (L, GLA_GATE_RANK, GLA_QK_WIDTH), GLA_GATE_RANK ** -0.5),
        'gla_b_decay_b': nrm(ks[11], (L, GLA_QK_WIDTH), 0.1),
        'gla_norm_w': 1.0 + nrm(ks[12], (L, GLA_V_WIDTH), 0.02),
        'w_branch_a': nrm(ks[13], (L, NA_WIDTH, D), NA_WIDTH ** -0.5 * DEEPNORM_BETA),
        'w_branch_b': nrm(ks[14], (L, GLA_V_WIDTH, D), GLA_V_WIDTH ** -0.5 * DEEPNORM_BETA),
        'w_out': nrm(ks[15], (L, D, D), D ** -0.5 * DEEPNORM_BETA),
        'ln1_g': 1.0 + nrm(ks[16], (L, D), 0.02),
        'ln1_b': nrm(ks[17], (L, D), 0.02),
        'router_w': nrm(ks[18], (L, D, N_EXPERTS), D ** -0.5),
        'router_bias': nrm(ks[19], (L, N_EXPERTS), 0.01),
        'exp_w_gate': nrm(ks[20], (L, N_EXPERTS, D, EXPERT_FF), D ** -0.5),
        'exp_w_up': nrm(ks[21], (L, N_EXPERTS, D, EXPERT_FF), D ** -0.5),
        'exp_w_down': nrm(ks[22], (L, N_EXPERTS, EXPERT_FF, D), EXPERT_FF ** -0.5 * DEEPNORM_BETA),
        'sh_w_gate': nrm(ks[23], (L, D, SHARED_FF), D ** -0.5),
        'sh_w_up': nrm(ks[24], (L, D, SHARED_FF), D ** -0.5),
        'sh_w_down': nrm(ks[25], (L, SHARED_FF, D), SHARED_FF ** -0.5 * DEEPNORM_BETA),
        'ln2_g': 1.0 + nrm(ks[26], (L, D), 0.02),
        'ln2_b': nrm(ks[27], (L, D), 0.02),
    }


def reference(x, c, ctx, c_ctx, w_mod, b_mod, w_in, na_rpb, gla_w_decay_f, gla_b_decay_f, gla_w_decay_b, gla_b_decay_b,
              gla_norm_w, w_branch_a, w_branch_b, w_out, ln1_g, ln1_b, router_w, router_bias, exp_w_gate, exp_w_up,
              exp_w_down, sh_w_gate, sh_w_up, sh_w_down, ln2_g, ln2_b):
    b, t_len, d = x.shape
    ctx_len = ctx.shape[1]
    for layer in range(DEPTH):
        need_ctx = layer < DEPTH - 1
        mod = jax.nn.silu(c) @ w_mod[layer] + b_mod[layer]
        mod_c = jax.nn.silu(c_ctx) @ w_mod[layer] + b_mod[layer]
        sh1, sc1, g1, sh2, sc2, g2 = [m[:, None, :] for m in jnp.split(mod, 6, axis=-1)]
        sh1c, sc1c, g1c, sh2c, sc2c, g2c = jnp.split(mod_c, 6)

        y_lat, y_ctx = token_mixer(x * (1.0 + sc1) + sh1, ctx * (1.0 + sc1c) + sh1c, w_in[layer], na_rpb[layer],
                                   gla_w_decay_f[layer], gla_b_decay_f[layer], gla_w_decay_b[layer], gla_b_decay_b[layer],
                                   gla_norm_w[layer], w_branch_a[layer], w_branch_b[layer], w_out[layer], need_ctx)
        x = layer_norm(DEEPNORM_ALPHA * x + g1 * y_lat, ln1_g[layer], ln1_b[layer])
        h2 = x * (1.0 + sc2) + sh2
        moe_args = (router_w[layer], router_bias[layer], exp_w_gate[layer], exp_w_up[layer], exp_w_down[layer],
                    sh_w_gate[layer], sh_w_up[layer], sh_w_down[layer])
        if need_ctx:
            ctx = layer_norm(DEEPNORM_ALPHA * ctx + g1c * y_ctx, ln1_g[layer], ln1_b[layer])
            h2c = ctx * (1.0 + sc2c) + sh2c
            f = moe_ffn(jnp.concatenate([h2c.reshape(-1, d), h2.reshape(-1, d)], axis=0), *moe_args)
            f_ctx = f[:b * ctx_len].reshape(b, ctx_len, d)
            f_lat = f[b * ctx_len:].reshape(b, t_len, d)
            ctx = layer_norm(DEEPNORM_ALPHA * ctx + g2c * f_ctx, ln2_g[layer], ln2_b[layer])
        else:
            f_lat = moe_ffn(h2.reshape(-1, d), *moe_args).reshape(b, t_len, d)
        x = layer_norm(DEEPNORM_ALPHA * x + g2 * f_lat, ln2_g[layer], ln2_b[layer])
    return x
```

```cpp
#include <hip/hip_runtime.h>
#include <stdint.h>
#include <stdio.h>

#ifndef MK_PER_PHASE
#define MK_PER_PHASE 0
#endif

namespace {
typedef unsigned short bf16_t;
typedef short bf16x8 __attribute__((ext_vector_type(8)));
typedef float f32x4 __attribute__((ext_vector_type(4)));
typedef unsigned u32x4 __attribute__((ext_vector_type(4)));
typedef unsigned u32x2 __attribute__((ext_vector_type(2)));
#define LAS __attribute__((address_space(3)))
#define DEVI __device__ __forceinline__

constexpr int NTOK = 32768, NROW = 34816, NPH = 16;
constexpr size_t MiB = 1ull << 20;
constexpr int LDS_TOTAL = 160 * 1024;
constexpr int LDS_BARW = LDS_TOTAL - 16;
constexpr int LDS_TAB = 131072;

constexpr size_t WS_CTL = 0, WS_CNT = 16384, WS_MOD = 1 * MiB, WS_EE = 2 * MiB, WS_TOPK_ID = 5 * MiB, WS_TOPK_W = 6 * MiB, WS_TOPK_POS = 7 * MiB, WS_SLOT = 8 * MiB;
constexpr size_t WS_BT_IN = 10 * MiB, WS_BT_BR = 24 * MiB  , WS_BT_OUT = 27 * MiB, WS_BT_RT = 29 * MiB, WS_BT_SHGU = 30 * MiB, WS_BT_SHD = 31 * MiB;
constexpr size_t WS_H = 32 * MiB, WS_QA = 100 * MiB, WS_KA = 132 * MiB, WS_QB = 166 * MiB, WS_KB = 198 * MiB, WS_GB = 232 * MiB, WS_SGA = 296 * MiB, WS_SGB = 360 * MiB;
constexpr size_t WS_VAT = 424 * MiB, WS_VBT = 458 * MiB, WS_QTF = 526 * MiB, WS_QTB = 558 * MiB, WS_KTF = 590 * MiB, WS_KTB = 624 * MiB, WS_KTTF = 658 * MiB, WS_KTTB = 692 * MiB;
constexpr size_t WS_OF = 726 * MiB, WS_OB = 790 * MiB, WS_AP = 896 * MiB, WS_LRT = 888 * MiB;
constexpr size_t WS_YM = 424 * MiB, WS_Z = 488 * MiB;
constexpr size_t WS_X1 = 32 * MiB, WS_H2 = 160 * MiB, WS_LOG0 = 224 * MiB, WS_LOG1 = 256 * MiB, WS_EXPD = 288 * MiB, WS_EXPGU = 416 * MiB, WS_HID = 672 * MiB;
constexpr size_t WS_Y8 = 945 * MiB, WS_END = 1009 * MiB;
DEVI size_t ws_y(int k) { return (k < 2 ? 160 + 64 * (size_t)k : (k < 6 ? 416 + 64 * (size_t)(k - 2) : 817 + 64 * (size_t)(k - 6))) * MiB; }

struct Params { const float* in[28]; float* out; unsigned char* ws; int ph_lo, ph_hi; };

typedef __bf16 bf16x2_t __attribute__((ext_vector_type(2)));
typedef float f32x2_t __attribute__((ext_vector_type(2)));
DEVI unsigned pk_bf16(float lo, float hi) { const f32x2_t v = {lo, hi}; const bf16x2_t r = __builtin_convertvector(v, bf16x2_t); return __builtin_bit_cast(unsigned, r); }
DEVI float bf2f(bf16_t b) { return __uint_as_float(((unsigned)b) << 16); }
DEVI float bflo(unsigned w) { return __uint_as_float(w << 16); }
DEVI float bfhi(unsigned w) { return __uint_as_float(w & 0xffff0000u); }
DEVI bf16_t f2bf(float f) { return (bf16_t)(pk_bf16(f, 0.f) & 0xffffu); }
DEVI float sigmoidf_(float x) { return __builtin_amdgcn_rcpf(1.0f + __expf(-x)); }
template <int N> struct IC { static constexpr int v = N; };
DEVI void lds_barrier() { asm volatile("s_waitcnt lgkmcnt(0)" ::: "memory"); __builtin_amdgcn_s_barrier(); asm volatile("" ::: "memory"); }
DEVI float wave_sum(float v) { v += __shfl_xor(v, 32); v += __shfl_xor(v, 16); v += __shfl_xor(v, 8); v += __shfl_xor(v, 4); v += __shfl_xor(v, 2); v += __shfl_xor(v, 1); return v; }

#define XB_TMO      128
#define XB_XCNT(j)  (256  + 64 * (j))
#define XB_XSUB(j)  (1280 + 64 * (j))
#define XB_XGEN(j)  (2304 + 64 * (j))
#define XB_TOP      3328
#define XB_TOPGEN   3392
#define XCD_BAR_WORDS 3456
#define XB_SPIN_CAP (1u << 22)
DEVI unsigned xb_ld(unsigned* p)              { return __hip_atomic_load(p, __ATOMIC_RELAXED, __HIP_MEMORY_SCOPE_AGENT); }
DEVI unsigned xb_add(unsigned* p, unsigned v) { return __hip_atomic_fetch_add(p, v, __ATOMIC_RELAXED, __HIP_MEMORY_SCOPE_AGENT); }
DEVI unsigned xb_xcc_id() { return (unsigned)__builtin_amdgcn_s_getreg((3 << 11) | 20) & 0xFu; }
#define XB_SPIN(cond, bar) do { unsigned _sp = 0; while (cond) { __builtin_amdgcn_s_sleep(1); \
    if ((++_sp & 255u) == 0u) { if (xb_ld(&(bar)[XB_TMO])) break; if (_sp > XB_SPIN_CAP) { atomicAdd(&(bar)[XB_TMO], 1u); break; } } } } while (0)
struct XcdBarrier { unsigned* bar; unsigned x; volatile LAS unsigned* st; };
DEVI XcdBarrier xcd_barrier_post(unsigned* bar, volatile LAS unsigned* st) {
    XcdBarrier b; b.bar = bar; b.x = xb_xcc_id(); b.st = st;
    if (threadIdx.x == 0) (void)xb_add(&bar[XB_XCNT(b.x)], 1u);
    return b;
}
DEVI void xcd_barrier_complete(unsigned* bar, unsigned x, unsigned& nloc, unsigned& nx) {
    const unsigned G = gridDim.x * gridDim.y * gridDim.z;
    unsigned sum, cnt, mine, sp = 0u;
    for (;;) {
        sum = 0u; cnt = 0u; mine = 0u;
#pragma unroll
        for (unsigned j = 0; j < 16; ++j) { const unsigned c = xb_ld(&bar[XB_XCNT(j)]); sum += c; cnt += (c > 0u) ? 1u : 0u; mine = (j == x) ? c : mine; }
        if (sum == G) break;
        __builtin_amdgcn_s_sleep(1);
        if ((++sp & 255u) == 0u) { if (xb_ld(&bar[XB_TMO])) break; if (sp > XB_SPIN_CAP) { atomicAdd(&bar[XB_TMO], 1u); break; } }
    }
    nloc = mine > 0u ? mine : 1u; nx = cnt > 0u ? cnt : 1u;
}
DEVI void xcd_barrier(const XcdBarrier& b) {
    asm volatile("s_waitcnt vmcnt(0)" ::: "memory");
    __syncthreads();
    if (threadIdx.x == 0) {
        unsigned* bar = b.bar;
        __builtin_amdgcn_s_waitcnt(0);
        unsigned nloc = b.st[0], nx = b.st[1];
        if (nloc == 0u) { xcd_barrier_complete(bar, b.x, nloc, nx); b.st[0] = nloc; b.st[1] = nx; }
        const unsigned old = xb_add(&bar[XB_XSUB(b.x)], 1u);
        const unsigned gen = old / nloc;
        if (old + 1u == (gen + 1u) * nloc) {
            __builtin_amdgcn_fence(__ATOMIC_RELEASE, "agent");
            asm volatile("s_waitcnt vmcnt(0)" ::: "memory");
            const unsigned og = xb_add(&bar[XB_TOP], 1u);
            const unsigned tg = og / nx;
            if (og + 1u == (tg + 1u) * nx) xb_add(&bar[XB_TOPGEN], 1u);
            else XB_SPIN(xb_ld(&bar[XB_TOPGEN]) == tg, bar);
            __builtin_amdgcn_fence(__ATOMIC_ACQUIRE, "agent");
            xb_add(&bar[XB_XGEN(b.x)], 1u);
            asm volatile("s_waitcnt vmcnt(0)" ::: "memory");
        } else {
            XB_SPIN(xb_ld(&bar[XB_XGEN(b.x)]) == gen, bar);
            __builtin_amdgcn_fence(__ATOMIC_ACQUIRE, "agent");
            asm volatile("s_waitcnt vmcnt(0)" ::: "memory");
        }
    }
    __syncthreads();
}

constexpr int BK = 64, HALF = 128, HTB = HALF * BK * 2;
DEVI int lds_byte(int r, int c) { const int st = (r >> 4) * 2 + (c >> 5), rr = r & 15, cc = c & 31, ob = rr * 64 + cc * 2; return st * 1024 + (ob ^ (((ob >> 9) & 1) << 5)); }
DEVI void stage_rc(int b, int& R, int& C) { const int st = b / 1024, sb = b % 1024, swz = sb ^ (((sb >> 9) & 1) << 5); R = (st >> 1) * 16 + swz / 64; C = (st & 1) * 32 + (swz % 64) / 2; }
DEVI int perm32(int rho) { const int n = rho >> 4, i = rho & 15; return 8 * (i >> 2) + 4 * n + (i & 3); }

struct GUnit {
    const char* a; const char* b;
    char* dst; int ldd; int i0, i1, i2; float f0;
};
typedef f32x4 Acc[2][2][4][2];
#define ZA1(a, b, m) acc[a][b][m][0] = z; acc[a][b][m][1] = z;
#define ZA2(a, b) ZA1(a, b, 0) ZA1(a, b, 1) ZA1(a, b, 2) ZA1(a, b, 3)
DEVI void zero_acc(Acc& acc) { f32x4 z = {0.f, 0.f, 0.f, 0.f}; asm volatile("" : "+v"(z)); ZA2(0, 0) ZA2(0, 1) ZA2(1, 0) ZA2(1, 1) }

template <class Sched, class Epi, bool GATHER>
DEVI void gemm_stream(LAS unsigned char* lds, const Sched& S, const Epi& E) {
    const int tid = threadIdx.x, wid = __builtin_amdgcn_readfirstlane(tid >> 6), lane = tid & 63, wr = wid >> 2, wc = wid & 3, fr = lane & 15, fq = lane >> 4;
    const unsigned lda = S.lda, ldb = S.ldb; const int nt = S.nt;
    unsigned voffA[2], voffB[2]; int R0 = 0;
#pragma unroll
    for (int i = 0; i < 2; ++i) { int R, C; stage_rc(tid * 16 + i * 8192, R, C); const int Rb = (R & ~31) + perm32(R & 31);
        if (i == 0) R0 = R;
        voffA[i] = GATHER ? (unsigned)(C * 2) : (unsigned)R * lda + (unsigned)(C * 2); voffB[i] = (unsigned)Rb * ldb + (unsigned)(C * 2); }
    const size_t kstep = (size_t)(BK * 2);
    const size_t hstepA = GATHER ? (size_t)0 : (size_t)HALF * lda, hstepB = (size_t)HALF * ldb;
    const unsigned ldsw = (unsigned)wid * 1024u;
    const int aoff = lds_byte(wr * 64 + fr, fq * 8), boff = lds_byte(wc * 32 + fr, fq * 8);
#define G_SA(b, h) (((b) * 2 + (h)) * HTB)
#define G_SB(b, h) ((4 + (b) * 2 + (h)) * HTB)
#define G_STAGE(bufoff, gbase, o0, o1) do { \
        __builtin_amdgcn_global_load_lds((const unsigned*)((const char*)(gbase) + (o0)), (LAS unsigned*)(lds + (bufoff) + ldsw), 16, 0, 0); \
        __builtin_amdgcn_global_load_lds((const unsigned*)((const char*)(gbase) + (o1)), (LAS unsigned*)(lds + (bufoff) + ldsw + 8192), 16, 0, 0); } while (0)
#define G_LDA(dst, b, h) do { _Pragma("unroll") for (int m = 0; m < 4; ++m) _Pragma("unroll") for (int k = 0; k < 2; ++k) dst[m][k] = *(const LAS bf16x8*)(lds + G_SA(b, h) + aoff + m * 2048 + k * 1024); } while (0)
#define G_LDB(dst, b, h) do { _Pragma("unroll") for (int n = 0; n < 2; ++n) _Pragma("unroll") for (int k = 0; k < 2; ++k) dst[n][k] = *(const LAS bf16x8*)(lds + G_SB(b, h) + boff + n * 2048 + k * 1024); } while (0)
#define G_MMA(ai, bj, At, Bt) do { __builtin_amdgcn_s_setprio(1); _Pragma("unroll") for (int m = 0; m < 4; ++m) _Pragma("unroll") for (int n = 0; n < 2; ++n) _Pragma("unroll") for (int k = 0; k < 2; ++k) \
        acc[ai][bj][m][n] = __builtin_amdgcn_mfma_f32_16x16x32_bf16(Bt[n][k], At[m][k], acc[ai][bj][m][n], 0, 0, 0); __builtin_amdgcn_s_setprio(0); } while (0)
#define G_WAIT_V(n) asm volatile("s_waitcnt vmcnt(" #n ")" ::: "memory")
#define G_WAIT_L(n) asm volatile("s_waitcnt lgkmcnt(" #n ")" ::: "memory")
#define G_BAR __builtin_amdgcn_s_barrier()
#define G_SCHED __builtin_amdgcn_sched_barrier(0)
    GUnit cur, nxt; int ui = 0;
    if (!S.next(0, cur)) return;
    unsigned gc[2][2], gn[2][2];
    gc[0][0] = voffA[0]; gc[0][1] = voffA[1]; gc[1][0] = voffA[0]; gc[1][1] = voffA[1];
    gn[0][0] = voffA[0]; gn[0][1] = voffA[1]; gn[1][0] = voffA[0]; gn[1][1] = voffA[1];
    if constexpr (GATHER) { S.gather(cur, R0, gc); gc[0][0] += voffA[0]; gc[0][1] += voffA[0]; gc[1][0] += voffA[0]; gc[1][1] += voffA[0]; }
    Acc acc; zero_acc(acc);
    typename Epi::Pre pre; E.pre(cur, wr, lane, pre);
    bf16x8 At[4][2], B0[2][2], B1[2][2];
    const char* cA = cur.a; const char* cB = cur.b;
    G_STAGE(G_SB(0, 0), cB, voffB[0], voffB[1]); G_STAGE(G_SA(0, 0), cA, gc[0][0], gc[0][1]); G_STAGE(G_SB(0, 1), cB + hstepB, voffB[0], voffB[1]); G_STAGE(G_SA(0, 1), cA + hstepA, gc[1][0], gc[1][1]);
    if (wr == 1) G_BAR;
    G_WAIT_V(4); G_BAR;
    G_STAGE(G_SB(1, 0), cB + kstep, voffB[0], voffB[1]); G_STAGE(G_SA(1, 0), cA + kstep, gc[0][0], gc[0][1]); G_STAGE(G_SB(1, 1), cB + hstepB + kstep, voffB[0], voffB[1]);
    G_WAIT_V(6); G_BAR;
    for (;;) {
        const bool has_next = S.next(ui + 1, nxt);
        const char* nA = has_next ? nxt.a : cA; const char* nB = has_next ? nxt.b : cB;
        for (int t = 0; t < nt; t += 2) {
            const bool last = (t == nt - 2);
            const char* a1 = cA + (size_t)(t + 1) * kstep;
            const char* a2 = last ? nA : cA + (size_t)(t + 2) * kstep; const char* b2 = last ? nB : cB + (size_t)(t + 2) * kstep;
            const char* a3 = a2 + kstep; const char* b3 = b2 + kstep;
            unsigned g2[2][2];
            if constexpr (GATHER) { g2[0][0] = last ? gn[0][0] : gc[0][0]; g2[0][1] = last ? gn[0][1] : gc[0][1]; g2[1][0] = last ? gn[1][0] : gc[1][0]; g2[1][1] = last ? gn[1][1] : gc[1][1]; }
            else { g2[0][0] = voffA[0]; g2[0][1] = voffA[1]; g2[1][0] = voffA[0]; g2[1][1] = voffA[1]; }
            if constexpr (GATHER) { if (t == nt - 4) {
                if (has_next) { S.gather(nxt, R0, gn); gn[0][0] += voffA[0]; gn[0][1] += voffA[0]; gn[1][0] += voffA[0]; gn[1][1] += voffA[0]; }
                else { gn[0][0] = gc[0][0]; gn[0][1] = gc[0][1]; gn[1][0] = gc[1][0]; gn[1][1] = gc[1][1]; } } }
            if constexpr (Epi::MID_T > 0) { if (t == Epi::MID_T) { int tz = threadIdx.x; asm volatile("" : "+v"(tz)); const int wz = tz >> 6, lz = tz & 63; E.mid(acc, cur, wz >> 2, wz & 3, lz & 15, lz >> 4); } }
            G_LDB(B0, 0, 0); G_SCHED; G_LDA(At, 0, 0); G_STAGE(G_SA(1, 1), a1 + hstepA, gc[1][0], gc[1][1]);
            G_WAIT_L(8); G_BAR; G_WAIT_L(0); G_MMA(0, 0, At, B0); G_BAR; G_SCHED;
            G_LDB(B1, 0, 1); G_STAGE(G_SB(0, 0), b2, voffB[0], voffB[1]);
            G_BAR; G_WAIT_L(0); G_MMA(0, 1, At, B1); G_BAR;
            G_LDA(At, 0, 1); G_STAGE(G_SA(0, 0), a2, g2[0][0], g2[0][1]);
            G_BAR; G_WAIT_L(0); G_MMA(1, 0, At, B0); G_BAR; G_SCHED;
            G_STAGE(G_SB(0, 1), b2 + hstepB, voffB[0], voffB[1]);
            G_WAIT_V(6); G_BAR; G_MMA(1, 1, At, B1); G_BAR;
            G_LDB(B0, 1, 0); G_SCHED; G_LDA(At, 1, 0); G_STAGE(G_SA(0, 1), a2 + hstepA, g2[1][0], g2[1][1]);
            G_WAIT_L(8); G_BAR; G_WAIT_L(0); G_MMA(0, 0, At, B0); G_BAR; G_SCHED;
            G_LDB(B1, 1, 1); G_STAGE(G_SB(1, 0), b3, voffB[0], voffB[1]);
            G_BAR; G_WAIT_L(0); G_MMA(0, 1, At, B1); G_BAR;
            G_LDA(At, 1, 1); G_STAGE(G_SA(1, 0), a3, g2[0][0], g2[0][1]);
            G_BAR; G_WAIT_L(0); G_MMA(1, 0, At, B0); G_BAR; G_SCHED;
            G_STAGE(G_SB(1, 1), b3 + hstepB, voffB[0], voffB[1]);
            G_WAIT_V(6); G_BAR; G_MMA(1, 1, At, B1); G_BAR;
        }
        { int tz = threadIdx.x; asm volatile("" : "+v"(tz)); const int wz = tz >> 6, lz = tz & 63; E(acc, cur, wz >> 2, wz & 3, lz & 15, lz >> 4, pre); }
        if (!has_next) break;
        zero_acc(acc);
        cur = nxt; cA = nA; cB = nB; ++ui;
        E.pre(cur, wr, lane, pre);
        if constexpr (GATHER) { gc[0][0] = gn[0][0]; gc[0][1] = gn[0][1]; gc[1][0] = gn[1][0]; gc[1][1] = gn[1][1]; }
    }
    G_WAIT_V(0);
    if (wr == 0) G_BAR;
    G_BAR;
}

struct EpiBf16 { static constexpr int MID_T = 0; DEVI void mid(Acc&, const GUnit&, int, int, int, int) const {}
    struct Pre {}; DEVI void pre(const GUnit&, int, int, Pre&) const {}
    DEVI void operator()(const Acc& acc, const GUnit& u, int wr, int wc, int fr, int fq, const Pre&) const {
        if (u.f0 < 0.f) {
            float* fb = (float*)u.dst;
#pragma unroll
            for (int m = 0; m < 4; ++m) { const int row = wr * 64 + m * 16 + fr;
                if (row < 32) { float* rp = fb + (size_t)row * u.ldd + wc * 32 + 8 * fq;
#pragma unroll
                    for (int bj = 0; bj < 2; ++bj) { *(f32x4*)(rp + bj * 128) = acc[0][bj][m][0]; *(f32x4*)(rp + bj * 128 + 4) = acc[0][bj][m][1]; } } }
            return;
        }
        bf16_t* base = (bf16_t*)u.dst; const float s = u.f0; const int act = u.i0;
#pragma unroll
        for (int ai = 0; ai < 2; ++ai)
#pragma unroll
            for (int m = 0; m < 4; ++m) {
                bf16_t* rp = base + (size_t)(ai * 128 + wr * 64 + m * 16 + fr) * u.ldd + wc * 32 + 8 * fq;
#pragma unroll
                for (int bj = 0; bj < 2; ++bj) {
                    f32x4 v0 = acc[ai][bj][m][0] * s, v1 = acc[ai][bj][m][1] * s;
                    if (act) {
#pragma unroll
                        for (int j = 0; j < 4; ++j) { v0[j] = sigmoidf_(v0[j]); v1[j] = sigmoidf_(v1[j]); }
                    }
                    u32x4 w; w.x = pk_bf16(v0[0], v0[1]); w.y = pk_bf16(v0[2], v0[3]); w.z = pk_bf16(v1[0], v1[1]); w.w = pk_bf16(v1[2], v1[3]);
                    *(u32x4*)(rp + bj * 128) = w;
                }
            }
    }
};
struct EpiF32 { static constexpr int MID_T = 0; DEVI void mid(Acc&, const GUnit&, int, int, int, int) const {}
    struct Pre {}; DEVI void pre(const GUnit&, int, int, Pre&) const {}
    DEVI void operator()(const Acc& acc, const GUnit& u, int wr, int wc, int fr, int fq, const Pre&) const {
        float* base = (float*)u.dst;
#pragma unroll
        for (int ai = 0; ai < 2; ++ai)
#pragma unroll
            for (int m = 0; m < 4; ++m) {
                float* rp = base + (size_t)(ai * 128 + wr * 64 + m * 16 + fr) * u.ldd + wc * 32 + 8 * fq;
#pragma unroll
                for (int bj = 0; bj < 2; ++bj) { *(f32x4*)(rp + bj * 128) = acc[ai][bj][m][0]; *(f32x4*)(rp + bj * 128 + 4) = acc[ai][bj][m][1]; }
            }
    }
};
struct EpiBranchC {
    static constexpr int MID_T = 8;
    const bf16_t* sga; const bf16_t* sgb; bf16_t* ym;
    struct Pre {}; DEVI void pre(const GUnit&, int, int, Pre&) const {}
    DEVI void mid(Acc& acc, const GUnit& u, int wr, int wc, int fr, int fq) const {
#pragma unroll
        for (int ai = 0; ai < 2; ++ai)
#pragma unroll
            for (int m = 0; m < 4; ++m) {
                const size_t ro = (size_t)(u.i1 + ai * 128 + wr * 64 + m * 16 + fr) * 1024 + u.i2 + wc * 32 + 8 * fq;
#pragma unroll
                for (int bj = 0; bj < 2; ++bj) {
                    const u32x4 ga = *(const u32x4*)(sga + ro + bj * 128), gb = *(const u32x4*)(sgb + ro + bj * 128);
                    f32x4 r0, r1;
                    r0[0] = bflo(ga.x) * __builtin_amdgcn_rcpf(bflo(gb.x)); r0[1] = bfhi(ga.x) * __builtin_amdgcn_rcpf(bfhi(gb.x)); r0[2] = bflo(ga.y) * __builtin_amdgcn_rcpf(bflo(gb.y)); r0[3] = bfhi(ga.y) * __builtin_amdgcn_rcpf(bfhi(gb.y));
                    r1[0] = bflo(ga.z) * __builtin_amdgcn_rcpf(bflo(gb.z)); r1[1] = bfhi(ga.z) * __builtin_amdgcn_rcpf(bfhi(gb.z)); r1[2] = bflo(ga.w) * __builtin_amdgcn_rcpf(bflo(gb.w)); r1[3] = bfhi(ga.w) * __builtin_amdgcn_rcpf(bfhi(gb.w));
                    acc[ai][bj][m][0] = acc[ai][bj][m][0] * r0; acc[ai][bj][m][1] = acc[ai][bj][m][1] * r1;
                }
            }
    }
    DEVI void operator()(const Acc& acc, const GUnit& u, int wr, int wc, int fr, int fq, const Pre&) const {
#pragma unroll
        for (int ai = 0; ai < 2; ++ai)
#pragma unroll
            for (int m = 0; m < 4; ++m) {
                const size_t ro = (size_t)(u.i1 + ai * 128 + wr * 64 + m * 16 + fr) * 1024 + u.i2 + wc * 32 + 8 * fq;
#pragma unroll
                for (int bj = 0; bj < 2; ++bj) {
                    const u32x4 gb = *(const u32x4*)(sgb + ro + bj * 128);
                    const f32x4 v0 = acc[ai][bj][m][0], v1 = acc[ai][bj][m][1];
                    u32x4 w;
                    w.x = pk_bf16(bflo(gb.x) * v0[0], bfhi(gb.x) * v0[1]); w.y = pk_bf16(bflo(gb.y) * v0[2], bfhi(gb.y) * v0[3]);
                    w.z = pk_bf16(bflo(gb.z) * v1[0], bfhi(gb.z) * v1[1]); w.w = pk_bf16(bflo(gb.w) * v1[2], bfhi(gb.w) * v1[3]);
                    *(u32x4*)(ym + ro + bj * 128) = w;
                }
            }
    }
};
struct EpiGateUp { static constexpr int MID_T = 0; DEVI void mid(Acc&, const GUnit&, int, int, int, int) const {}
    bf16_t* hid;
    struct Pre {}; DEVI void pre(const GUnit&, int, int, Pre&) const {}
    DEVI void operator()(const Acc& acc, const GUnit& u, int wr, int wc, int fr, int fq, const Pre&) const {
#pragma unroll
        for (int ai = 0; ai < 2; ++ai)
#pragma unroll
            for (int m = 0; m < 4; ++m) {
                const int row = ai * 128 + wr * 64 + m * 16 + fr;
                if (row < u.i1) {
                    const f32x4 g0 = acc[ai][0][m][0], g1 = acc[ai][0][m][1], u0 = acc[ai][1][m][0], u1 = acc[ai][1][m][1];
                    float h[8];
#pragma unroll
                    for (int j = 0; j < 4; ++j) { h[j] = g0[j] * sigmoidf_(g0[j]) * u0[j]; h[4 + j] = g1[j] * sigmoidf_(g1[j]) * u1[j]; }
                    u32x4 w; w.x = pk_bf16(h[0], h[1]); w.y = pk_bf16(h[2], h[3]); w.z = pk_bf16(h[4], h[5]); w.w = pk_bf16(h[6], h[7]);
                    *(u32x4*)(hid + (size_t)(u.i0 + row) * 256 + u.i2 * 128 + wc * 32 + 8 * fq) = w;
                }
            }
    }
};
struct EpiDown { static constexpr int MID_T = 0; DEVI void mid(Acc&, const GUnit&, int, int, int, int) const {}
    unsigned char* ws; const u32x2* slot; const float* topw;
    struct Pre { unsigned r0, r1; };
    DEVI void pre(const GUnit& u, int wr, int lane, Pre& P) const {
        P.r0 = 0u; P.r1 = 0u;
        if (u.i2 == 0) { const int ra = wr * 64 + lane, rb = ra + 128; if (ra < u.i1) P.r0 = slot[u.i0 + ra].x; if (rb < u.i1) P.r1 = slot[u.i0 + rb].x; }
    }
    DEVI void operator()(const Acc& acc, const GUnit& u, int wr, int wc, int fr, int fq, const Pre& P) const {
#pragma unroll
        for (int ai = 0; ai < 2; ++ai)
#pragma unroll
            for (int m = 0; m < 4; ++m) {
                const int row = ai * 128 + wr * 64 + m * 16 + fr;
                const unsigned recx = (unsigned)__shfl((int)(ai ? P.r1 : P.r0), m * 16 + fr);
                if (row < u.i1) {
                    if (u.i2 == 0) {
                        const int tok = (int)(recx >> 3), k = (int)(recx & 7u); const float w = topw[recx];
                        bf16_t* rp = (bf16_t*)(ws + ws_y(k)) + (size_t)tok * 1024 + u.ldd + wc * 32 + 8 * fq;
#pragma unroll
                        for (int bj = 0; bj < 2; ++bj) {
                            const f32x4 v0 = acc[ai][bj][m][0] * w, v1 = acc[ai][bj][m][1] * w;
                            u32x4 o; o.x = pk_bf16(v0[0], v0[1]); o.y = pk_bf16(v0[2], v0[3]); o.z = pk_bf16(v1[0], v1[1]); o.w = pk_bf16(v1[2], v1[3]);
                            *(u32x4*)(rp + bj * 128) = o;
                        }
                    } else {
                        bf16_t* rp = (bf16_t*)(ws + WS_Y8) + (size_t)(u.i0 + row) * 1024 + u.ldd + wc * 32 + 8 * fq;
#pragma unroll
                        for (int bj = 0; bj < 2; ++bj) {
                            const f32x4 v0 = acc[ai][bj][m][0], v1 = acc[ai][bj][m][1];
                            u32x4 o; o.x = pk_bf16(v0[0], v0[1]); o.y = pk_bf16(v0[2], v0[3]); o.z = pk_bf16(v1[0], v1[1]); o.w = pk_bf16(v1[2], v1[3]);
                            *(u32x4*)(rp + bj * 128) = o;
                        }
                    }
                }
            }
    }
};

struct SchedInProj {
    unsigned char* ws; int G, c;
    static constexpr unsigned lda = 2048, ldb = 2048; static constexpr int nt = 16;
    DEVI bool next(int i, GUnit& u) const {
        const int L = i * G + c; if (L >= 3544) return false;
        u.i0 = 0; u.i1 = 0; u.i2 = 0; u.f0 = 1.0f;
        const char* H = (const char*)(ws + WS_H); const char* BT = (const char*)(ws + WS_BT_IN);
        int pm, pn;
        if (L < 2592) {
            if (L < 2560) { const int x = L & 7, q = L >> 3, blk = q >> 5, w = q & 31; pm = 16 * x + 8 * (blk & 1) + (w & 7); pn = 4 * (blk >> 1) + (w >> 3); }
            else { const int j = L - 2560, jn = j >> 3; pm = 128 + (j & 7); pn = jn < 2 ? 2 + jn : 4 + jn; }
            u.a = H + (size_t)pm * 256 * 2048; u.b = BT + (size_t)pn * 256 * 2048;
            size_t base; int ld, col;
            if (pn < 2)       { base = WS_QA; ld = 512; col = pn * 256; u.f0 = 0.125f; }
            else if (pn < 4)  { base = WS_KA; ld = 512; col = (pn - 2) * 256; }
            else if (pn < 6)  { base = WS_QB; ld = 512; col = (pn - 4) * 256; }
            else if (pn < 8)  { base = WS_KB; ld = 512; col = (pn - 6) * 256; }
            else if (pn < 12) { base = WS_GB; ld = 1024; col = (pn - 8) * 256; }
            else if (pn < 16) { base = WS_SGA; ld = 1024; col = (pn - 12) * 256; u.i0 = 1; }
            else              { base = WS_SGB; ld = 1024; col = (pn - 16) * 256; u.i0 = 1; }
            u.dst = (char*)(ws + base) + ((size_t)pm * 256 * ld + col) * 2; u.ldd = ld;
        } else {
            const int j = L - 2592, x = j & 7, q = j >> 3, tn = 17 * x + q / 7, wm = q % 7;
            u.a = BT + (size_t)(5120 + wm * 256) * 2048; u.b = H + (size_t)tn * 256 * 2048;
            u.dst = (wm < 2 ? (char*)(ws + WS_VAT) + ((size_t)(wm * 256) * NROW + tn * 256) * 2 : (wm < 6 ? (char*)(ws + WS_VBT) + ((size_t)((wm - 2) * 256) * NROW + tn * 256) * 2 : (char*)(ws + WS_LRT) + (size_t)(tn * 256) * 4));
            u.ldd = NROW; if (wm == 6) u.f0 = -1.0f;
        }
        return true;
    }
};
struct SchedDense {
    const char* A; const char* Bt; char* dst; int K; int G, c; unsigned lda, ldb; int nt;
    DEVI bool next(int i, GUnit& u) const {
        const int L = i * G + c; if (L >= 512) return false;
        const int x = L & 7, q = L >> 3, blk = q >> 5, w = q & 31, pm = 16 * x + 8 * blk + (w & 7), pn = w >> 3;
        u.a = A + (size_t)pm * 256 * K * 2; u.b = Bt + (size_t)pn * 256 * K * 2;
        u.dst = dst + ((size_t)pm * 256 * 1024 + pn * 256) * 2; u.ldd = 1024; u.i0 = 0; u.i1 = pm * 256; u.i2 = pn * 256; u.f0 = 1.0f;
        return true;
    }
};
struct SchedRouter {
    unsigned char* ws; int G, c;
    static constexpr unsigned lda = 2048, ldb = 2048; static constexpr int nt = 8;
    DEVI bool next(int i, GUnit& u) const {
        const int L = i * G + c; if (L >= 256) return false;
        const int x = L & 7, q = L >> 3, pm = 16 * x + (q >> 1), ks = q & 1;
        u.a = (const char*)(ws + WS_H2) + (size_t)pm * 256 * 2048 + ks * 1024; u.b = (const char*)(ws + WS_BT_RT) + ks * 1024;
        u.dst = (char*)(ws + (ks ? WS_LOG1 : WS_LOG0)) + (size_t)pm * 256 * 256 * 4; u.ldd = 256; u.i0 = 0; u.i1 = 0; u.i2 = 0; u.f0 = 1.0f;
        return true;
    }
};
DEVI void moe_tables(const unsigned* gcnt, LAS int* T) {
    if (threadIdx.x < 64) {
        const int l = threadIdx.x; int c[4], t[4];
#pragma unroll
        for (int k = 0; k < 4; ++k) { c[k] = (int)gcnt[4 * l + k]; t[k] = (c[k] + 255) >> 8; }
        const int sc = c[0] + c[1] + c[2] + c[3], st = t[0] + t[1] + t[2] + t[3];
        int ic = sc, it = st;
#pragma unroll
        for (int o = 1; o < 64; o <<= 1) { const int a = __shfl_up(ic, o), b = __shfl_up(it, o); if (l >= o) { ic += a; it += b; } }
        int bc = ic - sc, bt = it - st;
#pragma unroll
        for (int k = 0; k < 4; ++k) { T[4 * l + k] = c[k]; T[256 + 4 * l + k] = bc; T[513 + 4 * l + k] = bt; bc += c[k]; bt += t[k]; }
        if (l == 63) { T[256 + 256] = ic; T[513 + 256] = it; }
    }
    __syncthreads();
    {
        const int TRt = T[513 + 256];
        for (int t = threadIdx.x; t < TRt; t += 512) { int lo = 0, hi = 256; while (hi - lo > 1) { const int mid = (lo + hi) >> 1; if (T[513 + mid] <= t) lo = mid; else hi = mid; } T[770 + t] = lo; }
    }
    __syncthreads();
}
DEVI int moe_find(const LAS int* toff, int t) {
    int lo = 0, hi = 256;
#pragma unroll 1
    while (hi - lo > 1) { const int mid = (lo + hi) >> 1; if (toff[mid] <= t) lo = mid; else hi = mid; }
    return __builtin_amdgcn_readfirstlane(lo);
}
struct SchedGateUp {
    unsigned char* ws; const LAS int* T; int G, c;
    static constexpr unsigned lda = 2048, ldb = 2048; static constexpr int nt = 16;
    DEVI bool next(int i, GUnit& u) const {
        const int L = i * G + c; const int TR = __builtin_amdgcn_readfirstlane(T[513 + 256]);
        if (L >= 2 * TR + 256) return false;
        u.a = (const char*)(ws + WS_H2); u.dst = nullptr; u.ldd = 0; u.f0 = 1.0f;
        if (L < 2 * TR) {
            const int t = L >> 1, pn = L & 1, e = __builtin_amdgcn_readfirstlane(T[770 + t]), mt = t - __builtin_amdgcn_readfirstlane(T[513 + e]), cnt = __builtin_amdgcn_readfirstlane(T[e]);
            u.b = (const char*)(ws + WS_EXPGU) + ((size_t)e * 512 + pn * 256) * 2048;
            u.i0 = __builtin_amdgcn_readfirstlane(T[256 + e]) + mt * 256; u.i1 = min(256, cnt - mt * 256); u.i2 = pn;
        } else {
            const int j = L - 2 * TR, mt = j >> 1, pn = j & 1;
            u.b = (const char*)(ws + WS_BT_SHGU) + (size_t)(pn * 256) * 2048;
            u.i0 = 262144 + mt * 256; u.i1 = 256; u.i2 = pn;
        }
        return true;
    }
    DEVI void gather(const GUnit& u, int R0, unsigned (&g)[2][2]) const {
        const u32x2* slot = (const u32x2*)(ws + WS_SLOT);
#pragma unroll
        for (int h = 0; h < 2; ++h)
#pragma unroll
            for (int i = 0; i < 2; ++i) {
                const int s = u.i0 + h * 128 + R0 + 64 * i; int tok;
                if (u.i0 >= 262144) tok = s - 262144; else tok = (int)(slot[min(s, 262143)].x >> 3);
                g[h][i] = (unsigned)tok * 2048u;
            }
    }
};
struct SchedDown {
    unsigned char* ws; const LAS int* T; int G, c;
    static constexpr unsigned lda = 512, ldb = 512; static constexpr int nt = 4;
    DEVI bool next(int i, GUnit& u) const {
        const int L = i * G + c; const int TR = __builtin_amdgcn_readfirstlane(T[513 + 256]);
        if (L >= 4 * TR + 512) return false;
        u.dst = nullptr; u.f0 = 1.0f;
        if (L < 4 * TR) {
            const int t = L >> 2, pn = L & 3, e = __builtin_amdgcn_readfirstlane(T[770 + t]), mt = t - __builtin_amdgcn_readfirstlane(T[513 + e]), cnt = __builtin_amdgcn_readfirstlane(T[e]);
            const int s0 = __builtin_amdgcn_readfirstlane(T[256 + e]) + mt * 256;
            u.a = (const char*)(ws + WS_HID) + (size_t)s0 * 512; u.b = (const char*)(ws + WS_EXPD) + ((size_t)e * 1024 + pn * 256) * 512;
            u.i0 = s0; u.i1 = min(256, cnt - mt * 256); u.i2 = 0; u.ldd = pn * 256;
        } else {
            const int j = L - 4 * TR, mt = j >> 2, pn = j & 3;
            u.a = (const char*)(ws + WS_HID) + (size_t)(262144 + mt * 256) * 512; u.b = (const char*)(ws + WS_BT_SHD) + (size_t)(pn * 256) * 512;
            u.i0 = mt * 256; u.i1 = 256; u.i2 = 1; u.ldd = pn * 256;
        }
        return true;
    }
};

DEVI void conv_tile(const float* src, int ldsrc, int ncols, bf16_t* dst, int ldd, int k0, int row0, int ilv, LAS float* t) {
    const int tid = threadIdx.x;
    f32x4 v[8];
#pragma unroll
    for (int i = 0; i < 8; ++i) { const int f = tid + 512 * i, row = f >> 6, c4 = (f & 63) * 4;
        v[i] = (c4 < ncols) ? *(const f32x4*)(src + (size_t)(k0 + row) * ldsrc + c4) : (f32x4){0.f, 0.f, 0.f, 0.f}; }
#pragma unroll
    for (int i = 0; i < 8; ++i) { const int f = tid + 512 * i, row = f >> 6, c4 = (f & 63) * 4; LAS float* q = t + row * 257 + c4; q[0] = v[i][0]; q[1] = v[i][1]; q[2] = v[i][2]; q[3] = v[i][3]; }
    __syncthreads();
#pragma unroll
    for (int j = 0; j < 4; ++j) {
        const int p = tid + 512 * j, kp = p & 7, n = p >> 3;
        if (n < ncols) {
            const LAS float* q = t + (kp * 8) * 257 + n;
            u32x4 w; w.x = pk_bf16(q[0], q[257]); w.y = pk_bf16(q[2 * 257], q[3 * 257]); w.z = pk_bf16(q[4 * 257], q[5 * 257]); w.w = pk_bf16(q[6 * 257], q[7 * 257]);
            const int drow = row0 + (ilv >= 0 ? ((n >> 7) * 256 + (n & 127) + ilv) : n);
            *(u32x4*)(dst + (size_t)drow * ldd + k0 + kp * 8) = w;
        }
    }
    __syncthreads();
}

DEVI void phase0(const Params& p, LAS unsigned char* lds, int part) {
    const int tid = threadIdx.x, lane = tid & 63, wid = tid >> 6;
    unsigned char* ws = p.ws;
    const int NT_IN = 16 * (2 + 2 + 2 + 2 + 4 + 4 + 4 + 2 + 4 + 1);
    const int NT0 = NT_IN + 8 * 4 + 16 * 4 + 16 * 4 + 16 + 16 + 16 + 4 * 4;
    for (int u = (part == 0 ? (int)blockIdx.x : 192 + (int)blockIdx.x); u < (part == 0 ? 192 : 192 + NT0); u += gridDim.x) {
        if (u < 192) {
            LAS float* sc = (LAS float*)lds; LAS float* red = (LAS float*)(lds + 9 * 1024 * 4);
            for (int i = tid; i < 9216; i += 512) { const int r = i >> 10, k = i & 1023; const float v = r < 8 ? p.in[1][r * 1024 + k] : p.in[3][k]; sc[i] = v / (1.0f + __expf(-v)); }
            __syncthreads();
            const int n0 = u * 32, col = lane & 31, rsub = lane >> 5;
            float acc[9];
#pragma unroll
            for (int r = 0; r < 9; ++r) acc[r] = 0.f;
            for (int it = 0; it < 64; ++it) { const int k = it * 16 + wid * 2 + rsub; const float w = p.in[4][(size_t)k * 6144 + n0 + col];
#pragma unroll
                for (int r = 0; r < 9; ++r) acc[r] += sc[r * 1024 + k] * w; }
#pragma unroll
            for (int r = 0; r < 9; ++r) red[((wid * 2 + rsub) * 9 + r) * 32 + col] = acc[r];
            __syncthreads();
            if (tid < 288) { const int r = tid >> 5, cc = tid & 31; float s = 0.f; for (int g = 0; g < 16; ++g) s += red[(g * 9 + r) * 32 + cc];
                ((float*)(ws + WS_MOD))[r * 6144 + n0 + cc] = s + p.in[5][n0 + cc]; }
            __syncthreads();
        } else {
            int t = u - 192; LAS float* tb = (LAS float*)lds;
            if (t < NT_IN) {
                const int kt = t & 15; int jb = t >> 4;
                int c0, r0, nc = 256;
                if (jb < 2)       { c0 = 0 + jb * 256;             r0 = 0 + jb * 256; }
                else if (jb < 4)  { c0 = 512 + (jb - 2) * 256;     r0 = 512 + (jb - 2) * 256; }
                else if (jb < 6)  { c0 = 1536 + (jb - 4) * 256;    r0 = 1024 + (jb - 4) * 256; }
                else if (jb < 8)  { c0 = 2048 + (jb - 6) * 256;    r0 = 1536 + (jb - 6) * 256; }
                else if (jb < 12) { c0 = 3584 + (jb - 8) * 256;    r0 = 2048 + (jb - 8) * 256; }
                else if (jb < 16) { c0 = 4640 + (jb - 12) * 256;   r0 = 3072 + (jb - 12) * 256; }
                else if (jb < 20) { c0 = 5664 + (jb - 16) * 256;   r0 = 4096 + (jb - 16) * 256; }
                else if (jb < 22) { c0 = 1024 + (jb - 20) * 256;   r0 = 5120 + (jb - 20) * 256; }
                else if (jb < 26) { c0 = 2560 + (jb - 22) * 256;   r0 = 5632 + (jb - 22) * 256; }
                else              { c0 = 4608; r0 = 6656; nc = 32; }
                conv_tile(p.in[6] + c0, 6688, nc, (bf16_t*)(ws + WS_BT_IN), 1024, kt * 64, r0, -1, tb);
            } else {
                t -= NT_IN;
                if (t < 32)        { const int kt = t & 7, nb = t >> 3;  conv_tile(p.in[13] + nb * 256, 1024, 256, (bf16_t*)(ws + WS_BT_BR), 1536, kt * 64, nb * 256, -1, tb); }
                else if (t < 96)   { t -= 32; const int kt = t & 15, nb = t >> 4; conv_tile(p.in[14] + nb * 256, 1024, 256, (bf16_t*)(ws + WS_BT_BR) + 512, 1536, kt * 64, nb * 256, -1, tb); }
                else if (t < 160)  { t -= 96; const int kt = t & 15, nb = t >> 4; conv_tile(p.in[15] + nb * 256, 1024, 256, (bf16_t*)(ws + WS_BT_OUT), 1024, kt * 64, nb * 256, -1, tb); }
                else if (t < 176)  { t -= 160; conv_tile(p.in[18], 256, 256, (bf16_t*)(ws + WS_BT_RT), 1024, t * 64, 0, -1, tb); }
                else if (t < 192)  { t -= 176; conv_tile(p.in[23], 256, 256, (bf16_t*)(ws + WS_BT_SHGU), 1024, t * 64, 0, 0, tb); }
                else if (t < 208)  { t -= 192; conv_tile(p.in[24], 256, 256, (bf16_t*)(ws + WS_BT_SHGU), 1024, t * 64, 0, 128, tb); }
                else               { t -= 208; const int kt = t & 3, nb = t >> 2; conv_tile(p.in[25] + nb * 256, 1024, 256, (bf16_t*)(ws + WS_BT_SHD), 256, kt * 64, nb * 256, -1, tb); }
            }
        }
    }
}

DEVI void phase1(const Params& p) {
    const float* mod = (const float*)(p.ws + WS_MOD); bf16_t* H = (bf16_t*)(p.ws + WS_H);
    for (size_t idx = (size_t)blockIdx.x * 512 + threadIdx.x; idx < (size_t)NROW * 128; idx += (size_t)gridDim.x * 512) {
        const int row = (int)(idx >> 7), k = (int)(idx & 127) * 8;
        const float* src = row < NTOK ? p.in[0] + (size_t)row * 1024 + k : p.in[2] + (size_t)(row - NTOK) * 1024 + k;
        const float* m = mod + (size_t)(row < NTOK ? (row >> 12) : 8) * 6144 + k;
        const f32x4 x0 = *(const f32x4*)src, x1 = *(const f32x4*)(src + 4), h0 = *(const f32x4*)m, h1 = *(const f32x4*)(m + 4), s0 = *(const f32x4*)(m + 1024), s1 = *(const f32x4*)(m + 1028);
        const f32x4 y0 = x0 * (s0 + 1.0f) + h0, y1 = x1 * (s1 + 1.0f) + h1;
        u32x4 w; w.x = pk_bf16(y0[0], y0[1]); w.y = pk_bf16(y0[2], y0[3]); w.z = pk_bf16(y1[0], y1[1]); w.w = pk_bf16(y1[2], y1[3]);
        *(u32x4*)(H + (size_t)row * 1024 + k) = w;
    }
}

DEVI float logsig16(float z) { return -(fmaxf(-z, 0.f) + __logf(1.0f + __expf(-fabsf(z)))) * 0.0625f; }
DEVI void phase3(const Params& p, LAS unsigned char* lds) {
    const int tid = threadIdx.x;
    unsigned char* ws = p.ws;
    LAS float* LRs = (LAS float*)lds;
    LAS float* CS = (LAS float*)(lds + 8192);
    LAS float* CUM = (LAS float*)(lds + 24576);
    LAS float* TOT = (LAS float*)(lds + 24576 + 65536);
    LAS bf16_t* KTs = (LAS bf16_t*)(lds + 24576 + 65536 + 2048);
    for (int i = tid; i < 2048; i += 512) { const int pos = i >> 5, j = i & 31; const float ang = (float)pos * powf(10000.0f, -(float)j / 32.0f); CS[2 * i] = cosf(ang); CS[2 * i + 1] = sinf(ang); }
    __syncthreads();
    const float* LRT = (const float*)(ws + WS_LRT);
    const bf16_t* QB = (const bf16_t*)(ws + WS_QB); const bf16_t* KB = (const bf16_t*)(ws + WS_KB);
    bf16_t* QTF = (bf16_t*)(ws + WS_QTF); bf16_t* QTB = (bf16_t*)(ws + WS_QTB); bf16_t* KTF = (bf16_t*)(ws + WS_KTF); bf16_t* KTB = (bf16_t*)(ws + WS_KTB);
    float* EE = (float*)(ws + WS_EE);
    for (int u = blockIdx.x; u < 8 * 68 * 4; u += gridDim.x) {
        const int h = u & 3, bs = u >> 2, b = bs / 68, slot = bs % 68; const bool isctx = slot < 4; const int chunk = slot - 4;
        const int rowbase = isctx ? NTOK + b * 256 + slot * 64 : b * 4096 + chunk * 64;
        { const int r = tid >> 4, c4 = (tid & 15) * 4; *(LAS f32x4*)(LRs + r * 64 + c4) = *(const f32x4*)(LRT + (size_t)r * NROW + rowbase + c4); }
        __syncthreads();
        {
            const int ch = tid & 127, grp = tid >> 7, dir = grp & 1, hf = grp >> 1;
            const float* w2p = p.in[dir ? 10 : 8] + h * 128 + ch; const float b2 = p.in[dir ? 11 : 9][h * 128 + ch];
            float w2[16];
#pragma unroll
            for (int r = 0; r < 16; ++r) w2[r] = w2p[r * 512];
            float run = 0.f;
            for (int k = 0; k < 32; ++k) {
                const int i = dir ? (32 * hf + 31 - k) : (32 * hf + k);
                float z = b2;
#pragma unroll
                for (int r = 0; r < 16; ++r) z += LRs[(16 * dir + r) * 64 + i] * w2[r];
                run += logsig16(z);
                CUM[(dir * 64 + i) * 128 + ch] = run;
            }
            TOT[(dir * 2 + hf) * 128 + ch] = run;
        }
        __syncthreads();
#pragma unroll
        for (int rep = 0; rep < 2; ++rep) {
            const int q = tid + 512 * rep, i = q >> 4, c8 = q & 15, ch0 = c8 * 8;
            float cf[8], cb[8];
            {
                const f32x4 a0 = *(const LAS f32x4*)(CUM + (0 * 64 + i) * 128 + ch0), a1 = *(const LAS f32x4*)(CUM + (0 * 64 + i) * 128 + ch0 + 4);
                const f32x4 b0 = *(const LAS f32x4*)(CUM + (1 * 64 + i) * 128 + ch0), b1 = *(const LAS f32x4*)(CUM + (1 * 64 + i) * 128 + ch0 + 4);
                f32x4 tf0 = {0.f, 0.f, 0.f, 0.f}, tf1 = tf0, tb0 = tf0, tb1 = tf0;
                if (i >= 32) { tf0 = *(const LAS f32x4*)(TOT + (0 * 2 + 0) * 128 + ch0); tf1 = *(const LAS f32x4*)(TOT + (0 * 2 + 0) * 128 + ch0 + 4); }
                else         { tb0 = *(const LAS f32x4*)(TOT + (1 * 2 + 1) * 128 + ch0); tb1 = *(const LAS f32x4*)(TOT + (1 * 2 + 1) * 128 + ch0 + 4); }
#pragma unroll
                for (int e = 0; e < 4; ++e) { cf[e] = a0[e] + tf0[e]; cf[4 + e] = a1[e] + tf1[e]; cb[e] = b0[e] + tb0[e]; cb[4 + e] = b1[e] + tb1[e]; }
            }
            const size_t go = (size_t)(rowbase + i) * 512 + h * 128 + ch0;
            const u32x4 kraw = *(const u32x4*)(KB + go);
            float kv[8] = {bflo(kraw.x), bfhi(kraw.x), bflo(kraw.y), bfhi(kraw.y), bflo(kraw.z), bfhi(kraw.z), bflo(kraw.w), bfhi(kraw.w)};
            float ef[8], eb[8];
#pragma unroll
            for (int e = 0; e < 8; ++e) { ef[e] = __expf(cf[e]); eb[e] = __expf(cb[e]); }
            if (!isctx) {
                const size_t gp = (size_t)(rowbase + i) * 512 + h * 128 + ((c8 ^ 4) * 8);
                const u32x4 kpr = *(const u32x4*)(KB + gp), qraw = *(const u32x4*)(QB + go), qpr = *(const u32x4*)(QB + gp);
                const float kp[8] = {bflo(kpr.x), bfhi(kpr.x), bflo(kpr.y), bfhi(kpr.y), bflo(kpr.z), bfhi(kpr.z), bflo(kpr.w), bfhi(kpr.w)};
                const float qv[8] = {bflo(qraw.x), bfhi(qraw.x), bflo(qraw.y), bfhi(qraw.y), bflo(qraw.z), bfhi(qraw.z), bflo(qraw.w), bfhi(qraw.w)};
                const float qp[8] = {bflo(qpr.x), bfhi(qpr.x), bflo(qpr.y), bfhi(qpr.y), bflo(qpr.z), bfhi(qpr.z), bflo(qpr.w), bfhi(qpr.w)};
                const int half = c8 >> 3, isx2 = (c8 >> 2) & 1, j0 = (c8 & 3) * 8, pos = half ? i : chunk;
                float qf[8], qb[8];
#pragma unroll
                for (int e = 0; e < 8; ++e) {
                    const float cs = CS[(pos * 32 + j0 + e) * 2], sn = CS[(pos * 32 + j0 + e) * 2 + 1];
                    const float rq = isx2 ? qv[e] * cs + qp[e] * sn : qv[e] * cs - qp[e] * sn;
                    kv[e] = isx2 ? kv[e] * cs + kp[e] * sn : kv[e] * cs - kp[e] * sn;
                    qf[e] = rq * 0.08838834764831845f * ef[e]; qb[e] = rq * 0.08838834764831845f * eb[e];
                }
                u32x4 wq; wq.x = pk_bf16(qf[0], qf[1]); wq.y = pk_bf16(qf[2], qf[3]); wq.z = pk_bf16(qf[4], qf[5]); wq.w = pk_bf16(qf[6], qf[7]); *(u32x4*)(QTF + go) = wq;
                wq.x = pk_bf16(qb[0], qb[1]); wq.y = pk_bf16(qb[2], qb[3]); wq.z = pk_bf16(qb[4], qb[5]); wq.w = pk_bf16(qb[6], qb[7]); *(u32x4*)(QTB + go) = wq;
            }
            float kf[8], kb[8];
#pragma unroll
            for (int e = 0; e < 8; ++e) { kf[e] = kv[e] * __builtin_amdgcn_rcpf(ef[e]); kb[e] = kv[e] * __builtin_amdgcn_rcpf(eb[e]); }
            u32x4 wf; wf.x = pk_bf16(kf[0], kf[1]); wf.y = pk_bf16(kf[2], kf[3]); wf.z = pk_bf16(kf[4], kf[5]); wf.w = pk_bf16(kf[6], kf[7]);
            u32x4 wb; wb.x = pk_bf16(kb[0], kb[1]); wb.y = pk_bf16(kb[2], kb[3]); wb.z = pk_bf16(kb[4], kb[5]); wb.w = pk_bf16(kb[6], kb[7]);
            *(u32x4*)(KTF + go) = wf; *(u32x4*)(KTB + go) = wb;
            *(LAS u32x4*)(KTs + (0 * 64 + i) * 136 + ch0) = wf; *(LAS u32x4*)(KTs + (1 * 64 + i) * 136 + ch0) = wb;
            if (i == 63) { float* ep = EE + ((size_t)(0 * 8 + b) * 68 + slot) * 512 + h * 128 + ch0; *(f32x4*)ep = (f32x4){ef[0], ef[1], ef[2], ef[3]}; *(f32x4*)(ep + 4) = (f32x4){ef[4], ef[5], ef[6], ef[7]}; }
            if (i == 0)  { float* ep = EE + ((size_t)(1 * 8 + b) * 68 + slot) * 512 + h * 128 + ch0; *(f32x4*)ep = (f32x4){eb[0], eb[1], eb[2], eb[3]}; *(f32x4*)(ep + 4) = (f32x4){eb[4], eb[5], eb[6], eb[7]}; }
        }
        __syncthreads();
#pragma unroll
        for (int rep = 0; rep < 4; ++rep) {
            const int q = tid + 512 * rep, ch = q & 127, t8 = (q >> 7) & 7, dir = q >> 10;
            const LAS bf16_t* sp = KTs + (dir * 64 + t8 * 8) * 136 + ch;
            u32x4 wv; wv.x = (unsigned)sp[0] | ((unsigned)sp[136] << 16); wv.y = (unsigned)sp[2 * 136] | ((unsigned)sp[3 * 136] << 16); wv.z = (unsigned)sp[4 * 136] | ((unsigned)sp[5 * 136] << 16); wv.w = (unsigned)sp[6 * 136] | ((unsigned)sp[7 * 136] << 16);
            *(u32x4*)((bf16_t*)(ws + (dir ? WS_KTTB : WS_KTTF)) + (size_t)(h * 128 + ch) * NROW + rowbase + t8 * 8) = wv;
        }
        __syncthreads();
    }
}

DEVI int gla_slot(int dir, int n) { return dir == 0 ? n : (n < 4 ? 3 - n : 71 - n); }
DEVI int gla_rowbase(int b, int slot) { return slot >= 4 ? b * 4096 + (slot - 4) * 64 : NTOK + b * 256 + slot * 64; }
DEVI void phase4_gla(const Params& p, LAS unsigned char* lds) {
    const int tid = threadIdx.x, lane = tid & 63, w = tid >> 6, l15 = lane & 15, fq = lane >> 4;
    unsigned char* ws = p.ws;
    LAS unsigned char* TQ = lds;
    LAS unsigned char* TK = lds + 32768;
    LAS unsigned char* TV = lds + 65536;
    LAS bf16_t* PM = (LAS bf16_t*)(lds + 81920);
    LAS bf16_t* SB = (LAS bf16_t*)(lds + 81920 + 9216);
    const bf16_t* VBT = (const bf16_t*)(ws + WS_VBT);
    const float* EE = (const float*)(ws + WS_EE);
    const int qr0 = tid >> 4, qp = tid & 15, vr = tid >> 3, vp = tid & 7;
    const int qoff0 = qr0 * 256 + ((qp ^ (qr0 & 15)) << 4), qoff1 = (qr0 + 32) * 256 + ((qp ^ ((qr0 + 32) & 15)) << 4);
    const int voff = vr * 128 + ((vp ^ ((vr >> 1) & 7)) << 4);
    struct PSet { u32x4 q0, q1, k0, k1, v; };
    struct KSet { bf16x8 a, b; f32x4 e; };
    for (int u = blockIdx.x; u < 256; u += gridDim.x) {
        const int xg = u & 7, kg = u >> 3, g = xg * 8 + (kg >> 2), dvq = kg & 3, dir = g & 1, h = (g >> 1) & 3, b = g >> 3;
        const bf16_t* QT = (const bf16_t*)(ws + (dir ? WS_QTB : WS_QTF)); const bf16_t* KT = (const bf16_t*)(ws + (dir ? WS_KTB : WS_KTF)); const bf16_t* KTT = (const bf16_t*)(ws + (dir ? WS_KTTB : WS_KTTF));
        bf16_t* OUT = (bf16_t*)(ws + (dir ? WS_OB : WS_OF));
        const int vrow0 = h * 256 + dvq * 64, krow0 = h * 128, kcol0 = h * 128;
        const float* EEu = EE + (size_t)(dir * 8 + b) * 68 * 512 + h * 128 + 16 * w + 4 * fq;
        const bf16_t* vsrc = VBT + (size_t)(vrow0 + vr) * NROW + vp * 8;
        const bf16_t* ktsrc = KTT + (size_t)(krow0 + 16 * w + l15) * NROW + 8 * fq;
        const size_t qsrc = (size_t)qr0 * 512 + kcol0 + qp * 8;
        f32x4 S[4];
#pragma unroll
        for (int i = 0; i < 4; ++i) S[i] = (f32x4){0.f, 0.f, 0.f, 0.f};
        PSet P0, P1; KSet K0, K1;
        P0.q0 = P0.q1 = P0.k0 = P0.k1 = P0.v = (u32x4){0u, 0u, 0u, 0u}; P1 = P0;
        auto load_p = [&](PSet& P, int n) {
            const int slot = gla_slot(dir, n), rb = gla_rowbase(b, slot);
            P.v = *(const u32x4*)(vsrc + rb);
            if (slot >= 4) { P.q0 = *(const u32x4*)(QT + (size_t)rb * 512 + qsrc); P.q1 = *(const u32x4*)(QT + (size_t)(rb + 32) * 512 + qsrc);
                             P.k0 = *(const u32x4*)(KT + (size_t)rb * 512 + qsrc); P.k1 = *(const u32x4*)(KT + (size_t)(rb + 32) * 512 + qsrc); }
        };
        auto store_p = [&](const PSet& P, int n) {
            const int slot = gla_slot(dir, n), bufo = n & 1;
            *(LAS u32x4*)(TV + bufo * 8192 + voff) = P.v;
            if (slot >= 4) { *(LAS u32x4*)(TQ + bufo * 16384 + qoff0) = P.q0; *(LAS u32x4*)(TQ + bufo * 16384 + qoff1) = P.q1; *(LAS u32x4*)(TK + bufo * 16384 + qoff0) = P.k0; *(LAS u32x4*)(TK + bufo * 16384 + qoff1) = P.k1; }
        };
        auto load_k = [&](KSet& K, int n) {
            const int slot = gla_slot(dir, n), rb = gla_rowbase(b, slot);
            K.a = *(const bf16x8*)(ktsrc + rb); K.b = *(const bf16x8*)(ktsrc + rb + 32); K.e = *(const f32x4*)(EEu + (size_t)slot * 512);
        };
        load_p(P0, 0); load_k(K0, 0); load_k(K1, 1); load_p(P1, 1);
        __syncthreads();
        store_p(P0, 0);
        auto step = [&](int n, PSet& Pload, const PSet& Pstore, KSet& K) {
            const int slot = gla_slot(dir, n); const bool lat = slot >= 4; const int rowbase = gla_rowbase(b, slot);
            const int cur = n & 1, nxt = cur ^ 1;
            LAS unsigned char* tq = TQ + cur * 16384; LAS unsigned char* tk = TK + cur * 16384; LAS unsigned char* tv = TV + cur * 8192;
            LAS bf16_t* sbc = SB + cur * 64 * 136; LAS bf16_t* sbn = SB + nxt * 64 * 136;
            lds_barrier();
            if (n + 2 < 68) load_p(Pload, n + 2);
            if (lat) {
                const int jt = w >> 1, it0 = 2 * (w & 1);
                f32x4 c0 = {0.f, 0.f, 0.f, 0.f}, c1 = {0.f, 0.f, 0.f, 0.f};
                const int rj = 16 * jt + l15, ri0 = 16 * it0 + l15, ri1 = ri0 + 16;
                bf16x8 fa[4], fb0[4], fb1[4];
#pragma unroll
                for (int ks = 0; ks < 4; ++ks) { const int pc = 4 * ks + fq;
                    fa[ks] = *(const LAS bf16x8*)(tk + rj * 256 + ((pc ^ l15) << 4)); fb0[ks] = *(const LAS bf16x8*)(tq + ri0 * 256 + ((pc ^ l15) << 4)); fb1[ks] = *(const LAS bf16x8*)(tq + ri1 * 256 + ((pc ^ l15) << 4)); }
                __builtin_amdgcn_sched_barrier(0);
#pragma unroll
                for (int ks = 0; ks < 4; ++ks) { c0 = __builtin_amdgcn_mfma_f32_16x16x32_bf16(fa[ks], fb0[ks], c0, 0, 0, 0); c1 = __builtin_amdgcn_mfma_f32_16x16x32_bf16(fa[ks], fb1[ks], c1, 0, 0, 0); }
#pragma unroll
                for (int r = 0; r < 4; ++r) { const int j = 16 * jt + 4 * fq + r;
                    const bool k0 = dir == 0 ? (j <= ri0) : (j >= ri0), k1 = dir == 0 ? (j <= ri1) : (j >= ri1);
                    c0[r] = k0 ? c0[r] : 0.f; c1[r] = k1 ? c1[r] : 0.f; }
                u32x2 w0; w0.x = pk_bf16(c0[0], c0[1]); w0.y = pk_bf16(c0[2], c0[3]); u32x2 w1; w1.x = pk_bf16(c1[0], c1[1]); w1.y = pk_bf16(c1[2], c1[3]);
                *(LAS u32x2*)(PM + ri0 * 72 + 16 * jt + 4 * fq) = w0; *(LAS u32x2*)(PM + ri1 * 72 + 16 * jt + 4 * fq) = w1;
            }
            lds_barrier();
            bf16x8 V[4][2];
#pragma unroll
            for (int dvt = 0; dvt < 4; ++dvt)
#pragma unroll
                for (int ks = 0; ks < 2; ++ks) { const int row = 16 * dvt + l15, pc = 4 * ks + fq; V[dvt][ks] = *(const LAS bf16x8*)(tv + row * 128 + ((pc ^ ((row >> 1) & 7)) << 4)); }
            __builtin_amdgcn_sched_barrier(0);
            if (lat) {
                const int it = w >> 1, dv0 = 2 * (w & 1), ri = 16 * it + l15;
                f32x4 o0 = {0.f, 0.f, 0.f, 0.f}, o1 = {0.f, 0.f, 0.f, 0.f};
                bf16x8 pB[2], pA0[2], pA1[2], sA0[4], sA1[4], sB[4];
                const LAS bf16_t* s0 = sbc + (16 * dv0 + l15) * 136 + 8 * fq; const LAS bf16_t* s1 = s0 + 16 * 136;
#pragma unroll
                for (int ks = 0; ks < 2; ++ks) { pB[ks] = *(const LAS bf16x8*)(PM + ri * 72 + 32 * ks + 8 * fq);
                    const int r0 = 16 * dv0 + l15, r1 = r0 + 16, pc = 4 * ks + fq;
                    pA0[ks] = *(const LAS bf16x8*)(tv + r0 * 128 + ((pc ^ ((r0 >> 1) & 7)) << 4)); pA1[ks] = *(const LAS bf16x8*)(tv + r1 * 128 + ((pc ^ ((r1 >> 1) & 7)) << 4)); }
#pragma unroll
                for (int ks = 0; ks < 4; ++ks) { const int pc = 4 * ks + fq;
                    sA0[ks] = *(const LAS bf16x8*)(s0 + 32 * ks); sA1[ks] = *(const LAS bf16x8*)(s1 + 32 * ks); sB[ks] = *(const LAS bf16x8*)(tq + ri * 256 + ((pc ^ l15) << 4)); }
                __builtin_amdgcn_sched_barrier(0);
#pragma unroll
                for (int ks = 0; ks < 2; ++ks) { o0 = __builtin_amdgcn_mfma_f32_16x16x32_bf16(pA0[ks], pB[ks], o0, 0, 0, 0); o1 = __builtin_amdgcn_mfma_f32_16x16x32_bf16(pA1[ks], pB[ks], o1, 0, 0, 0); }
#pragma unroll
                for (int ks = 0; ks < 4; ++ks) { o0 = __builtin_amdgcn_mfma_f32_16x16x32_bf16(sA0[ks], sB[ks], o0, 0, 0, 0); o1 = __builtin_amdgcn_mfma_f32_16x16x32_bf16(sA1[ks], sB[ks], o1, 0, 0, 0); }
                bf16_t* op = OUT + (size_t)(rowbase + ri) * 1024 + vrow0 + 16 * dv0 + 4 * fq;
                u32x2 w0; w0.x = pk_bf16(o0[0], o0[1]); w0.y = pk_bf16(o0[2], o0[3]); u32x2 w1; w1.x = pk_bf16(o1[0], o1[1]); w1.y = pk_bf16(o1[2], o1[3]);
                *(u32x2*)op = w0; *(u32x2*)(op + 16) = w1;
            }
#pragma unroll
            for (int dvt = 0; dvt < 4; ++dvt) { S[dvt] = __builtin_amdgcn_mfma_f32_16x16x32_bf16(K.a, V[dvt][0], S[dvt], 0, 0, 0); S[dvt] = __builtin_amdgcn_mfma_f32_16x16x32_bf16(K.b, V[dvt][1], S[dvt], 0, 0, 0); }
#pragma unroll
            for (int dvt = 0; dvt < 4; ++dvt) { S[dvt] = S[dvt] * K.e;
                u32x2 o; o.x = pk_bf16(S[dvt][0], S[dvt][1]); o.y = pk_bf16(S[dvt][2], S[dvt][3]);
                *(LAS u32x2*)(sbn + (16 * dvt + l15) * 136 + 16 * w + 4 * fq) = o; }
            if (n + 2 < 68) load_k(K, n + 2);
            if (n + 1 < 68) store_p(Pstore, n + 1);
        };
#pragma unroll 1
        for (int n = 0; n < 68; n += 2) { step(n, P0, P1, K0); step(n + 1, P1, P0, K1); }
        __syncthreads();
    }
}

DEVI void phase4_na(const Params& p, LAS unsigned char* lds) {
    const int tid = threadIdx.x; const int wsg = __builtin_amdgcn_readfirstlane(tid >> 6);
    unsigned char* ws = p.ws;
    LAS unsigned char* CK = lds;
    LAS unsigned char* CV = lds + 32768;
    LAS float* RP = (LAS float*)(lds + 65536);
    const bf16_t* QA = (const bf16_t*)(ws + WS_QA); const bf16_t* KA = (const bf16_t*)(ws + WS_KA); const bf16_t* VAT = (const bf16_t*)(ws + WS_VAT);
    bf16_t* OA = (bf16_t*)(ws + WS_AP);
    for (int u = blockIdx.x; u < 512; u += gridDim.x) {
        const int xg = u & 7, idx = u >> 3, bh = xg * 8 + (idx >> 3), rblk = idx & 7, h = bh & 7, b = bh >> 3;
        __syncthreads();
        for (int i = tid; i < 465; i += 512) RP[(i / 31) * 80 + 24 + (i % 31)] = p.in[7][h * 465 + i];
        int tz = tid; asm volatile("" : "+v"(tz));
#pragma unroll
        for (int rep = 0; rep < 4; ++rep) {
            const int q = tz + 512 * rep;
            { const int row = q >> 3, pc = q & 7; *(LAS u32x4*)(CK + row * 128 + ((pc ^ ((row >> 1) & 7)) << 4)) = *(const u32x4*)(KA + (size_t)(NTOK + b * 256 + row) * 512 + h * 64 + pc * 8); }
            { const int row = q >> 5, pc = q & 31; const u32x4 v = *(const u32x4*)(VAT + (size_t)(h * 64 + row) * NROW + NTOK + b * 256 + pc * 8);
              const int sw = (row & 15) << 1; u32x2 lo; lo.x = v.x; lo.y = v.y; u32x2 hi; hi.x = v.z; hi.y = v.w;
              *(LAS u32x2*)(CV + row * 512 + (((2 * pc) ^ sw) << 3)) = lo; *(LAS u32x2*)(CV + row * 512 + (((2 * pc + 1) ^ sw) << 3)) = hi; }
        }
        __syncthreads();
#pragma unroll 1
        for (int qt = 0; qt < 4; ++qt) {
            int lane = (int)__builtin_amdgcn_mbcnt_hi(~0u, __builtin_amdgcn_mbcnt_lo(~0u, 0u)); asm volatile("" : "+v"(lane));
            const int w = wsg, l15 = lane & 15, fq = lane >> 4, r = rblk * 8 + w, rs = min(max(r - 4, 0), 56);
            const int kc0 = min(max(16 * qt - 8, 0), 32);
            const int c = 16 * qt + l15, cs = min(max(c - 8, 0), 48);
            const bf16_t* qp = QA + (size_t)(b * 4096 + r * 64 + c) * 512 + h * 64 + 8 * fq;
            const bf16x8 Bq0 = *(const bf16x8*)qp, Bq1 = *(const bf16x8*)(qp + 32);
            const int lo = 15 + cs - c, d00 = kc0 - 16 * qt + 4 * fq - l15 + 15;
            const LAS unsigned char* rpl = (const LAS unsigned char*)RP + ((rs - r + 7) * 80 + 24 + d00) * 4;
            const char* kbase = (const char*)(KA + (size_t)(b * 4096 + rs * 64 + kc0) * 512 + h * 64); const unsigned klane = (unsigned)(l15 * 512 + 8 * fq) * 2u;
            const char* vbase = (const char*)(VAT + (size_t)(h * 64) * NROW + b * 4096 + rs * 64 + kc0); const unsigned vlane = (unsigned)(l15 * NROW + 4 * fq) * 2u;
#define NA_SB __builtin_amdgcn_sched_barrier(0)
            f32x4 sc[16];
#pragma unroll
            for (int hb = 0; hb < 4; ++hb) {
                bf16x8 kf[4][2];
#pragma unroll
                for (int tt = 0; tt < 4; ++tt) { const int t = 4 * hb + tt, kr = t >> 1, chh = t & 1; const char* kp = (kbase + (size_t)((kr * 64 + 16 * chh) * 1024)) + klane;
                    kf[tt][0] = *(const bf16x8*)kp; kf[tt][1] = *(const bf16x8*)(kp + 64); }
                NA_SB;
#pragma unroll
                for (int tt = 0; tt < 4; ++tt) { const int t = 4 * hb + tt, kr = t >> 1, chh = t & 1;
                    f32x4 a = {0.f, 0.f, 0.f, 0.f};
                    a = __builtin_amdgcn_mfma_f32_16x16x32_bf16(kf[tt][0], Bq0, a, 0, 0, 0); a = __builtin_amdgcn_mfma_f32_16x16x32_bf16(kf[tt][1], Bq1, a, 0, 0, 0);
#pragma unroll
                    for (int j = 0; j < 4; ++j) { const float bias = *(const LAS float*)(rpl + chh * 64 + kr * 320 + j * 4); a[j] = ((unsigned)(d00 + 16 * chh + j - lo) <= 15u) ? a[j] + bias : -INFINITY; }
                    sc[t] = a; }
                NA_SB;
            }
            u32x2 va0[2][4], va1[2][4];
            auto ld_vloc = [&](int uu0) {
#pragma unroll
                for (int q = 0; q < 2; ++q)
#pragma unroll
                    for (int mt = 0; mt < 4; ++mt) { const char* vp = (vbase + (size_t)((16 * mt * NROW + (uu0 + q) * 64) * 2)) + vlane; va0[q][mt] = *(const u32x2*)vp; va1[q][mt] = *(const u32x2*)(vp + 32); } };
            ld_vloc(0);
            NA_SB;
            float mA = -INFINITY;
#pragma unroll
            for (int t = 0; t < 16; ++t) mA = fmaxf(mA, fmaxf(fmaxf(sc[t][0], sc[t][1]), fmaxf(sc[t][2], sc[t][3])));
            mA = fmaxf(mA, __shfl_xor(mA, 16)); mA = fmaxf(mA, __shfl_xor(mA, 32));
            float lA = 0.f; u32x2 pp[16];
#pragma unroll
            for (int t = 0; t < 16; ++t) { const float e0 = __expf(sc[t][0] - mA), e1 = __expf(sc[t][1] - mA), e2 = __expf(sc[t][2] - mA), e3 = __expf(sc[t][3] - mA);
                lA += (e0 + e1) + (e2 + e3); pp[t].x = pk_bf16(e0, e1); pp[t].y = pk_bf16(e2, e3); }
            NA_SB;
            f32x4 o[4];
#pragma unroll
            for (int mt = 0; mt < 4; ++mt) o[mt] = (f32x4){0.f, 0.f, 0.f, 0.f};
            auto mm_vloc = [&](int uu0) {
#pragma unroll
                for (int q = 0; q < 2; ++q) { const int t0 = 2 * (uu0 + q), t1 = t0 + 1;
                    union { u32x4 w; bf16x8 v; } P; P.w.x = pp[t0].x; P.w.y = pp[t0].y; P.w.z = pp[t1].x; P.w.w = pp[t1].y;
#pragma unroll
                    for (int mt = 0; mt < 4; ++mt) { union { u32x4 w; bf16x8 v; } A; A.w.x = va0[q][mt].x; A.w.y = va0[q][mt].y; A.w.z = va1[q][mt].x; A.w.w = va1[q][mt].y; o[mt] = __builtin_amdgcn_mfma_f32_16x16x32_bf16(A.v, P.v, o[mt], 0, 0, 0); } } };
            mm_vloc(0); NA_SB; ld_vloc(2); NA_SB; mm_vloc(2); NA_SB; ld_vloc(4); NA_SB; mm_vloc(4); NA_SB; ld_vloc(6); NA_SB; mm_vloc(6); NA_SB;
            int lane2 = (int)__builtin_amdgcn_mbcnt_hi(~0u, __builtin_amdgcn_mbcnt_lo(~0u, 0u)); asm volatile("" : "+v"(lane2));
            const int l15b = lane2 & 15, fqb = lane2 >> 4, cks = (l15b >> 1) & 7, ck0 = l15b * 128 + ((fqb ^ cks) << 4), ck1 = l15b * 128 + (((4 + fqb) ^ cks) << 4);
            {
                bf16x8 kfA[2][2];
                auto ld_ctx = [&](bf16x8 (&kf)[2][2], auto G) {
#pragma unroll
                    for (int tt = 0; tt < 2; ++tt) { constexpr int tile = 0; const int to = (2 * decltype(G)::v + tt) * 2048 + tile;
                        kf[tt][0] = *(const LAS bf16x8*)(CK + to + ck0); kf[tt][1] = *(const LAS bf16x8*)(CK + to + ck1); } };
                auto mm_ctx = [&](const bf16x8 (&kf)[2][2], auto G) {
#pragma unroll
                    for (int tt = 0; tt < 2; ++tt) { f32x4 a = {0.f, 0.f, 0.f, 0.f};
                        a = __builtin_amdgcn_mfma_f32_16x16x32_bf16(kf[tt][0], Bq0, a, 0, 0, 0); a = __builtin_amdgcn_mfma_f32_16x16x32_bf16(kf[tt][1], Bq1, a, 0, 0, 0);
                        sc[2 * decltype(G)::v + tt] = a; } };
#define NA_CC(G0) ld_ctx(kfA, IC<G0>{}); NA_SB; mm_ctx(kfA, IC<G0>{}); NA_SB;
                NA_CC(0) NA_CC(1) NA_CC(2) NA_CC(3) NA_CC(4) NA_CC(5) NA_CC(6) NA_CC(7)
#undef NA_CC
            }
            float mB = -INFINITY;
#pragma unroll
            for (int t = 0; t < 16; ++t) mB = fmaxf(mB, fmaxf(fmaxf(sc[t][0], sc[t][1]), fmaxf(sc[t][2], sc[t][3])));
            mB = fmaxf(mB, __shfl_xor(mB, 16)); mB = fmaxf(mB, __shfl_xor(mB, 32));
            const float mx = fmaxf(mA, mB), fA = __expf(mA - mx);
            float lB = 0.f;
#pragma unroll
            for (int t = 0; t < 16; ++t) { const float e0 = __expf(sc[t][0] - mx), e1 = __expf(sc[t][1] - mx), e2 = __expf(sc[t][2] - mx), e3 = __expf(sc[t][3] - mx);
                lB += (e0 + e1) + (e2 + e3); pp[t].x = pk_bf16(e0, e1); pp[t].y = pk_bf16(e2, e3); }
            float sum = lA * fA + lB;
            sum += __shfl_xor(sum, 16); sum += __shfl_xor(sum, 32);
            const float inv = 1.0f / sum;
#pragma unroll
            for (int mt = 0; mt < 4; ++mt) o[mt] = o[mt] * fA;
            NA_SB;
            int cvo[4][2];
#pragma unroll
            for (int rr = 0; rr < 4; ++rr)
#pragma unroll
                for (int dd = 0; dd < 2; ++dd) cvo[rr][dd] = l15b * 512 + ((((8 * rr + fqb + 4 * dd) ^ (l15b << 1)) & 31) << 3);
            {
                u32x4 vfA[4], vfB[4];
                auto ld_v = [&](u32x4 (&vq)[4], auto U) {
                    constexpr int uu = decltype(U)::v, q4 = uu >> 2, rr = uu & 3;
#pragma unroll
                    for (int mt = 0; mt < 4; ++mt) { const u32x2 a0 = *(const LAS u32x2*)(CV + mt * 8192 + q4 * 256 + cvo[rr][0]), a1 = *(const LAS u32x2*)(CV + mt * 8192 + q4 * 256 + cvo[rr][1]); vq[mt] = (u32x4){a0.x, a0.y, a1.x, a1.y}; } };
                auto mm_v = [&](const u32x4 (&vq)[4], auto U) {
                    constexpr int uu = decltype(U)::v, t0 = 2 * uu, t1 = 2 * uu + 1;
                    union { u32x4 w; bf16x8 v; } P; P.w.x = pp[t0].x; P.w.y = pp[t0].y; P.w.z = pp[t1].x; P.w.w = pp[t1].y;
#pragma unroll
                    for (int mt = 0; mt < 4; ++mt) { union { u32x4 w; bf16x8 v; } A; A.w = vq[mt]; o[mt] = __builtin_amdgcn_mfma_f32_16x16x32_bf16(A.v, P.v, o[mt], 0, 0, 0); } };
#define NA_PV(U0, U1, U2, U3) mm_v(vfA, IC<U0>{}); NA_SB; ld_v(vfA, IC<U2>{}); NA_SB; mm_v(vfB, IC<U1>{}); NA_SB; ld_v(vfB, IC<U3>{}); NA_SB;
                ld_v(vfA, IC<0>{}); ld_v(vfB, IC<1>{}); NA_SB;
                NA_PV(0, 1, 2, 3) NA_PV(2, 3, 4, 5) NA_PV(4, 5, 6, 7)
                mm_v(vfA, IC<6>{}); NA_SB; mm_v(vfB, IC<7>{}); NA_SB;
#undef NA_PV
            }
#undef NA_SB
            bf16_t* op = OA + (size_t)(b * 4096 + r * 64 + c) * 1536 + h * 64 + 4 * fq;
#pragma unroll
            for (int mt = 0; mt < 4; ++mt) { u32x2 wv; wv.x = pk_bf16(o[mt][0] * inv, o[mt][1] * inv); wv.y = pk_bf16(o[mt][2] * inv, o[mt][3] * inv); *(u32x2*)(op + 16 * mt) = wv; }
        }
    }
}

DEVI void phase5(const Params& p) {
    const int lane = threadIdx.x & 63, gw = blockIdx.x * 8 + (threadIdx.x >> 6), nw = gridDim.x * 8;
    const bf16_t* OF = (const bf16_t*)(p.ws + WS_OF); const bf16_t* OB = (const bf16_t*)(p.ws + WS_OB); const bf16_t* GB = (const bf16_t*)(p.ws + WS_GB); bf16_t* AP = (bf16_t*)(p.ws + WS_AP);
    for (int tok = gw; tok < NTOK; tok += nw) {
#pragma unroll
        for (int hh = 0; hh < 2; ++hh) {
            const int col = hh * 512 + lane * 8;
            const size_t o = (size_t)tok * 1024 + col;
            const u32x4 a = *(const u32x4*)(OF + o), bb = *(const u32x4*)(OB + o), g = *(const u32x4*)(GB + o);
            float v[8] = {bflo(a.x) + bflo(bb.x), bfhi(a.x) + bfhi(bb.x), bflo(a.y) + bflo(bb.y), bfhi(a.y) + bfhi(bb.y), bflo(a.z) + bflo(bb.z), bfhi(a.z) + bfhi(bb.z), bflo(a.w) + bflo(bb.w), bfhi(a.w) + bfhi(bb.w)};
            float ss = 0.f;
#pragma unroll
            for (int e = 0; e < 8; ++e) ss += v[e] * v[e];
            ss += __shfl_xor(ss, 16); ss += __shfl_xor(ss, 8); ss += __shfl_xor(ss, 4); ss += __shfl_xor(ss, 2); ss += __shfl_xor(ss, 1);
            const float rs = rsqrtf(ss * (1.0f / 256.0f) + 1e-6f);
            const f32x4 n0 = *(const f32x4*)(p.in[12] + col), n1 = *(const f32x4*)(p.in[12] + col + 4);
            const float gg[8] = {bflo(g.x), bfhi(g.x), bflo(g.y), bfhi(g.y), bflo(g.z), bfhi(g.z), bflo(g.w), bfhi(g.w)};
            float r[8];
#pragma unroll
            for (int e = 0; e < 8; ++e) r[e] = v[e] * rs * (e < 4 ? n0[e & 3] : n1[e & 3]) * (gg[e] * sigmoidf_(gg[e]));
            u32x4 wv; wv.x = pk_bf16(r[0], r[1]); wv.y = pk_bf16(r[2], r[3]); wv.z = pk_bf16(r[4], r[5]); wv.w = pk_bf16(r[6], r[7]);
            *(u32x4*)(AP + (size_t)tok * 1536 + 512 + col) = wv;
        }
    }
}

DEVI void ln_row(f32x4 (&v)[4], const float* g, const float* bta, int lane) {
    float s = 0.f;
#pragma unroll
    for (int j = 0; j < 4; ++j) s += (v[j][0] + v[j][1]) + (v[j][2] + v[j][3]);
    const float mu = wave_sum(s) * (1.0f / 1024.0f);
    float q = 0.f;
#pragma unroll
    for (int j = 0; j < 4; ++j) { v[j] = v[j] - mu; q += (v[j][0] * v[j][0] + v[j][1] * v[j][1]) + (v[j][2] * v[j][2] + v[j][3] * v[j][3]); }
    const float rstd = rsqrtf(wave_sum(q) * (1.0f / 1024.0f) + 1e-6f);
#pragma unroll
    for (int j = 0; j < 4; ++j) { const f32x4 gg = *(const f32x4*)(g + lane * 4 + 256 * j), bb = *(const f32x4*)(bta + lane * 4 + 256 * j); v[j] = v[j] * rstd * gg + bb; }
}
DEVI void phase9(const Params& p) {
    const int lane = threadIdx.x & 63, gw = blockIdx.x * 8 + (threadIdx.x >> 6), nw = gridDim.x * 8;
    const float* mod = (const float*)(p.ws + WS_MOD); const bf16_t* Z = (const bf16_t*)(p.ws + WS_Z); float* X1 = (float*)(p.ws + WS_X1); bf16_t* H2 = (bf16_t*)(p.ws + WS_H2);
    for (int tok = gw; tok < NTOK; tok += nw) {
        const float* m = mod + (size_t)(tok >> 12) * 6144; float v[2][8];
#pragma unroll
        for (int j = 0; j < 2; ++j) { const int cidx = lane * 8 + 512 * j;
            const f32x4 x0 = *(const f32x4*)(p.in[0] + (size_t)tok * 1024 + cidx), x1 = *(const f32x4*)(p.in[0] + (size_t)tok * 1024 + cidx + 4), g0 = *(const f32x4*)(m + 2048 + cidx), g1 = *(const f32x4*)(m + 2048 + cidx + 4);
            const u32x4 z = *(const u32x4*)(Z + (size_t)tok * 1024 + cidx);
            float zf[8] = {bflo(z.x), bfhi(z.x), bflo(z.y), bfhi(z.y), bflo(z.z), bfhi(z.z), bflo(z.w), bfhi(z.w)};
#if defined(DBG_NOMIX)
#pragma unroll
            for (int e = 0; e < 8; ++e) zf[e] = 0.f;
#endif
#pragma unroll
            for (int e = 0; e < 4; ++e) { v[j][e] = x0[e] * 1.189207115f + g0[e] * zf[e]; v[j][4 + e] = x1[e] * 1.189207115f + g1[e] * zf[4 + e]; }
        }
        float sm = 0.f;
#pragma unroll
        for (int j = 0; j < 2; ++j)
#pragma unroll
            for (int e = 0; e < 8; ++e) sm += v[j][e];
        const float mu = wave_sum(sm) * (1.0f / 1024.0f); float q = 0.f;
#pragma unroll
        for (int j = 0; j < 2; ++j)
#pragma unroll
            for (int e = 0; e < 8; ++e) { v[j][e] -= mu; q += v[j][e] * v[j][e]; }
        const float rstd = rsqrtf(wave_sum(q) * (1.0f / 1024.0f) + 1e-6f);
#pragma unroll
        for (int j = 0; j < 2; ++j) { const int cidx = lane * 8 + 512 * j;
            const f32x4 g0 = *(const f32x4*)(p.in[16] + cidx), g1 = *(const f32x4*)(p.in[16] + cidx + 4), b0 = *(const f32x4*)(p.in[17] + cidx), b1 = *(const f32x4*)(p.in[17] + cidx + 4);
            const f32x4 sh0 = *(const f32x4*)(m + 3072 + cidx), sh1 = *(const f32x4*)(m + 3072 + cidx + 4), sc0 = *(const f32x4*)(m + 4096 + cidx), sc1 = *(const f32x4*)(m + 4096 + cidx + 4);
            f32x4 o0, o1; float hv[8];
#pragma unroll
            for (int e = 0; e < 4; ++e) { o0[e] = v[j][e] * rstd * g0[e] + b0[e]; o1[e] = v[j][4 + e] * rstd * g1[e] + b1[e]; hv[e] = o0[e] * (sc0[e] + 1.0f) + sh0[e]; hv[4 + e] = o1[e] * (sc1[e] + 1.0f) + sh1[e]; }
            *(f32x4*)(X1 + (size_t)tok * 1024 + cidx) = o0; *(f32x4*)(X1 + (size_t)tok * 1024 + cidx + 4) = o1;
            u32x4 wv; wv.x = pk_bf16(hv[0], hv[1]); wv.y = pk_bf16(hv[2], hv[3]); wv.z = pk_bf16(hv[4], hv[5]); wv.w = pk_bf16(hv[6], hv[7]);
            *(u32x4*)(H2 + (size_t)tok * 1024 + cidx) = wv; }
    }
}
DEVI void phase11(const Params& p) {
    const int lane = threadIdx.x & 63, gw = blockIdx.x * 8 + (threadIdx.x >> 6), nw = gridDim.x * 8, half = lane >> 5;
    const float* L0 = (const float*)(p.ws + WS_LOG0); const float* L1 = (const float*)(p.ws + WS_LOG1);
    int* TID = (int*)(p.ws + WS_TOPK_ID); float* TW = (float*)(p.ws + WS_TOPK_W); int* TP = (int*)(p.ws + WS_TOPK_POS); unsigned* CNT = (unsigned*)(p.ws + WS_CNT);
    float rb[4];
#pragma unroll
    for (int j = 0; j < 4; ++j) rb[j] = p.in[19][lane + 64 * j];
    for (int tok = gw; tok < NTOK; tok += nw) {
        float s[4], bz[4], gs[4];
#pragma unroll
        for (int j = 0; j < 4; ++j) { const float lg = L0[(size_t)tok * 256 + lane + 64 * j] + L1[(size_t)tok * 256 + lane + 64 * j]; s[j] = 1.0f / (1.0f + expf(-lg)); bz[j] = s[j] + rb[j]; }
#pragma unroll
        for (int j = 0; j < 4; ++j) { float m1 = bz[j], m2 = -INFINITY;
#pragma unroll
            for (int o = 1; o < 32; o <<= 1) { const float p1 = __shfl_xor(m1, o), p2 = __shfl_xor(m2, o); const float n1 = fmaxf(m1, p1), n2 = fmaxf(fminf(m1, p1), fmaxf(m2, p2)); m1 = n1; m2 = n2; }
            gs[j] = m1 + m2; }
        float Gv[8];
#pragma unroll
        for (int j = 0; j < 4; ++j) { const float oth = __shfl_xor(gs[j], 32); Gv[2 * j] = half ? oth : gs[j]; Gv[2 * j + 1] = half ? gs[j] : oth; }
        bool keep[8];
#pragma unroll
        for (int g = 0; g < 8; ++g) { int rank = 0;
#pragma unroll
            for (int g2 = 0; g2 < 8; ++g2) rank += (Gv[g2] > Gv[g] || (Gv[g2] == Gv[g] && g2 < g)) ? 1 : 0;
            keep[g] = rank < 4; }
        float mv[4];
#pragma unroll
        for (int j = 0; j < 4; ++j) { const bool k = half ? keep[2 * j + 1] : keep[2 * j]; mv[j] = k ? bz[j] : -INFINITY; }
        float ssum = 0.f, myS = 0.f; int myE = 0;
#pragma unroll 1
        for (int it = 0; it < 8; ++it) {
            float bv = mv[0], bs = s[0]; int be = lane;
#pragma unroll
            for (int j = 1; j < 4; ++j) if (mv[j] > bv) { bv = mv[j]; be = lane + 64 * j; bs = s[j]; }
#pragma unroll
            for (int o = 32; o >= 1; o >>= 1) { const float ov = __shfl_xor(bv, o), os = __shfl_xor(bs, o); const int oe = __shfl_xor(be, o); if (ov > bv || (ov == bv && oe < be)) { bv = ov; be = oe; bs = os; } }
#pragma unroll
            for (int j = 0; j < 4; ++j) if (be == lane + 64 * j) mv[j] = -INFINITY;
            if (lane == it) { myE = be; myS = bs; }
            ssum += bs;
        }
        if (lane < 8) { const int idx = tok * 8 + lane; TID[idx] = myE; TW[idx] = myS / ssum * 2.5f; TP[idx] = (int)atomicAdd(&CNT[myE], 1u); }
    }
}
DEVI void phase12(const Params& p, LAS unsigned char* lds, int part) {
    if (part == 0) {
    LAS int* T = (LAS int*)(lds + LDS_TAB);
    moe_tables((const unsigned*)(p.ws + WS_CNT), T);
    const int* TID = (const int*)(p.ws + WS_TOPK_ID); const int* TP = (const int*)(p.ws + WS_TOPK_POS); const float* TW = (const float*)(p.ws + WS_TOPK_W); u32x2* SL = (u32x2*)(p.ws + WS_SLOT);
    for (int idx = blockIdx.x * 512 + threadIdx.x; idx < NTOK * 8; idx += gridDim.x * 512) { u32x2 rec; rec.x = (unsigned)idx; rec.y = __float_as_uint(TW[idx]); SL[T[256 + TID[idx]] + TP[idx]] = rec; }
    return; }
    LAS float* tb = (LAS float*)lds;
    for (int t = blockIdx.x; t < 256 * 48; t += gridDim.x) {
        const int e = t / 48, r = t % 48;
        if (r < 16)      conv_tile(p.in[20] + (size_t)e * 262144, 256, 256, (bf16_t*)(p.ws + WS_EXPGU) + (size_t)e * 524288, 1024, r * 64, 0, 0, tb);
        else if (r < 32) conv_tile(p.in[21] + (size_t)e * 262144, 256, 256, (bf16_t*)(p.ws + WS_EXPGU) + (size_t)e * 524288, 1024, (r - 16) * 64, 0, 128, tb);
        else { const int kt = (r - 32) >> 2, nb = (r - 32) & 3; conv_tile(p.in[22] + (size_t)e * 262144 + nb * 256, 1024, 256, (bf16_t*)(p.ws + WS_EXPD) + (size_t)e * 262144, 256, kt * 64, nb * 256, -1, tb); }
    }
}
DEVI void phase15(const Params& p) {
    const int lane = threadIdx.x & 63, gw = blockIdx.x * 8 + (threadIdx.x >> 6), nw = gridDim.x * 8;
    const float* mod = (const float*)(p.ws + WS_MOD); const float* X1 = (const float*)(p.ws + WS_X1);
    for (int tok = gw; tok < NTOK; tok += nw) {
        const float* m = mod + (size_t)(tok >> 12) * 6144 + 5120; float v[2][8];
#pragma unroll
        for (int j = 0; j < 2; ++j) { const int cidx = lane * 8 + 512 * j; float a[8];
#pragma unroll
            for (int e = 0; e < 8; ++e) a[e] = 0.f;
#pragma unroll
            for (int k = 0; k < 9; ++k) { const u32x4 y = *(const u32x4*)((const bf16_t*)(p.ws + (k < 8 ? ws_y(k) : WS_Y8)) + (size_t)tok * 1024 + cidx);
                a[0] += bflo(y.x); a[1] += bfhi(y.x); a[2] += bflo(y.y); a[3] += bfhi(y.y); a[4] += bflo(y.z); a[5] += bfhi(y.z); a[6] += bflo(y.w); a[7] += bfhi(y.w); }
            const f32x4 g0 = *(const f32x4*)(m + cidx), g1 = *(const f32x4*)(m + cidx + 4), x0 = *(const f32x4*)(X1 + (size_t)tok * 1024 + cidx), x1 = *(const f32x4*)(X1 + (size_t)tok * 1024 + cidx + 4);
#if defined(DBG_NOMOE)
#pragma unroll
            for (int e = 0; e < 8; ++e) a[e] = 0.f;
#endif
#pragma unroll
            for (int e = 0; e < 4; ++e) { v[j][e] = x0[e] * 1.189207115f + g0[e] * a[e]; v[j][4 + e] = x1[e] * 1.189207115f + g1[e] * a[4 + e]; }
        }
        float sm = 0.f;
#pragma unroll
        for (int j = 0; j < 2; ++j)
#pragma unroll
            for (int e = 0; e < 8; ++e) sm += v[j][e];
        const float mu = wave_sum(sm) * (1.0f / 1024.0f); float q = 0.f;
#pragma unroll
        for (int j = 0; j < 2; ++j)
#pragma unroll
            for (int e = 0; e < 8; ++e) { v[j][e] -= mu; q += v[j][e] * v[j][e]; }
        const float rstd = rsqrtf(wave_sum(q) * (1.0f / 1024.0f) + 1e-6f);
#pragma unroll
        for (int j = 0; j < 2; ++j) { const int cidx = lane * 8 + 512 * j;
            const f32x4 g0 = *(const f32x4*)(p.in[26] + cidx), g1 = *(const f32x4*)(p.in[26] + cidx + 4), b0 = *(const f32x4*)(p.in[27] + cidx), b1 = *(const f32x4*)(p.in[27] + cidx + 4);
            f32x4 o0, o1;
#pragma unroll
            for (int e = 0; e < 4; ++e) { o0[e] = v[j][e] * rstd * g0[e] + b0[e]; o1[e] = v[j][4 + e] * rstd * g1[e] + b1[e]; }
            *(f32x4*)(p.out + (size_t)tok * 1024 + cidx) = o0; *(f32x4*)(p.out + (size_t)tok * 1024 + cidx + 4) = o1; }
    }
}

__global__ void __launch_bounds__(512, 2) mega(Params p) {
    extern __shared__ __attribute__((aligned(16))) unsigned char shm[];
    LAS unsigned char* lds = (LAS unsigned char*)shm;
    volatile LAS unsigned* xbw = (volatile LAS unsigned*)(lds + LDS_BARW);
    if (threadIdx.x == 0) { xbw[0] = 0u; xbw[1] = 0u; xbw[2] = 0u; xbw[3] = 0u; }
    __syncthreads();
    XcdBarrier bar; bar.bar = (unsigned*)(p.ws + WS_CTL); bar.x = 0; bar.st = xbw;
    const bool multi = (p.ph_hi - p.ph_lo) > 1;
    if (multi) bar = xcd_barrier_post((unsigned*)(p.ws + WS_CTL), xbw);
    unsigned char* ws = p.ws;
    const int G = gridDim.x, c = blockIdx.x;
#ifndef PHMASK
#define PHMASK 0xFFFF
#endif
#ifndef REPMASK
#define REPMASK 0
#endif
#define RUN(n) if (((PHMASK >> (n)) & 1) && p.ph_lo <= (n) && (n) < p.ph_hi)
#define SYNC(n) if (p.ph_lo <= (n) && (n) + 1 < p.ph_hi) xcd_barrier(bar); else __syncthreads()
    RUN(0) phase0(p, lds, 0);
#if (REPMASK >> 0) & 1
    __syncthreads();
    RUN(0) phase0(p, lds, 0);
#endif
    SYNC(0);
    RUN(1) { phase1(p); phase0(p, lds, 1); }
#if (REPMASK >> 1) & 1
    __syncthreads();
    RUN(1) { phase1(p); phase0(p, lds, 1); }
#endif
    SYNC(1);
    RUN(2) { SchedInProj S{ws, G, c}; EpiBf16 E; gemm_stream<SchedInProj, EpiBf16, false>(lds, S, E); }
#if (REPMASK >> 2) & 1
    __syncthreads();
    RUN(2) { SchedInProj S{ws, G, c}; EpiBf16 E; gemm_stream<SchedInProj, EpiBf16, false>(lds, S, E); }
#endif
    SYNC(2);
    RUN(3) phase3(p, lds);
#if (REPMASK >> 3) & 1
    __syncthreads();
    RUN(3) phase3(p, lds);
#endif
    SYNC(3);
    RUN(4) { if (c & 1) { phase4_na(p, lds); __syncthreads(); phase4_gla(p, lds); } else { phase4_gla(p, lds); __syncthreads(); phase4_na(p, lds); } }
    SYNC(4);
    RUN(5) phase5(p);
#if (REPMASK >> 5) & 1
    __syncthreads();
    RUN(5) phase5(p);
#endif
    SYNC(5);
#if (REPMASK >> 6) & 1
    __syncthreads();
#endif
    RUN(7) { SchedDense S{(const char*)(ws + WS_AP), (const char*)(ws + WS_BT_BR), (char*)(ws + WS_YM), 1536, G, c, 3072u, 3072u, 24}; EpiBranchC E{(const bf16_t*)(ws + WS_SGA), (const bf16_t*)(ws + WS_SGB), (bf16_t*)(ws + WS_YM)}; gemm_stream<SchedDense, EpiBranchC, false>(lds, S, E); }
#if (REPMASK >> 7) & 1
    __syncthreads();
    RUN(7) { SchedDense S{(const char*)(ws + WS_AP), (const char*)(ws + WS_BT_BR), (char*)(ws + WS_YM), 1536, G, c, 3072u, 3072u, 24}; EpiBranchC E{(const bf16_t*)(ws + WS_SGA), (const bf16_t*)(ws + WS_SGB), (bf16_t*)(ws + WS_YM)}; gemm_stream<SchedDense, EpiBranchC, false>(lds, S, E); }
#endif
    SYNC(7);
    RUN(8) { SchedDense S{(const char*)(ws + WS_YM), (const char*)(ws + WS_BT_OUT), (char*)(ws + WS_Z), 1024, G, c, 2048u, 2048u, 16}; EpiBf16 E; gemm_stream<SchedDense, EpiBf16, false>(lds, S, E); }
#if (REPMASK >> 8) & 1
    __syncthreads();
    RUN(8) { SchedDense S{(const char*)(ws + WS_YM), (const char*)(ws + WS_BT_OUT), (char*)(ws + WS_Z), 1024, G, c, 2048u, 2048u, 16}; EpiBf16 E; gemm_stream<SchedDense, EpiBf16, false>(lds, S, E); }
#endif
    SYNC(8);
    RUN(9) phase9(p);
#if (REPMASK >> 9) & 1
    __syncthreads();
    RUN(9) phase9(p);
#endif
    SYNC(9);
    RUN(10) { SchedRouter S{ws, G, c}; EpiF32 E; gemm_stream<SchedRouter, EpiF32, false>(lds, S, E); }
#if (REPMASK >> 10) & 1
    __syncthreads();
    RUN(10) { SchedRouter S{ws, G, c}; EpiF32 E; gemm_stream<SchedRouter, EpiF32, false>(lds, S, E); }
#endif
    SYNC(10);
    RUN(11) { if (c & 1) phase12(p, lds, 1); phase11(p); if (!(c & 1)) phase12(p, lds, 1); }
#if (REPMASK >> 11) & 1
    __syncthreads();
    RUN(11) { if (c & 1) phase12(p, lds, 1); phase11(p); if (!(c & 1)) phase12(p, lds, 1); }
#endif
    SYNC(11);
    RUN(12) phase12(p, lds, 0);
#if (REPMASK >> 12) & 1
    __syncthreads();
    RUN(12) phase12(p, lds, 0);
#endif
    SYNC(12);
    RUN(13) { LAS int* T = (LAS int*)(lds + LDS_TAB); moe_tables((const unsigned*)(ws + WS_CNT), T); SchedGateUp S{ws, T, G, c}; EpiGateUp E{(bf16_t*)(ws + WS_HID)}; gemm_stream<SchedGateUp, EpiGateUp, true>(lds, S, E); }
#if (REPMASK >> 13) & 1
    __syncthreads();
    RUN(13) { LAS int* T = (LAS int*)(lds + LDS_TAB); moe_tables((const unsigned*)(ws + WS_CNT), T); SchedGateUp S{ws, T, G, c}; EpiGateUp E{(bf16_t*)(ws + WS_HID)}; gemm_stream<SchedGateUp, EpiGateUp, true>(lds, S, E); }
#endif
    SYNC(13);
    RUN(14) { LAS int* T = (LAS int*)(lds + LDS_TAB); moe_tables((const unsigned*)(ws + WS_CNT), T); SchedDown S{ws, T, G, c}; EpiDown E{ws, (const u32x2*)(ws + WS_SLOT), (const float*)(ws + WS_TOPK_W)}; gemm_stream<SchedDown, EpiDown, false>(lds, S, E); }
#if (REPMASK >> 14) & 1
    __syncthreads();
    RUN(14) { LAS int* T = (LAS int*)(lds + LDS_TAB); moe_tables((const unsigned*)(ws + WS_CNT), T); SchedDown S{ws, T, G, c}; EpiDown E{ws, (const u32x2*)(ws + WS_SLOT), (const float*)(ws + WS_TOPK_W)}; gemm_stream<SchedDown, EpiDown, false>(lds, S, E); }
#endif
    SYNC(14);
    RUN(15) phase15(p);
#if (REPMASK >> 15) & 1
    __syncthreads();
    RUN(15) phase15(p);
#endif
}

#ifdef DBG_STOP
__global__ void dbg_dump(const unsigned short* base, size_t nwords, float* out, int accumulate) {
    for (size_t i = (size_t)blockIdx.x * blockDim.x + threadIdx.x; i < (size_t)33554432; i += (size_t)gridDim.x * blockDim.x) {
        float s = accumulate ? out[i] : 0.f;
        for (size_t j = i; j < nwords; j += (size_t)33554432) s += (float)base[j];
        out[i] = s;
    }
}
#endif
}

extern "C" void kernel_launch(void* const* d_in, const int* in_sizes, int n_in, void* d_out, int out_size, void* d_ws, size_t ws_size, hipStream_t stream) {
    static int grid = 0;
    if (grid == 0) {
        if (n_in != 28 || out_size != NTOK * 1024 || ws_size < WS_END) { fprintf(stderr, "kernel_launch: unexpected problem (n_in %d out %d ws %zu)\n", n_in, out_size, ws_size); grid = -1; return; }
        int dev = 0, cus = 0, per_cu = 0;
        if (hipGetDevice(&dev) != hipSuccess || hipDeviceGetAttribute(&cus, hipDeviceAttributeMultiprocessorCount, dev) != hipSuccess) { grid = -1; return; }
        if (hipFuncSetAttribute((const void*)mega, hipFuncAttributeMaxDynamicSharedMemorySize, LDS_TOTAL) != hipSuccess) { fprintf(stderr, "kernel_launch: hipFuncSetAttribute failed\n"); grid = -1; return; }
        if (hipOccupancyMaxActiveBlocksPerMultiprocessor(&per_cu, (const void*)mega, 512, LDS_TOTAL) != hipSuccess || per_cu < 1) fprintf(stderr, "kernel_launch: occupancy query says %d\n", per_cu);
        (void)hipGetLastError();
        grid = cus;
    }
    if (grid < 0) return;
    (void)hipMemsetAsync((char*)d_ws + WS_CTL, 0, 32768, stream);
    Params p{};
    for (int i = 0; i < 28; ++i) p.in[i] = (const float*)d_in[i];
    p.out = (float*)d_out; p.ws = (unsigned char*)d_ws;
#ifdef DBG_STOP
    for (int ph = 0; ph <= DBG_STOP; ++ph) { p.ph_lo = ph; p.ph_hi = ph + 1; hipLaunchKernelGGL(mega, dim3(grid), dim3(512), LDS_TOTAL, stream, p); }
    { const size_t regs[][2] = { DBG_REGS }; int first = 1;
      for (auto& r : regs) { hipLaunchKernelGGL(dbg_dump, dim3(2048), dim3(256), 0, stream, (const unsigned short*)((char*)d_ws + r[0] * MiB), (size_t)(r[1] * MiB / 2), (float*)d_out, first ? 0 : 1); first = 0; } }
#elif MK_PER_PHASE
    for (int ph = 0; ph < NPH; ++ph) {
#if defined(DBG_NOMOE)
        if (ph >= 10 && ph <= 14) continue;
#endif
        p.ph_lo = ph; p.ph_hi = ph + 1; hipLaunchKernelGGL(mega, dim3(grid), dim3(512), LDS_TOTAL, stream, p); }
#else
    p.ph_lo = 0; p.ph_hi = NPH; hipLaunchKernelGGL(mega, dim3(grid), dim3(512), LDS_TOTAL, stream, p);
#endif
}
```

```cpp
#include <hip/hip_runtime.h>
#include <stdint.h>
#include <stdio.h>

#ifndef MK_PER_PHASE
#define MK_PER_PHASE 0
#endif

namespace {
typedef unsigned short bf16_t;
typedef short bf16x8 __attribute__((ext_vector_type(8)));
typedef float f32x4 __attribute__((ext_vector_type(4)));
typedef unsigned u32x4 __attribute__((ext_vector_type(4)));
typedef unsigned u32x2 __attribute__((ext_vector_type(2)));
#define LAS __attribute__((address_space(3)))
#define DEVI __device__ __forceinline__

constexpr int NTOK = 32768, NROW = 34816, NPH = 16;
constexpr size_t MiB = 1ull << 20;
constexpr int LDS_TOTAL = 160 * 1024;
constexpr int LDS_BARW = LDS_TOTAL - 16;
constexpr int LDS_TAB = 131072;

constexpr size_t WS_CTL = 0, WS_CNT = 16384, WS_MOD = 1 * MiB, WS_EE = 2 * MiB, WS_TOPK_ID = 5 * MiB, WS_TOPK_W = 6 * MiB, WS_TOPK_POS = 7 * MiB, WS_SLOT = 8 * MiB;
constexpr size_t WS_BT_IN = 10 * MiB, WS_BT_BR = 24 * MiB  , WS_BT_OUT = 27 * MiB, WS_BT_RT = 29 * MiB, WS_BT_SHGU = 30 * MiB, WS_BT_SHD = 31 * MiB;
constexpr size_t WS_H = 32 * MiB, WS_QA = 100 * MiB, WS_KA = 132 * MiB, WS_QB = 166 * MiB, WS_KB = 198 * MiB, WS_GB = 232 * MiB, WS_SGA = 296 * MiB, WS_SGB = 360 * MiB;
constexpr size_t WS_VAT = 424 * MiB, WS_VBT = 458 * MiB, WS_QTF = 526 * MiB, WS_QTB = 558 * MiB, WS_KTF = 590 * MiB, WS_KTB = 624 * MiB, WS_KTTF = 658 * MiB, WS_KTTB = 692 * MiB;
constexpr size_t WS_OF = 726 * MiB, WS_OB = 790 * MiB, WS_AP = 896 * MiB, WS_LRT = 888 * MiB;
constexpr size_t WS_YM = 424 * MiB, WS_Z = 488 * MiB;
constexpr size_t WS_X1 = 32 * MiB, WS_H2 = 160 * MiB, WS_LOG0 = 224 * MiB, WS_LOG1 = 256 * MiB, WS_EXPD = 288 * MiB, WS_EXPGU = 416 * MiB, WS_HID = 672 * MiB;
constexpr size_t WS_Y8 = 945 * MiB, WS_END = 1009 * MiB;
DEVI size_t ws_y(int k) { return (k < 2 ? 160 + 64 * (size_t)k : (k < 6 ? 416 + 64 * (size_t)(k - 2) : 817 + 64 * (size_t)(k - 6))) * MiB; }

struct Params { const float* in[28]; float* out; unsigned char* ws; int ph_lo, ph_hi; };

typedef __bf16 bf16x2_t __attribute__((ext_vector_type(2)));
typedef float f32x2_t __attribute__((ext_vector_type(2)));
DEVI unsigned pk_bf16(float lo, float hi) { const f32x2_t v = {lo, hi}; const bf16x2_t r = __builtin_convertvector(v, bf16x2_t); return __builtin_bit_cast(unsigned, r); }
DEVI float bf2f(bf16_t b) { return __uint_as_float(((unsigned)b) << 16); }
DEVI float bflo(unsigned w) { return __uint_as_float(w << 16); }
DEVI float bfhi(unsigned w) { return __uint_as_float(w & 0xffff0000u); }
DEVI bf16_t f2bf(float f) { return (bf16_t)(pk_bf16(f, 0.f) & 0xffffu); }
DEVI float sigmoidf_(float x) { return __builtin_amdgcn_rcpf(1.0f + __expf(-x)); }
template <int N> struct IC { static constexpr int v = N; };
DEVI void lds_barrier() { asm volatile("s_waitcnt lgkmcnt(0)" ::: "memory"); __builtin_amdgcn_s_barrier(); asm volatile("" ::: "memory"); }
DEVI float wave_sum(float v) { v += __shfl_xor(v, 32); v += __shfl_xor(v, 16); v += __shfl_xor(v, 8); v += __shfl_xor(v, 4); v += __shfl_xor(v, 2); v += __shfl_xor(v, 1); return v; }

#define XB_TMO      128
#define XB_XCNT(j)  (256  + 64 * (j))
#define XB_XSUB(j)  (1280 + 64 * (j))
#define XB_XGEN(j)  (2304 + 64 * (j))
#define XB_TOP      3328
#define XB_TOPGEN   3392
#define XCD_BAR_WORDS 3456
#define XB_SPIN_CAP (1u << 22)
DEVI unsigned xb_ld(unsigned* p)              { return __hip_atomic_load(p, __ATOMIC_RELAXED, __HIP_MEMORY_SCOPE_AGENT); }
DEVI unsigned xb_add(unsigned* p, unsigned v) { return __hip_atomic_fetch_add(p, v, __ATOMIC_RELAXED, __HIP_MEMORY_SCOPE_AGENT); }
DEVI unsigned xb_xcc_id() { return (unsigned)__builtin_amdgcn_s_getreg((3 << 11) | 20) & 0xFu; }
#define XB_SPIN(cond, bar) do { unsigned _sp = 0; while (cond) { __builtin_amdgcn_s_sleep(1); \
    if ((++_sp & 255u) == 0u) { if (xb_ld(&(bar)[XB_TMO])) break; if (_sp > XB_SPIN_CAP) { atomicAdd(&(bar)[XB_TMO], 1u); break; } } } } while (0)
struct XcdBarrier { unsigned* bar; unsigned x; volatile LAS unsigned* st; };
DEVI XcdBarrier xcd_barrier_post(unsigned* bar, volatile LAS unsigned* st) {
    XcdBarrier b; b.bar = bar; b.x = xb_xcc_id(); b.st = st;
    if (threadIdx.x == 0) (void)xb_add(&bar[XB_XCNT(b.x)], 1u);
    return b;
}
DEVI void xcd_barrier_complete(unsigned* bar, unsigned x, unsigned& nloc, unsigned& nx) {
    const unsigned G = gridDim.x * gridDim.y * gridDim.z;
    unsigned sum, cnt, mine, sp = 0u;
    for (;;) {
        sum = 0u; cnt = 0u; mine = 0u;
#pragma unroll
        for (unsigned j = 0; j < 16; ++j) { const unsigned c = xb_ld(&bar[XB_XCNT(j)]); sum += c; cnt += (c > 0u) ? 1u : 0u; mine = (j == x) ? c : mine; }
        if (sum == G) break;
        __builtin_amdgcn_s_sleep(1);
        if ((++sp & 255u) == 0u) { if (xb_ld(&bar[XB_TMO])) break; if (sp > XB_SPIN_CAP) { atomicAdd(&bar[XB_TMO], 1u); break; } }
    }
    nloc = mine > 0u ? mine : 1u; nx = cnt > 0u ? cnt : 1u;
}
DEVI void xcd_barrier(const XcdBarrier& b) {
    asm volatile("s_waitcnt vmcnt(0)" ::: "memory");
    __syncthreads();
    if (threadIdx.x == 0) {
        unsigned* bar = b.bar;
        __builtin_amdgcn_s_waitcnt(0);
        unsigned nloc = b.st[0], nx = b.st[1];
        if (nloc == 0u) { xcd_barrier_complete(bar, b.x, nloc, nx); b.st[0] = nloc; b.st[1] = nx; }
        const unsigned old = xb_add(&bar[XB_XSUB(b.x)], 1u);
        const unsigned gen = old / nloc;
        if (old + 1u == (gen + 1u) * nloc) {
            __builtin_amdgcn_fence(__ATOMIC_RELEASE, "agent");
            asm volatile("s_waitcnt vmcnt(0)" ::: "memory");
            const unsigned og = xb_add(&bar[XB_TOP], 1u);
            const unsigned tg = og / nx;
            if (og + 1u == (tg + 1u) * nx) xb_add(&bar[XB_TOPGEN], 1u);
            else XB_SPIN(xb_ld(&bar[XB_TOPGEN]) == tg, bar);
            __builtin_amdgcn_fence(__ATOMIC_ACQUIRE, "agent");
            xb_add(&bar[XB_XGEN(b.x)], 1u);
            asm volatile("s_waitcnt vmcnt(0)" ::: "memory");
        } else {
            XB_SPIN(xb_ld(&bar[XB_XGEN(b.x)]) == gen, bar);
            __builtin_amdgcn_fence(__ATOMIC_ACQUIRE, "agent");
            asm volatile("s_waitcnt vmcnt(0)" ::: "memory");
        }
    }
    __syncthreads();
}

constexpr int BK = 64, HALF = 128, HTB = HALF * BK * 2;
DEVI int lds_byte(int r, int c) { const int st = (r >> 4) * 2 + (c >> 5), rr = r & 15, cc = c & 31, ob = rr * 64 + cc * 2; return st * 1024 + (ob ^ (((ob >> 9) & 1) << 5)); }
DEVI void stage_rc(int b, int& R, int& C) { const int st = b / 1024, sb = b % 1024, swz = sb ^ (((sb >> 9) & 1) << 5); R = (st >> 1) * 16 + swz / 64; C = (st & 1) * 32 + (swz % 64) / 2; }
DEVI int perm32(int rho) { const int n = rho >> 4, i = rho & 15; return 8 * (i >> 2) + 4 * n + (i & 3); }

struct GUnit {
    const char* a; const char* b;
    char* dst; int ldd; int i0, i1, i2; float f0;
};
typedef f32x4 Acc[2][2][4][2];
#define ZA1(a, b, m) acc[a][b][m][0] = z; acc[a][b][m][1] = z;
#define ZA2(a, b) ZA1(a, b, 0) ZA1(a, b, 1) ZA1(a, b, 2) ZA1(a, b, 3)
DEVI void zero_acc(Acc& acc) { f32x4 z = {0.f, 0.f, 0.f, 0.f}; asm volatile("" : "+v"(z)); ZA2(0, 0) ZA2(0, 1) ZA2(1, 0) ZA2(1, 1) }

template <class Sched, class Epi, bool GATHER>
DEVI void gemm_stream(LAS unsigned char* lds, const Sched& S, const Epi& E) {
    const int tid = threadIdx.x, wid = __builtin_amdgcn_readfirstlane(tid >> 6), lane = tid & 63, wr = wid >> 2, wc = wid & 3, fr = lane & 15, fq = lane >> 4;
    const unsigned lda = S.lda, ldb = S.ldb; const int nt = S.nt;
    unsigned voffA[2], voffB[2]; int R0 = 0;
#pragma unroll
    for (int i = 0; i < 2; ++i) { int R, C; stage_rc(tid * 16 + i * 8192, R, C); const int Rb = (R & ~31) + perm32(R & 31);
        if (i == 0) R0 = R;
        voffA[i] = GATHER ? (unsigned)(C * 2) : (unsigned)R * lda + (unsigned)(C * 2); voffB[i] = (unsigned)Rb * ldb + (unsigned)(C * 2); }
    const size_t kstep = (size_t)(BK * 2);
    const size_t hstepA = GATHER ? (size_t)0 : (size_t)HALF * lda, hstepB = (size_t)HALF * ldb;
    const unsigned ldsw = (unsigned)wid * 1024u;
    const int aoff = lds_byte(wr * 64 + fr, fq * 8), boff = lds_byte(wc * 32 + fr, fq * 8);
#define G_SA(b, h) (((b) * 2 + (h)) * HTB)
#define G_SB(b, h) ((4 + (b) * 2 + (h)) * HTB)
#define G_STAGE(bufoff, gbase, o0, o1) do { \
        __builtin_amdgcn_global_load_lds((const unsigned*)((const char*)(gbase) + (o0)), (LAS unsigned*)(lds + (bufoff) + ldsw), 16, 0, 0); \
        __builtin_amdgcn_global_load_lds((const unsigned*)((const char*)(gbase) + (o1)), (LAS unsigned*)(lds + (bufoff) + ldsw + 8192), 16, 0, 0); } while (0)
#define G_LDA(dst, b, h) do { _Pragma("unroll") for (int m = 0; m < 4; ++m) _Pragma("unroll") for (int k = 0; k < 2; ++k) dst[m][k] = *(const LAS bf16x8*)(lds + G_SA(b, h) + aoff + m * 2048 + k * 1024); } while (0)
#define G_LDB(dst, b, h) do { _Pragma("unroll") for (int n = 0; n < 2; ++n) _Pragma("unroll") for (int k = 0; k < 2; ++k) dst[n][k] = *(const LAS bf16x8*)(lds + G_SB(b, h) + boff + n * 2048 + k * 1024); } while (0)
#define G_MMA(ai, bj, At, Bt) do { __builtin_amdgcn_s_setprio(1); _Pragma("unroll") for (int m = 0; m < 4; ++m) _Pragma("unroll") for (int n = 0; n < 2; ++n) _Pragma("unroll") for (int k = 0; k < 2; ++k) \
        acc[ai][bj][m][n] = __builtin_amdgcn_mfma_f32_16x16x32_bf16(Bt[n][k], At[m][k], acc[ai][bj][m][n], 0, 0, 0); __builtin_amdgcn_s_setprio(0); } while (0)
#define G_WAIT_V(n) asm volatile("s_waitcnt vmcnt(" #n ")" ::: "memory")
#define G_WAIT_L(n) asm volatile("s_waitcnt lgkmcnt(" #n ")" ::: "memory")
#define G_BAR __builtin_amdgcn_s_barrier()
#define G_SCHED __builtin_amdgcn_sched_barrier(0)
    GUnit cur, nxt; int ui = 0;
    if (!S.next(0, cur)) return;
    unsigned gc[2][2], gn[2][2];
    gc[0][0] = voffA[0]; gc[0][1] = voffA[1]; gc[1][0] = voffA[0]; gc[1][1] = voffA[1];
    gn[0][0] = voffA[0]; gn[0][1] = voffA[1]; gn[1][0] = voffA[0]; gn[1][1] = voffA[1];
    if constexpr (GATHER) { S.gather(cur, R0, gc); gc[0][0] += voffA[0]; gc[0][1] += voffA[0]; gc[1][0] += voffA[0]; gc[1][1] += voffA[0]; }
    Acc acc; zero_acc(acc);
    typename Epi::Pre pre; E.pre(cur, wr, lane, pre);
    bf16x8 At[4][2], B0[2][2], B1[2][2];
    const char* cA = cur.a; const char* cB = cur.b;
    G_STAGE(G_SB(0, 0), cB, voffB[0], voffB[1]); G_STAGE(G_SA(0, 0), cA, gc[0][0], gc[0][1]); G_STAGE(G_SB(0, 1), cB + hstepB, voffB[0], voffB[1]); G_STAGE(G_SA(0, 1), cA + hstepA, gc[1][0], gc[1][1]);
    if (wr == 1) G_BAR;
    G_WAIT_V(4); G_BAR;
    G_STAGE(G_SB(1, 0), cB + kstep, voffB[0], voffB[1]); G_STAGE(G_SA(1, 0), cA + kstep, gc[0][0], gc[0][1]); G_STAGE(G_SB(1, 1), cB + hstepB + kstep, voffB[0], voffB[1]);
    G_WAIT_V(6); G_BAR;
    for (;;) {
        const bool has_next = S.next(ui + 1, nxt);
        const char* nA = has_next ? nxt.a : cA; const char* nB = has_next ? nxt.b : cB;
        for (int t = 0; t < nt; t += 2) {
            const bool last = (t == nt - 2);
            const char* a1 = cA + (size_t)(t + 1) * kstep;
            const char* a2 = last ? nA : cA + (size_t)(t + 2) * kstep; const char* b2 = last ? nB : cB + (size_t)(t + 2) * kstep;
            const char* a3 = a2 + kstep; const char* b3 = b2 + kstep;
            unsigned g2[2][2];
            if constexpr (GATHER) { g2[0][0] = last ? gn[0][0] : gc[0][0]; g2[0][1] = last ? gn[0][1] : gc[0][1]; g2[1][0] = last ? gn[1][0] : gc[1][0]; g2[1][1] = last ? gn[1][1] : gc[1][1]; }
            else { g2[0][0] = voffA[0]; g2[0][1] = voffA[1]; g2[1][0] = voffA[0]; g2[1][1] = voffA[1]; }
            if constexpr (GATHER) { if (t == nt - 4) {
                if (has_next) { S.gather(nxt, R0, gn); gn[0][0] += voffA[0]; gn[0][1] += voffA[0]; gn[1][0] += voffA[0]; gn[1][1] += voffA[0]; }
                else { gn[0][0] = gc[0][0]; gn[0][1] = gc[0][1]; gn[1][0] = gc[1][0]; gn[1][1] = gc[1][1]; } } }
            if constexpr (Epi::MID_T > 0) { if (t == Epi::MID_T) { int tz = threadIdx.x; asm volatile("" : "+v"(tz)); const int wz = tz >> 6, lz = tz & 63; E.mid(acc, cur, wz >> 2, wz & 3, lz & 15, lz >> 4); } }
            G_LDB(B0, 0, 0); G_SCHED; G_LDA(At, 0, 0); G_STAGE(G_SA(1, 1), a1 + hstepA, gc[1][0], gc[1][1]);
            G_WAIT_L(8); G_BAR; G_WAIT_L(0); G_MMA(0, 0, At, B0); G_BAR; G_SCHED;
            G_LDB(B1, 0, 1); G_STAGE(G_SB(0, 0), b2, voffB[0], voffB[1]);
            G_BAR; G_WAIT_L(0); G_MMA(0, 1, At, B1); G_BAR;
            G_LDA(At, 0, 1); G_STAGE(G_SA(0, 0), a2, g2[0][0], g2[0][1]);
            G_BAR; G_WAIT_L(0); G_MMA(1, 0, At, B0); G_BAR; G_SCHED;
            G_STAGE(G_SB(0, 1), b2 + hstepB, voffB[0], voffB[1]);
            G_WAIT_V(6); G_BAR; G_MMA(1, 1, At, B1); G_BAR;
            G_LDB(B0, 1, 0); G_SCHED; G_LDA(At, 1, 0); G_STAGE(G_SA(0, 1), a2 + hstepA, g2[1][0], g2[1][1]);
            G_WAIT_L(8); G_BAR; G_WAIT_L(0); G_MMA(0, 0, At, B0); G_BAR; G_SCHED;
            G_LDB(B1, 1, 1); G_STAGE(G_SB(1, 0), b3, voffB[0], voffB[1]);
            G_BAR; G_WAIT_L(0); G_MMA(0, 1, At, B1); G_BAR;
            G_LDA(At, 1, 1); G_STAGE(G_SA(1, 0), a3, g2[0][0], g2[0][1]);
            G_BAR; G_WAIT_L(0); G_MMA(1, 0, At, B0); G_BAR; G_SCHED;
            G_STAGE(G_SB(1, 1), b3 + hstepB, voffB[0], voffB[1]);
            G_WAIT_V(6); G_BAR; G_MMA(1, 1, At, B1); G_BAR;
        }
        { int tz = threadIdx.x; asm volatile("" : "+v"(tz)); const int wz = tz >> 6, lz = tz & 63; E(acc, cur, wz >> 2, wz & 3, lz & 15, lz >> 4, pre); }
        if (!has_next) break;
        zero_acc(acc);
        cur = nxt; cA = nA; cB = nB; ++ui;
        E.pre(cur, wr, lane, pre);
        if constexpr (GATHER) { gc[0][0] = gn[0][0]; gc[0][1] = gn[0][1]; gc[1][0] = gn[1][0]; gc[1][1] = gn[1][1]; }
    }
    G_WAIT_V(0);
    if (wr == 0) G_BAR;
    G_BAR;
}

struct EpiBf16 { static constexpr int MID_T = 0; DEVI void mid(Acc&, const GUnit&, int, int, int, int) const {}
    struct Pre {}; DEVI void pre(const GUnit&, int, int, Pre&) const {}
    DEVI void operator()(const Acc& acc, const GUnit& u, int wr, int wc, int fr, int fq, const Pre&) const {
        if (u.f0 < 0.f) {
            float* fb = (float*)u.dst;
#pragma unroll
            for (int m = 0; m < 4; ++m) { const int row = wr * 64 + m * 16 + fr;
                if (row < 32) { float* rp = fb + (size_t)row * u.ldd + wc * 32 + 8 * fq;
#pragma unroll
                    for (int bj = 0; bj < 2; ++bj) { *(f32x4*)(rp + bj * 128) = acc[0][bj][m][0]; *(f32x4*)(rp + bj * 128 + 4) = acc[0][bj][m][1]; } } }
            return;
        }
        bf16_t* base = (bf16_t*)u.dst; const float s = u.f0; const int act = u.i0;
#pragma unroll
        for (int ai = 0; ai < 2; ++ai)
#pragma unroll
            for (int m = 0; m < 4; ++m) {
                bf16_t* rp = base + (size_t)(ai * 128 + wr * 64 + m * 16 + fr) * u.ldd + wc * 32 + 8 * fq;
#pragma unroll
                for (int bj = 0; bj < 2; ++bj) {
                    f32x4 v0 = acc[ai][bj][m][0] * s, v1 = acc[ai][bj][m][1] * s;
                    if (act) {
#pragma unroll
                        for (int j = 0; j < 4; ++j) { v0[j] = sigmoidf_(v0[j]); v1[j] = sigmoidf_(v1[j]); }
                    }
                    u32x4 w; w.x = pk_bf16(v0[0], v0[1]); w.y = pk_bf16(v0[2], v0[3]); w.z = pk_bf16(v1[0], v1[1]); w.w = pk_bf16(v1[2], v1[3]);
                    *(u32x4*)(rp + bj * 128) = w;
                }
            }
    }
};
struct EpiF32 { static constexpr int MID_T = 0; DEVI void mid(Acc&, const GUnit&, int, int, int, int) const {}
    struct Pre {}; DEVI void pre(const GUnit&, int, int, Pre&) const {}
    DEVI void operator()(const Acc& acc, const GUnit& u, int wr, int wc, int fr, int fq, const Pre&) const {
        float* base = (float*)u.dst;
#pragma unroll
        for (int ai = 0; ai < 2; ++ai)
#pragma unroll
            for (int m = 0; m < 4; ++m) {
                float* rp = base + (size_t)(ai * 128 + wr * 64 + m * 16 + fr) * u.ldd + wc * 32 + 8 * fq;
#pragma unroll
                for (int bj = 0; bj < 2; ++bj) { *(f32x4*)(rp + bj * 128) = acc[ai][bj][m][0]; *(f32x4*)(rp + bj * 128 + 4) = acc[ai][bj][m][1]; }
            }
    }
};
struct EpiBranchC {
    static constexpr int MID_T = 8;
    const bf16_t* sga; const bf16_t* sgb; bf16_t* ym;
    struct Pre {}; DEVI void pre(const GUnit&, int, int, Pre&) const {}
    DEVI void mid(Acc& acc, const GUnit& u, int wr, int wc, int fr, int fq) const {
#pragma unroll
        for (int ai = 0; ai < 2; ++ai)
#pragma unroll
            for (int m = 0; m < 4; ++m) {
                const size_t ro = (size_t)(u.i1 + ai * 128 + wr * 64 + m * 16 + fr) * 1024 + u.i2 + wc * 32 + 8 * fq;
#pragma unroll
                for (int bj = 0; bj < 2; ++bj) {
                    const u32x4 ga = *(const u32x4*)(sga + ro + bj * 128), gb = *(const u32x4*)(sgb + ro + bj * 128);
                    f32x4 r0, r1;
                    r0[0] = bflo(ga.x) * __builtin_amdgcn_rcpf(bflo(gb.x)); r0[1] = bfhi(ga.x) * __builtin_amdgcn_rcpf(bfhi(gb.x)); r0[2] = bflo(ga.y) * __builtin_amdgcn_rcpf(bflo(gb.y)); r0[3] = bfhi(ga.y) * __builtin_amdgcn_rcpf(bfhi(gb.y));
                    r1[0] = bflo(ga.z) * __builtin_amdgcn_rcpf(bflo(gb.z)); r1[1] = bfhi(ga.z) * __builtin_amdgcn_rcpf(bfhi(gb.z)); r1[2] = bflo(ga.w) * __builtin_amdgcn_rcpf(bflo(gb.w)); r1[3] = bfhi(ga.w) * __builtin_amdgcn_rcpf(bfhi(gb.w));
                    acc[ai][bj][m][0] = acc[ai][bj][m][0] * r0; acc[ai][bj][m][1] = acc[ai][bj][m][1] * r1;
                }
            }
    }
    DEVI void operator()(const Acc& acc, const GUnit& u, int wr, int wc, int fr, int fq, const Pre&) const {
#pragma unroll
        for (int ai = 0; ai < 2; ++ai)
#pragma unroll
            for (int m = 0; m < 4; ++m) {
                const size_t ro = (size_t)(u.i1 + ai * 128 + wr * 64 + m * 16 + fr) * 1024 + u.i2 + wc * 32 + 8 * fq;
#pragma unroll
                for (int bj = 0; bj < 2; ++bj) {
                    const u32x4 gb = *(const u32x4*)(sgb + ro + bj * 128);
                    const f32x4 v0 = acc[ai][bj][m][0], v1 = acc[ai][bj][m][1];
                    u32x4 w;
                    w.x = pk_bf16(bflo(gb.x) * v0[0], bfhi(gb.x) * v0[1]); w.y = pk_bf16(bflo(gb.y) * v0[2], bfhi(gb.y) * v0[3]);
                    w.z = pk_bf16(bflo(gb.z) * v1[0], bfhi(gb.z) * v1[1]); w.w = pk_bf16(bflo(gb.w) * v1[2], bfhi(gb.w) * v1[3]);
                    *(u32x4*)(ym + ro + bj * 128) = w;
                }
            }
    }
};
struct EpiGateUp { static constexpr int MID_T = 0; DEVI void mid(Acc&, const GUnit&, int, int, int, int) const {}
    bf16_t* hid;
    struct Pre {}; DEVI void pre(const GUnit&, int, int, Pre&) const {}
    DEVI void operator()(const Acc& acc, const GUnit& u, int wr, int wc, int fr, int fq, const Pre&) const {
#pragma unroll
        for (int ai = 0; ai < 2; ++ai)
#pragma unroll
            for (int m = 0; m < 4; ++m) {
                const int row = ai * 128 + wr * 64 + m * 16 + fr;
                if (row < u.i1) {
                    const f32x4 g0 = acc[ai][0][m][0], g1 = acc[ai][0][m][1], u0 = acc[ai][1][m][0], u1 = acc[ai][1][m][1];
                    float h[8];
#pragma unroll
                    for (int j = 0; j < 4; ++j) { h[j] = g0[j] * sigmoidf_(g0[j]) * u0[j]; h[4 + j] = g1[j] * sigmoidf_(g1[j]) * u1[j]; }
                    u32x4 w; w.x = pk_bf16(h[0], h[1]); w.y = pk_bf16(h[2], h[3]); w.z = pk_bf16(h[4], h[5]); w.w = pk_bf16(h[6], h[7]);
                    *(u32x4*)(hid + (size_t)(u.i0 + row) * 256 + u.i2 * 128 + wc * 32 + 8 * fq) = w;
                }
            }
    }
};
struct EpiDown { static constexpr int MID_T = 0; DEVI void mid(Acc&, const GUnit&, int, int, int, int) const {}
    unsigned char* ws; const u32x2* slot; const float* topw;
    struct Pre { unsigned r0, r1; };
    DEVI void pre(const GUnit& u, int wr, int lane, Pre& P) const {
        P.r0 = 0u; P.r1 = 0u;
        if (u.i2 == 0) { const int ra = wr * 64 + lane, rb = ra + 128; if (ra < u.i1) P.r0 = slot[u.i0 + ra].x; if (rb < u.i1) P.r1 = slot[u.i0 + rb].x; }
    }
    DEVI void operator()(const Acc& acc, const GUnit& u, int wr, int wc, int fr, int fq, const Pre& P) const {
#pragma unroll
        for (int ai = 0; ai < 2; ++ai)
#pragma unroll
            for (int m = 0; m < 4; ++m) {
                const int row = ai * 128 + wr * 64 + m * 16 + fr;
                const unsigned recx = (unsigned)__shfl((int)(ai ? P.r1 : P.r0), m * 16 + fr);
                if (row < u.i1) {
                    if (u.i2 == 0) {
                        const int tok = (int)(recx >> 3), k = (int)(recx & 7u); const float w = topw[recx];
                        bf16_t* rp = (bf16_t*)(ws + ws_y(k)) + (size_t)tok * 1024 + u.ldd + wc * 32 + 8 * fq;
#pragma unroll
                        for (int bj = 0; bj < 2; ++bj) {
                            const f32x4 v0 = acc[ai][bj][m][0] * w, v1 = acc[ai][bj][m][1] * w;
                            u32x4 o; o.x = pk_bf16(v0[0], v0[1]); o.y = pk_bf16(v0[2], v0[3]); o.z = pk_bf16(v1[0], v1[1]); o.w = pk_bf16(v1[2], v1[3]);
                            *(u32x4*)(rp + bj * 128) = o;
                        }
                    } else {
                        bf16_t* rp = (bf16_t*)(ws + WS_Y8) + (size_t)(u.i0 + row) * 1024 + u.ldd + wc * 32 + 8 * fq;
#pragma unroll
                        for (int bj = 0; bj < 2; ++bj) {
                            const f32x4 v0 = acc[ai][bj][m][0], v1 = acc[ai][bj][m][1];
                            u32x4 o; o.x = pk_bf16(v0[0], v0[1]); o.y = pk_bf16(v0[2], v0[3]); o.z = pk_bf16(v1[0], v1[1]); o.w = pk_bf16(v1[2], v1[3]);
                            *(u32x4*)(rp + bj * 128) = o;
                        }
                    }
                }
            }
    }
};

struct SchedInProj {
    unsigned char* ws; int G, c;
    static constexpr unsigned lda = 2048, ldb = 2048; static constexpr int nt = 16;
    DEVI bool next(int i, GUnit& u) const {
        const int L = i * G + c; if (L >= 3544) return false;
        u.i0 = 0; u.i1 = 0; u.i2 = 0; u.f0 = 1.0f;
        const char* H = (const char*)(ws + WS_H); const char* BT = (const char*)(ws + WS_BT_IN);
        int pm, pn;
        if (L < 2592) {
            if (L < 2560) { const int x = L & 7, q = L >> 3, blk = q >> 5, w = q & 31; pm = 16 * x + 8 * (blk & 1) + (w & 7); pn = 4 * (blk >> 1) + (w >> 3); }
            else { const int j = L - 2560, jn = j >> 3; pm = 128 + (j & 7); pn = jn < 2 ? 2 + jn : 4 + jn; }
            u.a = H + (size_t)pm * 256 * 2048; u.b = BT + (size_t)pn * 256 * 2048;
            size_t base; int ld, col;
            if (pn < 2)       { base = WS_QA; ld = 512; col = pn * 256; u.f0 = 0.125f; }
            else if (pn < 4)  { base = WS_KA; ld = 512; col = (pn - 2) * 256; }
            else if (pn < 6)  { base = WS_QB; ld = 512; col = (pn - 4) * 256; }
            else if (pn < 8)  { base = WS_KB; ld = 512; col = (pn - 6) * 256; }
            else if (pn < 12) { base = WS_GB; ld = 1024; col = (pn - 8) * 256; }
            else if (pn < 16) { base = WS_SGA; ld = 1024; col = (pn - 12) * 256; u.i0 = 1; }
            else              { base = WS_SGB; ld = 1024; col = (pn - 16) * 256; u.i0 = 1; }
            u.dst = (char*)(ws + base) + ((size_t)pm * 256 * ld + col) * 2; u.ldd = ld;
        } else {
            const int j = L - 2592, x = j & 7, q = j >> 3, tn = 17 * x + q / 7, wm = q % 7;
            u.a = BT + (size_t)(5120 + wm * 256) * 2048; u.b = H + (size_t)tn * 256 * 2048;
            u.dst = (wm < 2 ? (char*)(ws + WS_VAT) + ((size_t)(wm * 256) * NROW + tn * 256) * 2 : (wm < 6 ? (char*)(ws + WS_VBT) + ((size_t)((wm - 2) * 256) * NROW + tn * 256) * 2 : (char*)(ws + WS_LRT) + (size_t)(tn * 256) * 4));
            u.ldd = NROW; if (wm == 6) u.f0 = -1.0f;
        }
        return true;
    }
};
struct SchedDense {
    const char* A; const char* Bt; char* dst; int K; int G, c; unsigned lda, ldb; int nt;
    DEVI bool next(int i, GUnit& u) const {
        const int L = i * G + c; if (L >= 512) return false;
        const int x = L & 7, q = L >> 3, blk = q >> 5, w = q & 31, pm = 16 * x + 8 * blk + (w & 7), pn = w >> 3;
        u.a = A + (size_t)pm * 256 * K * 2; u.b = Bt + (size_t)pn * 256 * K * 2;
        u.dst = dst + ((size_t)pm * 256 * 1024 + pn * 256) * 2; u.ldd = 1024; u.i0 = 0; u.i1 = pm * 256; u.i2 = pn * 256; u.f0 = 1.0f;
        return true;
    }
};
struct SchedRouter {
    unsigned char* ws; int G, c;
    static constexpr unsigned lda = 2048, ldb = 2048; static constexpr int nt = 8;
    DEVI bool next(int i, GUnit& u) const {
        const int L = i * G + c; if (L >= 256) return false;
        const int x = L & 7, q = L >> 3, pm = 16 * x + (q >> 1), ks = q & 1;
        u.a = (const char*)(ws + WS_H2) + (size_t)pm * 256 * 2048 + ks * 1024; u.b = (const char*)(ws + WS_BT_RT) + ks * 1024;
        u.dst = (char*)(ws + (ks ? WS_LOG1 : WS_LOG0)) + (size_t)pm * 256 * 256 * 4; u.ldd = 256; u.i0 = 0; u.i1 = 0; u.i2 = 0; u.f0 = 1.0f;
        return true;
    }
};
DEVI void moe_tables(const unsigned* gcnt, LAS int* T) {
    if (threadIdx.x < 64) {
        const int l = threadIdx.x; int c[4], t[4];
#pragma unroll
        for (int k = 0; k < 4; ++k) { c[k] = (int)gcnt[4 * l + k]; t[k] = (c[k] + 255) >> 8; }
        const int sc = c[0] + c[1] + c[2] + c[3], st = t[0] + t[1] + t[2] + t[3];
        int ic = sc, it = st;
#pragma unroll
        for (int o = 1; o < 64; o <<= 1) { const int a = __shfl_up(ic, o), b = __shfl_up(it, o); if (l >= o) { ic += a; it += b; } }
        int bc = ic - sc, bt = it - st;
#pragma unroll
        for (int k = 0; k < 4; ++k) { T[4 * l + k] = c[k]; T[256 + 4 * l + k] = bc; T[513 + 4 * l + k] = bt; bc += c[k]; bt += t[k]; }
        if (l == 63) { T[256 + 256] = ic; T[513 + 256] = it; }
    }
    __syncthreads();
    {
        const int TRt = T[513 + 256];
        for (int t = threadIdx.x; t < TRt; t += 512) { int lo = 0, hi = 256; while (hi - lo > 1) { const int mid = (lo + hi) >> 1; if (T[513 + mid] <= t) lo = mid; else hi = mid; } T[770 + t] = lo; }
    }
    __syncthreads();
}
DEVI int moe_find(const LAS int* toff, int t) {
    int lo = 0, hi = 256;
#pragma unroll 1
    while (hi - lo > 1) { const int mid = (lo + hi) >> 1; if (toff[mid] <= t) lo = mid; else hi = mid; }
    return __builtin_amdgcn_readfirstlane(lo);
}
struct SchedGateUp {
    unsigned char* ws; const LAS int* T; int G, c;
    static constexpr unsigned lda = 2048, ldb = 2048; static constexpr int nt = 16;
    DEVI bool next(int i, GUnit& u) const {
        const int L = i * G + c; const int TR = __builtin_amdgcn_readfirstlane(T[513 + 256]);
        if (L >= 2 * TR + 256) return false;
        u.a = (const char*)(ws + WS_H2); u.dst = nullptr; u.ldd = 0; u.f0 = 1.0f;
        if (L < 2 * TR) {
            const int t = L >> 1, pn = L & 1, e = __builtin_amdgcn_readfirstlane(T[770 + t]), mt = t - __builtin_amdgcn_readfirstlane(T[513 + e]), cnt = __builtin_amdgcn_readfirstlane(T[e]);
            u.b = (const char*)(ws + WS_EXPGU) + ((size_t)e * 512 + pn * 256) * 2048;
            u.i0 = __builtin_amdgcn_readfirstlane(T[256 + e]) + mt * 256; u.i1 = min(256, cnt - mt * 256); u.i2 = pn;
        } else {
            const int j = L - 2 * TR, mt = j >> 1, pn = j & 1;
            u.b = (const char*)(ws + WS_BT_SHGU) + (size_t)(pn * 256) * 2048;
            u.i0 = 262144 + mt * 256; u.i1 = 256; u.i2 = pn;
        }
        return true;
    }
    DEVI void gather(const GUnit& u, int R0, unsigned (&g)[2][2]) const {
        const u32x2* slot = (const u32x2*)(ws + WS_SLOT);
#pragma unroll
        for (int h = 0; h < 2; ++h)
#pragma unroll
            for (int i = 0; i < 2; ++i) {
                const int s = u.i0 + h * 128 + R0 + 64 * i; int tok;
                if (u.i0 >= 262144) tok = s - 262144; else tok = (int)(slot[min(s, 262143)].x >> 3);
                g[h][i] = (unsigned)tok * 2048u;
            }
    }
};
struct SchedDown {
    unsigned char* ws; const LAS int* T; int G, c;
    static constexpr unsigned lda = 512, ldb = 512; static constexpr int nt = 4;
    DEVI bool next(int i, GUnit& u) const {
        const int L = i * G + c; const int TR = __builtin_amdgcn_readfirstlane(T[513 + 256]);
        if (L >= 4 * TR + 512) return false;
        u.dst = nullptr; u.f0 = 1.0f;
        if (L < 4 * TR) {
            const int t = L >> 2, pn = L & 3, e = __builtin_amdgcn_readfirstlane(T[770 + t]), mt = t - __builtin_amdgcn_readfirstlane(T[513 + e]), cnt = __builtin_amdgcn_readfirstlane(T[e]);
            const int s0 = __builtin_amdgcn_readfirstlane(T[256 + e]) + mt * 256;
            u.a = (const char*)(ws + WS_HID) + (size_t)s0 * 512; u.b = (const char*)(ws + WS_EXPD) + ((size_t)e * 1024 + pn * 256) * 512;
            u.i0 = s0; u.i1 = min(256, cnt - mt * 256); u.i2 = 0; u.ldd = pn * 256;
        } else {
            const int j = L - 4 * TR, mt = j >> 2, pn = j & 3;
            u.a = (const char*)(ws + WS_HID) + (size_t)(262144 + mt * 256) * 512; u.b = (const char*)(ws + WS_BT_SHD) + (size_t)(pn * 256) * 512;
            u.i0 = mt * 256; u.i1 = 256; u.i2 = 1; u.ldd = pn * 256;
        }
        return true;
    }
};

DEVI void conv_tile(const float* src, int ldsrc, int ncols, bf16_t* dst, int ldd, int k0, int row0, int ilv, LAS float* t) {
    const int tid = threadIdx.x;
    f32x4 v[8];
#pragma unroll
    for (int i = 0; i < 8; ++i) { const int f = tid + 512 * i, row = f >> 6, c4 = (f & 63) * 4;
        v[i] = (c4 < ncols) ? *(const f32x4*)(src + (size_t)(k0 + row) * ldsrc + c4) : (f32x4){0.f, 0.f, 0.f, 0.f}; }
#pragma unroll
    for (int i = 0; i < 8; ++i) { const int f = tid + 512 * i, row = f >> 6, c4 = (f & 63) * 4; LAS float* q = t + row * 257 + c4; q[0] = v[i][0]; q[1] = v[i][1]; q[2] = v[i][2]; q[3] = v[i][3]; }
    __syncthreads();
#pragma unroll
    for (int j = 0; j < 4; ++j) {
        const int p = tid + 512 * j, kp = p & 7, n = p >> 3;
        if (n < ncols) {
            const LAS float* q = t + (kp * 8) * 257 + n;
            u32x4 w; w.x = pk_bf16(q[0], q[257]); w.y = pk_bf16(q[2 * 257], q[3 * 257]); w.z = pk_bf16(q[4 * 257], q[5 * 257]); w.w = pk_bf16(q[6 * 257], q[7 * 257]);
            const int drow = row0 + (ilv >= 0 ? ((n >> 7) * 256 + (n & 127) + ilv) : n);
            *(u32x4*)(dst + (size_t)drow * ldd + k0 + kp * 8) = w;
        }
    }
    __syncthreads();
}

DEVI void phase0(const Params& p, LAS unsigned char* lds, int part) {
    const int tid = threadIdx.x, lane = tid & 63, wid = tid >> 6;
    unsigned char* ws = p.ws;
    const int NT_IN = 16 * (2 + 2 + 2 + 2 + 4 + 4 + 4 + 2 + 4 + 1);
    const int NT0 = NT_IN + 8 * 4 + 16 * 4 + 16 * 4 + 16 + 16 + 16 + 4 * 4;
    for (int u = (part == 0 ? (int)blockIdx.x : 192 + (int)blockIdx.x); u < (part == 0 ? 192 : 192 + NT0); u += gridDim.x) {
        if (u < 192) {
            LAS float* sc = (LAS float*)lds; LAS float* red = (LAS float*)(lds + 9 * 1024 * 4);
            for (int i = tid; i < 9216; i += 512) { const int r = i >> 10, k = i & 1023; const float v = r < 8 ? p.in[1][r * 1024 + k] : p.in[3][k]; sc[i] = v / (1.0f + __expf(-v)); }
            __syncthreads();
            const int n0 = u * 32, col = lane & 31, rsub = lane >> 5;
            float acc[9];
#pragma unroll
            for (int r = 0; r < 9; ++r) acc[r] = 0.f;
            for (int it = 0; it < 64; ++it) { const int k = it * 16 + wid * 2 + rsub; const float w = p.in[4][(size_t)k * 6144 + n0 + col];
#pragma unroll
                for (int r = 0; r < 9; ++r) acc[r] += sc[r * 1024 + k] * w; }
#pragma unroll
            for (int r = 0; r < 9; ++r) red[((wid * 2 + rsub) * 9 + r) * 32 + col] = acc[r];
            __syncthreads();
            if (tid < 288) { const int r = tid >> 5, cc = tid & 31; float s = 0.f; for (int g = 0; g < 16; ++g) s += red[(g * 9 + r) * 32 + cc];
                ((float*)(ws + WS_MOD))[r * 6144 + n0 + cc] = s + p.in[5][n0 + cc]; }
            __syncthreads();
        } else {
            int t = u - 192; LAS float* tb = (LAS float*)lds;
            if (t < NT_IN) {
                const int kt = t & 15; int jb = t >> 4;
                int c0, r0, nc = 256;
                if (jb < 2)       { c0 = 0 + jb * 256;             r0 = 0 + jb * 256; }
                else if (jb < 4)  { c0 = 512 + (jb - 2) * 256;     r0 = 512 + (jb - 2) * 256; }
                else if (jb < 6)  { c0 = 1536 + (jb - 4) * 256;    r0 = 1024 + (jb - 4) * 256; }
                else if (jb < 8)  { c0 = 2048 + (jb - 6) * 256;    r0 = 1536 + (jb - 6) * 256; }
                else if (jb < 12) { c0 = 3584 + (jb - 8) * 256;    r0 = 2048 + (jb - 8) * 256; }
                else if (jb < 16) { c0 = 4640 + (jb - 12) * 256;   r0 = 3072 + (jb - 12) * 256; }
                else if (jb < 20) { c0 = 5664 + (jb - 16) * 256;   r0 = 4096 + (jb - 16) * 256; }
                else if (jb < 22) { c0 = 1024 + (jb - 20) * 256;   r0 = 5120 + (jb - 20) * 256; }
                else if (jb < 26) { c0 = 2560 + (jb - 22) * 256;   r0 = 5632 + (jb - 22) * 256; }
                else              { c0 = 4608; r0 = 6656; nc = 32; }
                conv_tile(p.in[6] + c0, 6688, nc, (bf16_t*)(ws + WS_BT_IN), 1024, kt * 64, r0, -1, tb);
            } else {
                t -= NT_IN;
                if (t < 32)        { const int kt = t & 7, nb = t >> 3;  conv_tile(p.in[13] + nb * 256, 1024, 256, (bf16_t*)(ws + WS_BT_BR), 1536, kt * 64, nb * 256, -1, tb); }
                else if (t < 96)   { t -= 32; const int kt = t & 15, nb = t >> 4; conv_tile(p.in[14] + nb * 256, 1024, 256, (bf16_t*)(ws + WS_BT_BR) + 512, 1536, kt * 64, nb * 256, -1, tb); }
                else if (t < 160)  { t -= 96; const int kt = t & 15, nb = t >> 4; conv_tile(p.in[15] + nb * 256, 1024, 256, (bf16_t*)(ws + WS_BT_OUT), 1024, kt * 64, nb * 256, -1, tb); }
                else if (t < 176)  { t -= 160; conv_tile(p.in[18], 256, 256, (bf16_t*)(ws + WS_BT_RT), 1024, t * 64, 0, -1, tb); }
                else if (t < 192)  { t -= 176; conv_tile(p.in[23], 256, 256, (bf16_t*)(ws + WS_BT_SHGU), 1024, t * 64, 0, 0, tb); }
                else if (t < 208)  { t -= 192; conv_tile(p.in[24], 256, 256, (bf16_t*)(ws + WS_BT_SHGU), 1024, t * 64, 0, 128, tb); }
                else               { t -= 208; const int kt = t & 3, nb = t >> 2; conv_tile(p.in[25] + nb * 256, 1024, 256, (bf16_t*)(ws + WS_BT_SHD), 256, kt * 64, nb * 256, -1, tb); }
            }
        }
    }
}

DEVI void phase1(const Params& p) {
    const float* mod = (const float*)(p.ws + WS_MOD); bf16_t* H = (bf16_t*)(p.ws + WS_H);
    for (size_t idx = (size_t)blockIdx.x * 512 + threadIdx.x; idx < (size_t)NROW * 128; idx += (size_t)gridDim.x * 512) {
        const int row = (int)(idx >> 7), k = (int)(idx & 127) * 8;
        const float* src = row < NTOK ? p.in[0] + (size_t)row * 1024 + k : p.in[2] + (size_t)(row - NTOK) * 1024 + k;
        const float* m = mod + (size_t)(row < NTOK ? (row >> 12) : 8) * 6144 + k;
        const f32x4 x0 = *(const f32x4*)src, x1 = *(const f32x4*)(src + 4), h0 = *(const f32x4*)m, h1 = *(const f32x4*)(m + 4), s0 = *(const f32x4*)(m + 1024), s1 = *(const f32x4*)(m + 1028);
        const f32x4 y0 = x0 * (s0 + 1.0f) + h0, y1 = x1 * (s1 + 1.0f) + h1;
        u32x4 w; w.x = pk_bf16(y0[0], y0[1]); w.y = pk_bf16(y0[2], y0[3]); w.z = pk_bf16(y1[0], y1[1]); w.w = pk_bf16(y1[2], y1[3]);
        *(u32x4*)(H + (size_t)row * 1024 + k) = w;
    }
}

DEVI float logsig16(float z) { return -(fmaxf(-z, 0.f) + __logf(1.0f + __expf(-fabsf(z)))) * 0.0625f; }
DEVI void phase3(const Params& p, LAS unsigned char* lds) {
    const int tid = threadIdx.x;
    unsigned char* ws = p.ws;
    LAS float* LRs = (LAS float*)lds;
    LAS float* CS = (LAS float*)(lds + 8192);
    LAS float* CUM = (LAS float*)(lds + 24576);
    LAS float* TOT = (LAS float*)(lds + 24576 + 65536);
    LAS bf16_t* KTs = (LAS bf16_t*)(lds + 24576 + 65536 + 2048);
    for (int i = tid; i < 2048; i += 512) { const int pos = i >> 5, j = i & 31; const float ang = (float)pos * powf(10000.0f, -(float)j / 32.0f); CS[2 * i] = cosf(ang); CS[2 * i + 1] = sinf(ang); }
    __syncthreads();
    const float* LRT = (const float*)(ws + WS_LRT);
    const bf16_t* QB = (const bf16_t*)(ws + WS_QB); const bf16_t* KB = (const bf16_t*)(ws + WS_KB);
    bf16_t* QTF = (bf16_t*)(ws + WS_QTF); bf16_t* QTB = (bf16_t*)(ws + WS_QTB); bf16_t* KTF = (bf16_t*)(ws + WS_KTF); bf16_t* KTB = (bf16_t*)(ws + WS_KTB);
    float* EE = (float*)(ws + WS_EE);
    for (int u = blockIdx.x; u < 8 * 68 * 4; u += gridDim.x) {
        const int h = u & 3, bs = u >> 2, b = bs / 68, slot = bs % 68; const bool isctx = slot < 4; const int chunk = slot - 4;
        const int rowbase = isctx ? NTOK + b * 256 + slot * 64 : b * 4096 + chunk * 64;
        { const int r = tid >> 4, c4 = (tid & 15) * 4; *(LAS f32x4*)(LRs + r * 64 + c4) = *(const f32x4*)(LRT + (size_t)r * NROW + rowbase + c4); }
        __syncthreads();
        {
            const int ch = tid & 127, grp = tid >> 7, dir = grp & 1, hf = grp >> 1;
            const float* w2p = p.in[dir ? 10 : 8] + h * 128 + ch; const float b2 = p.in[dir ? 11 : 9][h * 128 + ch];
            float w2[16];
#pragma unroll
            for (int r = 0; r < 16; ++r) w2[r] = w2p[r * 512];
            float run = 0.f;
            for (int k = 0; k < 32; ++k) {
                const int i = dir ? (32 * hf + 31 - k) : (32 * hf + k);
                float z = b2;
#pragma unroll
                for (int r = 0; r < 16; ++r) z += LRs[(16 * dir + r) * 64 + i] * w2[r];
                run += logsig16(z);
                CUM[(dir * 64 + i) * 128 + ch] = run;
            }
            TOT[(dir * 2 + hf) * 128 + ch] = run;
        }
        __syncthreads();
#pragma unroll
        for (int rep = 0; rep < 2; ++rep) {
            const int q = tid + 512 * rep, i = q >> 4, c8 = q & 15, ch0 = c8 * 8;
            float cf[8], cb[8];
            {
                const f32x4 a0 = *(const LAS f32x4*)(CUM + (0 * 64 + i) * 128 + ch0), a1 = *(const LAS f32x4*)(CUM + (0 * 64 + i) * 128 + ch0 + 4);
                const f32x4 b0 = *(const LAS f32x4*)(CUM + (1 * 64 + i) * 128 + ch0), b1 = *(const LAS f32x4*)(CUM + (1 * 64 + i) * 128 + ch0 + 4);
                f32x4 tf0 = {0.f, 0.f, 0.f, 0.f}, tf1 = tf0, tb0 = tf0, tb1 = tf0;
                if (i >= 32) { tf0 = *(const LAS f32x4*)(TOT + (0 * 2 + 0) * 128 + ch0); tf1 = *(const LAS f32x4*)(TOT + (0 * 2 + 0) * 128 + ch0 + 4); }
                else         { tb0 = *(const LAS f32x4*)(TOT + (1 * 2 + 1) * 128 + ch0); tb1 = *(const LAS f32x4*)(TOT + (1 * 2 + 1) * 128 + ch0 + 4); }
#pragma unroll
                for (int e = 0; e < 4; ++e) { cf[e] = a0[e] + tf0[e]; cf[4 + e] = a1[e] + tf1[e]; cb[e] = b0[e] + tb0[e]; cb[4 + e] = b1[e] + tb1[e]; }
            }
            const size_t go = (size_t)(rowbase + i) * 512 + h * 128 + ch0;
            const u32x4 kraw = *(const u32x4*)(KB + go);
            float kv[8] = {bflo(kraw.x), bfhi(kraw.x), bflo(kraw.y), bfhi(kraw.y), bflo(kraw.z), bfhi(kraw.z), bflo(kraw.w), bfhi(kraw.w)};
            float ef[8], eb[8];
#pragma unroll
            for (int e = 0; e < 8; ++e) { ef[e] = __expf(cf[e]); eb[e] = __expf(cb[e]); }
            if (!isctx) {
                const size_t gp = (size_t)(rowbase + i) * 512 + h * 128 + ((c8 ^ 4) * 8);
                const u32x4 kpr = *(const u32x4*)(KB + gp), qraw = *(const u32x4*)(QB + go), qpr = *(const u32x4*)(QB + gp);
                const float kp[8] = {bflo(kpr.x), bfhi(kpr.x), bflo(kpr.y), bfhi(kpr.y), bflo(kpr.z), bfhi(kpr.z), bflo(kpr.w), bfhi(kpr.w)};
                const float qv[8] = {bflo(qraw.x), bfhi(qraw.x), bflo(qraw.y), bfhi(qraw.y), bflo(qraw.z), bfhi(qraw.z), bflo(qraw.w), bfhi(qraw.w)};
                const float qp[8] = {bflo(qpr.x), bfhi(qpr.x), bflo(qpr.y), bfhi(qpr.y), bflo(qpr.z), bfhi(qpr.z), bflo(qpr.w), bfhi(qpr.w)};
                const int half = c8 >> 3, isx2 = (c8 >> 2) & 1, j0 = (c8 & 3) * 8, pos = half ? i : chunk;
                float qf[8], qb[8];
#pragma unroll
                for (int e = 0; e < 8; ++e) {
                    const float cs = CS[(pos * 32 + j0 + e) * 2], sn = CS[(pos * 32 + j0 + e) * 2 + 1];
                    const float rq = isx2 ? qv[e] * cs + qp[e] * sn : qv[e] * cs - qp[e] * sn;
                    kv[e] = isx2 ? kv[e] * cs + kp[e] * sn : kv[e] * cs - kp[e] * sn;
                    qf[e] = rq * 0.08838834764831845f * ef[e]; qb[e] = rq * 0.08838834764831845f * eb[e];
                }
                u32x4 wq; wq.x = pk_bf16(qf[0], qf[1]); wq.y = pk_bf16(qf[2], qf[3]); wq.z = pk_bf16(qf[4], qf[5]); wq.w = pk_bf16(qf[6], qf[7]); *(u32x4*)(QTF + go) = wq;
                wq.x = pk_bf16(qb[0], qb[1]); wq.y = pk_bf16(qb[2], qb[3]); wq.z = pk_bf16(qb[4], qb[5]); wq.w = pk_bf16(qb[6], qb[7]); *(u32x4*)(QTB + go) = wq;
            }
            float kf[8], kb[8];
#pragma unroll
            for (int e = 0; e < 8; ++e) { kf[e] = kv[e] * __builtin_amdgcn_rcpf(ef[e]); kb[e] = kv[e] * __builtin_amdgcn_rcpf(eb[e]); }
            u32x4 wf; wf.x = pk_bf16(kf[0], kf[1]); wf.y = pk_bf16(kf[2], kf[3]); wf.z = pk_bf16(kf[4], kf[5]); wf.w = pk_bf16(kf[6], kf[7]);
            u32x4 wb; wb.x = pk_bf16(kb[0], kb[1]); wb.y = pk_bf16(kb[2], kb[3]); wb.z = pk_bf16(kb[4], kb[5]); wb.w = pk_bf16(kb[6], kb[7]);
            *(u32x4*)(KTF + go) = wf; *(u32x4*)(KTB + go) = wb;
            *(LAS u32x4*)(KTs + (0 * 64 + i) * 136 + ch0) = wf; *(LAS u32x4*)(KTs + (1 * 64 + i) * 136 + ch0) = wb;
            if (i == 63) { float* ep = EE + ((size_t)(0 * 8 + b) * 68 + slot) * 512 + h * 128 + ch0; *(f32x4*)ep = (f32x4){ef[0], ef[1], ef[2], ef[3]}; *(f32x4*)(ep + 4) = (f32x4){ef[4], ef[5], ef[6], ef[7]}; }
            if (i == 0)  { float* ep = EE + ((size_t)(1 * 8 + b) * 68 + slot) * 512 + h * 128 + ch0; *(f32x4*)ep = (f32x4){eb[0], eb[1], eb[2], eb[3]}; *(f32x4*)(ep + 4) = (f32x4){eb[4], eb[5], eb[6], eb[7]}; }
        }
        __syncthreads();
#pragma unroll
        for (int rep = 0; rep < 4; ++rep) {
            const int q = tid + 512 * rep, ch = q & 127, t8 = (q >> 7) & 7, dir = q >> 10;
            const LAS bf16_t* sp = KTs + (dir * 64 + t8 * 8) * 136 + ch;
            u32x4 wv; wv.x = (unsigned)sp[0] | ((unsigned)sp[136] << 16); wv.y = (unsigned)sp[2 * 136] | ((unsigned)sp[3 * 136] << 16); wv.z = (unsigned)sp[4 * 136] | ((unsigned)sp[5 * 136] << 16); wv.w = (unsigned)sp[6 * 136] | ((unsigned)sp[7 * 136] << 16);
            *(u32x4*)((bf16_t*)(ws + (dir ? WS_KTTB : WS_KTTF)) + (size_t)(h * 128 + ch) * NROW + rowbase + t8 * 8) = wv;
        }
        __syncthreads();
    }
}

DEVI int gla_slot(int dir, int n) { return dir == 0 ? n : (n < 4 ? 3 - n : 71 - n); }
DEVI int gla_rowbase(int b, int slot) { return slot >= 4 ? b * 4096 + (slot - 4) * 64 : NTOK + b * 256 + slot * 64; }
DEVI void phase4_gla(const Params& p, LAS unsigned char* lds) {
    const int tid = threadIdx.x, lane = tid & 63, w = tid >> 6, l15 = lane & 15, fq = lane >> 4;
    unsigned char* ws = p.ws;
    LAS unsigned char* TQ = lds;
    LAS unsigned char* TK = lds + 32768;
    LAS unsigned char* TV = lds + 65536;
    LAS bf16_t* PM = (LAS bf16_t*)(lds + 81920);
    LAS bf16_t* SB = (LAS bf16_t*)(lds + 81920 + 9216);
    const bf16_t* VBT = (const bf16_t*)(ws + WS_VBT);
    const float* EE = (const float*)(ws + WS_EE);
    const int qr0 = tid >> 4, qp = tid & 15, vr = tid >> 3, vp = tid & 7;
    const int qoff0 = qr0 * 256 + ((qp ^ (qr0 & 15)) << 4), qoff1 = (qr0 + 32) * 256 + ((qp ^ ((qr0 + 32) & 15)) << 4);
    const int voff = vr * 128 + ((vp ^ ((vr >> 1) & 7)) << 4);
    struct PSet { u32x4 q0, q1, k0, k1, v; };
    struct KSet { bf16x8 a, b; f32x4 e; };
    for (int u = blockIdx.x; u < 256; u += gridDim.x) {
        const int xg = u & 7, kg = u >> 3, g = xg * 8 + (kg >> 2), dvq = kg & 3, dir = g & 1, h = (g >> 1) & 3, b = g >> 3;
        const bf16_t* QT = (const bf16_t*)(ws + (dir ? WS_QTB : WS_QTF)); const bf16_t* KT = (const bf16_t*)(ws + (dir ? WS_KTB : WS_KTF)); const bf16_t* KTT = (const bf16_t*)(ws + (dir ? WS_KTTB : WS_KTTF));
        bf16_t* OUT = (bf16_t*)(ws + (dir ? WS_OB : WS_OF));
        const int vrow0 = h * 256 + dvq * 64, krow0 = h * 128, kcol0 = h * 128;
        const float* EEu = EE + (size_t)(dir * 8 + b) * 68 * 512 + h * 128 + 16 * w + 4 * fq;
        const bf16_t* vsrc = VBT + (size_t)(vrow0 + vr) * NROW + vp * 8;
        const bf16_t* ktsrc = KTT + (size_t)(krow0 + 16 * w + l15) * NROW + 8 * fq;
        const size_t qsrc = (size_t)qr0 * 512 + kcol0 + qp * 8;
        f32x4 S[4];
#pragma unroll
        for (int i = 0; i < 4; ++i) S[i] = (f32x4){0.f, 0.f, 0.f, 0.f};
        PSet P0, P1; KSet K0, K1;
        P0.q0 = P0.q1 = P0.k0 = P0.k1 = P0.v = (u32x4){0u, 0u, 0u, 0u}; P1 = P0;
        auto load_p = [&](PSet& P, int n) {
            const int slot = gla_slot(dir, n), rb = gla_rowbase(b, slot);
            P.v = *(const u32x4*)(vsrc + rb);
            if (slot >= 4) { P.q0 = *(const u32x4*)(QT + (size_t)rb * 512 + qsrc); P.q1 = *(const u32x4*)(QT + (size_t)(rb + 32) * 512 + qsrc);
                             P.k0 = *(const u32x4*)(KT + (size_t)rb * 512 + qsrc); P.k1 = *(const u32x4*)(KT + (size_t)(rb + 32) * 512 + qsrc); }
        };
        auto store_p = [&](const PSet& P, int n) {
            const int slot = gla_slot(dir, n), bufo = n & 1;
            *(LAS u32x4*)(TV + bufo * 8192 + voff) = P.v;
            if (slot >= 4) { *(LAS u32x4*)(TQ + bufo * 16384 + qoff0) = P.q0; *(LAS u32x4*)(TQ + bufo * 16384 + qoff1) = P.q1; *(LAS u32x4*)(TK + bufo * 16384 + qoff0) = P.k0; *(LAS u32x4*)(TK + bufo * 16384 + qoff1) = P.k1; }
        };
        auto load_k = [&](KSet& K, int n) {
            const int slot = gla_slot(dir, n), rb = gla_rowbase(b, slot);
            K.a = *(const bf16x8*)(ktsrc + rb); K.b = *(const bf16x8*)(ktsrc + rb + 32); K.e = *(const f32x4*)(EEu + (size_t)slot * 512);
        };
        load_p(P0, 0); load_k(K0, 0); load_k(K1, 1); load_p(P1, 1);
        __syncthreads();
        store_p(P0, 0);
        auto step = [&](int n, PSet& Pload, const PSet& Pstore, KSet& K) {
            const int slot = gla_slot(dir, n); const bool lat = slot >= 4; const int rowbase = gla_rowbase(b, slot);
            const int cur = n & 1, nxt = cur ^ 1;
            LAS unsigned char* tq = TQ + cur * 16384; LAS unsigned char* tk = TK + cur * 16384; LAS unsigned char* tv = TV + cur * 8192;
            LAS bf16_t* sbc = SB + cur * 64 * 136; LAS bf16_t* sbn = SB + nxt * 64 * 136;
            lds_barrier();
            if (n + 2 < 68) load_p(Pload, n + 2);
            if (lat) {
                const int jt = w >> 1, it0 = 2 * (w & 1);
                f32x4 c0 = {0.f, 0.f, 0.f, 0.f}, c1 = {0.f, 0.f, 0.f, 0.f};
                const int rj = 16 * jt + l15, ri0 = 16 * it0 + l15, ri1 = ri0 + 16;
                bf16x8 fa[4], fb0[4], fb1[4];
#pragma unroll
                for (int ks = 0; ks < 4; ++ks) { const int pc = 4 * ks + fq;
                    fa[ks] = *(const LAS bf16x8*)(tk + rj * 256 + ((pc ^ l15) << 4)); fb0[ks] = *(const LAS bf16x8*)(tq + ri0 * 256 + ((pc ^ l15) << 4)); fb1[ks] = *(const LAS bf16x8*)(tq + ri1 * 256 + ((pc ^ l15) << 4)); }
                __builtin_amdgcn_sched_barrier(0);
#pragma unroll
                for (int ks = 0; ks < 4; ++ks) { c0 = __builtin_amdgcn_mfma_f32_16x16x32_bf16(fa[ks], fb0[ks], c0, 0, 0, 0); c1 = __builtin_amdgcn_mfma_f32_16x16x32_bf16(fa[ks], fb1[ks], c1, 0, 0, 0); }
#pragma unroll
                for (int r = 0; r < 4; ++r) { const int j = 16 * jt + 4 * fq + r;
                    const bool k0 = dir == 0 ? (j <= ri0) : (j >= ri0), k1 = dir == 0 ? (j <= ri1) : (j >= ri1);
                    c0[r] = k0 ? c0[r] : 0.f; c1[r] = k1 ? c1[r] : 0.f; }
                u32x2 w0; w0.x = pk_bf16(c0[0], c0[1]); w0.y = pk_bf16(c0[2], c0[3]); u32x2 w1; w1.x = pk_bf16(c1[0], c1[1]); w1.y = pk_bf16(c1[2], c1[3]);
                *(LAS u32x2*)(PM + ri0 * 72 + 16 * jt + 4 * fq) = w0; *(LAS u32x2*)(PM + ri1 * 72 + 16 * jt + 4 * fq) = w1;
            }
            lds_barrier();
            bf16x8 V[4][2];
#pragma unroll
            for (int dvt = 0; dvt < 4; ++dvt)
#pragma unroll
                for (int ks = 0; ks < 2; ++ks) { const int row = 16 * dvt + l15, pc = 4 * ks + fq; V[dvt][ks] = *(const LAS bf16x8*)(tv + row * 128 + ((pc ^ ((row >> 1) & 7)) << 4)); }
            __builtin_amdgcn_sched_barrier(0);
            if (lat) {
                const int it = w >> 1, dv0 = 2 * (w & 1), ri = 16 * it + l15;
                f32x4 o0 = {0.f, 0.f, 0.f, 0.f}, o1 = {0.f, 0.f, 0.f, 0.f};
                bf16x8 pB[2], pA0[2], pA1[2], sA0[4], sA1[4], sB[4];
                const LAS bf16_t* s0 = sbc + (16 * dv0 + l15) * 136 + 8 * fq; const LAS bf16_t* s1 = s0 + 16 * 136;
#pragma unroll
                for (int ks = 0; ks < 2; ++ks) { pB[ks] = *(const LAS bf16x8*)(PM + ri * 72 + 32 * ks + 8 * fq);
                    const int r0 = 16 * dv0 + l15, r1 = r0 + 16, pc = 4 * ks + fq;
                    pA0[ks] = *(const LAS bf16x8*)(tv + r0 * 128 + ((pc ^ ((r0 >> 1) & 7)) << 4)); pA1[ks] = *(const LAS bf16x8*)(tv + r1 * 128 + ((pc ^ ((r1 >> 1) & 7)) << 4)); }
#pragma unroll
                for (int ks = 0; ks < 4; ++ks) { const int pc = 4 * ks + fq;
                    sA0[ks] = *(const LAS bf16x8*)(s0 + 32 * ks); sA1[ks] = *(const LAS bf16x8*)(s1 + 32 * ks); sB[ks] = *(const LAS bf16x8*)(tq + ri * 256 + ((pc ^ l15) << 4)); }
                __builtin_amdgcn_sched_barrier(0);
#pragma unroll
                for (int ks = 0; ks < 2; ++ks) { o0 = __builtin_amdgcn_mfma_f32_16x16x32_bf16(pA0[ks], pB[ks], o0, 0, 0, 0); o1 = __builtin_amdgcn_mfma_f32_16x16x32_bf16(pA1[ks], pB[ks], o1, 0, 0, 0); }
#pragma unroll
                for (int ks = 0; ks < 4; ++ks) { o0 = __builtin_amdgcn_mfma_f32_16x16x32_bf16(sA0[ks], sB[ks], o0, 0, 0, 0); o1 = __builtin_amdgcn_mfma_f32_16x16x32_bf16(sA1[ks], sB[ks], o1, 0, 0, 0); }
                bf16_t* op = OUT + (size_t)(rowbase + ri) * 1024 + vrow0 + 16 * dv0 + 4 * fq;
                u32x2 w0; w0.x = pk_bf16(o0[0], o0[1]); w0.y = pk_bf16(o0[2], o0[3]); u32x2 w1; w1.x = pk_bf16(o1[0], o1[1]); w1.y = pk_bf16(o1[2], o1[3]);
                *(u32x2*)op = w0; *(u32x2*)(op + 16) = w1;
            }
#pragma unroll
            for (int dvt = 0; dvt < 4; ++dvt) { S[dvt] = __builtin_amdgcn_mfma_f32_16x16x32_bf16(K.a, V[dvt][0], S[dvt], 0, 0, 0); S[dvt] = __builtin_amdgcn_mfma_f32_16x16x32_bf16(K.b, V[dvt][1], S[dvt], 0, 0, 0); }
#pragma unroll
            for (int dvt = 0; dvt < 4; ++dvt) { S[dvt] = S[dvt] * K.e;
                u32x2 o; o.x = pk_bf16(S[dvt][0], S[dvt][1]); o.y = pk_bf16(S[dvt][2], S[dvt][3]);
                *(LAS u32x2*)(sbn + (16 * dvt + l15) * 136 + 16 * w + 4 * fq) = o; }
            if (n + 2 < 68) load_k(K, n + 2);
            if (n + 1 < 68) store_p(Pstore, n + 1);
        };
#pragma unroll 1
        for (int n = 0; n < 68; n += 2) { step(n, P0, P1, K0); step(n + 1, P1, P0, K1); }
        __syncthreads();
    }
}

DEVI void phase4_na(const Params& p, LAS unsigned char* lds) {
    const int tid = threadIdx.x; const int wsg = __builtin_amdgcn_readfirstlane(tid >> 6);
    unsigned char* ws = p.ws;
    LAS unsigned char* CK = lds;
    LAS unsigned char* CV = lds + 32768;
    LAS float* RP = (LAS float*)(lds + 65536);
    const bf16_t* QA = (const bf16_t*)(ws + WS_QA); const bf16_t* KA = (const bf16_t*)(ws + WS_KA); const bf16_t* VAT = (const bf16_t*)(ws + WS_VAT);
    bf16_t* OA = (bf16_t*)(ws + WS_AP);
    for (int u = blockIdx.x; u < 512; u += gridDim.x) {
        const int xg = u & 7, idx = u >> 3, bh = xg * 8 + (idx >> 3), rblk = idx & 7, h = bh & 7, b = bh >> 3;
        __syncthreads();
        for (int i = tid; i < 465; i += 512) RP[(i / 31) * 80 + 24 + (i % 31)] = p.in[7][h * 465 + i];
        int tz = tid; asm volatile("" : "+v"(tz));
#pragma unroll
        for (int rep = 0; rep < 4; ++rep) {
            const int q = tz + 512 * rep;
            { const int row = q >> 3, pc = q & 7; *(LAS u32x4*)(CK + row * 128 + ((pc ^ ((row >> 1) & 7)) << 4)) = *(const u32x4*)(KA + (size_t)(NTOK + b * 256 + row) * 512 + h * 64 + pc * 8); }
            { const int row = q >> 5, pc = q & 31; const u32x4 v = *(const u32x4*)(VAT + (size_t)(h * 64 + row) * NROW + NTOK + b * 256 + pc * 8);
              const int sw = (row & 15) << 1; u32x2 lo; lo.x = v.x; lo.y = v.y; u32x2 hi; hi.x = v.z; hi.y = v.w;
              *(LAS u32x2*)(CV + row * 512 + (((2 * pc) ^ sw) << 3)) = lo; *(LAS u32x2*)(CV + row * 512 + (((2 * pc + 1) ^ sw) << 3)) = hi; }
        }
        __syncthreads();
#pragma unroll 1
        for (int qt = 0; qt < 4; ++qt) {
            int lane = (int)__builtin_amdgcn_mbcnt_hi(~0u, __builtin_amdgcn_mbcnt_lo(~0u, 0u)); asm volatile("" : "+v"(lane));
            const int w = wsg, l15 = lane & 15, fq = lane >> 4, r = rblk * 8 + w, rs = min(max(r - 4, 0), 56);
            const int kc0 = min(max(16 * qt - 8, 0), 32);
            const int c = 16 * qt + l15, cs = min(max(c - 8, 0), 48);
            const bf16_t* qp = QA + (size_t)(b * 4096 + r * 64 + c) * 512 + h * 64 + 8 * fq;
            const bf16x8 Bq0 = *(const bf16x8*)qp, Bq1 = *(const bf16x8*)(qp + 32);
            const int lo = 15 + cs - c, d00 = kc0 - 16 * qt + 4 * fq - l15 + 15;
            const LAS unsigned char* rpl = (const LAS unsigned char*)RP + ((rs - r + 7) * 80 + 24 + d00) * 4;
            const char* kbase = (const char*)(KA + (size_t)(b * 4096 + rs * 64 + kc0) * 512 + h * 64); const unsigned klane = (unsigned)(l15 * 512 + 8 * fq) * 2u;
            const char* vbase = (const char*)(VAT + (size_t)(h * 64) * NROW + b * 4096 + rs * 64 + kc0); const unsigned vlane = (unsigned)(l15 * NROW + 4 * fq) * 2u;
#define NA_SB __builtin_amdgcn_sched_barrier(0)
            f32x4 sc[16];
#pragma unroll
            for (int hb = 0; hb < 4; ++hb) {
                bf16x8 kf[4][2];
#pragma unroll
                for (int tt = 0; tt < 4; ++tt) { const int t = 4 * hb + tt, kr = t >> 1, chh = t & 1; const char* kp = (kbase + (size_t)((kr * 64 + 16 * chh) * 1024)) + klane;
                    kf[tt][0] = *(const bf16x8*)kp; kf[tt][1] = *(const bf16x8*)(kp + 64); }
                NA_SB;
#pragma unroll
                for (int tt = 0; tt < 4; ++tt) { const int t = 4 * hb + tt, kr = t >> 1, chh = t & 1;
                    f32x4 a = {0.f, 0.f, 0.f, 0.f};
                    a = __builtin_amdgcn_mfma_f32_16x16x32_bf16(kf[tt][0], Bq0, a, 0, 0, 0); a = __builtin_amdgcn_mfma_f32_16x16x32_bf16(kf[tt][1], Bq1, a, 0, 0, 0);
#pragma unroll
                    for (int j = 0; j < 4; ++j) { const float bias = *(const LAS float*)(rpl + chh * 64 + kr * 320 + j * 4); a[j] = ((unsigned)(d00 + 16 * chh + j - lo) <= 15u) ? a[j] + bias : -INFINITY; }
                    sc[t] = a; }
                NA_SB;
            }
            u32x2 va0[2][4], va1[2][4];
            auto ld_vloc = [&](int uu0) {
#pragma unroll
                for (int q = 0; q < 2; ++q)
#pragma unroll
                    for (int mt = 0; mt < 4; ++mt) { const char* vp = (vbase + (size_t)((16 * mt * NROW + (uu0 + q) * 64) * 2)) + vlane; va0[q][mt] = *(const u32x2*)vp; va1[q][mt] = *(const u32x2*)(vp + 32); } };
            ld_vloc(0);
            NA_SB;
            float mA = -INFINITY;
#pragma unroll
            for (int t = 0; t < 16; ++t) mA = fmaxf(mA, fmaxf(fmaxf(sc[t][0], sc[t][1]), fmaxf(sc[t][2], sc[t][3])));
            mA = fmaxf(mA, __shfl_xor(mA, 16)); mA = fmaxf(mA, __shfl_xor(mA, 32));
            float lA = 0.f; u32x2 pp[16];
#pragma unroll
            for (int t = 0; t < 16; ++t) { const float e0 = __expf(sc[t][0] - mA), e1 = __expf(sc[t][1] - mA), e2 = __expf(sc[t][2] - mA), e3 = __expf(sc[t][3] - mA);
                lA += (e0 + e1) + (e2 + e3); pp[t].x = pk_bf16(e0, e1); pp[t].y = pk_bf16(e2, e3); }
            NA_SB;
            f32x4 o[4];
#pragma unroll
            for (int mt = 0; mt < 4; ++mt) o[mt] = (f32x4){0.f, 0.f, 0.f, 0.f};
            auto mm_vloc = [&](int uu0) {
#pragma unroll
                for (int q = 0; q < 2; ++q) { const int t0 = 2 * (uu0 + q), t1 = t0 + 1;
                    union { u32x4 w; bf16x8 v; } P; P.w.x = pp[t0].x; P.w.y = pp[t0].y; P.w.z = pp[t1].x; P.w.w = pp[t1].y;
#pragma unroll
                    for (int mt = 0; mt < 4; ++mt) { union { u32x4 w; bf16x8 v; } A; A.w.x = va0[q][mt].x; A.w.y = va0[q][mt].y; A.w.z = va1[q][mt].x; A.w.w = va1[q][mt].y; o[mt] = __builtin_amdgcn_mfma_f32_16x16x32_bf16(A.v, P.v, o[mt], 0, 0, 0); } } };
            mm_vloc(0); NA_SB; ld_vloc(2); NA_SB; mm_vloc(2); NA_SB; ld_vloc(4); NA_SB; mm_vloc(4); NA_SB; ld_vloc(6); NA_SB; mm_vloc(6); NA_SB;
            int lane2 = (int)__builtin_amdgcn_mbcnt_hi(~0u, __builtin_amdgcn_mbcnt_lo(~0u, 0u)); asm volatile("" : "+v"(lane2));
            const int l15b = lane2 & 15, fqb = lane2 >> 4, cks = (l15b >> 1) & 7, ck0 = l15b * 128 + ((fqb ^ cks) << 4), ck1 = l15b * 128 + (((4 + fqb) ^ cks) << 4);
            {
                bf16x8 kfA[2][2];
                auto ld_ctx = [&](bf16x8 (&kf)[2][2], auto G) {
#pragma unroll
                    for (int tt = 0; tt < 2; ++tt) { constexpr int tile = 0; const int to = (2 * decltype(G)::v + tt) * 2048 + tile;
                        kf[tt][0] = *(const LAS bf16x8*)(CK + to + ck0); kf[tt][1] = *(const LAS bf16x8*)(CK + to + ck1); } };
                auto mm_ctx = [&](const bf16x8 (&kf)[2][2], auto G) {
#pragma unroll
                    for (int tt = 0; tt < 2; ++tt) { f32x4 a = {0.f, 0.f, 0.f, 0.f};
                        a = __builtin_amdgcn_mfma_f32_16x16x32_bf16(kf[tt][0], Bq0, a, 0, 0, 0); a = __builtin_amdgcn_mfma_f32_16x16x32_bf16(kf[tt][1], Bq1, a, 0, 0, 0);
                        sc[2 * decltype(G)::v + tt] = a; } };
#define NA_CC(G0) ld_ctx(kfA, IC<G0>{}); NA_SB; mm_ctx(kfA, IC<G0>{}); NA_SB;
                NA_CC(0) NA_CC(1) NA_CC(2) NA_CC(3) NA_CC(4) NA_CC(5) NA_CC(6) NA_CC(7)
#undef NA_CC
            }
            float mB = -INFINITY;
#pragma unroll
            for (int t = 0; t < 16; ++t) mB = fmaxf(mB, fmaxf(fmaxf(sc[t][0], sc[t][1]), fmaxf(sc[t][2], sc[t][3])));
            mB = fmaxf(mB, __shfl_xor(mB, 16)); mB = fmaxf(mB, __shfl_xor(mB, 32));
            const float mx = fmaxf(mA, mB), fA = __expf(mA - mx);
            float lB = 0.f;
#pragma unroll
            for (int t = 0; t < 16; ++t) { const float e0 = __expf(sc[t][0] - mx), e1 = __expf(sc[t][1] - mx), e2 = __expf(sc[t][2] - mx), e3 = __expf(sc[t][3] - mx);
                lB += (e0 + e1) + (e2 + e3); pp[t].x = pk_bf16(e0, e1); pp[t].y = pk_bf16(e2, e3); }
            float sum = lA * fA + lB;
            sum += __shfl_xor(sum, 16); sum += __shfl_xor(sum, 32);
            const float inv = 1.0f / sum;
#pragma unroll
            for (int mt = 0; mt < 4; ++mt) o[mt] = o[mt] * fA;
            NA_SB;
            int cvo[4][2];
#pragma unroll
            for (int rr = 0; rr < 4; ++rr)
#pragma unroll
                for (int dd = 0; dd < 2; ++dd) cvo[rr][dd] = l15b * 512 + ((((8 * rr + fqb + 4 * dd) ^ (l15b << 1)) & 31) << 3);
            {
                u32x4 vfA[4], vfB[4];
                auto ld_v = [&](u32x4 (&vq)[4], auto U) {
                    constexpr int uu = decltype(U)::v, q4 = uu >> 2, rr = uu & 3;
#pragma unroll
                    for (int mt = 0; mt < 4; ++mt) { const u32x2 a0 = *(const LAS u32x2*)(CV + mt * 8192 + q4 * 256 + cvo[rr][0]), a1 = *(const LAS u32x2*)(CV + mt * 8192 + q4 * 256 + cvo[rr][1]); vq[mt] = (u32x4){a0.x, a0.y, a1.x, a1.y}; } };
                auto mm_v = [&](const u32x4 (&vq)[4], auto U) {
                    constexpr int uu = decltype(U)::v, t0 = 2 * uu, t1 = 2 * uu + 1;
                    union { u32x4 w; bf16x8 v; } P; P.w.x = pp[t0].x; P.w.y = pp[t0].y; P.w.z = pp[t1].x; P.w.w = pp[t1].y;
#pragma unroll
                    for (int mt = 0; mt < 4; ++mt) { union { u32x4 w; bf16x8 v; } A; A.w = vq[mt]; o[mt] = __builtin_amdgcn_mfma_f32_16x16x32_bf16(A.v, P.v, o[mt], 0, 0, 0); } };
#define NA_PV(U0, U1, U2, U3) mm_v(vfA, IC<U0>{}); NA_SB; ld_v(vfA, IC<U2>{}); NA_SB; mm_v(vfB, IC<U1>{}); NA_SB; ld_v(vfB, IC<U3>{}); NA_SB;
                ld_v(vfA, IC<0>{}); ld_v(vfB, IC<1>{}); NA_SB;
                NA_PV(0, 1, 2, 3) NA_PV(2, 3, 4, 5) NA_PV(4, 5, 6, 7)
                mm_v(vfA, IC<6>{}); NA_SB; mm_v(vfB, IC<7>{}); NA_SB;
#undef NA_PV
            }
#undef NA_SB
            bf16_t* op = OA + (size_t)(b * 4096 + r * 64 + c) * 1536 + h * 64 + 4 * fq;
#pragma unroll
            for (int mt = 0; mt < 4; ++mt) { u32x2 wv; wv.x = pk_bf16(o[mt][0] * inv, o[mt][1] * inv); wv.y = pk_bf16(o[mt][2] * inv, o[mt][3] * inv); *(u32x2*)(op + 16 * mt) = wv; }
        }
    }
}

DEVI void phase5(const Params& p) {
    const int lane = threadIdx.x & 63, gw = blockIdx.x * 8 + (threadIdx.x >> 6), nw = gridDim.x * 8;
    const bf16_t* OF = (const bf16_t*)(p.ws + WS_OF); const bf16_t* OB = (const bf16_t*)(p.ws + WS_OB); const bf16_t* GB = (const bf16_t*)(p.ws + WS_GB); bf16_t* AP = (bf16_t*)(p.ws + WS_AP);
    for (int tok = gw; tok < NTOK; tok += nw) {
#pragma unroll
        for (int hh = 0; hh < 2; ++hh) {
            const int col = hh * 512 + lane * 8;
            const size_t o = (size_t)tok * 1024 + col;
            const u32x4 a = *(const u32x4*)(OF + o), bb = *(const u32x4*)(OB + o), g = *(const u32x4*)(GB + o);
            float v[8] = {bflo(a.x) + bflo(bb.x), bfhi(a.x) + bfhi(bb.x), bflo(a.y) + bflo(bb.y), bfhi(a.y) + bfhi(bb.y), bflo(a.z) + bflo(bb.z), bfhi(a.z) + bfhi(bb.z), bflo(a.w) + bflo(bb.w), bfhi(a.w) + bfhi(bb.w)};
            float ss = 0.f;
#pragma unroll
            for (int e = 0; e < 8; ++e) ss += v[e] * v[e];
            ss += __shfl_xor(ss, 16); ss += __shfl_xor(ss, 8); ss += __shfl_xor(ss, 4); ss += __shfl_xor(ss, 2); ss += __shfl_xor(ss, 1);
            const float rs = rsqrtf(ss * (1.0f / 256.0f) + 1e-6f);
            const f32x4 n0 = *(const f32x4*)(p.in[12] + col), n1 = *(const f32x4*)(p.in[12] + col + 4);
            const float gg[8] = {bflo(g.x), bfhi(g.x), bflo(g.y), bfhi(g.y), bflo(g.z), bfhi(g.z), bflo(g.w), bfhi(g.w)};
            float r[8];
#pragma unroll
            for (int e = 0; e < 8; ++e) r[e] = v[e] * rs * (e < 4 ? n0[e & 3] : n1[e & 3]) * (gg[e] * sigmoidf_(gg[e]));
            u32x4 wv; wv.x = pk_bf16(r[0], r[1]); wv.y = pk_bf16(r[2], r[3]); wv.z = pk_bf16(r[4], r[5]); wv.w = pk_bf16(r[6], r[7]);
            *(u32x4*)(AP + (size_t)tok * 1536 + 512 + col) = wv;
        }
    }
}

DEVI void ln_row(f32x4 (&v)[4], const float* g, const float* bta, int lane) {
    float s = 0.f;
#pragma unroll
    for (int j = 0; j < 4; ++j) s += (v[j][0] + v[j][1]) + (v[j][2] + v[j][3]);
    const float mu = wave_sum(s) * (1.0f / 1024.0f);
    float q = 0.f;
#pragma unroll
    for (int j = 0; j < 4; ++j) { v[j] = v[j] - mu; q += (v[j][0] * v[j][0] + v[j][1] * v[j][1]) + (v[j][2] * v[j][2] + v[j][3] * v[j][3]); }
    const float rstd = rsqrtf(wave_sum(q) * (1.0f / 1024.0f) + 1e-6f);
#pragma unroll
    for (int j = 0; j < 4; ++j) { const f32x4 gg = *(const f32x4*)(g + lane * 4 + 256 * j), bb = *(const f32x4*)(bta + lane * 4 + 256 * j); v[j] = v[j] * rstd * gg + bb; }
}
DEVI void phase9(const Params& p) {
    const int lane = threadIdx.x & 63, gw = blockIdx.x * 8 + (threadIdx.x >> 6), nw = gridDim.x * 8;
    const float* mod = (const float*)(p.ws + WS_MOD); const bf16_t* Z = (const bf16_t*)(p.ws + WS_Z); float* X1 = (float*)(p.ws + WS_X1); bf16_t* H2 = (bf16_t*)(p.ws + WS_H2);
    for (int tok = gw; tok < NTOK; tok += nw) {
        const float* m = mod + (size_t)(tok >> 12) * 6144; float v[2][8];
#pragma unroll
        for (int j = 0; j < 2; ++j) { const int cidx = lane * 8 + 512 * j;
            const f32x4 x0 = *(const f32x4*)(p.in[0] + (size_t)tok * 1024 + cidx), x1 = *(const f32x4*)(p.in[0] + (size_t)tok * 1024 + cidx + 4), g0 = *(const f32x4*)(m + 2048 + cidx), g1 = *(const f32x4*)(m + 2048 + cidx + 4);
            const u32x4 z = *(const u32x4*)(Z + (size_t)tok * 1024 + cidx);
            float zf[8] = {bflo(z.x), bfhi(z.x), bflo(z.y), bfhi(z.y), bflo(z.z), bfhi(z.z), bflo(z.w), bfhi(z.w)};
#if defined(DBG_NOMIX)
#pragma unroll
            for (int e = 0; e < 8; ++e) zf[e] = 0.f;
#endif
#pragma unroll
            for (int e = 0; e < 4; ++e) { v[j][e] = x0[e] * 1.189207115f + g0[e] * zf[e]; v[j][4 + e] = x1[e] * 1.189207115f + g1[e] * zf[4 + e]; }
        }
        float sm = 0.f;
#pragma unroll
        for (int j = 0; j < 2; ++j)
#pragma unroll
            for (int e = 0; e < 8; ++e) sm += v[j][e];
        const float mu = wave_sum(sm) * (1.0f / 1024.0f); float q = 0.f;
#pragma unroll
        for (int j = 0; j < 2; ++j)
#pragma unroll
            for (int e = 0; e < 8; ++e) { v[j][e] -= mu; q += v[j][e] * v[j][e]; }
        const float rstd = rsqrtf(wave_sum(q) * (1.0f / 1024.0f) + 1e-6f);
#pragma unroll
        for (int j = 0; j < 2; ++j) { const int cidx = lane * 8 + 512 * j;
            const f32x4 g0 = *(const f32x4*)(p.in[16] + cidx), g1 = *(const f32x4*)(p.in[16] + cidx + 4), b0 = *(const f32x4*)(p.in[17] + cidx), b1 = *(const f32x4*)(p.in[17] + cidx + 4);
            const f32x4 sh0 = *(const f32x4*)(m + 3072 + cidx), sh1 = *(const f32x4*)(m + 3072 + cidx + 4), sc0 = *(const f32x4*)(m + 4096 + cidx), sc1 = *(const f32x4*)(m + 4096 + cidx + 4);
            f32x4 o0, o1; float hv[8];
#pragma unroll
            for (int e = 0; e < 4; ++e) { o0[e] = v[j][e] * rstd * g0[e] + b0[e]; o1[e] = v[j][4 + e] * rstd * g1[e] + b1[e]; hv[e] = o0[e] * (sc0[e] + 1.0f) + sh0[e]; hv[4 + e] = o1[e] * (sc1[e] + 1.0f) + sh1[e]; }
            *(f32x4*)(X1 + (size_t)tok * 1024 + cidx) = o0; *(f32x4*)(X1 + (size_t)tok * 1024 + cidx + 4) = o1;
            u32x4 wv; wv.x = pk_bf16(hv[0], hv[1]); wv.y = pk_bf16(hv[2], hv[3]); wv.z = pk_bf16(hv[4], hv[5]); wv.w = pk_bf16(hv[6], hv[7]);
            *(u32x4*)(H2 + (size_t)tok * 1024 + cidx) = wv; }
    }
}
DEVI void phase11(const Params& p, LAS unsigned char* lds) {
    const int lane = threadIdx.x & 63, gw = blockIdx.x * 8 + (threadIdx.x >> 6), nw = gridDim.x * 8, half = lane >> 5;
    LAS unsigned* LC = (LAS unsigned*)(lds + LDS_TAB); LAS unsigned* LB = LC + 256;
    if (threadIdx.x < 256) LC[threadIdx.x] = 0u;
    __syncthreads();
    const float* L0 = (const float*)(p.ws + WS_LOG0); const float* L1 = (const float*)(p.ws + WS_LOG1);
    int* TID = (int*)(p.ws + WS_TOPK_ID); float* TW = (float*)(p.ws + WS_TOPK_W); int* TP = (int*)(p.ws + WS_TOPK_POS); unsigned* CNT = (unsigned*)(p.ws + WS_CNT);
    float rb[4];
#pragma unroll
    for (int j = 0; j < 4; ++j) rb[j] = p.in[19][lane + 64 * j];
    for (int tok = gw; tok < NTOK; tok += nw) {
        float s[4], bz[4], gs[4];
#pragma unroll
        for (int j = 0; j < 4; ++j) { const float lg = L0[(size_t)tok * 256 + lane + 64 * j] + L1[(size_t)tok * 256 + lane + 64 * j]; s[j] = 1.0f / (1.0f + expf(-lg)); bz[j] = s[j] + rb[j]; }
#pragma unroll
        for (int j = 0; j < 4; ++j) { float m1 = bz[j], m2 = -INFINITY;
#pragma unroll
            for (int o = 1; o < 32; o <<= 1) { const float p1 = __shfl_xor(m1, o), p2 = __shfl_xor(m2, o); const float n1 = fmaxf(m1, p1), n2 = fmaxf(fminf(m1, p1), fmaxf(m2, p2)); m1 = n1; m2 = n2; }
            gs[j] = m1 + m2; }
        float Gv[8];
#pragma unroll
        for (int j = 0; j < 4; ++j) { const float oth = __shfl_xor(gs[j], 32); Gv[2 * j] = half ? oth : gs[j]; Gv[2 * j + 1] = half ? gs[j] : oth; }
        bool keep[8];
#pragma unroll
        for (int g = 0; g < 8; ++g) { int rank = 0;
#pragma unroll
            for (int g2 = 0; g2 < 8; ++g2) rank += (Gv[g2] > Gv[g] || (Gv[g2] == Gv[g] && g2 < g)) ? 1 : 0;
            keep[g] = rank < 4; }
        float mv[4];
#pragma unroll
        for (int j = 0; j < 4; ++j) { const bool k = half ? keep[2 * j + 1] : keep[2 * j]; mv[j] = k ? bz[j] : -INFINITY; }
        float ssum = 0.f, myS = 0.f; int myE = 0;
#pragma unroll 1
        for (int it = 0; it < 8; ++it) {
            float bv = mv[0], bs = s[0]; int be = lane;
#pragma unroll
            for (int j = 1; j < 4; ++j) if (mv[j] > bv) { bv = mv[j]; be = lane + 64 * j; bs = s[j]; }
#pragma unroll
            for (int o = 32; o >= 1; o >>= 1) { const float ov = __shfl_xor(bv, o), os = __shfl_xor(bs, o); const int oe = __shfl_xor(be, o); if (ov > bv || (ov == bv && oe < be)) { bv = ov; be = oe; bs = os; } }
#pragma unroll
            for (int j = 0; j < 4; ++j) if (be == lane + 64 * j) mv[j] = -INFINITY;
            if (lane == it) { myE = be; myS = bs; }
            ssum += bs;
        }
        if (lane < 8) { const int idx = tok * 8 + lane; TID[idx] = myE; TW[idx] = myS / ssum * 2.5f; TP[idx] = (int)__hip_atomic_fetch_add(LC + myE, 1u, __ATOMIC_RELAXED, __HIP_MEMORY_SCOPE_WORKGROUP); }
    }
    __syncthreads();
    if (threadIdx.x < 256) { const unsigned cnt = LC[threadIdx.x]; LB[threadIdx.x] = cnt ? atomicAdd(&CNT[threadIdx.x], cnt) : 0u; }
    __syncthreads();
    for (int tok = gw; tok < NTOK; tok += nw) if (lane < 8) { const int idx = tok * 8 + lane; TP[idx] += (int)LB[TID[idx]]; }
}
DEVI void phase12(const Params& p, LAS unsigned char* lds, int part) {
    if (part == 0) {
    LAS int* T = (LAS int*)(lds + LDS_TAB);
    moe_tables((const unsigned*)(p.ws + WS_CNT), T);
    const int* TID = (const int*)(p.ws + WS_TOPK_ID); const int* TP = (const int*)(p.ws + WS_TOPK_POS); const float* TW = (const float*)(p.ws + WS_TOPK_W); u32x2* SL = (u32x2*)(p.ws + WS_SLOT);
    for (int idx = blockIdx.x * 512 + threadIdx.x; idx < NTOK * 8; idx += gridDim.x * 512) { u32x2 rec; rec.x = (unsigned)idx; rec.y = __float_as_uint(TW[idx]); SL[T[256 + TID[idx]] + TP[idx]] = rec; }
    return; }
    LAS float* tb = (LAS float*)lds;
    for (int t = blockIdx.x; t < 256 * 48; t += gridDim.x) {
        const int e = t / 48, r = t % 48;
        if (r < 16)      conv_tile(p.in[20] + (size_t)e * 262144, 256, 256, (bf16_t*)(p.ws + WS_EXPGU) + (size_t)e * 524288, 1024, r * 64, 0, 0, tb);
        else if (r < 32) conv_tile(p.in[21] + (size_t)e * 262144, 256, 256, (bf16_t*)(p.ws + WS_EXPGU) + (size_t)e * 524288, 1024, (r - 16) * 64, 0, 128, tb);
        else { const int kt = (r - 32) >> 2, nb = (r - 32) & 3; conv_tile(p.in[22] + (size_t)e * 262144 + nb * 256, 1024, 256, (bf16_t*)(p.ws + WS_EXPD) + (size_t)e * 262144, 256, kt * 64, nb * 256, -1, tb); }
    }
}
DEVI void phase15(const Params& p) {
    const int lane = threadIdx.x & 63, gw = blockIdx.x * 8 + (threadIdx.x >> 6), nw = gridDim.x * 8;
    const float* mod = (const float*)(p.ws + WS_MOD); const float* X1 = (const float*)(p.ws + WS_X1);
    for (int tok = gw; tok < NTOK; tok += nw) {
        const float* m = mod + (size_t)(tok >> 12) * 6144 + 5120; float v[2][8];
#pragma unroll
        for (int j = 0; j < 2; ++j) { const int cidx = lane * 8 + 512 * j; float a[8];
#pragma unroll
            for (int e = 0; e < 8; ++e) a[e] = 0.f;
#pragma unroll
            for (int k = 0; k < 9; ++k) { const u32x4 y = *(const u32x4*)((const bf16_t*)(p.ws + (k < 8 ? ws_y(k) : WS_Y8)) + (size_t)tok * 1024 + cidx);
                a[0] += bflo(y.x); a[1] += bfhi(y.x); a[2] += bflo(y.y); a[3] += bfhi(y.y); a[4] += bflo(y.z); a[5] += bfhi(y.z); a[6] += bflo(y.w); a[7] += bfhi(y.w); }
            const f32x4 g0 = *(const f32x4*)(m + cidx), g1 = *(const f32x4*)(m + cidx + 4), x0 = *(const f32x4*)(X1 + (size_t)tok * 1024 + cidx), x1 = *(const f32x4*)(X1 + (size_t)tok * 1024 + cidx + 4);
#if defined(DBG_NOMOE)
#pragma unroll
            for (int e = 0; e < 8; ++e) a[e] = 0.f;
#endif
#pragma unroll
            for (int e = 0; e < 4; ++e) { v[j][e] = x0[e] * 1.189207115f + g0[e] * a[e]; v[j][4 + e] = x1[e] * 1.189207115f + g1[e] * a[4 + e]; }
        }
        float sm = 0.f;
#pragma unroll
        for (int j = 0; j < 2; ++j)
#pragma unroll
            for (int e = 0; e < 8; ++e) sm += v[j][e];
        const float mu = wave_sum(sm) * (1.0f / 1024.0f); float q = 0.f;
#pragma unroll
        for (int j = 0; j < 2; ++j)
#pragma unroll
            for (int e = 0; e < 8; ++e) { v[j][e] -= mu; q += v[j][e] * v[j][e]; }
        const float rstd = rsqrtf(wave_sum(q) * (1.0f / 1024.0f) + 1e-6f);
#pragma unroll
        for (int j = 0; j < 2; ++j) { const int cidx = lane * 8 + 512 * j;
            const f32x4 g0 = *(const f32x4*)(p.in[26] + cidx), g1 = *(const f32x4*)(p.in[26] + cidx + 4), b0 = *(const f32x4*)(p.in[27] + cidx), b1 = *(const f32x4*)(p.in[27] + cidx + 4);
            f32x4 o0, o1;
#pragma unroll
            for (int e = 0; e < 4; ++e) { o0[e] = v[j][e] * rstd * g0[e] + b0[e]; o1[e] = v[j][4 + e] * rstd * g1[e] + b1[e]; }
            *(f32x4*)(p.out + (size_t)tok * 1024 + cidx) = o0; *(f32x4*)(p.out + (size_t)tok * 1024 + cidx + 4) = o1; }
    }
}

__global__ void __launch_bounds__(512, 2) mega(Params p) {
    extern __shared__ __attribute__((aligned(16))) unsigned char shm[];
    LAS unsigned char* lds = (LAS unsigned char*)shm;
    volatile LAS unsigned* xbw = (volatile LAS unsigned*)(lds + LDS_BARW);
    if (threadIdx.x == 0) { xbw[0] = 0u; xbw[1] = 0u; xbw[2] = 0u; xbw[3] = 0u; }
    __syncthreads();
    XcdBarrier bar; bar.bar = (unsigned*)(p.ws + WS_CTL); bar.x = 0; bar.st = xbw;
    const bool multi = (p.ph_hi - p.ph_lo) > 1;
    if (multi) bar = xcd_barrier_post((unsigned*)(p.ws + WS_CTL), xbw);
    unsigned char* ws = p.ws;
    const int G = gridDim.x, c = blockIdx.x;
#ifndef PHMASK
#define PHMASK 0xFFFF
#endif
#ifndef REPMASK
#define REPMASK 0
#endif
#define RUN(n) if (((PHMASK >> (n)) & 1) && p.ph_lo <= (n) && (n) < p.ph_hi)
#define SYNC(n) if (p.ph_lo <= (n) && (n) + 1 < p.ph_hi) xcd_barrier(bar); else __syncthreads()
    RUN(0) phase0(p, lds, 0);
#if (REPMASK >> 0) & 1
    __syncthreads();
    RUN(0) phase0(p, lds, 0);
#endif
    SYNC(0);
    RUN(1) { phase1(p); phase0(p, lds, 1); }
#if (REPMASK >> 1) & 1
    __syncthreads();
    RUN(1) { phase1(p); phase0(p, lds, 1); }
#endif
    SYNC(1);
    RUN(2) { SchedInProj S{ws, G, c}; EpiBf16 E; gemm_stream<SchedInProj, EpiBf16, false>(lds, S, E); }
#if (REPMASK >> 2) & 1
    __syncthreads();
    RUN(2) { SchedInProj S{ws, G, c}; EpiBf16 E; gemm_stream<SchedInProj, EpiBf16, false>(lds, S, E); }
#endif
    SYNC(2);
    RUN(3) phase3(p, lds);
#if (REPMASK >> 3) & 1
    __syncthreads();
    RUN(3) phase3(p, lds);
#endif
    SYNC(3);
    RUN(4) { if (c & 1) { phase4_na(p, lds); __syncthreads(); phase4_gla(p, lds); } else { phase4_gla(p, lds); __syncthreads(); phase4_na(p, lds); } }
    SYNC(4);
    RUN(5) phase5(p);
#if (REPMASK >> 5) & 1
    __syncthreads();
    RUN(5) phase5(p);
#endif
    SYNC(5);
#if (REPMASK >> 6) & 1
    __syncthreads();
#endif
    RUN(7) { SchedDense S{(const char*)(ws + WS_AP), (const char*)(ws + WS_BT_BR), (char*)(ws + WS_YM), 1536, G, c, 3072u, 3072u, 24}; EpiBranchC E{(const bf16_t*)(ws + WS_SGA), (const bf16_t*)(ws + WS_SGB), (bf16_t*)(ws + WS_YM)}; gemm_stream<SchedDense, EpiBranchC, false>(lds, S, E); }
#if (REPMASK >> 7) & 1
    __syncthreads();
    RUN(7) { SchedDense S{(const char*)(ws + WS_AP), (const char*)(ws + WS_BT_BR), (char*)(ws + WS_YM), 1536, G, c, 3072u, 3072u, 24}; EpiBranchC E{(const bf16_t*)(ws + WS_SGA), (const bf16_t*)(ws + WS_SGB), (bf16_t*)(ws + WS_YM)}; gemm_stream<SchedDense, EpiBranchC, false>(lds, S, E); }
#endif
    SYNC(7);
    RUN(8) { SchedDense S{(const char*)(ws + WS_YM), (const char*)(ws + WS_BT_OUT), (char*)(ws + WS_Z), 1024, G, c, 2048u, 2048u, 16}; EpiBf16 E; gemm_stream<SchedDense, EpiBf16, false>(lds, S, E); }
#if (REPMASK >> 8) & 1
    __syncthreads();
    RUN(8) { SchedDense S{(const char*)(ws + WS_YM), (const char*)(ws + WS_BT_OUT), (char*)(ws + WS_Z), 1024, G, c, 2048u, 2048u, 16}; EpiBf16 E; gemm_stream<SchedDense, EpiBf16, false>(lds, S, E); }
#endif
    SYNC(8);
    RUN(9) phase9(p);
#if (REPMASK >> 9) & 1
    __syncthreads();
    RUN(9) phase9(p);
#endif
    SYNC(9);
    RUN(10) { SchedRouter S{ws, G, c}; EpiF32 E; gemm_stream<SchedRouter, EpiF32, false>(lds, S, E); }
#if (REPMASK >> 10) & 1
    __syncthreads();
    RUN(10) { SchedRouter S{ws, G, c}; EpiF32 E; gemm_stream<SchedRouter, EpiF32, false>(lds, S, E); }
#endif
    SYNC(10);
    RUN(11) { if (c & 1) phase12(p, lds, 1); phase11(p, lds); if (!(c & 1)) phase12(p, lds, 1); }
#if (REPMASK >> 11) & 1
    __syncthreads();
    RUN(11) { if (c & 1) phase12(p, lds, 1); phase11(p, lds); if (!(c & 1)) phase12(p, lds, 1); }
#endif
    SYNC(11);
    RUN(12) phase12(p, lds, 0);
#if (REPMASK >> 12) & 1
    __syncthreads();
    RUN(12) phase12(p, lds, 0);
#endif
    SYNC(12);
    RUN(13) { LAS int* T = (LAS int*)(lds + LDS_TAB); moe_tables((const unsigned*)(ws + WS_CNT), T); SchedGateUp S{ws, T, G, c}; EpiGateUp E{(bf16_t*)(ws + WS_HID)}; gemm_stream<SchedGateUp, EpiGateUp, true>(lds, S, E); }
#if (REPMASK >> 13) & 1
    __syncthreads();
    RUN(13) { LAS int* T = (LAS int*)(lds + LDS_TAB); moe_tables((const unsigned*)(ws + WS_CNT), T); SchedGateUp S{ws, T, G, c}; EpiGateUp E{(bf16_t*)(ws + WS_HID)}; gemm_stream<SchedGateUp, EpiGateUp, true>(lds, S, E); }
#endif
    SYNC(13);
    RUN(14) { LAS int* T = (LAS int*)(lds + LDS_TAB); moe_tables((const unsigned*)(ws + WS_CNT), T); SchedDown S{ws, T, G, c}; EpiDown E{ws, (const u32x2*)(ws + WS_SLOT), (const float*)(ws + WS_TOPK_W)}; gemm_stream<SchedDown, EpiDown, false>(lds, S, E); }
#if (REPMASK >> 14) & 1
    __syncthreads();
    RUN(14) { LAS int* T = (LAS int*)(lds + LDS_TAB); moe_tables((const unsigned*)(ws + WS_CNT), T); SchedDown S{ws, T, G, c}; EpiDown E{ws, (const u32x2*)(ws + WS_SLOT), (const float*)(ws + WS_TOPK_W)}; gemm_stream<SchedDown, EpiDown, false>(lds, S, E); }
#endif
    SYNC(14);
    RUN(15) phase15(p);
#if (REPMASK >> 15) & 1
    __syncthreads();
    RUN(15) phase15(p);
#endif
}

#ifdef DBG_STOP
__global__ void dbg_dump(const unsigned short* base, size_t nwords, float* out, int accumulate) {
    for (size_t i = (size_t)blockIdx.x * blockDim.x + threadIdx.x; i < (size_t)33554432; i += (size_t)gridDim.x * blockDim.x) {
        float s = accumulate ? out[i] : 0.f;
        for (size_t j = i; j < nwords; j += (size_t)33554432) s += (float)base[j];
        out[i] = s;
    }
}
#endif
}

extern "C" void kernel_launch(void* const* d_in, const int* in_sizes, int n_in, void* d_out, int out_size, void* d_ws, size_t ws_size, hipStream_t stream) {
    static int grid = 0;
    if (grid == 0) {
        if (n_in != 28 || out_size != NTOK * 1024 || ws_size < WS_END) { fprintf(stderr, "kernel_launch: unexpected problem (n_in %d out %d ws %zu)\n", n_in, out_size, ws_size); grid = -1; return; }
        int dev = 0, cus = 0, per_cu = 0;
        if (hipGetDevice(&dev) != hipSuccess || hipDeviceGetAttribute(&cus, hipDeviceAttributeMultiprocessorCount, dev) != hipSuccess) { grid = -1; return; }
        if (hipFuncSetAttribute((const void*)mega, hipFuncAttributeMaxDynamicSharedMemorySize, LDS_TOTAL) != hipSuccess) { fprintf(stderr, "kernel_launch: hipFuncSetAttribute failed\n"); grid = -1; return; }
        if (hipOccupancyMaxActiveBlocksPerMultiprocessor(&per_cu, (const void*)mega, 512, LDS_TOTAL) != hipSuccess || per_cu < 1) fprintf(stderr, "kernel_launch: occupancy query says %d\n", per_cu);
        (void)hipGetLastError();
        grid = cus;
    }
    if (grid < 0) return;
    (void)hipMemsetAsync((char*)d_ws + WS_CTL, 0, 32768, stream);
    Params p{};
    for (int i = 0; i < 28; ++i) p.in[i] = (const float*)d_in[i];
    p.out = (float*)d_out; p.ws = (unsigned char*)d_ws;
#ifdef DBG_STOP
    for (int ph = 0; ph <= DBG_STOP; ++ph) { p.ph_lo = ph; p.ph_hi = ph + 1; hipLaunchKernelGGL(mega, dim3(grid), dim3(512), LDS_TOTAL, stream, p); }
    { const size_t regs[][2] = { DBG_REGS }; int first = 1;
      for (auto& r : regs) { hipLaunchKernelGGL(dbg_dump, dim3(2048), dim3(256), 0, stream, (const unsigned short*)((char*)d_ws + r[0] * MiB), (size_t)(r[1] * MiB / 2), (float*)d_out, first ? 0 : 1); first = 0; } }
#elif MK_PER_PHASE
    for (int ph = 0; ph < NPH; ++ph) {
#if defined(DBG_NOMOE)
        if (ph >= 10 && ph <= 14) continue;
#endif
        p.ph_lo = ph; p.ph_hi = ph + 1; hipLaunchKernelGGL(mega, dim3(grid), dim3(512), LDS_TOTAL, stream, p); }
#else
    p.ph_lo = 0; p.ph_hi = NPH; hipLaunchKernelGGL(mega, dim3(grid), dim3(512), LDS_TOTAL, stream, p);
#endif
}
```

```cpp
#include <hip/hip_runtime.h>
#include <stdint.h>
#include <stdio.h>

#ifndef MK_PER_PHASE
#define MK_PER_PHASE 0
#endif

namespace {
typedef unsigned short bf16_t;
typedef short bf16x8 __attribute__((ext_vector_type(8)));
typedef float f32x4 __attribute__((ext_vector_type(4)));
typedef unsigned u32x4 __attribute__((ext_vector_type(4)));
typedef unsigned u32x2 __attribute__((ext_vector_type(2)));
#define LAS __attribute__((address_space(3)))
#define DEVI __device__ __forceinline__

constexpr int NTOK = 32768, NROW = 34816, NPH = 16;
constexpr size_t MiB = 1ull << 20;
constexpr int LDS_TOTAL = 160 * 1024;
constexpr int LDS_BARW = LDS_TOTAL - 16;
constexpr int LDS_TAB = 131072;

constexpr size_t WS_CTL = 0, WS_CNT = 16384, WS_MOD = 1 * MiB, WS_EE = 2 * MiB, WS_TOPK_ID = 5 * MiB, WS_TOPK_W = 6 * MiB, WS_TOPK_POS = 7 * MiB, WS_SLOT = 8 * MiB;
constexpr size_t WS_BT_IN = 10 * MiB, WS_BT_BR = 24 * MiB  , WS_BT_OUT = 27 * MiB, WS_BT_RT = 29 * MiB, WS_BT_SHGU = 30 * MiB, WS_BT_SHD = 31 * MiB;
constexpr size_t WS_H = 32 * MiB, WS_QA = 100 * MiB, WS_KA = 132 * MiB, WS_QB = 166 * MiB, WS_KB = 198 * MiB, WS_GB = 232 * MiB, WS_SGA = 296 * MiB, WS_SGB = 360 * MiB;
constexpr size_t WS_VAT = 424 * MiB, WS_VBT = 458 * MiB, WS_QTF = 526 * MiB, WS_QTB = 558 * MiB, WS_KTF = 590 * MiB, WS_KTB = 624 * MiB, WS_KTTF = 658 * MiB, WS_KTTB = 692 * MiB;
constexpr size_t WS_OF = 726 * MiB, WS_OB = 790 * MiB, WS_AP = 896 * MiB, WS_LRT = 888 * MiB;
constexpr size_t WS_YM = 424 * MiB, WS_Z = 488 * MiB;
constexpr size_t WS_X1 = 32 * MiB, WS_EXPD = 160 * MiB, WS_LOG0 = 288 * MiB, WS_LOG1 = 320 * MiB, WS_EXPGU = 352 * MiB, WS_H2 = 608 * MiB, WS_HID = 864 * MiB;
constexpr size_t WS_YS = 288 * MiB;
constexpr size_t WS_Y8 = 800 * MiB, WS_END = 1009 * MiB;
DEVI size_t ws_ys(int slot) { return WS_YS + (size_t)slot * 2048; }
DEVI size_t ws_y(int k) { return (k < 2 ? 160 + 64 * (size_t)k : (k < 6 ? 416 + 64 * (size_t)(k - 2) : 817 + 64 * (size_t)(k - 6))) * MiB; }

struct Params { const float* in[28]; float* out; unsigned char* ws; int ph_lo, ph_hi; };

typedef __bf16 bf16x2_t __attribute__((ext_vector_type(2)));
typedef float f32x2_t __attribute__((ext_vector_type(2)));
DEVI unsigned pk_bf16(float lo, float hi) { const f32x2_t v = {lo, hi}; const bf16x2_t r = __builtin_convertvector(v, bf16x2_t); return __builtin_bit_cast(unsigned, r); }
DEVI float bf2f(bf16_t b) { return __uint_as_float(((unsigned)b) << 16); }
DEVI float bflo(unsigned w) { return __uint_as_float(w << 16); }
DEVI float bfhi(unsigned w) { return __uint_as_float(w & 0xffff0000u); }
DEVI bf16_t f2bf(float f) { return (bf16_t)(pk_bf16(f, 0.f) & 0xffffu); }
DEVI float sigmoidf_(float x) { return __builtin_amdgcn_rcpf(1.0f + __expf(-x)); }
template <int N> struct IC { static constexpr int v = N; };
DEVI void lds_barrier() { asm volatile("s_waitcnt lgkmcnt(0)" ::: "memory"); __builtin_amdgcn_s_barrier(); asm volatile("" ::: "memory"); }
DEVI float wave_sum(float v) { v += __shfl_xor(v, 32); v += __shfl_xor(v, 16); v += __shfl_xor(v, 8); v += __shfl_xor(v, 4); v += __shfl_xor(v, 2); v += __shfl_xor(v, 1); return v; }

#define XB_TMO      128
#define XB_XCNT(j)  (256  + 64 * (j))
#define XB_XSUB(j)  (1280 + 64 * (j))
#define XB_XGEN(j)  (2304 + 64 * (j))
#define XB_TOP      3328
#define XB_TOPGEN   3392
#define XCD_BAR_WORDS 3456
#define XB_SPIN_CAP (1u << 22)
DEVI unsigned xb_ld(unsigned* p)              { return __hip_atomic_load(p, __ATOMIC_RELAXED, __HIP_MEMORY_SCOPE_AGENT); }
DEVI unsigned xb_add(unsigned* p, unsigned v) { return __hip_atomic_fetch_add(p, v, __ATOMIC_RELAXED, __HIP_MEMORY_SCOPE_AGENT); }
DEVI unsigned xb_xcc_id() { return (unsigned)__builtin_amdgcn_s_getreg((3 << 11) | 20) & 0xFu; }
#define XB_SPIN(cond, bar) do { unsigned _sp = 0; while (cond) { __builtin_amdgcn_s_sleep(1); \
    if ((++_sp & 255u) == 0u) { if (xb_ld(&(bar)[XB_TMO])) break; if (_sp > XB_SPIN_CAP) { atomicAdd(&(bar)[XB_TMO], 1u); break; } } } } while (0)
struct XcdBarrier { unsigned* bar; unsigned x; volatile LAS unsigned* st; };
DEVI XcdBarrier xcd_barrier_post(unsigned* bar, volatile LAS unsigned* st) {
    XcdBarrier b; b.bar = bar; b.x = xb_xcc_id(); b.st = st;
    if (threadIdx.x == 0) (void)xb_add(&bar[XB_XCNT(b.x)], 1u);
    return b;
}
DEVI void xcd_barrier_complete(unsigned* bar, unsigned x, unsigned& nloc, unsigned& nx) {
    const unsigned G = gridDim.x * gridDim.y * gridDim.z;
    unsigned sum, cnt, mine, sp = 0u;
    for (;;) {
        sum = 0u; cnt = 0u; mine = 0u;
#pragma unroll
        for (unsigned j = 0; j < 16; ++j) { const unsigned c = xb_ld(&bar[XB_XCNT(j)]); sum += c; cnt += (c > 0u) ? 1u : 0u; mine = (j == x) ? c : mine; }
        if (sum == G) break;
        __builtin_amdgcn_s_sleep(1);
        if ((++sp & 255u) == 0u) { if (xb_ld(&bar[XB_TMO])) break; if (sp > XB_SPIN_CAP) { atomicAdd(&bar[XB_TMO], 1u); break; } }
    }
    nloc = mine > 0u ? mine : 1u; nx = cnt > 0u ? cnt : 1u;
}
DEVI void xcd_barrier(const XcdBarrier& b) {
    asm volatile("s_waitcnt vmcnt(0)" ::: "memory");
    __syncthreads();
    if (threadIdx.x == 0) {
        unsigned* bar = b.bar;
        __builtin_amdgcn_s_waitcnt(0);
        unsigned nloc = b.st[0], nx = b.st[1];
        if (nloc == 0u) { xcd_barrier_complete(bar, b.x, nloc, nx); b.st[0] = nloc; b.st[1] = nx; }
        const unsigned old = xb_add(&bar[XB_XSUB(b.x)], 1u);
        const unsigned gen = old / nloc;
        if (old + 1u == (gen + 1u) * nloc) {
            __builtin_amdgcn_fence(__ATOMIC_RELEASE, "agent");
            asm volatile("s_waitcnt vmcnt(0)" ::: "memory");
            const unsigned og = xb_add(&bar[XB_TOP], 1u);
            const unsigned tg = og / nx;
            if (og + 1u == (tg + 1u) * nx) xb_add(&bar[XB_TOPGEN], 1u);
            else XB_SPIN(xb_ld(&bar[XB_TOPGEN]) == tg, bar);
            __builtin_amdgcn_fence(__ATOMIC_ACQUIRE, "agent");
            xb_add(&bar[XB_XGEN(b.x)], 1u);
            asm volatile("s_waitcnt vmcnt(0)" ::: "memory");
        } else {
            XB_SPIN(xb_ld(&bar[XB_XGEN(b.x)]) == gen, bar);
            __builtin_amdgcn_fence(__ATOMIC_ACQUIRE, "agent");
            asm volatile("s_waitcnt vmcnt(0)" ::: "memory");
        }
    }
    __syncthreads();
}

constexpr int BK = 64, HALF = 128, HTB = HALF * BK * 2;
DEVI int lds_byte(int r, int c) { const int st = (r >> 4) * 2 + (c >> 5), rr = r & 15, cc = c & 31, ob = rr * 64 + cc * 2; return st * 1024 + (ob ^ (((ob >> 9) & 1) << 5)); }
DEVI void stage_rc(int b, int& R, int& C) { const int st = b / 1024, sb = b % 1024, swz = sb ^ (((sb >> 9) & 1) << 5); R = (st >> 1) * 16 + swz / 64; C = (st & 1) * 32 + (swz % 64) / 2; }
DEVI int perm32(int rho) { const int n = rho >> 4, i = rho & 15; return 8 * (i >> 2) + 4 * n + (i & 3); }

struct GUnit {
    const char* a; const char* b;
    char* dst; int ldd; int i0, i1, i2; float f0;
};
typedef f32x4 Acc[2][2][4][2];
#define ZA1(a, b, m) acc[a][b][m][0] = z; acc[a][b][m][1] = z;
#define ZA2(a, b) ZA1(a, b, 0) ZA1(a, b, 1) ZA1(a, b, 2) ZA1(a, b, 3)
DEVI void zero_acc(Acc& acc) { f32x4 z = {0.f, 0.f, 0.f, 0.f}; asm volatile("" : "+v"(z)); ZA2(0, 0) ZA2(0, 1) ZA2(1, 0) ZA2(1, 1) }

template <class Sched, class Epi, bool GATHER>
DEVI void gemm_stream(LAS unsigned char* lds, const Sched& S, const Epi& E) {
    const int tid = threadIdx.x, wid = __builtin_amdgcn_readfirstlane(tid >> 6), lane = tid & 63, wr = wid >> 2, wc = wid & 3, fr = lane & 15, fq = lane >> 4;
    const unsigned lda = S.lda, ldb = S.ldb; const int nt = S.nt;
    unsigned voffA[2], voffB[2]; int R0 = 0;
#pragma unroll
    for (int i = 0; i < 2; ++i) { int R, C; stage_rc(tid * 16 + i * 8192, R, C); const int Rb = (R & ~31) + perm32(R & 31);
        if (i == 0) R0 = R;
        voffA[i] = GATHER ? (unsigned)(C * 2) : (unsigned)R * lda + (unsigned)(C * 2); voffB[i] = (unsigned)Rb * ldb + (unsigned)(C * 2); }
    const size_t kstep = (size_t)(BK * 2);
    const size_t hstepA = GATHER ? (size_t)0 : (size_t)HALF * lda, hstepB = (size_t)HALF * ldb;
    const unsigned ldsw = (unsigned)wid * 1024u;
    const int aoff = lds_byte(wr * 64 + fr, fq * 8), boff = lds_byte(wc * 32 + fr, fq * 8);
#define G_SA(b, h) (((b) * 2 + (h)) * HTB)
#define G_SB(b, h) ((4 + (b) * 2 + (h)) * HTB)
#define G_STAGE(bufoff, gbase, o0, o1) do { \
        __builtin_amdgcn_global_load_lds((const unsigned*)((const char*)(gbase) + (o0)), (LAS unsigned*)(lds + (bufoff) + ldsw), 16, 0, 0); \
        __builtin_amdgcn_global_load_lds((const unsigned*)((const char*)(gbase) + (o1)), (LAS unsigned*)(lds + (bufoff) + ldsw + 8192), 16, 0, 0); } while (0)
#define G_LDA(dst, b, h) do { _Pragma("unroll") for (int m = 0; m < 4; ++m) _Pragma("unroll") for (int k = 0; k < 2; ++k) dst[m][k] = *(const LAS bf16x8*)(lds + G_SA(b, h) + aoff + m * 2048 + k * 1024); } while (0)
#define G_LDB(dst, b, h) do { _Pragma("unroll") for (int n = 0; n < 2; ++n) _Pragma("unroll") for (int k = 0; k < 2; ++k) dst[n][k] = *(const LAS bf16x8*)(lds + G_SB(b, h) + boff + n * 2048 + k * 1024); } while (0)
#define G_MMA(ai, bj, At, Bt) do { __builtin_amdgcn_s_setprio(1); _Pragma("unroll") for (int m = 0; m < 4; ++m) _Pragma("unroll") for (int n = 0; n < 2; ++n) _Pragma("unroll") for (int k = 0; k < 2; ++k) \
        acc[ai][bj][m][n] = __builtin_amdgcn_mfma_f32_16x16x32_bf16(Bt[n][k], At[m][k], acc[ai][bj][m][n], 0, 0, 0); __builtin_amdgcn_s_setprio(0); } while (0)
#define G_WAIT_V(n) asm volatile("s_waitcnt vmcnt(" #n ")" ::: "memory")
#define G_WAIT_L(n) asm volatile("s_waitcnt lgkmcnt(" #n ")" ::: "memory")
#define G_BAR __builtin_amdgcn_s_barrier()
#define G_SCHED __builtin_amdgcn_sched_barrier(0)
    GUnit cur, nxt; int ui = 0;
    if (!S.next(0, cur)) return;
    unsigned gc[2][2], gn[2][2];
    gc[0][0] = voffA[0]; gc[0][1] = voffA[1]; gc[1][0] = voffA[0]; gc[1][1] = voffA[1];
    gn[0][0] = voffA[0]; gn[0][1] = voffA[1]; gn[1][0] = voffA[0]; gn[1][1] = voffA[1];
    if constexpr (GATHER) { S.gather(cur, R0, gc); gc[0][0] += voffA[0]; gc[0][1] += voffA[0]; gc[1][0] += voffA[0]; gc[1][1] += voffA[0]; }
    Acc acc; zero_acc(acc);
    typename Epi::Pre pre; E.pre(cur, wr, lane, pre);
    bf16x8 At[4][2], B0[2][2], B1[2][2];
    const char* cA = cur.a; const char* cB = cur.b;
    G_STAGE(G_SB(0, 0), cB, voffB[0], voffB[1]); G_STAGE(G_SA(0, 0), cA, gc[0][0], gc[0][1]); G_STAGE(G_SB(0, 1), cB + hstepB, voffB[0], voffB[1]); G_STAGE(G_SA(0, 1), cA + hstepA, gc[1][0], gc[1][1]);
    if (wr == 1) G_BAR;
    G_WAIT_V(4); G_BAR;
    G_STAGE(G_SB(1, 0), cB + kstep, voffB[0], voffB[1]); G_STAGE(G_SA(1, 0), cA + kstep, gc[0][0], gc[0][1]); G_STAGE(G_SB(1, 1), cB + hstepB + kstep, voffB[0], voffB[1]);
    G_WAIT_V(6); G_BAR;
    for (;;) {
        const bool has_next = S.next(ui + 1, nxt);
        const char* nA = has_next ? nxt.a : cA; const char* nB = has_next ? nxt.b : cB;
        for (int t = 0; t < nt; t += 2) {
            const bool last = (t == nt - 2);
            const char* a1 = cA + (size_t)(t + 1) * kstep;
            const char* a2 = last ? nA : cA + (size_t)(t + 2) * kstep; const char* b2 = last ? nB : cB + (size_t)(t + 2) * kstep;
            const char* a3 = a2 + kstep; const char* b3 = b2 + kstep;
            unsigned g2[2][2];
            if constexpr (GATHER) { g2[0][0] = last ? gn[0][0] : gc[0][0]; g2[0][1] = last ? gn[0][1] : gc[0][1]; g2[1][0] = last ? gn[1][0] : gc[1][0]; g2[1][1] = last ? gn[1][1] : gc[1][1]; }
            else { g2[0][0] = voffA[0]; g2[0][1] = voffA[1]; g2[1][0] = voffA[0]; g2[1][1] = voffA[1]; }
            if constexpr (GATHER) { if (t == nt - 4) {
                if (has_next) { S.gather(nxt, R0, gn); gn[0][0] += voffA[0]; gn[0][1] += voffA[0]; gn[1][0] += voffA[0]; gn[1][1] += voffA[0]; }
                else { gn[0][0] = gc[0][0]; gn[0][1] = gc[0][1]; gn[1][0] = gc[1][0]; gn[1][1] = gc[1][1]; } } }
            if constexpr (Epi::MID_T > 0) { if (t == Epi::MID_T) { int tz = threadIdx.x; asm volatile("" : "+v"(tz)); const int wz = tz >> 6, lz = tz & 63; E.mid(acc, cur, wz >> 2, wz & 3, lz & 15, lz >> 4); } }
            G_LDB(B0, 0, 0); G_SCHED; G_LDA(At, 0, 0); G_STAGE(G_SA(1, 1), a1 + hstepA, gc[1][0], gc[1][1]);
            G_WAIT_L(8); G_BAR; G_WAIT_L(0); G_MMA(0, 0, At, B0); G_BAR; G_SCHED;
            G_LDB(B1, 0, 1); G_STAGE(G_SB(0, 0), b2, voffB[0], voffB[1]);
            G_BAR; G_WAIT_L(0); G_MMA(0, 1, At, B1); G_BAR;
            G_LDA(At, 0, 1); G_STAGE(G_SA(0, 0), a2, g2[0][0], g2[0][1]);
            G_BAR; G_WAIT_L(0); G_MMA(1, 0, At, B0); G_BAR; G_SCHED;
            G_STAGE(G_SB(0, 1), b2 + hstepB, voffB[0], voffB[1]);
            G_WAIT_V(6); G_BAR; G_MMA(1, 1, At, B1); G_BAR;
            G_LDB(B0, 1, 0); G_SCHED; G_LDA(At, 1, 0); G_STAGE(G_SA(0, 1), a2 + hstepA, g2[1][0], g2[1][1]);
            G_WAIT_L(8); G_BAR; G_WAIT_L(0); G_MMA(0, 0, At, B0); G_BAR; G_SCHED;
            G_LDB(B1, 1, 1); G_STAGE(G_SB(1, 0), b3, voffB[0], voffB[1]);
            G_BAR; G_WAIT_L(0); G_MMA(0, 1, At, B1); G_BAR;
            G_LDA(At, 1, 1); G_STAGE(G_SA(1, 0), a3, g2[0][0], g2[0][1]);
            G_BAR; G_WAIT_L(0); G_MMA(1, 0, At, B0); G_BAR; G_SCHED;
            G_STAGE(G_SB(1, 1), b3 + hstepB, voffB[0], voffB[1]);
            G_WAIT_V(6); G_BAR; G_MMA(1, 1, At, B1); G_BAR;
        }
        { int tz = threadIdx.x; asm volatile("" : "+v"(tz)); const int wz = tz >> 6, lz = tz & 63; E(acc, cur, wz >> 2, wz & 3, lz & 15, lz >> 4, pre); }
        if (!has_next) break;
        zero_acc(acc);
        cur = nxt; cA = nA; cB = nB; ++ui;
        E.pre(cur, wr, lane, pre);
        if constexpr (GATHER) { gc[0][0] = gn[0][0]; gc[0][1] = gn[0][1]; gc[1][0] = gn[1][0]; gc[1][1] = gn[1][1]; }
    }
    G_WAIT_V(0);
    if (wr == 0) G_BAR;
    G_BAR;
}

struct EpiBf16 { static constexpr int MID_T = 0; DEVI void mid(Acc&, const GUnit&, int, int, int, int) const {}
    struct Pre {}; DEVI void pre(const GUnit&, int, int, Pre&) const {}
    DEVI void operator()(const Acc& acc, const GUnit& u, int wr, int wc, int fr, int fq, const Pre&) const {
        if (u.f0 < 0.f) {
            float* fb = (float*)u.dst;
#pragma unroll
            for (int m = 0; m < 4; ++m) { const int row = wr * 64 + m * 16 + fr;
                if (row < 32) { float* rp = fb + (size_t)row * u.ldd + wc * 32 + 8 * fq;
#pragma unroll
                    for (int bj = 0; bj < 2; ++bj) { *(f32x4*)(rp + bj * 128) = acc[0][bj][m][0]; *(f32x4*)(rp + bj * 128 + 4) = acc[0][bj][m][1]; } } }
            return;
        }
        bf16_t* base = (bf16_t*)u.dst; const float s = u.f0; const int act = u.i0;
#pragma unroll
        for (int ai = 0; ai < 2; ++ai)
#pragma unroll
            for (int m = 0; m < 4; ++m) {
                bf16_t* rp = base + (size_t)(ai * 128 + wr * 64 + m * 16 + fr) * u.ldd + wc * 32 + 8 * fq;
#pragma unroll
                for (int bj = 0; bj < 2; ++bj) {
                    f32x4 v0 = acc[ai][bj][m][0] * s, v1 = acc[ai][bj][m][1] * s;
                    if (act) {
#pragma unroll
                        for (int j = 0; j < 4; ++j) { v0[j] = sigmoidf_(v0[j]); v1[j] = sigmoidf_(v1[j]); }
                    }
                    u32x4 w; w.x = pk_bf16(v0[0], v0[1]); w.y = pk_bf16(v0[2], v0[3]); w.z = pk_bf16(v1[0], v1[1]); w.w = pk_bf16(v1[2], v1[3]);
                    *(u32x4*)(rp + bj * 128) = w;
                }
            }
    }
};
struct EpiF32 { static constexpr int MID_T = 0; DEVI void mid(Acc&, const GUnit&, int, int, int, int) const {}
    struct Pre {}; DEVI void pre(const GUnit&, int, int, Pre&) const {}
    DEVI void operator()(const Acc& acc, const GUnit& u, int wr, int wc, int fr, int fq, const Pre&) const {
        float* base = (float*)u.dst;
#pragma unroll
        for (int ai = 0; ai < 2; ++ai)
#pragma unroll
            for (int m = 0; m < 4; ++m) {
                float* rp = base + (size_t)(ai * 128 + wr * 64 + m * 16 + fr) * u.ldd + wc * 32 + 8 * fq;
#pragma unroll
                for (int bj = 0; bj < 2; ++bj) { *(f32x4*)(rp + bj * 128) = acc[ai][bj][m][0]; *(f32x4*)(rp + bj * 128 + 4) = acc[ai][bj][m][1]; }
            }
    }
};
struct EpiBranchC {
    static constexpr int MID_T = 8;
    const bf16_t* sga; const bf16_t* sgb; bf16_t* ym;
    struct Pre {}; DEVI void pre(const GUnit&, int, int, Pre&) const {}
    DEVI void mid(Acc& acc, const GUnit& u, int wr, int wc, int fr, int fq) const {
#pragma unroll
        for (int ai = 0; ai < 2; ++ai)
#pragma unroll
            for (int m = 0; m < 4; ++m) {
                const size_t ro = (size_t)(u.i1 + ai * 128 + wr * 64 + m * 16 + fr) * 1024 + u.i2 + wc * 32 + 8 * fq;
#pragma unroll
                for (int bj = 0; bj < 2; ++bj) {
                    const u32x4 ga = *(const u32x4*)(sga + ro + bj * 128), gb = *(const u32x4*)(sgb + ro + bj * 128);
                    f32x4 r0, r1;
                    r0[0] = bflo(ga.x) * __builtin_amdgcn_rcpf(bflo(gb.x)); r0[1] = bfhi(ga.x) * __builtin_amdgcn_rcpf(bfhi(gb.x)); r0[2] = bflo(ga.y) * __builtin_amdgcn_rcpf(bflo(gb.y)); r0[3] = bfhi(ga.y) * __builtin_amdgcn_rcpf(bfhi(gb.y));
                    r1[0] = bflo(ga.z) * __builtin_amdgcn_rcpf(bflo(gb.z)); r1[1] = bfhi(ga.z) * __builtin_amdgcn_rcpf(bfhi(gb.z)); r1[2] = bflo(ga.w) * __builtin_amdgcn_rcpf(bflo(gb.w)); r1[3] = bfhi(ga.w) * __builtin_amdgcn_rcpf(bfhi(gb.w));
                    acc[ai][bj][m][0] = acc[ai][bj][m][0] * r0; acc[ai][bj][m][1] = acc[ai][bj][m][1] * r1;
                }
            }
    }
    DEVI void operator()(const Acc& acc, const GUnit& u, int wr, int wc, int fr, int fq, const Pre&) const {
#pragma unroll
        for (int ai = 0; ai < 2; ++ai)
#pragma unroll
            for (int m = 0; m < 4; ++m) {
                const size_t ro = (size_t)(u.i1 + ai * 128 + wr * 64 + m * 16 + fr) * 1024 + u.i2 + wc * 32 + 8 * fq;
#pragma unroll
                for (int bj = 0; bj < 2; ++bj) {
                    const u32x4 gb = *(const u32x4*)(sgb + ro + bj * 128);
                    const f32x4 v0 = acc[ai][bj][m][0], v1 = acc[ai][bj][m][1];
                    u32x4 w;
                    w.x = pk_bf16(bflo(gb.x) * v0[0], bfhi(gb.x) * v0[1]); w.y = pk_bf16(bflo(gb.y) * v0[2], bfhi(gb.y) * v0[3]);
                    w.z = pk_bf16(bflo(gb.z) * v1[0], bfhi(gb.z) * v1[1]); w.w = pk_bf16(bflo(gb.w) * v1[2], bfhi(gb.w) * v1[3]);
                    *(u32x4*)(ym + ro + bj * 128) = w;
                }
            }
    }
};
struct EpiGateUp { static constexpr int MID_T = 0; DEVI void mid(Acc&, const GUnit&, int, int, int, int) const {}
    bf16_t* hid;
    struct Pre {}; DEVI void pre(const GUnit&, int, int, Pre&) const {}
    DEVI void operator()(const Acc& acc, const GUnit& u, int wr, int wc, int fr, int fq, const Pre&) const {
#pragma unroll
        for (int ai = 0; ai < 2; ++ai)
#pragma unroll
            for (int m = 0; m < 4; ++m) {
                const int row = ai * 128 + wr * 64 + m * 16 + fr;
                if (row < u.i1) {
                    const f32x4 g0 = acc[ai][0][m][0], g1 = acc[ai][0][m][1], u0 = acc[ai][1][m][0], u1 = acc[ai][1][m][1];
                    float h[8];
#pragma unroll
                    for (int j = 0; j < 4; ++j) { h[j] = g0[j] * sigmoidf_(g0[j]) * u0[j]; h[4 + j] = g1[j] * sigmoidf_(g1[j]) * u1[j]; }
                    u32x4 w; w.x = pk_bf16(h[0], h[1]); w.y = pk_bf16(h[2], h[3]); w.z = pk_bf16(h[4], h[5]); w.w = pk_bf16(h[6], h[7]);
                    *(u32x4*)(hid + (size_t)(u.i0 + row) * 256 + u.i2 * 128 + wc * 32 + 8 * fq) = w;
                }
            }
    }
};
struct EpiDown {
    static constexpr int MID_T = 0; DEVI void mid(Acc&, const GUnit&, int, int, int, int) const {}
    unsigned char* ws;
    struct Pre {}; DEVI void pre(const GUnit&, int, int, Pre&) const {}
    DEVI void operator()(const Acc& acc, const GUnit& u, int wr, int wc, int fr, int fq, const Pre&) const {
#pragma unroll
        for (int ai = 0; ai < 2; ++ai)
#pragma unroll
            for (int m = 0; m < 4; ++m) {
                const int row = ai * 128 + wr * 64 + m * 16 + fr;
                if (row < u.i1) {
                    bf16_t* rp = (u.i2 == 0 ? (bf16_t*)(ws + ws_ys(u.i0 + row)) : (bf16_t*)(ws + WS_Y8) + (size_t)(u.i0 + row) * 1024) + u.ldd + wc * 32 + 8 * fq;
#pragma unroll
                    for (int bj = 0; bj < 2; ++bj) {
                        const f32x4 v0 = acc[ai][bj][m][0], v1 = acc[ai][bj][m][1];
                        u32x4 o; o.x = pk_bf16(v0[0], v0[1]); o.y = pk_bf16(v0[2], v0[3]); o.z = pk_bf16(v1[0], v1[1]); o.w = pk_bf16(v1[2], v1[3]);
                        *(u32x4*)(rp + bj * 128) = o;
                    }
                }
            }
    }
};

struct SchedInProj {
    unsigned char* ws; int G, c;
    static constexpr unsigned lda = 2048, ldb = 2048; static constexpr int nt = 16;
    DEVI bool next(int i, GUnit& u) const {
        const int L = i * G + c; if (L >= 3544) return false;
        u.i0 = 0; u.i1 = 0; u.i2 = 0; u.f0 = 1.0f;
        const char* H = (const char*)(ws + WS_H); const char* BT = (const char*)(ws + WS_BT_IN);
        int pm, pn;
        if (L < 2592) {
            if (L < 2560) { const int x = L & 7, q = L >> 3, blk = q >> 5, w = q & 31; pm = 16 * x + 8 * (blk & 1) + (w & 7); pn = 4 * (blk >> 1) + (w >> 3); }
            else { const int j = L - 2560, jn = j >> 3; pm = 128 + (j & 7); pn = jn < 2 ? 2 + jn : 4 + jn; }
            u.a = H + (size_t)pm * 256 * 2048; u.b = BT + (size_t)pn * 256 * 2048;
            size_t base; int ld, col;
            if (pn < 2)       { base = WS_QA; ld = 512; col = pn * 256; u.f0 = 0.125f; }
            else if (pn < 4)  { base = WS_KA; ld = 512; col = (pn - 2) * 256; }
            else if (pn < 6)  { base = WS_QB; ld = 512; col = (pn - 4) * 256; }
            else if (pn < 8)  { base = WS_KB; ld = 512; col = (pn - 6) * 256; }
            else if (pn < 12) { base = WS_GB; ld = 1024; col = (pn - 8) * 256; }
            else if (pn < 16) { base = WS_SGA; ld = 1024; col = (pn - 12) * 256; u.i0 = 1; }
            else              { base = WS_SGB; ld = 1024; col = (pn - 16) * 256; u.i0 = 1; }
            u.dst = (char*)(ws + base) + ((size_t)pm * 256 * ld + col) * 2; u.ldd = ld;
        } else {
            const int j = L - 2592, x = j & 7, q = j >> 3, tn = 17 * x + q / 7, wm = q % 7;
            u.a = BT + (size_t)(5120 + wm * 256) * 2048; u.b = H + (size_t)tn * 256 * 2048;
            u.dst = (wm < 2 ? (char*)(ws + WS_VAT) + ((size_t)(wm * 256) * NROW + tn * 256) * 2 : (wm < 6 ? (char*)(ws + WS_VBT) + ((size_t)((wm - 2) * 256) * NROW + tn * 256) * 2 : (char*)(ws + WS_LRT) + (size_t)(tn * 256) * 4));
            u.ldd = NROW; if (wm == 6) u.f0 = -1.0f;
        }
        return true;
    }
};
struct SchedDense {
    const char* A; const char* Bt; char* dst; int K; int G, c; unsigned lda, ldb; int nt;
    DEVI bool next(int i, GUnit& u) const {
        const int L = i * G + c; if (L >= 512) return false;
        const int x = L & 7, q = L >> 3, blk = q >> 5, w = q & 31, pm = 16 * x + 8 * blk + (w & 7), pn = w >> 3;
        u.a = A + (size_t)pm * 256 * K * 2; u.b = Bt + (size_t)pn * 256 * K * 2;
        u.dst = dst + ((size_t)pm * 256 * 1024 + pn * 256) * 2; u.ldd = 1024; u.i0 = 0; u.i1 = pm * 256; u.i2 = pn * 256; u.f0 = 1.0f;
        return true;
    }
};
struct SchedRouter {
    unsigned char* ws; int G, c;
    static constexpr unsigned lda = 2048, ldb = 2048; static constexpr int nt = 8;
    DEVI bool next(int i, GUnit& u) const {
        const int L = i * G + c; if (L >= 256) return false;
        const int x = L & 7, q = L >> 3, pm = 16 * x + (q >> 1), ks = q & 1;
        u.a = (const char*)(ws + WS_H2) + (size_t)pm * 256 * 2048 + ks * 1024; u.b = (const char*)(ws + WS_BT_RT) + ks * 1024;
        u.dst = (char*)(ws + (ks ? WS_LOG1 : WS_LOG0)) + (size_t)pm * 256 * 256 * 4; u.ldd = 256; u.i0 = 0; u.i1 = 0; u.i2 = 0; u.f0 = 1.0f;
        return true;
    }
};
DEVI void moe_tables(const unsigned* gcnt, LAS int* T) {
    if (threadIdx.x < 64) {
        const int l = threadIdx.x; int c[4], t[4];
#pragma unroll
        for (int k = 0; k < 4; ++k) { c[k] = (int)gcnt[4 * l + k]; t[k] = (c[k] + 255) >> 8; }
        const int sc = c[0] + c[1] + c[2] + c[3], st = t[0] + t[1] + t[2] + t[3];
        int ic = sc, it = st;
#pragma unroll
        for (int o = 1; o < 64; o <<= 1) { const int a = __shfl_up(ic, o), b = __shfl_up(it, o); if (l >= o) { ic += a; it += b; } }
        int bc = ic - sc, bt = it - st;
#pragma unroll
        for (int k = 0; k < 4; ++k) { T[4 * l + k] = c[k]; T[256 + 4 * l + k] = bc; T[513 + 4 * l + k] = bt; bc += c[k]; bt += t[k]; }
        if (l == 63) { T[256 + 256] = ic; T[513 + 256] = it; }
    }
    __syncthreads();
    {
        const int TRt = T[513 + 256];
        for (int t = threadIdx.x; t < TRt; t += 512) { int lo = 0, hi = 256; while (hi - lo > 1) { const int mid = (lo + hi) >> 1; if (T[513 + mid] <= t) lo = mid; else hi = mid; } T[770 + t] = lo; }
    }
    __syncthreads();
}
DEVI int moe_find(const LAS int* toff, int t) {
    int lo = 0, hi = 256;
#pragma unroll 1
    while (hi - lo > 1) { const int mid = (lo + hi) >> 1; if (toff[mid] <= t) lo = mid; else hi = mid; }
    return __builtin_amdgcn_readfirstlane(lo);
}
struct SchedGateUp {
    unsigned char* ws; const LAS int* T; int G, c;
    static constexpr unsigned lda = 2048, ldb = 2048; static constexpr int nt = 16;
    DEVI bool next(int i, GUnit& u) const {
        const int L = i * G + c; const int TR = __builtin_amdgcn_readfirstlane(T[513 + 256]);
        if (L >= 2 * TR + 256) return false;
        u.a = (const char*)(ws + WS_H2); u.dst = nullptr; u.ldd = 0; u.f0 = 1.0f;
        if (L < 2 * TR) {
            const int t = L >> 1, pn = L & 1, e = __builtin_amdgcn_readfirstlane(T[770 + t]), mt = t - __builtin_amdgcn_readfirstlane(T[513 + e]), cnt = __builtin_amdgcn_readfirstlane(T[e]);
            u.b = (const char*)(ws + WS_EXPGU) + ((size_t)e * 512 + pn * 256) * 2048;
            u.i0 = __builtin_amdgcn_readfirstlane(T[256 + e]) + mt * 256; u.i1 = min(256, cnt - mt * 256); u.i2 = pn;
        } else {
            const int j = L - 2 * TR, mt = j >> 1, pn = j & 1;
            u.b = (const char*)(ws + WS_BT_SHGU) + (size_t)(pn * 256) * 2048;
            u.i0 = 262144 + mt * 256; u.i1 = 256; u.i2 = pn;
        }
        return true;
    }
    DEVI void gather(const GUnit& u, int R0, unsigned (&g)[2][2]) const {
        const u32x2* slot = (const u32x2*)(ws + WS_SLOT);
#pragma unroll
        for (int h = 0; h < 2; ++h)
#pragma unroll
            for (int i = 0; i < 2; ++i) {
                const int s = u.i0 + h * 128 + R0 + 64 * i; int tok;
                if (u.i0 >= 262144) tok = s - 262144; else tok = (int)(slot[min(s, 262143)].x >> 3);
                g[h][i] = (unsigned)tok * 2048u;
            }
    }
};
struct SchedDown {
    unsigned char* ws; const LAS int* T; int G, c;
    static constexpr unsigned lda = 512, ldb = 512; static constexpr int nt = 4;
    DEVI bool next(int i, GUnit& u) const {
        const int L = i * G + c; const int TR = __builtin_amdgcn_readfirstlane(T[513 + 256]);
        if (L >= 4 * TR + 512) return false;
        u.dst = nullptr; u.f0 = 1.0f;
        if (L < 4 * TR) {
            const int t = L >> 2, pn = L & 3, e = __builtin_amdgcn_readfirstlane(T[770 + t]), mt = t - __builtin_amdgcn_readfirstlane(T[513 + e]), cnt = __builtin_amdgcn_readfirstlane(T[e]);
            const int s0 = __builtin_amdgcn_readfirstlane(T[256 + e]) + mt * 256;
            u.a = (const char*)(ws + WS_HID) + (size_t)s0 * 512; u.b = (const char*)(ws + WS_EXPD) + ((size_t)e * 1024 + pn * 256) * 512;
            u.i0 = s0; u.i1 = min(256, cnt - mt * 256); u.i2 = 0; u.ldd = pn * 256;
        } else {
            const int j = L - 4 * TR, mt = j >> 2, pn = j & 3;
            u.a = (const char*)(ws + WS_HID) + (size_t)(262144 + mt * 256) * 512; u.b = (const char*)(ws + WS_BT_SHD) + (size_t)(pn * 256) * 512;
            u.i0 = mt * 256; u.i1 = 256; u.i2 = 1; u.ldd = pn * 256;
        }
        return true;
    }
};

DEVI void conv_tile(const float* src, int ldsrc, int ncols, bf16_t* dst, int ldd, int k0, int row0, int ilv, LAS float* t) {
    const int tid = threadIdx.x;
    f32x4 v[8];
#pragma unroll
    for (int i = 0; i < 8; ++i) { const int f = tid + 512 * i, row = f >> 6, c4 = (f & 63) * 4;
        v[i] = (c4 < ncols) ? *(const f32x4*)(src + (size_t)(k0 + row) * ldsrc + c4) : (f32x4){0.f, 0.f, 0.f, 0.f}; }
#pragma unroll
    for (int i = 0; i < 8; ++i) { const int f = tid + 512 * i, row = f >> 6, c4 = (f & 63) * 4; LAS float* q = t + row * 257 + c4; q[0] = v[i][0]; q[1] = v[i][1]; q[2] = v[i][2]; q[3] = v[i][3]; }
    __syncthreads();
#pragma unroll
    for (int j = 0; j < 4; ++j) {
        const int p = tid + 512 * j, kp = p & 7, n = p >> 3;
        if (n < ncols) {
            const LAS float* q = t + (kp * 8) * 257 + n;
            u32x4 w; w.x = pk_bf16(q[0], q[257]); w.y = pk_bf16(q[2 * 257], q[3 * 257]); w.z = pk_bf16(q[4 * 257], q[5 * 257]); w.w = pk_bf16(q[6 * 257], q[7 * 257]);
            const int drow = row0 + (ilv >= 0 ? ((n >> 7) * 256 + (n & 127) + ilv) : n);
            *(u32x4*)(dst + (size_t)drow * ldd + k0 + kp * 8) = w;
        }
    }
    __syncthreads();
}

DEVI void phase0(const Params& p, LAS unsigned char* lds, int part) {
    const int tid = threadIdx.x, lane = tid & 63, wid = tid >> 6;
    unsigned char* ws = p.ws;
    const int NT_IN = 16 * (2 + 2 + 2 + 2 + 4 + 4 + 4 + 2 + 4 + 1);
    const int NT0 = NT_IN + 8 * 4 + 16 * 4 + 16 * 4 + 16 + 16 + 16 + 4 * 4;
    for (int u = (part == 0 ? (int)blockIdx.x : 192 + (int)blockIdx.x); u < (part == 0 ? 192 : 192 + NT0); u += gridDim.x) {
        if (u < 192) {
            LAS float* sc = (LAS float*)lds; LAS float* red = (LAS float*)(lds + 9 * 1024 * 4);
            for (int i = tid; i < 9216; i += 512) { const int r = i >> 10, k = i & 1023; const float v = r < 8 ? p.in[1][r * 1024 + k] : p.in[3][k]; sc[i] = v / (1.0f + __expf(-v)); }
            __syncthreads();
            const int n0 = u * 32, col = lane & 31, rsub = lane >> 5;
            float acc[9];
#pragma unroll
            for (int r = 0; r < 9; ++r) acc[r] = 0.f;
            for (int it = 0; it < 64; ++it) { const int k = it * 16 + wid * 2 + rsub; const float w = p.in[4][(size_t)k * 6144 + n0 + col];
#pragma unroll
                for (int r = 0; r < 9; ++r) acc[r] += sc[r * 1024 + k] * w; }
#pragma unroll
            for (int r = 0; r < 9; ++r) red[((wid * 2 + rsub) * 9 + r) * 32 + col] = acc[r];
            __syncthreads();
            if (tid < 288) { const int r = tid >> 5, cc = tid & 31; float s = 0.f; for (int g = 0; g < 16; ++g) s += red[(g * 9 + r) * 32 + cc];
                ((float*)(ws + WS_MOD))[r * 6144 + n0 + cc] = s + p.in[5][n0 + cc]; }
            __syncthreads();
        } else {
            int t = u - 192; LAS float* tb = (LAS float*)lds;
            if (t < NT_IN) {
                const int kt = t & 15; int jb = t >> 4;
                int c0, r0, nc = 256;
                if (jb < 2)       { c0 = 0 + jb * 256;             r0 = 0 + jb * 256; }
                else if (jb < 4)  { c0 = 512 + (jb - 2) * 256;     r0 = 512 + (jb - 2) * 256; }
                else if (jb < 6)  { c0 = 1536 + (jb - 4) * 256;    r0 = 1024 + (jb - 4) * 256; }
                else if (jb < 8)  { c0 = 2048 + (jb - 6) * 256;    r0 = 1536 + (jb - 6) * 256; }
                else if (jb < 12) { c0 = 3584 + (jb - 8) * 256;    r0 = 2048 + (jb - 8) * 256; }
                else if (jb < 16) { c0 = 4640 + (jb - 12) * 256;   r0 = 3072 + (jb - 12) * 256; }
                else if (jb < 20) { c0 = 5664 + (jb - 16) * 256;   r0 = 4096 + (jb - 16) * 256; }
                else if (jb < 22) { c0 = 1024 + (jb - 20) * 256;   r0 = 5120 + (jb - 20) * 256; }
                else if (jb < 26) { c0 = 2560 + (jb - 22) * 256;   r0 = 5632 + (jb - 22) * 256; }
                else              { c0 = 4608; r0 = 6656; nc = 32; }
                conv_tile(p.in[6] + c0, 6688, nc, (bf16_t*)(ws + WS_BT_IN), 1024, kt * 64, r0, -1, tb);
            } else {
                t -= NT_IN;
                if (t < 32)        { const int kt = t & 7, nb = t >> 3;  conv_tile(p.in[13] + nb * 256, 1024, 256, (bf16_t*)(ws + WS_BT_BR), 1536, kt * 64, nb * 256, -1, tb); }
                else if (t < 96)   { t -= 32; const int kt = t & 15, nb = t >> 4; conv_tile(p.in[14] + nb * 256, 1024, 256, (bf16_t*)(ws + WS_BT_BR) + 512, 1536, kt * 64, nb * 256, -1, tb); }
                else if (t < 160)  { t -= 96; const int kt = t & 15, nb = t >> 4; conv_tile(p.in[15] + nb * 256, 1024, 256, (bf16_t*)(ws + WS_BT_OUT), 1024, kt * 64, nb * 256, -1, tb); }
                else if (t < 176)  { t -= 160; conv_tile(p.in[18], 256, 256, (bf16_t*)(ws + WS_BT_RT), 1024, t * 64, 0, -1, tb); }
                else if (t < 192)  { t -= 176; conv_tile(p.in[23], 256, 256, (bf16_t*)(ws + WS_BT_SHGU), 1024, t * 64, 0, 0, tb); }
                else if (t < 208)  { t -= 192; conv_tile(p.in[24], 256, 256, (bf16_t*)(ws + WS_BT_SHGU), 1024, t * 64, 0, 128, tb); }
                else               { t -= 208; const int kt = t & 3, nb = t >> 2; conv_tile(p.in[25] + nb * 256, 1024, 256, (bf16_t*)(ws + WS_BT_SHD), 256, kt * 64, nb * 256, -1, tb); }
            }
        }
    }
}

DEVI void phase1(const Params& p) {
    const float* mod = (const float*)(p.ws + WS_MOD); bf16_t* H = (bf16_t*)(p.ws + WS_H);
    for (size_t idx = (size_t)blockIdx.x * 512 + threadIdx.x; idx < (size_t)NROW * 128; idx += (size_t)gridDim.x * 512) {
        const int row = (int)(idx >> 7), k = (int)(idx & 127) * 8;
        const float* src = row < NTOK ? p.in[0] + (size_t)row * 1024 + k : p.in[2] + (size_t)(row - NTOK) * 1024 + k;
        const float* m = mod + (size_t)(row < NTOK ? (row >> 12) : 8) * 6144 + k;
        const f32x4 x0 = *(const f32x4*)src, x1 = *(const f32x4*)(src + 4), h0 = *(const f32x4*)m, h1 = *(const f32x4*)(m + 4), s0 = *(const f32x4*)(m + 1024), s1 = *(const f32x4*)(m + 1028);
        const f32x4 y0 = x0 * (s0 + 1.0f) + h0, y1 = x1 * (s1 + 1.0f) + h1;
        u32x4 w; w.x = pk_bf16(y0[0], y0[1]); w.y = pk_bf16(y0[2], y0[3]); w.z = pk_bf16(y1[0], y1[1]); w.w = pk_bf16(y1[2], y1[3]);
        *(u32x4*)(H + (size_t)row * 1024 + k) = w;
    }
}

DEVI float logsig16(float z) { return -(fmaxf(-z, 0.f) + __logf(1.0f + __expf(-fabsf(z)))) * 0.0625f; }
DEVI void phase3(const Params& p, LAS unsigned char* lds) {
    const int tid = threadIdx.x;
    unsigned char* ws = p.ws;
    LAS float* LRs = (LAS float*)lds;
    LAS float* CS = (LAS float*)(lds + 8192);
    LAS float* CUM = (LAS float*)(lds + 24576);
    LAS float* TOT = (LAS float*)(lds + 24576 + 65536);
    LAS bf16_t* KTs = (LAS bf16_t*)(lds + 24576 + 65536 + 2048);
    for (int i = tid; i < 2048; i += 512) { const int pos = i >> 5, j = i & 31; const float ang = (float)pos * powf(10000.0f, -(float)j / 32.0f); CS[2 * i] = cosf(ang); CS[2 * i + 1] = sinf(ang); }
    __syncthreads();
    const float* LRT = (const float*)(ws + WS_LRT);
    const bf16_t* QB = (const bf16_t*)(ws + WS_QB); const bf16_t* KB = (const bf16_t*)(ws + WS_KB);
    bf16_t* QTF = (bf16_t*)(ws + WS_QTF); bf16_t* QTB = (bf16_t*)(ws + WS_QTB); bf16_t* KTF = (bf16_t*)(ws + WS_KTF); bf16_t* KTB = (bf16_t*)(ws + WS_KTB);
    float* EE = (float*)(ws + WS_EE);
    for (int u = blockIdx.x; u < 8 * 68 * 4; u += gridDim.x) {
        const int h = u & 3, bs = u >> 2, b = bs / 68, slot = bs % 68; const bool isctx = slot < 4; const int chunk = slot - 4;
        const int rowbase = isctx ? NTOK + b * 256 + slot * 64 : b * 4096 + chunk * 64;
        { const int r = tid >> 4, c4 = (tid & 15) * 4; *(LAS f32x4*)(LRs + r * 64 + c4) = *(const f32x4*)(LRT + (size_t)r * NROW + rowbase + c4); }
        __syncthreads();
        {
            const int ch = tid & 127, grp = tid >> 7, dir = grp & 1, hf = grp >> 1;
            const float* w2p = p.in[dir ? 10 : 8] + h * 128 + ch; const float b2 = p.in[dir ? 11 : 9][h * 128 + ch];
            float w2[16];
#pragma unroll
            for (int r = 0; r < 16; ++r) w2[r] = w2p[r * 512];
            float run = 0.f;
            for (int k = 0; k < 32; ++k) {
                const int i = dir ? (32 * hf + 31 - k) : (32 * hf + k);
                float z = b2;
#pragma unroll
                for (int r = 0; r < 16; ++r) z += LRs[(16 * dir + r) * 64 + i] * w2[r];
                run += logsig16(z);
                CUM[(dir * 64 + i) * 128 + ch] = run;
            }
            TOT[(dir * 2 + hf) * 128 + ch] = run;
        }
        __syncthreads();
#pragma unroll
        for (int rep = 0; rep < 2; ++rep) {
            const int q = tid + 512 * rep, i = q >> 4, c8 = q & 15, ch0 = c8 * 8;
            float cf[8], cb[8];
            {
                const f32x4 a0 = *(const LAS f32x4*)(CUM + (0 * 64 + i) * 128 + ch0), a1 = *(const LAS f32x4*)(CUM + (0 * 64 + i) * 128 + ch0 + 4);
                const f32x4 b0 = *(const LAS f32x4*)(CUM + (1 * 64 + i) * 128 + ch0), b1 = *(const LAS f32x4*)(CUM + (1 * 64 + i) * 128 + ch0 + 4);
                f32x4 tf0 = {0.f, 0.f, 0.f, 0.f}, tf1 = tf0, tb0 = tf0, tb1 = tf0;
                if (i >= 32) { tf0 = *(const LAS f32x4*)(TOT + (0 * 2 + 0) * 128 + ch0); tf1 = *(const LAS f32x4*)(TOT + (0 * 2 + 0) * 128 + ch0 + 4); }
                else         { tb0 = *(const LAS f32x4*)(TOT + (1 * 2 + 1) * 128 + ch0); tb1 = *(const LAS f32x4*)(TOT + (1 * 2 + 1) * 128 + ch0 + 4); }
#pragma unroll
                for (int e = 0; e < 4; ++e) { cf[e] = a0[e] + tf0[e]; cf[4 + e] = a1[e] + tf1[e]; cb[e] = b0[e] + tb0[e]; cb[4 + e] = b1[e] + tb1[e]; }
            }
            const size_t go = (size_t)(rowbase + i) * 512 + h * 128 + ch0;
            const u32x4 kraw = *(const u32x4*)(KB + go);
            float kv[8] = {bflo(kraw.x), bfhi(kraw.x), bflo(kraw.y), bfhi(kraw.y), bflo(kraw.z), bfhi(kraw.z), bflo(kraw.w), bfhi(kraw.w)};
            float ef[8], eb[8];
#pragma unroll
            for (int e = 0; e < 8; ++e) { ef[e] = __expf(cf[e]); eb[e] = __expf(cb[e]); }
            if (!isctx) {
                const size_t gp = (size_t)(rowbase + i) * 512 + h * 128 + ((c8 ^ 4) * 8);
                const u32x4 kpr = *(const u32x4*)(KB + gp), qraw = *(const u32x4*)(QB + go), qpr = *(const u32x4*)(QB + gp);
                const float kp[8] = {bflo(kpr.x), bfhi(kpr.x), bflo(kpr.y), bfhi(kpr.y), bflo(kpr.z), bfhi(kpr.z), bflo(kpr.w), bfhi(kpr.w)};
                const float qv[8] = {bflo(qraw.x), bfhi(qraw.x), bflo(qraw.y), bfhi(qraw.y), bflo(qraw.z), bfhi(qraw.z), bflo(qraw.w), bfhi(qraw.w)};
                const float qp[8] = {bflo(qpr.x), bfhi(qpr.x), bflo(qpr.y), bfhi(qpr.y), bflo(qpr.z), bfhi(qpr.z), bflo(qpr.w), bfhi(qpr.w)};
                const int half = c8 >> 3, isx2 = (c8 >> 2) & 1, j0 = (c8 & 3) * 8, pos = half ? i : chunk;
                float qf[8], qb[8];
#pragma unroll
                for (int e = 0; e < 8; ++e) {
                    const float cs = CS[(pos * 32 + j0 + e) * 2], sn = CS[(pos * 32 + j0 + e) * 2 + 1];
                    const float rq = isx2 ? qv[e] * cs + qp[e] * sn : qv[e] * cs - qp[e] * sn;
                    kv[e] = isx2 ? kv[e] * cs + kp[e] * sn : kv[e] * cs - kp[e] * sn;
                    qf[e] = rq * 0.08838834764831845f * ef[e]; qb[e] = rq * 0.08838834764831845f * eb[e];
                }
                u32x4 wq; wq.x = pk_bf16(qf[0], qf[1]); wq.y = pk_bf16(qf[2], qf[3]); wq.z = pk_bf16(qf[4], qf[5]); wq.w = pk_bf16(qf[6], qf[7]); *(u32x4*)(QTF + go) = wq;
                wq.x = pk_bf16(qb[0], qb[1]); wq.y = pk_bf16(qb[2], qb[3]); wq.z = pk_bf16(qb[4], qb[5]); wq.w = pk_bf16(qb[6], qb[7]); *(u32x4*)(QTB + go) = wq;
            }
            float kf[8], kb[8];
#pragma unroll
            for (int e = 0; e < 8; ++e) { kf[e] = kv[e] * __builtin_amdgcn_rcpf(ef[e]); kb[e] = kv[e] * __builtin_amdgcn_rcpf(eb[e]); }
            u32x4 wf; wf.x = pk_bf16(kf[0], kf[1]); wf.y = pk_bf16(kf[2], kf[3]); wf.z = pk_bf16(kf[4], kf[5]); wf.w = pk_bf16(kf[6], kf[7]);
            u32x4 wb; wb.x = pk_bf16(kb[0], kb[1]); wb.y = pk_bf16(kb[2], kb[3]); wb.z = pk_bf16(kb[4], kb[5]); wb.w = pk_bf16(kb[6], kb[7]);
            *(u32x4*)(KTF + go) = wf; *(u32x4*)(KTB + go) = wb;
            *(LAS u32x4*)(KTs + (0 * 64 + i) * 136 + ch0) = wf; *(LAS u32x4*)(KTs + (1 * 64 + i) * 136 + ch0) = wb;
            if (i == 63) { float* ep = EE + ((size_t)(0 * 8 + b) * 68 + slot) * 512 + h * 128 + ch0; *(f32x4*)ep = (f32x4){ef[0], ef[1], ef[2], ef[3]}; *(f32x4*)(ep + 4) = (f32x4){ef[4], ef[5], ef[6], ef[7]}; }
            if (i == 0)  { float* ep = EE + ((size_t)(1 * 8 + b) * 68 + slot) * 512 + h * 128 + ch0; *(f32x4*)ep = (f32x4){eb[0], eb[1], eb[2], eb[3]}; *(f32x4*)(ep + 4) = (f32x4){eb[4], eb[5], eb[6], eb[7]}; }
        }
        __syncthreads();
#pragma unroll
        for (int rep = 0; rep < 4; ++rep) {
            const int q = tid + 512 * rep, ch = q & 127, t8 = (q >> 7) & 7, dir = q >> 10;
            const LAS bf16_t* sp = KTs + (dir * 64 + t8 * 8) * 136 + ch;
            u32x4 wv; wv.x = (unsigned)sp[0] | ((unsigned)sp[136] << 16); wv.y = (unsigned)sp[2 * 136] | ((unsigned)sp[3 * 136] << 16); wv.z = (unsigned)sp[4 * 136] | ((unsigned)sp[5 * 136] << 16); wv.w = (unsigned)sp[6 * 136] | ((unsigned)sp[7 * 136] << 16);
            *(u32x4*)((bf16_t*)(ws + (dir ? WS_KTTB : WS_KTTF)) + (size_t)(h * 128 + ch) * NROW + rowbase + t8 * 8) = wv;
        }
        __syncthreads();
    }
}

DEVI int gla_slot(int dir, int n) { return dir == 0 ? n : (n < 4 ? 3 - n : 71 - n); }
DEVI int gla_rowbase(int b, int slot) { return slot >= 4 ? b * 4096 + (slot - 4) * 64 : NTOK + b * 256 + slot * 64; }
DEVI void phase4_gla(const Params& p, LAS unsigned char* lds) {
    const int tid = threadIdx.x, lane = tid & 63, w = tid >> 6, l15 = lane & 15, fq = lane >> 4;
    unsigned char* ws = p.ws;
    LAS unsigned char* TQ = lds;
    LAS unsigned char* TK = lds + 32768;
    LAS unsigned char* TV = lds + 65536;
    LAS bf16_t* PM = (LAS bf16_t*)(lds + 81920);
    LAS bf16_t* SB = (LAS bf16_t*)(lds + 81920 + 9216);
    const bf16_t* VBT = (const bf16_t*)(ws + WS_VBT);
    const float* EE = (const float*)(ws + WS_EE);
    const int qr0 = tid >> 4, qp = tid & 15, vr = tid >> 3, vp = tid & 7;
    const int qoff0 = qr0 * 256 + ((qp ^ (qr0 & 15)) << 4), qoff1 = (qr0 + 32) * 256 + ((qp ^ ((qr0 + 32) & 15)) << 4);
    const int voff = vr * 128 + ((vp ^ ((vr >> 1) & 7)) << 4);
    struct PSet { u32x4 q0, q1, k0, k1, v; };
    struct KSet { bf16x8 a, b; f32x4 e; };
    for (int u = blockIdx.x; u < 256; u += gridDim.x) {
        const int xg = u & 7, kg = u >> 3, g = xg * 8 + (kg >> 2), dvq = kg & 3, dir = g & 1, h = (g >> 1) & 3, b = g >> 3;
        const bf16_t* QT = (const bf16_t*)(ws + (dir ? WS_QTB : WS_QTF)); const bf16_t* KT = (const bf16_t*)(ws + (dir ? WS_KTB : WS_KTF)); const bf16_t* KTT = (const bf16_t*)(ws + (dir ? WS_KTTB : WS_KTTF));
        bf16_t* OUT = (bf16_t*)(ws + (dir ? WS_OB : WS_OF));
        const int vrow0 = h * 256 + dvq * 64, krow0 = h * 128, kcol0 = h * 128;
        const float* EEu = EE + (size_t)(dir * 8 + b) * 68 * 512 + h * 128 + 16 * w + 4 * fq;
        const bf16_t* vsrc = VBT + (size_t)(vrow0 + vr) * NROW + vp * 8;
        const bf16_t* ktsrc = KTT + (size_t)(krow0 + 16 * w + l15) * NROW + 8 * fq;
        const size_t qsrc = (size_t)qr0 * 512 + kcol0 + qp * 8;
        f32x4 S[4];
#pragma unroll
        for (int i = 0; i < 4; ++i) S[i] = (f32x4){0.f, 0.f, 0.f, 0.f};
        PSet P0, P1; KSet K0, K1;
        P0.q0 = P0.q1 = P0.k0 = P0.k1 = P0.v = (u32x4){0u, 0u, 0u, 0u}; P1 = P0;
        auto load_p = [&](PSet& P, int n) {
            const int slot = gla_slot(dir, n), rb = gla_rowbase(b, slot);
            P.v = *(const u32x4*)(vsrc + rb);
            if (slot >= 4) { P.q0 = *(const u32x4*)(QT + (size_t)rb * 512 + qsrc); P.q1 = *(const u32x4*)(QT + (size_t)(rb + 32) * 512 + qsrc);
                             P.k0 = *(const u32x4*)(KT + (size_t)rb * 512 + qsrc); P.k1 = *(const u32x4*)(KT + (size_t)(rb + 32) * 512 + qsrc); }
        };
        auto store_p = [&](const PSet& P, int n) {
            const int slot = gla_slot(dir, n), bufo = n & 1;
            *(LAS u32x4*)(TV + bufo * 8192 + voff) = P.v;
            if (slot >= 4) { *(LAS u32x4*)(TQ + bufo * 16384 + qoff0) = P.q0; *(LAS u32x4*)(TQ + bufo * 16384 + qoff1) = P.q1; *(LAS u32x4*)(TK + bufo * 16384 + qoff0) = P.k0; *(LAS u32x4*)(TK + bufo * 16384 + qoff1) = P.k1; }
        };
        auto load_k = [&](KSet& K, int n) {
            const int slot = gla_slot(dir, n), rb = gla_rowbase(b, slot);
            K.a = *(const bf16x8*)(ktsrc + rb); K.b = *(const bf16x8*)(ktsrc + rb + 32); K.e = *(const f32x4*)(EEu + (size_t)slot * 512);
        };
        load_p(P0, 0); load_k(K0, 0); load_k(K1, 1); load_p(P1, 1);
        __syncthreads();
        store_p(P0, 0);
        auto step = [&](int n, PSet& Pload, const PSet& Pstore, KSet& K) {
            const int slot = gla_slot(dir, n); const bool lat = slot >= 4; const int rowbase = gla_rowbase(b, slot);
            const int cur = n & 1, nxt = cur ^ 1;
            LAS unsigned char* tq = TQ + cur * 16384; LAS unsigned char* tk = TK + cur * 16384; LAS unsigned char* tv = TV + cur * 8192;
            LAS bf16_t* sbc = SB + cur * 64 * 136; LAS bf16_t* sbn = SB + nxt * 64 * 136;
            lds_barrier();
            if (n + 2 < 68) load_p(Pload, n + 2);
            if (lat) {
                const int jt = w >> 1, it0 = 2 * (w & 1);
                f32x4 c0 = {0.f, 0.f, 0.f, 0.f}, c1 = {0.f, 0.f, 0.f, 0.f};
                const int rj = 16 * jt + l15, ri0 = 16 * it0 + l15, ri1 = ri0 + 16;
                bf16x8 fa[4], fb0[4], fb1[4];
#pragma unroll
                for (int ks = 0; ks < 4; ++ks) { const int pc = 4 * ks + fq;
                    fa[ks] = *(const LAS bf16x8*)(tk + rj * 256 + ((pc ^ l15) << 4)); fb0[ks] = *(const LAS bf16x8*)(tq + ri0 * 256 + ((pc ^ l15) << 4)); fb1[ks] = *(const LAS bf16x8*)(tq + ri1 * 256 + ((pc ^ l15) << 4)); }
                __builtin_amdgcn_sched_barrier(0);
#pragma unroll
                for (int ks = 0; ks < 4; ++ks) { c0 = __builtin_amdgcn_mfma_f32_16x16x32_bf16(fa[ks], fb0[ks], c0, 0, 0, 0); c1 = __builtin_amdgcn_mfma_f32_16x16x32_bf16(fa[ks], fb1[ks], c1, 0, 0, 0); }
#pragma unroll
                for (int r = 0; r < 4; ++r) { const int j = 16 * jt + 4 * fq + r;
                    const bool k0 = dir == 0 ? (j <= ri0) : (j >= ri0), k1 = dir == 0 ? (j <= ri1) : (j >= ri1);
                    c0[r] = k0 ? c0[r] : 0.f; c1[r] = k1 ? c1[r] : 0.f; }
                u32x2 w0; w0.x = pk_bf16(c0[0], c0[1]); w0.y = pk_bf16(c0[2], c0[3]); u32x2 w1; w1.x = pk_bf16(c1[0], c1[1]); w1.y = pk_bf16(c1[2], c1[3]);
                *(LAS u32x2*)(PM + ri0 * 72 + 16 * jt + 4 * fq) = w0; *(LAS u32x2*)(PM + ri1 * 72 + 16 * jt + 4 * fq) = w1;
            }
            lds_barrier();
            bf16x8 V[4][2];
#pragma unroll
            for (int dvt = 0; dvt < 4; ++dvt)
#pragma unroll
                for (int ks = 0; ks < 2; ++ks) { const int row = 16 * dvt + l15, pc = 4 * ks + fq; V[dvt][ks] = *(const LAS bf16x8*)(tv + row * 128 + ((pc ^ ((row >> 1) & 7)) << 4)); }
            __builtin_amdgcn_sched_barrier(0);
            if (lat) {
                const int it = w >> 1, dv0 = 2 * (w & 1), ri = 16 * it + l15;
                f32x4 o0 = {0.f, 0.f, 0.f, 0.f}, o1 = {0.f, 0.f, 0.f, 0.f};
                bf16x8 pB[2], pA0[2], pA1[2], sA0[4], sA1[4], sB[4];
                const LAS bf16_t* s0 = sbc + (16 * dv0 + l15) * 136 + 8 * fq; const LAS bf16_t* s1 = s0 + 16 * 136;
#pragma unroll
                for (int ks = 0; ks < 2; ++ks) { pB[ks] = *(const LAS bf16x8*)(PM + ri * 72 + 32 * ks + 8 * fq);
                    const int r0 = 16 * dv0 + l15, r1 = r0 + 16, pc = 4 * ks + fq;
                    pA0[ks] = *(const LAS bf16x8*)(tv + r0 * 128 + ((pc ^ ((r0 >> 1) & 7)) << 4)); pA1[ks] = *(const LAS bf16x8*)(tv + r1 * 128 + ((pc ^ ((r1 >> 1) & 7)) << 4)); }
#pragma unroll
                for (int ks = 0; ks < 4; ++ks) { const int pc = 4 * ks + fq;
                    sA0[ks] = *(const LAS bf16x8*)(s0 + 32 * ks); sA1[ks] = *(const LAS bf16x8*)(s1 + 32 * ks); sB[ks] = *(const LAS bf16x8*)(tq + ri * 256 + ((pc ^ l15) << 4)); }
                __builtin_amdgcn_sched_barrier(0);
#pragma unroll
                for (int ks = 0; ks < 2; ++ks) { o0 = __builtin_amdgcn_mfma_f32_16x16x32_bf16(pA0[ks], pB[ks], o0, 0, 0, 0); o1 = __builtin_amdgcn_mfma_f32_16x16x32_bf16(pA1[ks], pB[ks], o1, 0, 0, 0); }
#pragma unroll
                for (int ks = 0; ks < 4; ++ks) { o0 = __builtin_amdgcn_mfma_f32_16x16x32_bf16(sA0[ks], sB[ks], o0, 0, 0, 0); o1 = __builtin_amdgcn_mfma_f32_16x16x32_bf16(sA1[ks], sB[ks], o1, 0, 0, 0); }
                bf16_t* op = OUT + (size_t)(rowbase + ri) * 1024 + vrow0 + 16 * dv0 + 4 * fq;
                u32x2 w0; w0.x = pk_bf16(o0[0], o0[1]); w0.y = pk_bf16(o0[2], o0[3]); u32x2 w1; w1.x = pk_bf16(o1[0], o1[1]); w1.y = pk_bf16(o1[2], o1[3]);
                *(u32x2*)op = w0; *(u32x2*)(op + 16) = w1;
            }
#pragma unroll
            for (int dvt = 0; dvt < 4; ++dvt) { S[dvt] = __builtin_amdgcn_mfma_f32_16x16x32_bf16(K.a, V[dvt][0], S[dvt], 0, 0, 0); S[dvt] = __builtin_amdgcn_mfma_f32_16x16x32_bf16(K.b, V[dvt][1], S[dvt], 0, 0, 0); }
#pragma unroll
            for (int dvt = 0; dvt < 4; ++dvt) { S[dvt] = S[dvt] * K.e;
                u32x2 o; o.x = pk_bf16(S[dvt][0], S[dvt][1]); o.y = pk_bf16(S[dvt][2], S[dvt][3]);
                *(LAS u32x2*)(sbn + (16 * dvt + l15) * 136 + 16 * w + 4 * fq) = o; }
            if (n + 2 < 68) load_k(K, n + 2);
            if (n + 1 < 68) store_p(Pstore, n + 1);
        };
#pragma unroll 1
        for (int n = 0; n < 68; n += 2) { step(n, P0, P1, K0); step(n + 1, P1, P0, K1); }
        __syncthreads();
    }
}

DEVI void phase4_na(const Params& p, LAS unsigned char* lds) {
    const int tid = threadIdx.x; const int wsg = __builtin_amdgcn_readfirstlane(tid >> 6);
    unsigned char* ws = p.ws;
    LAS unsigned char* CK = lds;
    LAS unsigned char* CV = lds + 32768;
    LAS float* RP = (LAS float*)(lds + 65536);
    const bf16_t* QA = (const bf16_t*)(ws + WS_QA); const bf16_t* KA = (const bf16_t*)(ws + WS_KA); const bf16_t* VAT = (const bf16_t*)(ws + WS_VAT);
    bf16_t* OA = (bf16_t*)(ws + WS_AP);
    for (int u = blockIdx.x; u < 512; u += gridDim.x) {
        const int xg = u & 7, idx = u >> 3, bh = xg * 8 + (idx >> 3), rblk = idx & 7, h = bh & 7, b = bh >> 3;
        __syncthreads();
        for (int i = tid; i < 465; i += 512) RP[(i / 31) * 80 + 24 + (i % 31)] = p.in[7][h * 465 + i];
        int tz = tid; asm volatile("" : "+v"(tz));
#pragma unroll
        for (int rep = 0; rep < 4; ++rep) {
            const int q = tz + 512 * rep;
            { const int row = q >> 3, pc = q & 7; *(LAS u32x4*)(CK + row * 128 + ((pc ^ ((row >> 1) & 7)) << 4)) = *(const u32x4*)(KA + (size_t)(NTOK + b * 256 + row) * 512 + h * 64 + pc * 8); }
            { const int row = q >> 5, pc = q & 31; const u32x4 v = *(const u32x4*)(VAT + (size_t)(h * 64 + row) * NROW + NTOK + b * 256 + pc * 8);
              const int sw = (row & 15) << 1; u32x2 lo; lo.x = v.x; lo.y = v.y; u32x2 hi; hi.x = v.z; hi.y = v.w;
              *(LAS u32x2*)(CV + row * 512 + (((2 * pc) ^ sw) << 3)) = lo; *(LAS u32x2*)(CV + row * 512 + (((2 * pc + 1) ^ sw) << 3)) = hi; }
        }
        __syncthreads();
#pragma unroll 1
        for (int qt = 0; qt < 4; ++qt) {
            int lane = (int)__builtin_amdgcn_mbcnt_hi(~0u, __builtin_amdgcn_mbcnt_lo(~0u, 0u)); asm volatile("" : "+v"(lane));
            const int w = wsg, l15 = lane & 15, fq = lane >> 4, r = rblk * 8 + w, rs = min(max(r - 4, 0), 56);
            const int kc0 = min(max(16 * qt - 8, 0), 32);
            const int c = 16 * qt + l15, cs = min(max(c - 8, 0), 48);
            const bf16_t* qp = QA + (size_t)(b * 4096 + r * 64 + c) * 512 + h * 64 + 8 * fq;
            const bf16x8 Bq0 = *(const bf16x8*)qp, Bq1 = *(const bf16x8*)(qp + 32);
            const int lo = 15 + cs - c, d00 = kc0 - 16 * qt + 4 * fq - l15 + 15;
            const LAS unsigned char* rpl = (const LAS unsigned char*)RP + ((rs - r + 7) * 80 + 24 + d00) * 4;
            const char* kbase = (const char*)(KA + (size_t)(b * 4096 + rs * 64 + kc0) * 512 + h * 64); const unsigned klane = (unsigned)(l15 * 512 + 8 * fq) * 2u;
            const char* vbase = (const char*)(VAT + (size_t)(h * 64) * NROW + b * 4096 + rs * 64 + kc0); const unsigned vlane = (unsigned)(l15 * NROW + 4 * fq) * 2u;
#define NA_SB __builtin_amdgcn_sched_barrier(0)
            f32x4 sc[16];
#pragma unroll
            for (int hb = 0; hb < 4; ++hb) {
                bf16x8 kf[4][2];
#pragma unroll
                for (int tt = 0; tt < 4; ++tt) { const int t = 4 * hb + tt, kr = t >> 1, chh = t & 1; const char* kp = (kbase + (size_t)((kr * 64 + 16 * chh) * 1024)) + klane;
                    kf[tt][0] = *(const bf16x8*)kp; kf[tt][1] = *(const bf16x8*)(kp + 64); }
                NA_SB;
#pragma unroll
                for (int tt = 0; tt < 4; ++tt) { const int t = 4 * hb + tt, kr = t >> 1, chh = t & 1;
                    f32x4 a = {0.f, 0.f, 0.f, 0.f};
                    a = __builtin_amdgcn_mfma_f32_16x16x32_bf16(kf[tt][0], Bq0, a, 0, 0, 0); a = __builtin_amdgcn_mfma_f32_16x16x32_bf16(kf[tt][1], Bq1, a, 0, 0, 0);
#pragma unroll
                    for (int j = 0; j < 4; ++j) { const float bias = *(const LAS float*)(rpl + chh * 64 + kr * 320 + j * 4); a[j] = ((unsigned)(d00 + 16 * chh + j - lo) <= 15u) ? a[j] + bias : -INFINITY; }
                    sc[t] = a; }
                NA_SB;
            }
            u32x2 va0[2][4], va1[2][4];
            auto ld_vloc = [&](int uu0) {
#pragma unroll
                for (int q = 0; q < 2; ++q)
#pragma unroll
                    for (int mt = 0; mt < 4; ++mt) { const char* vp = (vbase + (size_t)((16 * mt * NROW + (uu0 + q) * 64) * 2)) + vlane; va0[q][mt] = *(const u32x2*)vp; va1[q][mt] = *(const u32x2*)(vp + 32); } };
            ld_vloc(0);
            NA_SB;
            float mA = -INFINITY;
#pragma unroll
            for (int t = 0; t < 16; ++t) mA = fmaxf(mA, fmaxf(fmaxf(sc[t][0], sc[t][1]), fmaxf(sc[t][2], sc[t][3])));
            mA = fmaxf(mA, __shfl_xor(mA, 16)); mA = fmaxf(mA, __shfl_xor(mA, 32));
            float lA = 0.f; u32x2 pp[16];
#pragma unroll
            for (int t = 0; t < 16; ++t) { const float e0 = __expf(sc[t][0] - mA), e1 = __expf(sc[t][1] - mA), e2 = __expf(sc[t][2] - mA), e3 = __expf(sc[t][3] - mA);
                lA += (e0 + e1) + (e2 + e3); pp[t].x = pk_bf16(e0, e1); pp[t].y = pk_bf16(e2, e3); }
            NA_SB;
            f32x4 o[4];
#pragma unroll
            for (int mt = 0; mt < 4; ++mt) o[mt] = (f32x4){0.f, 0.f, 0.f, 0.f};
            auto mm_vloc = [&](int uu0) {
#pragma unroll
                for (int q = 0; q < 2; ++q) { const int t0 = 2 * (uu0 + q), t1 = t0 + 1;
                    union { u32x4 w; bf16x8 v; } P; P.w.x = pp[t0].x; P.w.y = pp[t0].y; P.w.z = pp[t1].x; P.w.w = pp[t1].y;
#pragma unroll
                    for (int mt = 0; mt < 4; ++mt) { union { u32x4 w; bf16x8 v; } A; A.w.x = va0[q][mt].x; A.w.y = va0[q][mt].y; A.w.z = va1[q][mt].x; A.w.w = va1[q][mt].y; o[mt] = __builtin_amdgcn_mfma_f32_16x16x32_bf16(A.v, P.v, o[mt], 0, 0, 0); } } };
            mm_vloc(0); NA_SB; ld_vloc(2); NA_SB; mm_vloc(2); NA_SB; ld_vloc(4); NA_SB; mm_vloc(4); NA_SB; ld_vloc(6); NA_SB; mm_vloc(6); NA_SB;
            int lane2 = (int)__builtin_amdgcn_mbcnt_hi(~0u, __builtin_amdgcn_mbcnt_lo(~0u, 0u)); asm volatile("" : "+v"(lane2));
            const int l15b = lane2 & 15, fqb = lane2 >> 4, cks = (l15b >> 1) & 7, ck0 = l15b * 128 + ((fqb ^ cks) << 4), ck1 = l15b * 128 + (((4 + fqb) ^ cks) << 4);
            {
                bf16x8 kfA[2][2];
                auto ld_ctx = [&](bf16x8 (&kf)[2][2], auto G) {
#pragma unroll
                    for (int tt = 0; tt < 2; ++tt) { constexpr int tile = 0; const int to = (2 * decltype(G)::v + tt) * 2048 + tile;
                        kf[tt][0] = *(const LAS bf16x8*)(CK + to + ck0); kf[tt][1] = *(const LAS bf16x8*)(CK + to + ck1); } };
                auto mm_ctx = [&](const bf16x8 (&kf)[2][2], auto G) {
#pragma unroll
                    for (int tt = 0; tt < 2; ++tt) { f32x4 a = {0.f, 0.f, 0.f, 0.f};
                        a = __builtin_amdgcn_mfma_f32_16x16x32_bf16(kf[tt][0], Bq0, a, 0, 0, 0); a = __builtin_amdgcn_mfma_f32_16x16x32_bf16(kf[tt][1], Bq1, a, 0, 0, 0);
                        sc[2 * decltype(G)::v + tt] = a; } };
#define NA_CC(G0) ld_ctx(kfA, IC<G0>{}); NA_SB; mm_ctx(kfA, IC<G0>{}); NA_SB;
                NA_CC(0) NA_CC(1) NA_CC(2) NA_CC(3) NA_CC(4) NA_CC(5) NA_CC(6) NA_CC(7)
#undef NA_CC
            }
            float mB = -INFINITY;
#pragma unroll
            for (int t = 0; t < 16; ++t) mB = fmaxf(mB, fmaxf(fmaxf(sc[t][0], sc[t][1]), fmaxf(sc[t][2], sc[t][3])));
            mB = fmaxf(mB, __shfl_xor(mB, 16)); mB = fmaxf(mB, __shfl_xor(mB, 32));
            const float mx = fmaxf(mA, mB), fA = __expf(mA - mx);
            float lB = 0.f;
#pragma unroll
            for (int t = 0; t < 16; ++t) { const float e0 = __expf(sc[t][0] - mx), e1 = __expf(sc[t][1] - mx), e2 = __expf(sc[t][2] - mx), e3 = __expf(sc[t][3] - mx);
                lB += (e0 + e1) + (e2 + e3); pp[t].x = pk_bf16(e0, e1); pp[t].y = pk_bf16(e2, e3); }
            float sum = lA * fA + lB;
            sum += __shfl_xor(sum, 16); sum += __shfl_xor(sum, 32);
            const float inv = 1.0f / sum;
#pragma unroll
            for (int mt = 0; mt < 4; ++mt) o[mt] = o[mt] * fA;
            NA_SB;
            int cvo[4][2];
#pragma unroll
            for (int rr = 0; rr < 4; ++rr)
#pragma unroll
                for (int dd = 0; dd < 2; ++dd) cvo[rr][dd] = l15b * 512 + ((((8 * rr + fqb + 4 * dd) ^ (l15b << 1)) & 31) << 3);
            {
                u32x4 vfA[4], vfB[4];
                auto ld_v = [&](u32x4 (&vq)[4], auto U) {
                    constexpr int uu = decltype(U)::v, q4 = uu >> 2, rr = uu & 3;
#pragma unroll
                    for (int mt = 0; mt < 4; ++mt) { const u32x2 a0 = *(const LAS u32x2*)(CV + mt * 8192 + q4 * 256 + cvo[rr][0]), a1 = *(const LAS u32x2*)(CV + mt * 8192 + q4 * 256 + cvo[rr][1]); vq[mt] = (u32x4){a0.x, a0.y, a1.x, a1.y}; } };
                auto mm_v = [&](const u32x4 (&vq)[4], auto U) {
                    constexpr int uu = decltype(U)::v, t0 = 2 * uu, t1 = 2 * uu + 1;
                    union { u32x4 w; bf16x8 v; } P; P.w.x = pp[t0].x; P.w.y = pp[t0].y; P.w.z = pp[t1].x; P.w.w = pp[t1].y;
#pragma unroll
                    for (int mt = 0; mt < 4; ++mt) { union { u32x4 w; bf16x8 v; } A; A.w = vq[mt]; o[mt] = __builtin_amdgcn_mfma_f32_16x16x32_bf16(A.v, P.v, o[mt], 0, 0, 0); } };
#define NA_PV(U0, U1, U2, U3) mm_v(vfA, IC<U0>{}); NA_SB; ld_v(vfA, IC<U2>{}); NA_SB; mm_v(vfB, IC<U1>{}); NA_SB; ld_v(vfB, IC<U3>{}); NA_SB;
                ld_v(vfA, IC<0>{}); ld_v(vfB, IC<1>{}); NA_SB;
                NA_PV(0, 1, 2, 3) NA_PV(2, 3, 4, 5) NA_PV(4, 5, 6, 7)
                mm_v(vfA, IC<6>{}); NA_SB; mm_v(vfB, IC<7>{}); NA_SB;
#undef NA_PV
            }
#undef NA_SB
            bf16_t* op = OA + (size_t)(b * 4096 + r * 64 + c) * 1536 + h * 64 + 4 * fq;
#pragma unroll
            for (int mt = 0; mt < 4; ++mt) { u32x2 wv; wv.x = pk_bf16(o[mt][0] * inv, o[mt][1] * inv); wv.y = pk_bf16(o[mt][2] * inv, o[mt][3] * inv); *(u32x2*)(op + 16 * mt) = wv; }
        }
    }
}

DEVI void phase5(const Params& p) {
    const int lane = threadIdx.x & 63, gw = blockIdx.x * 8 + (threadIdx.x >> 6), nw = gridDim.x * 8;
    const bf16_t* OF = (const bf16_t*)(p.ws + WS_OF); const bf16_t* OB = (const bf16_t*)(p.ws + WS_OB); const bf16_t* GB = (const bf16_t*)(p.ws + WS_GB); bf16_t* AP = (bf16_t*)(p.ws + WS_AP);
    for (int tok = gw; tok < NTOK; tok += nw) {
#pragma unroll
        for (int hh = 0; hh < 2; ++hh) {
            const int col = hh * 512 + lane * 8;
            const size_t o = (size_t)tok * 1024 + col;
            const u32x4 a = *(const u32x4*)(OF + o), bb = *(const u32x4*)(OB + o), g = *(const u32x4*)(GB + o);
            float v[8] = {bflo(a.x) + bflo(bb.x), bfhi(a.x) + bfhi(bb.x), bflo(a.y) + bflo(bb.y), bfhi(a.y) + bfhi(bb.y), bflo(a.z) + bflo(bb.z), bfhi(a.z) + bfhi(bb.z), bflo(a.w) + bflo(bb.w), bfhi(a.w) + bfhi(bb.w)};
            float ss = 0.f;
#pragma unroll
            for (int e = 0; e < 8; ++e) ss += v[e] * v[e];
            ss += __shfl_xor(ss, 16); ss += __shfl_xor(ss, 8); ss += __shfl_xor(ss, 4); ss += __shfl_xor(ss, 2); ss += __shfl_xor(ss, 1);
            const float rs = rsqrtf(ss * (1.0f / 256.0f) + 1e-6f);
            const f32x4 n0 = *(const f32x4*)(p.in[12] + col), n1 = *(const f32x4*)(p.in[12] + col + 4);
            const float gg[8] = {bflo(g.x), bfhi(g.x), bflo(g.y), bfhi(g.y), bflo(g.z), bfhi(g.z), bflo(g.w), bfhi(g.w)};
            float r[8];
#pragma unroll
            for (int e = 0; e < 8; ++e) r[e] = v[e] * rs * (e < 4 ? n0[e & 3] : n1[e & 3]) * (gg[e] * sigmoidf_(gg[e]));
            u32x4 wv; wv.x = pk_bf16(r[0], r[1]); wv.y = pk_bf16(r[2], r[3]); wv.z = pk_bf16(r[4], r[5]); wv.w = pk_bf16(r[6], r[7]);
            *(u32x4*)(AP + (size_t)tok * 1536 + 512 + col) = wv;
        }
    }
}

DEVI void ln_row(f32x4 (&v)[4], const float* g, const float* bta, int lane) {
    float s = 0.f;
#pragma unroll
    for (int j = 0; j < 4; ++j) s += (v[j][0] + v[j][1]) + (v[j][2] + v[j][3]);
    const float mu = wave_sum(s) * (1.0f / 1024.0f);
    float q = 0.f;
#pragma unroll
    for (int j = 0; j < 4; ++j) { v[j] = v[j] - mu; q += (v[j][0] * v[j][0] + v[j][1] * v[j][1]) + (v[j][2] * v[j][2] + v[j][3] * v[j][3]); }
    const float rstd = rsqrtf(wave_sum(q) * (1.0f / 1024.0f) + 1e-6f);
#pragma unroll
    for (int j = 0; j < 4; ++j) { const f32x4 gg = *(const f32x4*)(g + lane * 4 + 256 * j), bb = *(const f32x4*)(bta + lane * 4 + 256 * j); v[j] = v[j] * rstd * gg + bb; }
}
DEVI void phase9(const Params& p) {
    const int lane = threadIdx.x & 63, gw = blockIdx.x * 8 + (threadIdx.x >> 6), nw = gridDim.x * 8;
    const float* mod = (const float*)(p.ws + WS_MOD); const bf16_t* Z = (const bf16_t*)(p.ws + WS_Z); float* X1 = (float*)(p.ws + WS_X1); bf16_t* H2 = (bf16_t*)(p.ws + WS_H2);
    for (int tok = gw; tok < NTOK; tok += nw) {
        const float* m = mod + (size_t)(tok >> 12) * 6144; float v[2][8];
#pragma unroll
        for (int j = 0; j < 2; ++j) { const int cidx = lane * 8 + 512 * j;
            const f32x4 x0 = *(const f32x4*)(p.in[0] + (size_t)tok * 1024 + cidx), x1 = *(const f32x4*)(p.in[0] + (size_t)tok * 1024 + cidx + 4), g0 = *(const f32x4*)(m + 2048 + cidx), g1 = *(const f32x4*)(m + 2048 + cidx + 4);
            const u32x4 z = *(const u32x4*)(Z + (size_t)tok * 1024 + cidx);
            float zf[8] = {bflo(z.x), bfhi(z.x), bflo(z.y), bfhi(z.y), bflo(z.z), bfhi(z.z), bflo(z.w), bfhi(z.w)};
#if defined(DBG_NOMIX)
#pragma unroll
            for (int e = 0; e < 8; ++e) zf[e] = 0.f;
#endif
#pragma unroll
            for (int e = 0; e < 4; ++e) { v[j][e] = x0[e] * 1.189207115f + g0[e] * zf[e]; v[j][4 + e] = x1[e] * 1.189207115f + g1[e] * zf[4 + e]; }
        }
        float sm = 0.f;
#pragma unroll
        for (int j = 0; j < 2; ++j)
#pragma unroll
            for (int e = 0; e < 8; ++e) sm += v[j][e];
        const float mu = wave_sum(sm) * (1.0f / 1024.0f); float q = 0.f;
#pragma unroll
        for (int j = 0; j < 2; ++j)
#pragma unroll
            for (int e = 0; e < 8; ++e) { v[j][e] -= mu; q += v[j][e] * v[j][e]; }
        const float rstd = rsqrtf(wave_sum(q) * (1.0f / 1024.0f) + 1e-6f);
#pragma unroll
        for (int j = 0; j < 2; ++j) { const int cidx = lane * 8 + 512 * j;
            const f32x4 g0 = *(const f32x4*)(p.in[16] + cidx), g1 = *(const f32x4*)(p.in[16] + cidx + 4), b0 = *(const f32x4*)(p.in[17] + cidx), b1 = *(const f32x4*)(p.in[17] + cidx + 4);
            const f32x4 sh0 = *(const f32x4*)(m + 3072 + cidx), sh1 = *(const f32x4*)(m + 3072 + cidx + 4), sc0 = *(const f32x4*)(m + 4096 + cidx), sc1 = *(const f32x4*)(m + 4096 + cidx + 4);
            f32x4 o0, o1; float hv[8];
#pragma unroll
            for (int e = 0; e < 4; ++e) { o0[e] = v[j][e] * rstd * g0[e] + b0[e]; o1[e] = v[j][4 + e] * rstd * g1[e] + b1[e]; hv[e] = o0[e] * (sc0[e] + 1.0f) + sh0[e]; hv[4 + e] = o1[e] * (sc1[e] + 1.0f) + sh1[e]; }
            *(f32x4*)(X1 + (size_t)tok * 1024 + cidx) = o0; *(f32x4*)(X1 + (size_t)tok * 1024 + cidx + 4) = o1;
            u32x4 wv; wv.x = pk_bf16(hv[0], hv[1]); wv.y = pk_bf16(hv[2], hv[3]); wv.z = pk_bf16(hv[4], hv[5]); wv.w = pk_bf16(hv[6], hv[7]);
            *(u32x4*)(H2 + (size_t)tok * 1024 + cidx) = wv; }
    }
}
DEVI void phase11(const Params& p, LAS unsigned char* lds) {
    const int lane = threadIdx.x & 63, gw = blockIdx.x * 8 + (threadIdx.x >> 6), nw = gridDim.x * 8, half = lane >> 5;
    LAS unsigned* LC = (LAS unsigned*)(lds + LDS_TAB); LAS unsigned* LB = LC + 256;
    if (threadIdx.x < 256) LC[threadIdx.x] = 0u;
    __syncthreads();
    const float* L0 = (const float*)(p.ws + WS_LOG0); const float* L1 = (const float*)(p.ws + WS_LOG1);
    int* TID = (int*)(p.ws + WS_TOPK_ID); float* TW = (float*)(p.ws + WS_TOPK_W); int* TP = (int*)(p.ws + WS_TOPK_POS); unsigned* CNT = (unsigned*)(p.ws + WS_CNT);
    float rb[4];
#pragma unroll
    for (int j = 0; j < 4; ++j) rb[j] = p.in[19][lane + 64 * j];
    for (int tok = gw; tok < NTOK; tok += nw) {
        float s[4], bz[4], gs[4];
#pragma unroll
        for (int j = 0; j < 4; ++j) { const float lg = L0[(size_t)tok * 256 + lane + 64 * j] + L1[(size_t)tok * 256 + lane + 64 * j]; s[j] = 1.0f / (1.0f + expf(-lg)); bz[j] = s[j] + rb[j]; }
#pragma unroll
        for (int j = 0; j < 4; ++j) { float m1 = bz[j], m2 = -INFINITY;
#pragma unroll
            for (int o = 1; o < 32; o <<= 1) { const float p1 = __shfl_xor(m1, o), p2 = __shfl_xor(m2, o); const float n1 = fmaxf(m1, p1), n2 = fmaxf(fminf(m1, p1), fmaxf(m2, p2)); m1 = n1; m2 = n2; }
            gs[j] = m1 + m2; }
        float Gv[8];
#pragma unroll
        for (int j = 0; j < 4; ++j) { const float oth = __shfl_xor(gs[j], 32); Gv[2 * j] = half ? oth : gs[j]; Gv[2 * j + 1] = half ? gs[j] : oth; }
        bool keep[8];
#pragma unroll
        for (int g = 0; g < 8; ++g) { int rank = 0;
#pragma unroll
            for (int g2 = 0; g2 < 8; ++g2) rank += (Gv[g2] > Gv[g] || (Gv[g2] == Gv[g] && g2 < g)) ? 1 : 0;
            keep[g] = rank < 4; }
        float mv[4];
#pragma unroll
        for (int j = 0; j < 4; ++j) { const bool k = half ? keep[2 * j + 1] : keep[2 * j]; mv[j] = k ? bz[j] : -INFINITY; }
        float ssum = 0.f, myS = 0.f; int myE = 0;
#pragma unroll 1
        for (int it = 0; it < 8; ++it) {
            float bv = mv[0], bs = s[0]; int be = lane;
#pragma unroll
            for (int j = 1; j < 4; ++j) if (mv[j] > bv) { bv = mv[j]; be = lane + 64 * j; bs = s[j]; }
#pragma unroll
            for (int o = 32; o >= 1; o >>= 1) { const float ov = __shfl_xor(bv, o), os = __shfl_xor(bs, o); const int oe = __shfl_xor(be, o); if (ov > bv || (ov == bv && oe < be)) { bv = ov; be = oe; bs = os; } }
#pragma unroll
            for (int j = 0; j < 4; ++j) if (be == lane + 64 * j) mv[j] = -INFINITY;
            if (lane == it) { myE = be; myS = bs; }
            ssum += bs;
        }
        if (lane < 8) { const int idx = tok * 8 + lane; TID[idx] = myE; TW[idx] = myS / ssum * 2.5f; TP[idx] = (int)__hip_atomic_fetch_add(LC + myE, 1u, __ATOMIC_RELAXED, __HIP_MEMORY_SCOPE_WORKGROUP); }
    }
    __syncthreads();
    if (threadIdx.x < 256) { const unsigned cnt = LC[threadIdx.x]; LB[threadIdx.x] = cnt ? atomicAdd(&CNT[threadIdx.x], cnt) : 0u; }
    __syncthreads();
    for (int tok = gw; tok < NTOK; tok += nw) if (lane < 8) { const int idx = tok * 8 + lane; TP[idx] += (int)LB[TID[idx]]; }
}
DEVI void phase12(const Params& p, LAS unsigned char* lds, int part) {
    if (part == 0) {
    LAS int* T = (LAS int*)(lds + LDS_TAB);
    moe_tables((const unsigned*)(p.ws + WS_CNT), T);
    const int* TID = (const int*)(p.ws + WS_TOPK_ID); const int* TP = (const int*)(p.ws + WS_TOPK_POS); int* TPw = (int*)(p.ws + WS_TOPK_POS); const float* TW = (const float*)(p.ws + WS_TOPK_W); u32x2* SL = (u32x2*)(p.ws + WS_SLOT);
    for (int idx = blockIdx.x * 512 + threadIdx.x; idx < NTOK * 8; idx += gridDim.x * 512) { const int slot_ = T[256 + TID[idx]] + TP[idx]; u32x2 rec; rec.x = (unsigned)idx; rec.y = __float_as_uint(TW[idx]); SL[slot_] = rec; TPw[idx] = slot_; }
    return; }
    LAS float* tb = (LAS float*)lds;
    for (int t = blockIdx.x; t < 256 * 48; t += gridDim.x) {
        const int e = t / 48, r = t % 48;
        if (r < 16)      conv_tile(p.in[20] + (size_t)e * 262144, 256, 256, (bf16_t*)(p.ws + WS_EXPGU) + (size_t)e * 524288, 1024, r * 64, 0, 0, tb);
        else if (r < 32) conv_tile(p.in[21] + (size_t)e * 262144, 256, 256, (bf16_t*)(p.ws + WS_EXPGU) + (size_t)e * 524288, 1024, (r - 16) * 64, 0, 128, tb);
        else { const int kt = (r - 32) >> 2, nb = (r - 32) & 3; conv_tile(p.in[22] + (size_t)e * 262144 + nb * 256, 1024, 256, (bf16_t*)(p.ws + WS_EXPD) + (size_t)e * 262144, 256, kt * 64, nb * 256, -1, tb); }
    }
}
DEVI void phase15(const Params& p) {
    const int lane = threadIdx.x & 63, gw = blockIdx.x * 8 + (threadIdx.x >> 6), nw = gridDim.x * 8;
    const float* mod = (const float*)(p.ws + WS_MOD); const float* X1 = (const float*)(p.ws + WS_X1);
    for (int tok = gw; tok < NTOK; tok += nw) {
        const float* m = mod + (size_t)(tok >> 12) * 6144 + 5120; float v[2][8];
        int sl[8]; float tw[8];
        { const int* tp = (const int*)(p.ws + WS_TOPK_POS) + (size_t)tok * 8; const float* twp = (const float*)(p.ws + WS_TOPK_W) + (size_t)tok * 8;
#pragma unroll
          for (int k = 0; k < 8; ++k) { sl[k] = __builtin_amdgcn_readfirstlane(tp[k]); tw[k] = twp[k]; } }
#pragma unroll
        for (int j = 0; j < 2; ++j) { const int cidx = lane * 8 + 512 * j; float a[8];
#pragma unroll
            for (int e = 0; e < 8; ++e) a[e] = 0.f;
#pragma unroll
            for (int k = 0; k < 9; ++k) { const u32x4 y = *(const u32x4*)((k < 8 ? (const bf16_t*)(p.ws + ws_ys(sl[k])) : (const bf16_t*)(p.ws + WS_Y8) + (size_t)tok * 1024) + cidx); const float w = k < 8 ? tw[k] : 1.0f;
                a[0] += w * bflo(y.x); a[1] += w * bfhi(y.x); a[2] += w * bflo(y.y); a[3] += w * bfhi(y.y); a[4] += w * bflo(y.z); a[5] += w * bfhi(y.z); a[6] += w * bflo(y.w); a[7] += w * bfhi(y.w); }
            const f32x4 g0 = *(const f32x4*)(m + cidx), g1 = *(const f32x4*)(m + cidx + 4), x0 = *(const f32x4*)(X1 + (size_t)tok * 1024 + cidx), x1 = *(const f32x4*)(X1 + (size_t)tok * 1024 + cidx + 4);
#if defined(DBG_NOMOE)
#pragma unroll
            for (int e = 0; e < 8; ++e) a[e] = 0.f;
#endif
#pragma unroll
            for (int e = 0; e < 4; ++e) { v[j][e] = x0[e] * 1.189207115f + g0[e] * a[e]; v[j][4 + e] = x1[e] * 1.189207115f + g1[e] * a[4 + e]; }
        }
        float sm = 0.f;
#pragma unroll
        for (int j = 0; j < 2; ++j)
#pragma unroll
            for (int e = 0; e < 8; ++e) sm += v[j][e];
        const float mu = wave_sum(sm) * (1.0f / 1024.0f); float q = 0.f;
#pragma unroll
        for (int j = 0; j < 2; ++j)
#pragma unroll
            for (int e = 0; e < 8; ++e) { v[j][e] -= mu; q += v[j][e] * v[j][e]; }
        const float rstd = rsqrtf(wave_sum(q) * (1.0f / 1024.0f) + 1e-6f);
#pragma unroll
        for (int j = 0; j < 2; ++j) { const int cidx = lane * 8 + 512 * j;
            const f32x4 g0 = *(const f32x4*)(p.in[26] + cidx), g1 = *(const f32x4*)(p.in[26] + cidx + 4), b0 = *(const f32x4*)(p.in[27] + cidx), b1 = *(const f32x4*)(p.in[27] + cidx + 4);
            f32x4 o0, o1;
#pragma unroll
            for (int e = 0; e < 4; ++e) { o0[e] = v[j][e] * rstd * g0[e] + b0[e]; o1[e] = v[j][4 + e] * rstd * g1[e] + b1[e]; }
            *(f32x4*)(p.out + (size_t)tok * 1024 + cidx) = o0; *(f32x4*)(p.out + (size_t)tok * 1024 + cidx + 4) = o1; }
    }
}

__global__ void __launch_bounds__(512, 2) mega(Params p) {
    extern __shared__ __attribute__((aligned(16))) unsigned char shm[];
    LAS unsigned char* lds = (LAS unsigned char*)shm;
    volatile LAS unsigned* xbw = (volatile LAS unsigned*)(lds + LDS_BARW);
    if (threadIdx.x == 0) { xbw[0] = 0u; xbw[1] = 0u; xbw[2] = 0u; xbw[3] = 0u; }
    __syncthreads();
    XcdBarrier bar; bar.bar = (unsigned*)(p.ws + WS_CTL); bar.x = 0; bar.st = xbw;
    const bool multi = (p.ph_hi - p.ph_lo) > 1;
    if (multi) bar = xcd_barrier_post((unsigned*)(p.ws + WS_CTL), xbw);
    unsigned char* ws = p.ws;
    const int G = gridDim.x, c = blockIdx.x;
#ifndef PHMASK
#define PHMASK 0xFFFF
#endif
#ifndef REPMASK
#define REPMASK 0
#endif
#define RUN(n) if (((PHMASK >> (n)) & 1) && p.ph_lo <= (n) && (n) < p.ph_hi)
#define SYNC(n) if (p.ph_lo <= (n) && (n) + 1 < p.ph_hi) xcd_barrier(bar); else __syncthreads()
    RUN(0) phase0(p, lds, 0);
#if (REPMASK >> 0) & 1
    __syncthreads();
    RUN(0) phase0(p, lds, 0);
#endif
    SYNC(0);
    RUN(1) { phase1(p); phase0(p, lds, 1); }
#if (REPMASK >> 1) & 1
    __syncthreads();
    RUN(1) { phase1(p); phase0(p, lds, 1); }
#endif
    SYNC(1);
    RUN(2) { SchedInProj S{ws, G, c}; EpiBf16 E; gemm_stream<SchedInProj, EpiBf16, false>(lds, S, E); }
#if (REPMASK >> 2) & 1
    __syncthreads();
    RUN(2) { SchedInProj S{ws, G, c}; EpiBf16 E; gemm_stream<SchedInProj, EpiBf16, false>(lds, S, E); }
#endif
    SYNC(2);
    RUN(3) phase3(p, lds);
#if (REPMASK >> 3) & 1
    __syncthreads();
    RUN(3) phase3(p, lds);
#endif
    SYNC(3);
    RUN(4) { if (c & 1) { phase4_na(p, lds); __syncthreads(); phase4_gla(p, lds); } else { phase4_gla(p, lds); __syncthreads(); phase4_na(p, lds); } }
    SYNC(4);
    RUN(5) phase5(p);
#if (REPMASK >> 5) & 1
    __syncthreads();
    RUN(5) phase5(p);
#endif
    SYNC(5);
#if (REPMASK >> 6) & 1
    __syncthreads();
#endif
    RUN(7) { SchedDense S{(const char*)(ws + WS_AP), (const char*)(ws + WS_BT_BR), (char*)(ws + WS_YM), 1536, G, c, 3072u, 3072u, 24}; EpiBranchC E{(const bf16_t*)(ws + WS_SGA), (const bf16_t*)(ws + WS_SGB), (bf16_t*)(ws + WS_YM)}; gemm_stream<SchedDense, EpiBranchC, false>(lds, S, E); }
#if (REPMASK >> 7) & 1
    __syncthreads();
    RUN(7) { SchedDense S{(const char*)(ws + WS_AP), (const char*)(ws + WS_BT_BR), (char*)(ws + WS_YM), 1536, G, c, 3072u, 3072u, 24}; EpiBranchC E{(const bf16_t*)(ws + WS_SGA), (const bf16_t*)(ws + WS_SGB), (bf16_t*)(ws + WS_YM)}; gemm_stream<SchedDense, EpiBranchC, false>(lds, S, E); }
#endif
    SYNC(7);
    RUN(8) { SchedDense S{(const char*)(ws + WS_YM), (const char*)(ws + WS_BT_OUT), (char*)(ws + WS_Z), 1024, G, c, 2048u, 2048u, 16}; EpiBf16 E; gemm_stream<SchedDense, EpiBf16, false>(lds, S, E); }
#if (REPMASK >> 8) & 1
    __syncthreads();
    RUN(8) { SchedDense S{(const char*)(ws + WS_YM), (const char*)(ws + WS_BT_OUT), (char*)(ws + WS_Z), 1024, G, c, 2048u, 2048u, 16}; EpiBf16 E; gemm_stream<SchedDense, EpiBf16, false>(lds, S, E); }
#endif
    SYNC(8);
    RUN(9) phase9(p);
#if (REPMASK >> 9) & 1
    __syncthreads();
    RUN(9) phase9(p);
#endif
    SYNC(9);
    RUN(10) { SchedRouter S{ws, G, c}; EpiF32 E; gemm_stream<SchedRouter, EpiF32, false>(lds, S, E); }
#if (REPMASK >> 10) & 1
    __syncthreads();
    RUN(10) { SchedRouter S{ws, G, c}; EpiF32 E; gemm_stream<SchedRouter, EpiF32, false>(lds, S, E); }
#endif
    SYNC(10);
    RUN(11) { if (c & 1) phase12(p, lds, 1); phase11(p, lds); if (!(c & 1)) phase12(p, lds, 1); }
#if (REPMASK >> 11) & 1
    __syncthreads();
    RUN(11) { if (c & 1) phase12(p, lds, 1); phase11(p, lds); if (!(c & 1)) phase12(p, lds, 1); }
#endif
    SYNC(11);
    RUN(12) phase12(p, lds, 0);
#if (REPMASK >> 12) & 1
    __syncthreads();
    RUN(12) phase12(p, lds, 0);
#endif
    SYNC(12);
    RUN(13) { LAS int* T = (LAS int*)(lds + LDS_TAB); moe_tables((const unsigned*)(ws + WS_CNT), T); SchedGateUp S{ws, T, G, c}; EpiGateUp E{(bf16_t*)(ws + WS_HID)}; gemm_stream<SchedGateUp, EpiGateUp, true>(lds, S, E); }
#if (REPMASK >> 13) & 1
    __syncthreads();
    RUN(13) { LAS int* T = (LAS int*)(lds + LDS_TAB); moe_tables((const unsigned*)(ws + WS_CNT), T); SchedGateUp S{ws, T, G, c}; EpiGateUp E{(bf16_t*)(ws + WS_HID)}; gemm_stream<SchedGateUp, EpiGateUp, true>(lds, S, E); }
#endif
    SYNC(13);
    RUN(14) { LAS int* T = (LAS int*)(lds + LDS_TAB); moe_tables((const unsigned*)(ws + WS_CNT), T); SchedDown S{ws, T, G, c}; EpiDown E{ws}; gemm_stream<SchedDown, EpiDown, false>(lds, S, E); }
#if (REPMASK >> 14) & 1
    __syncthreads();
    RUN(14) { LAS int* T = (LAS int*)(lds + LDS_TAB); moe_tables((const unsigned*)(ws + WS_CNT), T); SchedDown S{ws, T, G, c}; EpiDown E{ws}; gemm_stream<SchedDown, EpiDown, false>(lds, S, E); }
#endif
    SYNC(14);
    RUN(15) phase15(p);
#if (REPMASK >> 15) & 1
    __syncthreads();
    RUN(15) phase15(p);
#endif
}

#ifdef DBG_STOP
__global__ void dbg_dump(const unsigned short* base, size_t nwords, float* out, int accumulate) {
    for (size_t i = (size_t)blockIdx.x * blockDim.x + threadIdx.x; i < (size_t)33554432; i += (size_t)gridDim.x * blockDim.x) {
        float s = accumulate ? out[i] : 0.f;
        for (size_t j = i; j < nwords; j += (size_t)33554432) s += (float)base[j];
        out[i] = s;
    }
}
#endif
}

extern "C" void kernel_launch(void* const* d_in, const int* in_sizes, int n_in, void* d_out, int out_size, void* d_ws, size_t ws_size, hipStream_t stream) {
    static int grid = 0;
    if (grid == 0) {
        if (n_in != 28 || out_size != NTOK * 1024 || ws_size < WS_END) { fprintf(stderr, "kernel_launch: unexpected problem (n_in %d out %d ws %zu)\n", n_in, out_size, ws_size); grid = -1; return; }
        int dev = 0, cus = 0, per_cu = 0;
        if (hipGetDevice(&dev) != hipSuccess || hipDeviceGetAttribute(&cus, hipDeviceAttributeMultiprocessorCount, dev) != hipSuccess) { grid = -1; return; }
        if (hipFuncSetAttribute((const void*)mega, hipFuncAttributeMaxDynamicSharedMemorySize, LDS_TOTAL) != hipSuccess) { fprintf(stderr, "kernel_launch: hipFuncSetAttribute failed\n"); grid = -1; return; }
        if (hipOccupancyMaxActiveBlocksPerMultiprocessor(&per_cu, (const void*)mega, 512, LDS_TOTAL) != hipSuccess || per_cu < 1) fprintf(stderr, "kernel_launch: occupancy query says %d\n", per_cu);
        (void)hipGetLastError();
        grid = cus;
    }
    if (grid < 0) return;
    (void)hipMemsetAsync((char*)d_ws + WS_CTL, 0, 32768, stream);
    Params p{};
    for (int i = 0; i < 28; ++i) p.in[i] = (const float*)d_in[i];
    p.out = (float*)d_out; p.ws = (unsigned char*)d_ws;
#ifdef DBG_STOP
    for (int ph = 0; ph <= DBG_STOP; ++ph) { p.ph_lo = ph; p.ph_hi = ph + 1; hipLaunchKernelGGL(mega, dim3(grid), dim3(512), LDS_TOTAL, stream, p); }
    { const size_t regs[][2] = { DBG_REGS }; int first = 1;
      for (auto& r : regs) { hipLaunchKernelGGL(dbg_dump, dim3(2048), dim3(256), 0, stream, (const unsigned short*)((char*)d_ws + r[0] * MiB), (size_t)(r[1] * MiB / 2), (float*)d_out, first ? 0 : 1); first = 0; } }
#elif MK_PER_PHASE
    for (int ph = 0; ph < NPH; ++ph) {
#if defined(DBG_NOMOE)
        if (ph >= 10 && ph <= 14) continue;
#endif
        p.ph_lo = ph; p.ph_hi = ph + 1; hipLaunchKernelGGL(mega, dim3(grid), dim3(512), LDS_TOTAL, stream, p); }
#else
    p.ph_lo = 0; p.ph_hi = NPH; hipLaunchKernelGGL(mega, dim3(grid), dim3(512), LDS_TOTAL, stream, p);
#endif
}
```

```cpp
#include <hip/hip_runtime.h>
#include <stdint.h>
#include <stdio.h>

#ifndef MK_PER_PHASE
#define MK_PER_PHASE 0
#endif

namespace {
typedef unsigned short bf16_t;
typedef short bf16x8 __attribute__((ext_vector_type(8)));
typedef float f32x4 __attribute__((ext_vector_type(4)));
typedef unsigned u32x4 __attribute__((ext_vector_type(4)));
typedef unsigned u32x2 __attribute__((ext_vector_type(2)));
#define LAS __attribute__((address_space(3)))
#define DEVI __device__ __forceinline__

constexpr int NTOK = 32768, NROW = 34816, NPH = 16;
constexpr size_t MiB = 1ull << 20;
constexpr int LDS_TOTAL = 160 * 1024;
constexpr int LDS_BARW = LDS_TOTAL - 16;
constexpr int LDS_TAB = 131072;

constexpr size_t WS_CTL = 0, WS_CNT = 16384, WS_MOD = 1 * MiB, WS_EE = 2 * MiB, WS_TOPK_ID = 5 * MiB, WS_TOPK_W = 6 * MiB, WS_TOPK_POS = 7 * MiB, WS_SLOT = 8 * MiB;
constexpr size_t WS_BT_IN = 10 * MiB, WS_BT_BR = 24 * MiB  , WS_BT_OUT = 27 * MiB, WS_BT_RT = 29 * MiB, WS_BT_SHGU = 30 * MiB, WS_BT_SHD = 31 * MiB;
constexpr size_t WS_H = 32 * MiB, WS_QA = 100 * MiB, WS_KA = 132 * MiB, WS_QB = 166 * MiB, WS_KB = 198 * MiB, WS_GB = 232 * MiB, WS_SGA = 296 * MiB, WS_SGB = 360 * MiB;
constexpr size_t WS_VAT = 424 * MiB, WS_VBT = 458 * MiB, WS_QTF = 526 * MiB, WS_QTB = 558 * MiB, WS_KTF = 590 * MiB, WS_KTB = 624 * MiB, WS_KTTF = 658 * MiB, WS_KTTB = 692 * MiB;
constexpr size_t WS_OF = 726 * MiB, WS_OB = 790 * MiB, WS_AP = 896 * MiB, WS_LRT = 888 * MiB;
constexpr size_t WS_YM = 424 * MiB, WS_Z = 488 * MiB;
constexpr size_t WS_X1 = 32 * MiB, WS_EXPD = 160 * MiB, WS_LOG0 = 288 * MiB, WS_LOG1 = 320 * MiB, WS_EXPGU = 352 * MiB, WS_H2 = 608 * MiB, WS_HID = 864 * MiB;
constexpr size_t WS_YS = 288 * MiB;
constexpr size_t WS_Y8 = 800 * MiB, WS_END = 1009 * MiB;
DEVI size_t ws_ys(int slot) { return WS_YS + (size_t)slot * 2048; }
DEVI size_t ws_y(int k) { return (k < 2 ? 160 + 64 * (size_t)k : (k < 6 ? 416 + 64 * (size_t)(k - 2) : 817 + 64 * (size_t)(k - 6))) * MiB; }

struct Params { const float* in[28]; float* out; unsigned char* ws; int ph_lo, ph_hi; };

typedef __bf16 bf16x2_t __attribute__((ext_vector_type(2)));
typedef float f32x2_t __attribute__((ext_vector_type(2)));
DEVI unsigned pk_bf16(float lo, float hi) { const f32x2_t v = {lo, hi}; const bf16x2_t r = __builtin_convertvector(v, bf16x2_t); return __builtin_bit_cast(unsigned, r); }
DEVI float bf2f(bf16_t b) { return __uint_as_float(((unsigned)b) << 16); }
DEVI float bflo(unsigned w) { return __uint_as_float(w << 16); }
DEVI float bfhi(unsigned w) { return __uint_as_float(w & 0xffff0000u); }
DEVI bf16_t f2bf(float f) { return (bf16_t)(pk_bf16(f, 0.f) & 0xffffu); }
DEVI float sigmoidf_(float x) { return __builtin_amdgcn_rcpf(1.0f + __expf(-x)); }
template <int N> struct IC { static constexpr int v = N; };
DEVI void lds_barrier() { asm volatile("s_waitcnt lgkmcnt(0)" ::: "memory"); __builtin_amdgcn_s_barrier(); asm volatile("" ::: "memory"); }
template <int CTRL> DEVI float dppf(float v) { return __builtin_bit_cast(float, __builtin_amdgcn_update_dpp(__builtin_bit_cast(int, v), __builtin_bit_cast(int, v), CTRL, 0xF, 0xF, false)); }
template <int CTRL> DEVI int dppi(int v) { return __builtin_amdgcn_update_dpp(v, v, CTRL, 0xF, 0xF, false); }
DEVI float x16f(float v, int lane) { const auto r = __builtin_amdgcn_permlane16_swap(__builtin_bit_cast(unsigned, v), __builtin_bit_cast(unsigned, v), false, false); return __builtin_bit_cast(float, (lane & 16) ? r[0] : r[1]); }
DEVI int   x16i(int v, int lane)   { const auto r = __builtin_amdgcn_permlane16_swap((unsigned)v, (unsigned)v, false, false); return (int)((lane & 16) ? r[0] : r[1]); }
DEVI float x32f(float v, int lane) { const auto r = __builtin_amdgcn_permlane32_swap(__builtin_bit_cast(unsigned, v), __builtin_bit_cast(unsigned, v), false, false); return __builtin_bit_cast(float, (lane & 32) ? r[0] : r[1]); }
DEVI int   x32i(int v, int lane)   { const auto r = __builtin_amdgcn_permlane32_swap((unsigned)v, (unsigned)v, false, false); return (int)((lane & 32) ? r[0] : r[1]); }
#define DPP_X1 0xB1
#define DPP_X2 0x4E
#define DPP_HM 0x141
#define DPP_RM 0x140
DEVI float wave_sum(float v) { const int lane = threadIdx.x & 63; v += dppf<DPP_X1>(v); v += dppf<DPP_X2>(v); v += dppf<DPP_HM>(v); v += dppf<DPP_RM>(v); v += x16f(v, lane); v += x32f(v, lane); return v; }

#define XB_TMO      128
#define XB_XCNT(j)  (256  + 64 * (j))
#define XB_XSUB(j)  (1280 + 64 * (j))
#define XB_XGEN(j)  (2304 + 64 * (j))
#define XB_TOP      3328
#define XB_TOPGEN   3392
#define XCD_BAR_WORDS 3456
#define XB_SPIN_CAP (1u << 22)
DEVI unsigned xb_ld(unsigned* p)              { return __hip_atomic_load(p, __ATOMIC_RELAXED, __HIP_MEMORY_SCOPE_AGENT); }
DEVI unsigned xb_add(unsigned* p, unsigned v) { return __hip_atomic_fetch_add(p, v, __ATOMIC_RELAXED, __HIP_MEMORY_SCOPE_AGENT); }
DEVI unsigned xb_xcc_id() { return (unsigned)__builtin_amdgcn_s_getreg((3 << 11) | 20) & 0xFu; }
#define XB_SPIN(cond, bar) do { unsigned _sp = 0; while (cond) { __builtin_amdgcn_s_sleep(1); \
    if ((++_sp & 255u) == 0u) { if (xb_ld(&(bar)[XB_TMO])) break; if (_sp > XB_SPIN_CAP) { atomicAdd(&(bar)[XB_TMO], 1u); break; } } } } while (0)
struct XcdBarrier { unsigned* bar; unsigned x; volatile LAS unsigned* st; };
DEVI XcdBarrier xcd_barrier_post(unsigned* bar, volatile LAS unsigned* st) {
    XcdBarrier b; b.bar = bar; b.x = xb_xcc_id(); b.st = st;
    if (threadIdx.x == 0) (void)xb_add(&bar[XB_XCNT(b.x)], 1u);
    return b;
}
DEVI void xcd_barrier_complete(unsigned* bar, unsigned x, unsigned& nloc, unsigned& nx) {
    const unsigned G = gridDim.x * gridDim.y * gridDim.z;
    unsigned sum, cnt, mine, sp = 0u;
    for (;;) {
        sum = 0u; cnt = 0u; mine = 0u;
#pragma unroll
        for (unsigned j = 0; j < 16; ++j) { const unsigned c = xb_ld(&bar[XB_XCNT(j)]); sum += c; cnt += (c > 0u) ? 1u : 0u; mine = (j == x) ? c : mine; }
        if (sum == G) break;
        __builtin_amdgcn_s_sleep(1);
        if ((++sp & 255u) == 0u) { if (xb_ld(&bar[XB_TMO])) break; if (sp > XB_SPIN_CAP) { atomicAdd(&bar[XB_TMO], 1u); break; } }
    }
    nloc = mine > 0u ? mine : 1u; nx = cnt > 0u ? cnt : 1u;
}
DEVI void xcd_barrier(const XcdBarrier& b) {
    asm volatile("s_waitcnt vmcnt(0)" ::: "memory");
    __syncthreads();
    if (threadIdx.x == 0) {
        unsigned* bar = b.bar;
        __builtin_amdgcn_s_waitcnt(0);
        unsigned nloc = b.st[0], nx = b.st[1];
        if (nloc == 0u) { xcd_barrier_complete(bar, b.x, nloc, nx); b.st[0] = nloc; b.st[1] = nx; }
        const unsigned old = xb_add(&bar[XB_XSUB(b.x)], 1u);
        const unsigned gen = old / nloc;
        if (old + 1u == (gen + 1u) * nloc) {
            __builtin_amdgcn_fence(__ATOMIC_RELEASE, "agent");
            asm volatile("s_waitcnt vmcnt(0)" ::: "memory");
            const unsigned og = xb_add(&bar[XB_TOP], 1u);
            const unsigned tg = og / nx;
            if (og + 1u == (tg + 1u) * nx) xb_add(&bar[XB_TOPGEN], 1u);
            else XB_SPIN(xb_ld(&bar[XB_TOPGEN]) == tg, bar);
            __builtin_amdgcn_fence(__ATOMIC_ACQUIRE, "agent");
            xb_add(&bar[XB_XGEN(b.x)], 1u);
            asm volatile("s_waitcnt vmcnt(0)" ::: "memory");
        } else {
            XB_SPIN(xb_ld(&bar[XB_XGEN(b.x)]) == gen, bar);
            __builtin_amdgcn_fence(__ATOMIC_ACQUIRE, "agent");
            asm volatile("s_waitcnt vmcnt(0)" ::: "memory");
        }
    }
    __syncthreads();
}

constexpr int BK = 64, HALF = 128, HTB = HALF * BK * 2;
DEVI int lds_byte(int r, int c) { const int st = (r >> 4) * 2 + (c >> 5), rr = r & 15, cc = c & 31, ob = rr * 64 + cc * 2; return st * 1024 + (ob ^ (((ob >> 9) & 1) << 5)); }
DEVI void stage_rc(int b, int& R, int& C) { const int st = b / 1024, sb = b % 1024, swz = sb ^ (((sb >> 9) & 1) << 5); R = (st >> 1) * 16 + swz / 64; C = (st & 1) * 32 + (swz % 64) / 2; }
DEVI int perm32(int rho) { const int n = rho >> 4, i = rho & 15; return 8 * (i >> 2) + 4 * n + (i & 3); }

struct GUnit {
    const char* a; const char* b;
    char* dst; int ldd; int i0, i1, i2; float f0;
};
typedef f32x4 Acc[2][2][4][2];
#define ZA1(a, b, m) acc[a][b][m][0] = z; acc[a][b][m][1] = z;
#define ZA2(a, b) ZA1(a, b, 0) ZA1(a, b, 1) ZA1(a, b, 2) ZA1(a, b, 3)
DEVI void zero_acc(Acc& acc) { f32x4 z = {0.f, 0.f, 0.f, 0.f}; asm volatile("" : "+v"(z)); ZA2(0, 0) ZA2(0, 1) ZA2(1, 0) ZA2(1, 1) }

template <class Sched, class Epi, bool GATHER>
DEVI void gemm_stream(LAS unsigned char* lds, const Sched& S, const Epi& E) {
    const int tid = threadIdx.x, wid = __builtin_amdgcn_readfirstlane(tid >> 6), lane = tid & 63, wr = wid >> 2, wc = wid & 3, fr = lane & 15, fq = lane >> 4;
    const unsigned lda = S.lda, ldb = S.ldb; const int nt = S.nt;
    unsigned voffA[2], voffB[2]; int R0 = 0;
#pragma unroll
    for (int i = 0; i < 2; ++i) { int R, C; stage_rc(tid * 16 + i * 8192, R, C); const int Rb = (R & ~31) + perm32(R & 31);
        if (i == 0) R0 = R;
        voffA[i] = GATHER ? (unsigned)(C * 2) : (unsigned)R * lda + (unsigned)(C * 2); voffB[i] = (unsigned)Rb * ldb + (unsigned)(C * 2); }
    const size_t kstep = (size_t)(BK * 2);
    const size_t hstepA = GATHER ? (size_t)0 : (size_t)HALF * lda, hstepB = (size_t)HALF * ldb;
    const unsigned ldsw = (unsigned)wid * 1024u;
    const int aoff = lds_byte(wr * 64 + fr, fq * 8), boff = lds_byte(wc * 32 + fr, fq * 8);
#define G_SA(b, h) (((b) * 2 + (h)) * HTB)
#define G_SB(b, h) ((4 + (b) * 2 + (h)) * HTB)
#define G_STAGE(bufoff, gbase, o0, o1) do { \
        __builtin_amdgcn_global_load_lds((const unsigned*)((const char*)(gbase) + (o0)), (LAS unsigned*)(lds + (bufoff) + ldsw), 16, 0, 0); \
        __builtin_amdgcn_global_load_lds((const unsigned*)((const char*)(gbase) + (o1)), (LAS unsigned*)(lds + (bufoff) + ldsw + 8192), 16, 0, 0); } while (0)
#define G_LDA(dst, b, h) do { _Pragma("unroll") for (int m = 0; m < 4; ++m) _Pragma("unroll") for (int k = 0; k < 2; ++k) dst[m][k] = *(const LAS bf16x8*)(lds + G_SA(b, h) + aoff + m * 2048 + k * 1024); } while (0)
#define G_LDB(dst, b, h) do { _Pragma("unroll") for (int n = 0; n < 2; ++n) _Pragma("unroll") for (int k = 0; k < 2; ++k) dst[n][k] = *(const LAS bf16x8*)(lds + G_SB(b, h) + boff + n * 2048 + k * 1024); } while (0)
#define G_MMA(ai, bj, At, Bt) do { __builtin_amdgcn_s_setprio(1); _Pragma("unroll") for (int m = 0; m < 4; ++m) _Pragma("unroll") for (int n = 0; n < 2; ++n) _Pragma("unroll") for (int k = 0; k < 2; ++k) \
        acc[ai][bj][m][n] = __builtin_amdgcn_mfma_f32_16x16x32_bf16(Bt[n][k], At[m][k], acc[ai][bj][m][n], 0, 0, 0); __builtin_amdgcn_s_setprio(0); } while (0)
#define G_WAIT_V(n) asm volatile("s_waitcnt vmcnt(" #n ")" ::: "memory")
#define G_WAIT_L(n) asm volatile("s_waitcnt lgkmcnt(" #n ")" ::: "memory")
#define G_BAR __builtin_amdgcn_s_barrier()
#define G_SCHED __builtin_amdgcn_sched_barrier(0)
    GUnit cur, nxt; int ui = 0;
    if (!S.next(0, cur)) return;
    unsigned gc[2][2], gn[2][2];
    gc[0][0] = voffA[0]; gc[0][1] = voffA[1]; gc[1][0] = voffA[0]; gc[1][1] = voffA[1];
    gn[0][0] = voffA[0]; gn[0][1] = voffA[1]; gn[1][0] = voffA[0]; gn[1][1] = voffA[1];
    if constexpr (GATHER) { S.gather(cur, R0, gc); gc[0][0] += voffA[0]; gc[0][1] += voffA[0]; gc[1][0] += voffA[0]; gc[1][1] += voffA[0]; }
    Acc acc; zero_acc(acc);
    typename Epi::Pre pre; E.pre(cur, wr, lane, pre);
    bf16x8 At[4][2], B0[2][2], B1[2][2];
    const char* cA = cur.a; const char* cB = cur.b;
    G_STAGE(G_SB(0, 0), cB, voffB[0], voffB[1]); G_STAGE(G_SA(0, 0), cA, gc[0][0], gc[0][1]); G_STAGE(G_SB(0, 1), cB + hstepB, voffB[0], voffB[1]); G_STAGE(G_SA(0, 1), cA + hstepA, gc[1][0], gc[1][1]);
    if (wr == 1) G_BAR;
    G_WAIT_V(4); G_BAR;
    G_STAGE(G_SB(1, 0), cB + kstep, voffB[0], voffB[1]); G_STAGE(G_SA(1, 0), cA + kstep, gc[0][0], gc[0][1]); G_STAGE(G_SB(1, 1), cB + hstepB + kstep, voffB[0], voffB[1]);
    G_WAIT_V(6); G_BAR;
    for (;;) {
        const bool has_next = S.next(ui + 1, nxt);
        const char* nA = has_next ? nxt.a : cA; const char* nB = has_next ? nxt.b : cB;
        for (int t = 0; t < nt; t += 2) {
            const bool last = (t == nt - 2);
            const char* a1 = cA + (size_t)(t + 1) * kstep;
            const char* a2 = last ? nA : cA + (size_t)(t + 2) * kstep; const char* b2 = last ? nB : cB + (size_t)(t + 2) * kstep;
            const char* a3 = a2 + kstep; const char* b3 = b2 + kstep;
            unsigned g2[2][2];
            if constexpr (GATHER) { g2[0][0] = last ? gn[0][0] : gc[0][0]; g2[0][1] = last ? gn[0][1] : gc[0][1]; g2[1][0] = last ? gn[1][0] : gc[1][0]; g2[1][1] = last ? gn[1][1] : gc[1][1]; }
            else { g2[0][0] = voffA[0]; g2[0][1] = voffA[1]; g2[1][0] = voffA[0]; g2[1][1] = voffA[1]; }
            if constexpr (GATHER) { if (t == nt - 4) {
                if (has_next) { S.gather(nxt, R0, gn); gn[0][0] += voffA[0]; gn[0][1] += voffA[0]; gn[1][0] += voffA[0]; gn[1][1] += voffA[0]; }
                else { gn[0][0] = gc[0][0]; gn[0][1] = gc[0][1]; gn[1][0] = gc[1][0]; gn[1][1] = gc[1][1]; } } }
            if constexpr (Epi::MID_T > 0) { if (t == Epi::MID_T) { int tz = threadIdx.x; asm volatile("" : "+v"(tz)); const int wz = tz >> 6, lz = tz & 63; E.mid(acc, cur, wz >> 2, wz & 3, lz & 15, lz >> 4); } }
            G_LDB(B0, 0, 0); G_SCHED; G_LDA(At, 0, 0); G_STAGE(G_SA(1, 1), a1 + hstepA, gc[1][0], gc[1][1]);
            G_WAIT_L(8); G_BAR; G_WAIT_L(0); G_MMA(0, 0, At, B0); G_BAR; G_SCHED;
            G_LDB(B1, 0, 1); G_STAGE(G_SB(0, 0), b2, voffB[0], voffB[1]);
            G_BAR; G_WAIT_L(0); G_MMA(0, 1, At, B1); G_BAR;
            G_LDA(At, 0, 1); G_STAGE(G_SA(0, 0), a2, g2[0][0], g2[0][1]);
            G_BAR; G_WAIT_L(0); G_MMA(1, 0, At, B0); G_BAR; G_SCHED;
            G_STAGE(G_SB(0, 1), b2 + hstepB, voffB[0], voffB[1]);
            G_WAIT_V(6); G_BAR; G_MMA(1, 1, At, B1); G_BAR;
            G_LDB(B0, 1, 0); G_SCHED; G_LDA(At, 1, 0); G_STAGE(G_SA(0, 1), a2 + hstepA, g2[1][0], g2[1][1]);
            G_WAIT_L(8); G_BAR; G_WAIT_L(0); G_MMA(0, 0, At, B0); G_BAR; G_SCHED;
            G_LDB(B1, 1, 1); G_STAGE(G_SB(1, 0), b3, voffB[0], voffB[1]);
            G_BAR; G_WAIT_L(0); G_MMA(0, 1, At, B1); G_BAR;
            G_LDA(At, 1, 1); G_STAGE(G_SA(1, 0), a3, g2[0][0], g2[0][1]);
            G_BAR; G_WAIT_L(0); G_MMA(1, 0, At, B0); G_BAR; G_SCHED;
            G_STAGE(G_SB(1, 1), b3 + hstepB, voffB[0], voffB[1]);
            G_WAIT_V(6); G_BAR; G_MMA(1, 1, At, B1); G_BAR;
        }
        { int tz = threadIdx.x; asm volatile("" : "+v"(tz)); const int wz = tz >> 6, lz = tz & 63; E(acc, cur, wz >> 2, wz & 3, lz & 15, lz >> 4, pre); }
        if (!has_next) break;
        zero_acc(acc);
        cur = nxt; cA = nA; cB = nB; ++ui;
        E.pre(cur, wr, lane, pre);
        if constexpr (GATHER) { gc[0][0] = gn[0][0]; gc[0][1] = gn[0][1]; gc[1][0] = gn[1][0]; gc[1][1] = gn[1][1]; }
    }
    G_WAIT_V(0);
    if (wr == 0) G_BAR;
    G_BAR;
}

struct EpiBf16 { static constexpr int MID_T = 0; DEVI void mid(Acc&, const GUnit&, int, int, int, int) const {}
    struct Pre {}; DEVI void pre(const GUnit&, int, int, Pre&) const {}
    DEVI void operator()(const Acc& acc, const GUnit& u, int wr, int wc, int fr, int fq, const Pre&) const {
        if (u.f0 < 0.f) {
            float* fb = (float*)u.dst;
#pragma unroll
            for (int m = 0; m < 4; ++m) { const int row = wr * 64 + m * 16 + fr;
                if (row < 32) { float* rp = fb + (size_t)row * u.ldd + wc * 32 + 8 * fq;
#pragma unroll
                    for (int bj = 0; bj < 2; ++bj) { *(f32x4*)(rp + bj * 128) = acc[0][bj][m][0]; *(f32x4*)(rp + bj * 128 + 4) = acc[0][bj][m][1]; } } }
            return;
        }
        bf16_t* base = (bf16_t*)u.dst; const float s = u.f0; const int act = u.i0;
#pragma unroll
        for (int ai = 0; ai < 2; ++ai)
#pragma unroll
            for (int m = 0; m < 4; ++m) {
                bf16_t* rp = base + (size_t)(ai * 128 + wr * 64 + m * 16 + fr) * u.ldd + wc * 32 + 8 * fq;
#pragma unroll
                for (int bj = 0; bj < 2; ++bj) {
                    f32x4 v0 = acc[ai][bj][m][0] * s, v1 = acc[ai][bj][m][1] * s;
                    if (act) {
#pragma unroll
                        for (int j = 0; j < 4; ++j) { v0[j] = sigmoidf_(v0[j]); v1[j] = sigmoidf_(v1[j]); }
                    }
                    u32x4 w; w.x = pk_bf16(v0[0], v0[1]); w.y = pk_bf16(v0[2], v0[3]); w.z = pk_bf16(v1[0], v1[1]); w.w = pk_bf16(v1[2], v1[3]);
                    *(u32x4*)(rp + bj * 128) = w;
                }
            }
    }
};
struct EpiF32 { static constexpr int MID_T = 0; DEVI void mid(Acc&, const GUnit&, int, int, int, int) const {}
    struct Pre {}; DEVI void pre(const GUnit&, int, int, Pre&) const {}
    DEVI void operator()(const Acc& acc, const GUnit& u, int wr, int wc, int fr, int fq, const Pre&) const {
        float* base = (float*)u.dst;
#pragma unroll
        for (int ai = 0; ai < 2; ++ai)
#pragma unroll
            for (int m = 0; m < 4; ++m) {
                float* rp = base + (size_t)(ai * 128 + wr * 64 + m * 16 + fr) * u.ldd + wc * 32 + 8 * fq;
#pragma unroll
                for (int bj = 0; bj < 2; ++bj) { *(f32x4*)(rp + bj * 128) = acc[ai][bj][m][0]; *(f32x4*)(rp + bj * 128 + 4) = acc[ai][bj][m][1]; }
            }
    }
};
struct EpiBranchC {
    static constexpr int MID_T = 8;
    const bf16_t* sga; const bf16_t* sgb; bf16_t* ym;
    struct Pre {}; DEVI void pre(const GUnit&, int, int, Pre&) const {}
    DEVI void mid(Acc& acc, const GUnit& u, int wr, int wc, int fr, int fq) const {
#pragma unroll
        for (int ai = 0; ai < 2; ++ai)
#pragma unroll
            for (int m = 0; m < 4; ++m) {
                const size_t ro = (size_t)(u.i1 + ai * 128 + wr * 64 + m * 16 + fr) * 1024 + u.i2 + wc * 32 + 8 * fq;
#pragma unroll
                for (int bj = 0; bj < 2; ++bj) {
                    const u32x4 ga = *(const u32x4*)(sga + ro + bj * 128), gb = *(const u32x4*)(sgb + ro + bj * 128);
                    f32x4 r0, r1;
                    r0[0] = bflo(ga.x) * __builtin_amdgcn_rcpf(bflo(gb.x)); r0[1] = bfhi(ga.x) * __builtin_amdgcn_rcpf(bfhi(gb.x)); r0[2] = bflo(ga.y) * __builtin_amdgcn_rcpf(bflo(gb.y)); r0[3] = bfhi(ga.y) * __builtin_amdgcn_rcpf(bfhi(gb.y));
                    r1[0] = bflo(ga.z) * __builtin_amdgcn_rcpf(bflo(gb.z)); r1[1] = bfhi(ga.z) * __builtin_amdgcn_rcpf(bfhi(gb.z)); r1[2] = bflo(ga.w) * __builtin_amdgcn_rcpf(bflo(gb.w)); r1[3] = bfhi(ga.w) * __builtin_amdgcn_rcpf(bfhi(gb.w));
                    acc[ai][bj][m][0] = acc[ai][bj][m][0] * r0; acc[ai][bj][m][1] = acc[ai][bj][m][1] * r1;
                }
            }
    }
    DEVI void operator()(const Acc& acc, const GUnit& u, int wr, int wc, int fr, int fq, const Pre&) const {
#pragma unroll
        for (int ai = 0; ai < 2; ++ai)
#pragma unroll
            for (int m = 0; m < 4; ++m) {
                const size_t ro = (size_t)(u.i1 + ai * 128 + wr * 64 + m * 16 + fr) * 1024 + u.i2 + wc * 32 + 8 * fq;
#pragma unroll
                for (int bj = 0; bj < 2; ++bj) {
                    const u32x4 gb = *(const u32x4*)(sgb + ro + bj * 128);
                    const f32x4 v0 = acc[ai][bj][m][0], v1 = acc[ai][bj][m][1];
                    u32x4 w;
                    w.x = pk_bf16(bflo(gb.x) * v0[0], bfhi(gb.x) * v0[1]); w.y = pk_bf16(bflo(gb.y) * v0[2], bfhi(gb.y) * v0[3]);
                    w.z = pk_bf16(bflo(gb.z) * v1[0], bfhi(gb.z) * v1[1]); w.w = pk_bf16(bflo(gb.w) * v1[2], bfhi(gb.w) * v1[3]);
                    *(u32x4*)(ym + ro + bj * 128) = w;
                }
            }
    }
};
struct EpiGateUp { static constexpr int MID_T = 0; DEVI void mid(Acc&, const GUnit&, int, int, int, int) const {}
    bf16_t* hid;
    struct Pre {}; DEVI void pre(const GUnit&, int, int, Pre&) const {}
    DEVI void operator()(const Acc& acc, const GUnit& u, int wr, int wc, int fr, int fq, const Pre&) const {
#pragma unroll
        for (int ai = 0; ai < 2; ++ai)
#pragma unroll
            for (int m = 0; m < 4; ++m) {
                const int row = ai * 128 + wr * 64 + m * 16 + fr;
                if (row < u.i1) {
                    const f32x4 g0 = acc[ai][0][m][0], g1 = acc[ai][0][m][1], u0 = acc[ai][1][m][0], u1 = acc[ai][1][m][1];
                    float h[8];
#pragma unroll
                    for (int j = 0; j < 4; ++j) { h[j] = g0[j] * sigmoidf_(g0[j]) * u0[j]; h[4 + j] = g1[j] * sigmoidf_(g1[j]) * u1[j]; }
                    u32x4 w; w.x = pk_bf16(h[0], h[1]); w.y = pk_bf16(h[2], h[3]); w.z = pk_bf16(h[4], h[5]); w.w = pk_bf16(h[6], h[7]);
                    *(u32x4*)(hid + (size_t)(u.i0 + row) * 256 + u.i2 * 128 + wc * 32 + 8 * fq) = w;
                }
            }
    }
};
struct EpiDown {
    static constexpr int MID_T = 0; DEVI void mid(Acc&, const GUnit&, int, int, int, int) const {}
    unsigned char* ws;
    struct Pre {}; DEVI void pre(const GUnit&, int, int, Pre&) const {}
    DEVI void operator()(const Acc& acc, const GUnit& u, int wr, int wc, int fr, int fq, const Pre&) const {
#pragma unroll
        for (int ai = 0; ai < 2; ++ai)
#pragma unroll
            for (int m = 0; m < 4; ++m) {
                const int row = ai * 128 + wr * 64 + m * 16 + fr;
                if (row < u.i1) {
                    bf16_t* rp = (u.i2 == 0 ? (bf16_t*)(ws + ws_ys(u.i0 + row)) : (bf16_t*)(ws + WS_Y8) + (size_t)(u.i0 + row) * 1024) + u.ldd + wc * 32 + 8 * fq;
#pragma unroll
                    for (int bj = 0; bj < 2; ++bj) {
                        const f32x4 v0 = acc[ai][bj][m][0], v1 = acc[ai][bj][m][1];
                        u32x4 o; o.x = pk_bf16(v0[0], v0[1]); o.y = pk_bf16(v0[2], v0[3]); o.z = pk_bf16(v1[0], v1[1]); o.w = pk_bf16(v1[2], v1[3]);
                        *(u32x4*)(rp + bj * 128) = o;
                    }
                }
            }
    }
};

struct SchedInProj {
    unsigned char* ws; int G, c;
    static constexpr unsigned lda = 2048, ldb = 2048; static constexpr int nt = 16;
    DEVI bool next(int i, GUnit& u) const {
        const int L = i * G + c; if (L >= 3544) return false;
        u.i0 = 0; u.i1 = 0; u.i2 = 0; u.f0 = 1.0f;
        const char* H = (const char*)(ws + WS_H); const char* BT = (const char*)(ws + WS_BT_IN);
        int pm, pn;
        if (L < 2592) {
            if (L < 2560) { const int x = L & 7, q = L >> 3, blk = q >> 5, w = q & 31; pm = 16 * x + 8 * (blk & 1) + (w & 7); pn = 4 * (blk >> 1) + (w >> 3); }
            else { const int j = L - 2560, jn = j >> 3; pm = 128 + (j & 7); pn = jn < 2 ? 2 + jn : 4 + jn; }
            u.a = H + (size_t)pm * 256 * 2048; u.b = BT + (size_t)pn * 256 * 2048;
            size_t base; int ld, col;
            if (pn < 2)       { base = WS_QA; ld = 512; col = pn * 256; u.f0 = 0.125f; }
            else if (pn < 4)  { base = WS_KA; ld = 512; col = (pn - 2) * 256; }
            else if (pn < 6)  { base = WS_QB; ld = 512; col = (pn - 4) * 256; }
            else if (pn < 8)  { base = WS_KB; ld = 512; col = (pn - 6) * 256; }
            else if (pn < 12) { base = WS_GB; ld = 1024; col = (pn - 8) * 256; }
            else if (pn < 16) { base = WS_SGA; ld = 1024; col = (pn - 12) * 256; u.i0 = 1; }
            else              { base = WS_SGB; ld = 1024; col = (pn - 16) * 256; u.i0 = 1; }
            u.dst = (char*)(ws + base) + ((size_t)pm * 256 * ld + col) * 2; u.ldd = ld;
        } else {
            const int j = L - 2592, x = j & 7, q = j >> 3, tn = 17 * x + q / 7, wm = q % 7;
            u.a = BT + (size_t)(5120 + wm * 256) * 2048; u.b = H + (size_t)tn * 256 * 2048;
            u.dst = (wm < 2 ? (char*)(ws + WS_VAT) + ((size_t)(wm * 256) * NROW + tn * 256) * 2 : (wm < 6 ? (char*)(ws + WS_VBT) + ((size_t)((wm - 2) * 256) * NROW + tn * 256) * 2 : (char*)(ws + WS_LRT) + (size_t)(tn * 256) * 4));
            u.ldd = NROW; if (wm == 6) u.f0 = -1.0f;
        }
        return true;
    }
};
struct SchedDense {
    const char* A; const char* Bt; char* dst; int K; int G, c; unsigned lda, ldb; int nt;
    DEVI bool next(int i, GUnit& u) const {
        const int L = i * G + c; if (L >= 512) return false;
        const int x = L & 7, q = L >> 3, blk = q >> 5, w = q & 31, pm = 16 * x + 8 * blk + (w & 7), pn = w >> 3;
        u.a = A + (size_t)pm * 256 * K * 2; u.b = Bt + (size_t)pn * 256 * K * 2;
        u.dst = dst + ((size_t)pm * 256 * 1024 + pn * 256) * 2; u.ldd = 1024; u.i0 = 0; u.i1 = pm * 256; u.i2 = pn * 256; u.f0 = 1.0f;
        return true;
    }
};
struct SchedRouter {
    unsigned char* ws; int G, c;
    static constexpr unsigned lda = 2048, ldb = 2048; static constexpr int nt = 8;
    DEVI bool next(int i, GUnit& u) const {
        const int L = i * G + c; if (L >= 256) return false;
        const int x = L & 7, q = L >> 3, pm = 16 * x + (q >> 1), ks = q & 1;
        u.a = (const char*)(ws + WS_H2) + (size_t)pm * 256 * 2048 + ks * 1024; u.b = (const char*)(ws + WS_BT_RT) + ks * 1024;
        u.dst = (char*)(ws + (ks ? WS_LOG1 : WS_LOG0)) + (size_t)pm * 256 * 256 * 4; u.ldd = 256; u.i0 = 0; u.i1 = 0; u.i2 = 0; u.f0 = 1.0f;
        return true;
    }
};
DEVI void moe_tables(const unsigned* gcnt, LAS int* T) {
    if (threadIdx.x < 64) {
        const int l = threadIdx.x; int c[4], t[4];
#pragma unroll
        for (int k = 0; k < 4; ++k) { c[k] = (int)gcnt[4 * l + k]; t[k] = (c[k] + 255) >> 8; }
        const int sc = c[0] + c[1] + c[2] + c[3], st = t[0] + t[1] + t[2] + t[3];
        int ic = sc, it = st;
#pragma unroll
        for (int o = 1; o < 64; o <<= 1) { const int a = __shfl_up(ic, o), b = __shfl_up(it, o); if (l >= o) { ic += a; it += b; } }
        int bc = ic - sc, bt = it - st;
#pragma unroll
        for (int k = 0; k < 4; ++k) { T[4 * l + k] = c[k]; T[256 + 4 * l + k] = bc; T[513 + 4 * l + k] = bt; bc += c[k]; bt += t[k]; }
        if (l == 63) { T[256 + 256] = ic; T[513 + 256] = it; }
    }
    __syncthreads();
    {
        const int TRt = T[513 + 256];
        for (int t = threadIdx.x; t < TRt; t += 512) { int lo = 0, hi = 256; while (hi - lo > 1) { const int mid = (lo + hi) >> 1; if (T[513 + mid] <= t) lo = mid; else hi = mid; } T[770 + t] = lo; }
    }
    __syncthreads();
}
DEVI int moe_find(const LAS int* toff, int t) {
    int lo = 0, hi = 256;
#pragma unroll 1
    while (hi - lo > 1) { const int mid = (lo + hi) >> 1; if (toff[mid] <= t) lo = mid; else hi = mid; }
    return __builtin_amdgcn_readfirstlane(lo);
}
struct SchedGateUp {
    unsigned char* ws; const LAS int* T; int G, c;
    static constexpr unsigned lda = 2048, ldb = 2048; static constexpr int nt = 16;
    DEVI bool next(int i, GUnit& u) const {
        const int L = i * G + c; const int TR = __builtin_amdgcn_readfirstlane(T[513 + 256]);
        if (L >= 2 * TR + 256) return false;
        u.a = (const char*)(ws + WS_H2); u.dst = nullptr; u.ldd = 0; u.f0 = 1.0f;
        if (L < 2 * TR) {
            const int t = L >> 1, pn = L & 1, e = __builtin_amdgcn_readfirstlane(T[770 + t]), mt = t - __builtin_amdgcn_readfirstlane(T[513 + e]), cnt = __builtin_amdgcn_readfirstlane(T[e]);
            u.b = (const char*)(ws + WS_EXPGU) + ((size_t)e * 512 + pn * 256) * 2048;
            u.i0 = __builtin_amdgcn_readfirstlane(T[256 + e]) + mt * 256; u.i1 = min(256, cnt - mt * 256); u.i2 = pn;
        } else {
            const int j = L - 2 * TR, mt = j >> 1, pn = j & 1;
            u.b = (const char*)(ws + WS_BT_SHGU) + (size_t)(pn * 256) * 2048;
            u.i0 = 262144 + mt * 256; u.i1 = 256; u.i2 = pn;
        }
        return true;
    }
    DEVI void gather(const GUnit& u, int R0, unsigned (&g)[2][2]) const {
        const u32x2* slot = (const u32x2*)(ws + WS_SLOT);
#pragma unroll
        for (int h = 0; h < 2; ++h)
#pragma unroll
            for (int i = 0; i < 2; ++i) {
                const int s = u.i0 + h * 128 + R0 + 64 * i; int tok;
                if (u.i0 >= 262144) tok = s - 262144; else tok = (int)(slot[min(s, 262143)].x >> 3);
                g[h][i] = (unsigned)tok * 2048u;
            }
    }
};
struct SchedDown {
    unsigned char* ws; const LAS int* T; int G, c;
    static constexpr unsigned lda = 512, ldb = 512; static constexpr int nt = 4;
    DEVI bool next(int i, GUnit& u) const {
        const int L = i * G + c; const int TR = __builtin_amdgcn_readfirstlane(T[513 + 256]);
        if (L >= 4 * TR + 512) return false;
        u.dst = nullptr; u.f0 = 1.0f;
        if (L < 4 * TR) {
            const int t = L >> 2, pn = L & 3, e = __builtin_amdgcn_readfirstlane(T[770 + t]), mt = t - __builtin_amdgcn_readfirstlane(T[513 + e]), cnt = __builtin_amdgcn_readfirstlane(T[e]);
            const int s0 = __builtin_amdgcn_readfirstlane(T[256 + e]) + mt * 256;
            u.a = (const char*)(ws + WS_HID) + (size_t)s0 * 512; u.b = (const char*)(ws + WS_EXPD) + ((size_t)e * 1024 + pn * 256) * 512;
            u.i0 = s0; u.i1 = min(256, cnt - mt * 256); u.i2 = 0; u.ldd = pn * 256;
        } else {
            const int j = L - 4 * TR, mt = j >> 2, pn = j & 3;
            u.a = (const char*)(ws + WS_HID) + (size_t)(262144 + mt * 256) * 512; u.b = (const char*)(ws + WS_BT_SHD) + (size_t)(pn * 256) * 512;
            u.i0 = mt * 256; u.i1 = 256; u.i2 = 1; u.ldd = pn * 256;
        }
        return true;
    }
};

DEVI void conv_tile(const float* src, int ldsrc, int ncols, bf16_t* dst, int ldd, int k0, int row0, int ilv, LAS float* t) {
    const int tid = threadIdx.x;
    f32x4 v[8];
#pragma unroll
    for (int i = 0; i < 8; ++i) { const int f = tid + 512 * i, row = f >> 6, c4 = (f & 63) * 4;
        v[i] = (c4 < ncols) ? *(const f32x4*)(src + (size_t)(k0 + row) * ldsrc + c4) : (f32x4){0.f, 0.f, 0.f, 0.f}; }
#pragma unroll
    for (int i = 0; i < 8; ++i) { const int f = tid + 512 * i, row = f >> 6, c4 = (f & 63) * 4; LAS float* q = t + row * 257 + c4; q[0] = v[i][0]; q[1] = v[i][1]; q[2] = v[i][2]; q[3] = v[i][3]; }
    __syncthreads();
#pragma unroll
    for (int j = 0; j < 4; ++j) {
        const int p = tid + 512 * j, kp = p & 7, n = p >> 3;
        if (n < ncols) {
            const LAS float* q = t + (kp * 8) * 257 + n;
            u32x4 w; w.x = pk_bf16(q[0], q[257]); w.y = pk_bf16(q[2 * 257], q[3 * 257]); w.z = pk_bf16(q[4 * 257], q[5 * 257]); w.w = pk_bf16(q[6 * 257], q[7 * 257]);
            const int drow = row0 + (ilv >= 0 ? ((n >> 7) * 256 + (n & 127) + ilv) : n);
            *(u32x4*)(dst + (size_t)drow * ldd + k0 + kp * 8) = w;
        }
    }
    __syncthreads();
}

DEVI void phase0(const Params& p, LAS unsigned char* lds, int part) {
    const int tid = threadIdx.x, lane = tid & 63, wid = tid >> 6;
    unsigned char* ws = p.ws;
    const int NT_IN = 16 * (2 + 2 + 2 + 2 + 4 + 4 + 4 + 2 + 4 + 1);
    const int NT0 = NT_IN + 8 * 4 + 16 * 4 + 16 * 4 + 16 + 16 + 16 + 4 * 4;
    for (int u = (part == 0 ? (int)blockIdx.x : 192 + (int)blockIdx.x); u < (part == 0 ? 192 : 192 + NT0); u += gridDim.x) {
        if (u < 192) {
            LAS float* sc = (LAS float*)lds; LAS float* red = (LAS float*)(lds + 9 * 1024 * 4);
            for (int i = tid; i < 9216; i += 512) { const int r = i >> 10, k = i & 1023; const float v = r < 8 ? p.in[1][r * 1024 + k] : p.in[3][k]; sc[i] = v / (1.0f + __expf(-v)); }
            __syncthreads();
            const int n0 = u * 32, col = lane & 31, rsub = lane >> 5;
            float acc[9];
#pragma unroll
            for (int r = 0; r < 9; ++r) acc[r] = 0.f;
            for (int it = 0; it < 64; ++it) { const int k = it * 16 + wid * 2 + rsub; const float w = p.in[4][(size_t)k * 6144 + n0 + col];
#pragma unroll
                for (int r = 0; r < 9; ++r) acc[r] += sc[r * 1024 + k] * w; }
#pragma unroll
            for (int r = 0; r < 9; ++r) red[((wid * 2 + rsub) * 9 + r) * 32 + col] = acc[r];
            __syncthreads();
            if (tid < 288) { const int r = tid >> 5, cc = tid & 31; float s = 0.f; for (int g = 0; g < 16; ++g) s += red[(g * 9 + r) * 32 + cc];
                ((float*)(ws + WS_MOD))[r * 6144 + n0 + cc] = s + p.in[5][n0 + cc]; }
            __syncthreads();
        } else {
            int t = u - 192; LAS float* tb = (LAS float*)lds;
            if (t < NT_IN) {
                const int kt = t & 15; int jb = t >> 4;
                int c0, r0, nc = 256;
                if (jb < 2)       { c0 = 0 + jb * 256;             r0 = 0 + jb * 256; }
                else if (jb < 4)  { c0 = 512 + (jb - 2) * 256;     r0 = 512 + (jb - 2) * 256; }
                else if (jb < 6)  { c0 = 1536 + (jb - 4) * 256;    r0 = 1024 + (jb - 4) * 256; }
                else if (jb < 8)  { c0 = 2048 + (jb - 6) * 256;    r0 = 1536 + (jb - 6) * 256; }
                else if (jb < 12) { c0 = 3584 + (jb - 8) * 256;    r0 = 2048 + (jb - 8) * 256; }
                else if (jb < 16) { c0 = 4640 + (jb - 12) * 256;   r0 = 3072 + (jb - 12) * 256; }
                else if (jb < 20) { c0 = 5664 + (jb - 16) * 256;   r0 = 4096 + (jb - 16) * 256; }
                else if (jb < 22) { c0 = 1024 + (jb - 20) * 256;   r0 = 5120 + (jb - 20) * 256; }
                else if (jb < 26) { c0 = 2560 + (jb - 22) * 256;   r0 = 5632 + (jb - 22) * 256; }
                else              { c0 = 4608; r0 = 6656; nc = 32; }
                conv_tile(p.in[6] + c0, 6688, nc, (bf16_t*)(ws + WS_BT_IN), 1024, kt * 64, r0, -1, tb);
            } else {
                t -= NT_IN;
                if (t < 32)        { const int kt = t & 7, nb = t >> 3;  conv_tile(p.in[13] + nb * 256, 1024, 256, (bf16_t*)(ws + WS_BT_BR), 1536, kt * 64, nb * 256, -1, tb); }
                else if (t < 96)   { t -= 32; const int kt = t & 15, nb = t >> 4; conv_tile(p.in[14] + nb * 256, 1024, 256, (bf16_t*)(ws + WS_BT_BR) + 512, 1536, kt * 64, nb * 256, -1, tb); }
                else if (t < 160)  { t -= 96; const int kt = t & 15, nb = t >> 4; conv_tile(p.in[15] + nb * 256, 1024, 256, (bf16_t*)(ws + WS_BT_OUT), 1024, kt * 64, nb * 256, -1, tb); }
                else if (t < 176)  { t -= 160; conv_tile(p.in[18], 256, 256, (bf16_t*)(ws + WS_BT_RT), 1024, t * 64, 0, -1, tb); }
                else if (t < 192)  { t -= 176; conv_tile(p.in[23], 256, 256, (bf16_t*)(ws + WS_BT_SHGU), 1024, t * 64, 0, 0, tb); }
                else if (t < 208)  { t -= 192; conv_tile(p.in[24], 256, 256, (bf16_t*)(ws + WS_BT_SHGU), 1024, t * 64, 0, 128, tb); }
                else               { t -= 208; const int kt = t & 3, nb = t >> 2; conv_tile(p.in[25] + nb * 256, 1024, 256, (bf16_t*)(ws + WS_BT_SHD), 256, kt * 64, nb * 256, -1, tb); }
            }
        }
    }
}

DEVI void phase1(const Params& p) {
    const float* mod = (const float*)(p.ws + WS_MOD); bf16_t* H = (bf16_t*)(p.ws + WS_H);
    for (size_t idx = (size_t)blockIdx.x * 512 + threadIdx.x; idx < (size_t)NROW * 128; idx += (size_t)gridDim.x * 512) {
        const int row = (int)(idx >> 7), k = (int)(idx & 127) * 8;
        const float* src = row < NTOK ? p.in[0] + (size_t)row * 1024 + k : p.in[2] + (size_t)(row - NTOK) * 1024 + k;
        const float* m = mod + (size_t)(row < NTOK ? (row >> 12) : 8) * 6144 + k;
        const f32x4 x0 = *(const f32x4*)src, x1 = *(const f32x4*)(src + 4), h0 = *(const f32x4*)m, h1 = *(const f32x4*)(m + 4), s0 = *(const f32x4*)(m + 1024), s1 = *(const f32x4*)(m + 1028);
        const f32x4 y0 = x0 * (s0 + 1.0f) + h0, y1 = x1 * (s1 + 1.0f) + h1;
        u32x4 w; w.x = pk_bf16(y0[0], y0[1]); w.y = pk_bf16(y0[2], y0[3]); w.z = pk_bf16(y1[0], y1[1]); w.w = pk_bf16(y1[2], y1[3]);
        *(u32x4*)(H + (size_t)row * 1024 + k) = w;
    }
}

DEVI float logsig16(float z) { return -(fmaxf(-z, 0.f) + __logf(1.0f + __expf(-fabsf(z)))) * 0.0625f; }
DEVI void phase3(const Params& p, LAS unsigned char* lds) {
    const int tid = threadIdx.x;
    unsigned char* ws = p.ws;
    LAS float* LRs = (LAS float*)lds;
    LAS float* CS = (LAS float*)(lds + 8192);
    LAS float* CUM = (LAS float*)(lds + 24576);
    LAS float* TOT = (LAS float*)(lds + 24576 + 65536);
    LAS bf16_t* KTs = (LAS bf16_t*)(lds + 24576 + 65536 + 2048);
    for (int i = tid; i < 2048; i += 512) { const int pos = i >> 5, j = i & 31; const float ang = (float)pos * powf(10000.0f, -(float)j / 32.0f); CS[2 * i] = cosf(ang); CS[2 * i + 1] = sinf(ang); }
    __syncthreads();
    const float* LRT = (const float*)(ws + WS_LRT);
    const bf16_t* QB = (const bf16_t*)(ws + WS_QB); const bf16_t* KB = (const bf16_t*)(ws + WS_KB);
    bf16_t* QTF = (bf16_t*)(ws + WS_QTF); bf16_t* QTB = (bf16_t*)(ws + WS_QTB); bf16_t* KTF = (bf16_t*)(ws + WS_KTF); bf16_t* KTB = (bf16_t*)(ws + WS_KTB);
    float* EE = (float*)(ws + WS_EE);
    for (int u = blockIdx.x; u < 8 * 68 * 4; u += gridDim.x) {
        const int h = u & 3, bs = u >> 2, b = bs / 68, slot = bs % 68; const bool isctx = slot < 4; const int chunk = slot - 4;
        const int rowbase = isctx ? NTOK + b * 256 + slot * 64 : b * 4096 + chunk * 64;
        { const int r = tid >> 4, c4 = (tid & 15) * 4; const f32x4 lv = *(const f32x4*)(LRT + (size_t)r * NROW + rowbase + c4);
          LRs[(c4 + 0) * 32 + r] = lv[0]; LRs[(c4 + 1) * 32 + r] = lv[1]; LRs[(c4 + 2) * 32 + r] = lv[2]; LRs[(c4 + 3) * 32 + r] = lv[3]; }
        __syncthreads();
        {
            const int ch = tid & 127, grp = tid >> 7, dir = grp & 1, hf = grp >> 1;
            const float* w2p = p.in[dir ? 10 : 8] + h * 128 + ch; const float b2 = p.in[dir ? 11 : 9][h * 128 + ch];
            float w2[16];
#pragma unroll
            for (int r = 0; r < 16; ++r) w2[r] = w2p[r * 512];
            float run = 0.f;
            for (int k = 0; k < 32; ++k) {
                const int i = dir ? (32 * hf + 31 - k) : (32 * hf + k);
                const LAS f32x4* lp = (const LAS f32x4*)(LRs + i * 32 + 16 * dir);
                const f32x4 l0 = lp[0], l1 = lp[1], l2 = lp[2], l3 = lp[3];
                const float z0 = (l0[0] * w2[0] + l0[1] * w2[1]) + (l0[2] * w2[2] + l0[3] * w2[3]), z1 = (l1[0] * w2[4] + l1[1] * w2[5]) + (l1[2] * w2[6] + l1[3] * w2[7]);
                const float z2 = (l2[0] * w2[8] + l2[1] * w2[9]) + (l2[2] * w2[10] + l2[3] * w2[11]), z3 = (l3[0] * w2[12] + l3[1] * w2[13]) + (l3[2] * w2[14] + l3[3] * w2[15]);
                const float z = b2 + ((z0 + z1) + (z2 + z3));
                run += logsig16(z);
                CUM[(dir * 64 + i) * 128 + ch] = run;
            }
            TOT[(dir * 2 + hf) * 128 + ch] = run;
        }
        __syncthreads();
#pragma unroll
        for (int rep = 0; rep < 2; ++rep) {
            const int q = tid + 512 * rep, i = q >> 4, c8 = q & 15, ch0 = c8 * 8;
            float cf[8], cb[8];
            {
                const f32x4 a0 = *(const LAS f32x4*)(CUM + (0 * 64 + i) * 128 + ch0), a1 = *(const LAS f32x4*)(CUM + (0 * 64 + i) * 128 + ch0 + 4);
                const f32x4 b0 = *(const LAS f32x4*)(CUM + (1 * 64 + i) * 128 + ch0), b1 = *(const LAS f32x4*)(CUM + (1 * 64 + i) * 128 + ch0 + 4);
                f32x4 tf0 = {0.f, 0.f, 0.f, 0.f}, tf1 = tf0, tb0 = tf0, tb1 = tf0;
                if (i >= 32) { tf0 = *(const LAS f32x4*)(TOT + (0 * 2 + 0) * 128 + ch0); tf1 = *(const LAS f32x4*)(TOT + (0 * 2 + 0) * 128 + ch0 + 4); }
                else         { tb0 = *(const LAS f32x4*)(TOT + (1 * 2 + 1) * 128 + ch0); tb1 = *(const LAS f32x4*)(TOT + (1 * 2 + 1) * 128 + ch0 + 4); }
#pragma unroll
                for (int e = 0; e < 4; ++e) { cf[e] = a0[e] + tf0[e]; cf[4 + e] = a1[e] + tf1[e]; cb[e] = b0[e] + tb0[e]; cb[4 + e] = b1[e] + tb1[e]; }
            }
            const size_t go = (size_t)(rowbase + i) * 512 + h * 128 + ch0;
            const u32x4 kraw = *(const u32x4*)(KB + go);
            float kv[8] = {bflo(kraw.x), bfhi(kraw.x), bflo(kraw.y), bfhi(kraw.y), bflo(kraw.z), bfhi(kraw.z), bflo(kraw.w), bfhi(kraw.w)};
            float ef[8], eb[8];
#pragma unroll
            for (int e = 0; e < 8; ++e) { ef[e] = __expf(cf[e]); eb[e] = __expf(cb[e]); }
            if (!isctx) {
                const size_t gp = (size_t)(rowbase + i) * 512 + h * 128 + ((c8 ^ 4) * 8);
                const u32x4 kpr = *(const u32x4*)(KB + gp), qraw = *(const u32x4*)(QB + go), qpr = *(const u32x4*)(QB + gp);
                const float kp[8] = {bflo(kpr.x), bfhi(kpr.x), bflo(kpr.y), bfhi(kpr.y), bflo(kpr.z), bfhi(kpr.z), bflo(kpr.w), bfhi(kpr.w)};
                const float qv[8] = {bflo(qraw.x), bfhi(qraw.x), bflo(qraw.y), bfhi(qraw.y), bflo(qraw.z), bfhi(qraw.z), bflo(qraw.w), bfhi(qraw.w)};
                const float qp[8] = {bflo(qpr.x), bfhi(qpr.x), bflo(qpr.y), bfhi(qpr.y), bflo(qpr.z), bfhi(qpr.z), bflo(qpr.w), bfhi(qpr.w)};
                const int half = c8 >> 3, isx2 = (c8 >> 2) & 1, j0 = (c8 & 3) * 8, pos = half ? i : chunk;
                float qf[8], qb[8];
                const LAS f32x4* cp = (const LAS f32x4*)(CS + (pos * 32 + j0) * 2); const f32x4 c0 = cp[0], c1 = cp[1], c2 = cp[2], c3 = cp[3];
                const float csv[8] = {c0[0], c0[2], c1[0], c1[2], c2[0], c2[2], c3[0], c3[2]}, snv[8] = {c0[1], c0[3], c1[1], c1[3], c2[1], c2[3], c3[1], c3[3]};
#pragma unroll
                for (int e = 0; e < 8; ++e) {
                    const float cs = csv[e], sn = snv[e];
                    const float rq = isx2 ? qv[e] * cs + qp[e] * sn : qv[e] * cs - qp[e] * sn;
                    kv[e] = isx2 ? kv[e] * cs + kp[e] * sn : kv[e] * cs - kp[e] * sn;
                    qf[e] = rq * 0.08838834764831845f * ef[e]; qb[e] = rq * 0.08838834764831845f * eb[e];
                }
                u32x4 wq; wq.x = pk_bf16(qf[0], qf[1]); wq.y = pk_bf16(qf[2], qf[3]); wq.z = pk_bf16(qf[4], qf[5]); wq.w = pk_bf16(qf[6], qf[7]); *(u32x4*)(QTF + go) = wq;
                wq.x = pk_bf16(qb[0], qb[1]); wq.y = pk_bf16(qb[2], qb[3]); wq.z = pk_bf16(qb[4], qb[5]); wq.w = pk_bf16(qb[6], qb[7]); *(u32x4*)(QTB + go) = wq;
            }
            float kf[8], kb[8];
#pragma unroll
            for (int e = 0; e < 8; ++e) { kf[e] = kv[e] * __builtin_amdgcn_rcpf(ef[e]); kb[e] = kv[e] * __builtin_amdgcn_rcpf(eb[e]); }
            u32x4 wf; wf.x = pk_bf16(kf[0], kf[1]); wf.y = pk_bf16(kf[2], kf[3]); wf.z = pk_bf16(kf[4], kf[5]); wf.w = pk_bf16(kf[6], kf[7]);
            u32x4 wb; wb.x = pk_bf16(kb[0], kb[1]); wb.y = pk_bf16(kb[2], kb[3]); wb.z = pk_bf16(kb[4], kb[5]); wb.w = pk_bf16(kb[6], kb[7]);
            *(u32x4*)(KTF + go) = wf; *(u32x4*)(KTB + go) = wb;
            *(LAS u32x4*)(KTs + (0 * 64 + i) * 136 + ch0) = wf; *(LAS u32x4*)(KTs + (1 * 64 + i) * 136 + ch0) = wb;
            if (i == 63) { float* ep = EE + ((size_t)(0 * 8 + b) * 68 + slot) * 512 + h * 128 + ch0; *(f32x4*)ep = (f32x4){ef[0], ef[1], ef[2], ef[3]}; *(f32x4*)(ep + 4) = (f32x4){ef[4], ef[5], ef[6], ef[7]}; }
            if (i == 0)  { float* ep = EE + ((size_t)(1 * 8 + b) * 68 + slot) * 512 + h * 128 + ch0; *(f32x4*)ep = (f32x4){eb[0], eb[1], eb[2], eb[3]}; *(f32x4*)(ep + 4) = (f32x4){eb[4], eb[5], eb[6], eb[7]}; }
        }
        __syncthreads();
#pragma unroll
        for (int rep = 0; rep < 4; ++rep) {
            const int q = tid + 512 * rep, ch = q & 127, t8 = (q >> 7) & 7, dir = q >> 10;
            const LAS bf16_t* sp = KTs + (dir * 64 + t8 * 8) * 136 + ch;
            u32x4 wv; wv.x = (unsigned)sp[0] | ((unsigned)sp[136] << 16); wv.y = (unsigned)sp[2 * 136] | ((unsigned)sp[3 * 136] << 16); wv.z = (unsigned)sp[4 * 136] | ((unsigned)sp[5 * 136] << 16); wv.w = (unsigned)sp[6 * 136] | ((unsigned)sp[7 * 136] << 16);
            *(u32x4*)((bf16_t*)(ws + (dir ? WS_KTTB : WS_KTTF)) + (size_t)(h * 128 + ch) * NROW + rowbase + t8 * 8) = wv;
        }
        __syncthreads();
    }
}

DEVI int gla_slot(int dir, int n) { return dir == 0 ? n : (n < 4 ? 3 - n : 71 - n); }
DEVI int gla_rowbase(int b, int slot) { return slot >= 4 ? b * 4096 + (slot - 4) * 64 : NTOK + b * 256 + slot * 64; }
DEVI void phase4_gla(const Params& p, LAS unsigned char* lds) {
    const int tid = threadIdx.x, lane = tid & 63, w = tid >> 6, l15 = lane & 15, fq = lane >> 4;
    unsigned char* ws = p.ws;
    LAS unsigned char* TQ = lds;
    LAS unsigned char* TK = lds + 32768;
    LAS unsigned char* TV = lds + 65536;
    LAS bf16_t* PM = (LAS bf16_t*)(lds + 81920);
    LAS bf16_t* SB = (LAS bf16_t*)(lds + 81920 + 9216);
    const bf16_t* VBT = (const bf16_t*)(ws + WS_VBT);
    const float* EE = (const float*)(ws + WS_EE);
    const int qr0 = tid >> 4, qp = tid & 15, vr = tid >> 3, vp = tid & 7;
    const int qoff0 = qr0 * 256 + ((qp ^ (qr0 & 15)) << 4), qoff1 = (qr0 + 32) * 256 + ((qp ^ ((qr0 + 32) & 15)) << 4);
    const int voff = vr * 128 + ((vp ^ ((vr >> 1) & 7)) << 4);
    struct PSet { u32x4 q0, q1, k0, k1, v; };
    struct KSet { bf16x8 a, b; f32x4 e; };
    for (int u = blockIdx.x; u < 256; u += gridDim.x) {
        const int xg = u & 7, kg = u >> 3, g = xg * 8 + (kg >> 2), dvq = kg & 3, dir = g & 1, h = (g >> 1) & 3, b = g >> 3;
        const bf16_t* QT = (const bf16_t*)(ws + (dir ? WS_QTB : WS_QTF)); const bf16_t* KT = (const bf16_t*)(ws + (dir ? WS_KTB : WS_KTF)); const bf16_t* KTT = (const bf16_t*)(ws + (dir ? WS_KTTB : WS_KTTF));
        bf16_t* OUT = (bf16_t*)(ws + (dir ? WS_OB : WS_OF));
        const int vrow0 = h * 256 + dvq * 64, krow0 = h * 128, kcol0 = h * 128;
        const float* EEu = EE + (size_t)(dir * 8 + b) * 68 * 512 + h * 128 + 16 * w + 4 * fq;
        const bf16_t* vsrc = VBT + (size_t)(vrow0 + vr) * NROW + vp * 8;
        const bf16_t* ktsrc = KTT + (size_t)(krow0 + 16 * w + l15) * NROW + 8 * fq;
        const size_t qsrc = (size_t)qr0 * 512 + kcol0 + qp * 8;
        f32x4 S[4];
#pragma unroll
        for (int i = 0; i < 4; ++i) S[i] = (f32x4){0.f, 0.f, 0.f, 0.f};
        PSet P0, P1; KSet K0, K1;
        P0.q0 = P0.q1 = P0.k0 = P0.k1 = P0.v = (u32x4){0u, 0u, 0u, 0u}; P1 = P0;
        auto load_p = [&](PSet& P, int n) {
            const int slot = gla_slot(dir, n), rb = gla_rowbase(b, slot);
            P.v = *(const u32x4*)(vsrc + rb);
            if (slot >= 4) { P.q0 = *(const u32x4*)(QT + (size_t)rb * 512 + qsrc); P.q1 = *(const u32x4*)(QT + (size_t)(rb + 32) * 512 + qsrc);
                             P.k0 = *(const u32x4*)(KT + (size_t)rb * 512 + qsrc); P.k1 = *(const u32x4*)(KT + (size_t)(rb + 32) * 512 + qsrc); }
        };
        auto store_p = [&](const PSet& P, int n) {
            const int slot = gla_slot(dir, n), bufo = n & 1;
            *(LAS u32x4*)(TV + bufo * 8192 + voff) = P.v;
            if (slot >= 4) { *(LAS u32x4*)(TQ + bufo * 16384 + qoff0) = P.q0; *(LAS u32x4*)(TQ + bufo * 16384 + qoff1) = P.q1; *(LAS u32x4*)(TK + bufo * 16384 + qoff0) = P.k0; *(LAS u32x4*)(TK + bufo * 16384 + qoff1) = P.k1; }
        };
        auto load_k = [&](KSet& K, int n) {
            const int slot = gla_slot(dir, n), rb = gla_rowbase(b, slot);
            K.a = *(const bf16x8*)(ktsrc + rb); K.b = *(const bf16x8*)(ktsrc + rb + 32); K.e = *(const f32x4*)(EEu + (size_t)slot * 512);
        };
        load_p(P0, 0); load_k(K0, 0); load_k(K1, 1); load_p(P1, 1);
        __syncthreads();
        store_p(P0, 0);
        auto step = [&](int n, PSet& Pload, const PSet& Pstore, KSet& K) {
            const int slot = gla_slot(dir, n); const bool lat = slot >= 4; const int rowbase = gla_rowbase(b, slot);
            const int cur = n & 1, nxt = cur ^ 1;
            LAS unsigned char* tq = TQ + cur * 16384; LAS unsigned char* tk = TK + cur * 16384; LAS unsigned char* tv = TV + cur * 8192;
            LAS bf16_t* sbc = SB + cur * 64 * 136; LAS bf16_t* sbn = SB + nxt * 64 * 136;
            lds_barrier();
            if (n + 2 < 68) load_p(Pload, n + 2);
            if (lat) {
                const int jt = w >> 1, it0 = 2 * (w & 1);
                f32x4 c0 = {0.f, 0.f, 0.f, 0.f}, c1 = {0.f, 0.f, 0.f, 0.f};
                const int rj = 16 * jt + l15, ri0 = 16 * it0 + l15, ri1 = ri0 + 16;
                bf16x8 fa[4], fb0[4], fb1[4];
#pragma unroll
                for (int ks = 0; ks < 4; ++ks) { const int pc = 4 * ks + fq;
                    fa[ks] = *(const LAS bf16x8*)(tk + rj * 256 + ((pc ^ l15) << 4)); fb0[ks] = *(const LAS bf16x8*)(tq + ri0 * 256 + ((pc ^ l15) << 4)); fb1[ks] = *(const LAS bf16x8*)(tq + ri1 * 256 + ((pc ^ l15) << 4)); }
                __builtin_amdgcn_sched_barrier(0);
#pragma unroll
                for (int ks = 0; ks < 4; ++ks) { c0 = __builtin_amdgcn_mfma_f32_16x16x32_bf16(fa[ks], fb0[ks], c0, 0, 0, 0); c1 = __builtin_amdgcn_mfma_f32_16x16x32_bf16(fa[ks], fb1[ks], c1, 0, 0, 0); }
#pragma unroll
                for (int r = 0; r < 4; ++r) { const int j = 16 * jt + 4 * fq + r;
                    const bool k0 = dir == 0 ? (j <= ri0) : (j >= ri0), k1 = dir == 0 ? (j <= ri1) : (j >= ri1);
                    c0[r] = k0 ? c0[r] : 0.f; c1[r] = k1 ? c1[r] : 0.f; }
                u32x2 w0; w0.x = pk_bf16(c0[0], c0[1]); w0.y = pk_bf16(c0[2], c0[3]); u32x2 w1; w1.x = pk_bf16(c1[0], c1[1]); w1.y = pk_bf16(c1[2], c1[3]);
                *(LAS u32x2*)(PM + ri0 * 72 + 16 * jt + 4 * fq) = w0; *(LAS u32x2*)(PM + ri1 * 72 + 16 * jt + 4 * fq) = w1;
            }
            lds_barrier();
            bf16x8 V[4][2];
#pragma unroll
            for (int dvt = 0; dvt < 4; ++dvt)
#pragma unroll
                for (int ks = 0; ks < 2; ++ks) { const int row = 16 * dvt + l15, pc = 4 * ks + fq; V[dvt][ks] = *(const LAS bf16x8*)(tv + row * 128 + ((pc ^ ((row >> 1) & 7)) << 4)); }
            __builtin_amdgcn_sched_barrier(0);
            if (lat) {
                const int it = w >> 1, dv0 = 2 * (w & 1), ri = 16 * it + l15;
                f32x4 o0 = {0.f, 0.f, 0.f, 0.f}, o1 = {0.f, 0.f, 0.f, 0.f};
                bf16x8 pB[2], pA0[2], pA1[2], sA0[4], sA1[4], sB[4];
                const LAS bf16_t* s0 = sbc + (16 * dv0 + l15) * 136 + 8 * fq; const LAS bf16_t* s1 = s0 + 16 * 136;
#pragma unroll
                for (int ks = 0; ks < 2; ++ks) { pB[ks] = *(const LAS bf16x8*)(PM + ri * 72 + 32 * ks + 8 * fq);
                    const int r0 = 16 * dv0 + l15, r1 = r0 + 16, pc = 4 * ks + fq;
                    pA0[ks] = *(const LAS bf16x8*)(tv + r0 * 128 + ((pc ^ ((r0 >> 1) & 7)) << 4)); pA1[ks] = *(const LAS bf16x8*)(tv + r1 * 128 + ((pc ^ ((r1 >> 1) & 7)) << 4)); }
#pragma unroll
                for (int ks = 0; ks < 4; ++ks) { const int pc = 4 * ks + fq;
                    sA0[ks] = *(const LAS bf16x8*)(s0 + 32 * ks); sA1[ks] = *(const LAS bf16x8*)(s1 + 32 * ks); sB[ks] = *(const LAS bf16x8*)(tq + ri * 256 + ((pc ^ l15) << 4)); }
                __builtin_amdgcn_sched_barrier(0);
#pragma unroll
                for (int ks = 0; ks < 2; ++ks) { o0 = __builtin_amdgcn_mfma_f32_16x16x32_bf16(pA0[ks], pB[ks], o0, 0, 0, 0); o1 = __builtin_amdgcn_mfma_f32_16x16x32_bf16(pA1[ks], pB[ks], o1, 0, 0, 0); }
#pragma unroll
                for (int ks = 0; ks < 4; ++ks) { o0 = __builtin_amdgcn_mfma_f32_16x16x32_bf16(sA0[ks], sB[ks], o0, 0, 0, 0); o1 = __builtin_amdgcn_mfma_f32_16x16x32_bf16(sA1[ks], sB[ks], o1, 0, 0, 0); }
                bf16_t* op = OUT + (size_t)(rowbase + ri) * 1024 + vrow0 + 16 * dv0 + 4 * fq;
                u32x2 w0; w0.x = pk_bf16(o0[0], o0[1]); w0.y = pk_bf16(o0[2], o0[3]); u32x2 w1; w1.x = pk_bf16(o1[0], o1[1]); w1.y = pk_bf16(o1[2], o1[3]);
                *(u32x2*)op = w0; *(u32x2*)(op + 16) = w1;
            }
#pragma unroll
            for (int dvt = 0; dvt < 4; ++dvt) { S[dvt] = __builtin_amdgcn_mfma_f32_16x16x32_bf16(K.a, V[dvt][0], S[dvt], 0, 0, 0); S[dvt] = __builtin_amdgcn_mfma_f32_16x16x32_bf16(K.b, V[dvt][1], S[dvt], 0, 0, 0); }
#pragma unroll
            for (int dvt = 0; dvt < 4; ++dvt) { S[dvt] = S[dvt] * K.e;
                u32x2 o; o.x = pk_bf16(S[dvt][0], S[dvt][1]); o.y = pk_bf16(S[dvt][2], S[dvt][3]);
                *(LAS u32x2*)(sbn + (16 * dvt + l15) * 136 + 16 * w + 4 * fq) = o; }
            if (n + 2 < 68) load_k(K, n + 2);
            if (n + 1 < 68) store_p(Pstore, n + 1);
        };
#pragma unroll 1
        for (int n = 0; n < 68; n += 2) { step(n, P0, P1, K0); step(n + 1, P1, P0, K1); }
        __syncthreads();
    }
}

DEVI void phase4_na(const Params& p, LAS unsigned char* lds) {
    const int tid = threadIdx.x; const int wsg = __builtin_amdgcn_readfirstlane(tid >> 6);
    unsigned char* ws = p.ws;
    LAS unsigned char* CK = lds;
    LAS unsigned char* CV = lds + 32768;
    LAS float* RP = (LAS float*)(lds + 65536);
    const bf16_t* QA = (const bf16_t*)(ws + WS_QA); const bf16_t* KA = (const bf16_t*)(ws + WS_KA); const bf16_t* VAT = (const bf16_t*)(ws + WS_VAT);
    bf16_t* OA = (bf16_t*)(ws + WS_AP);
    for (int u = blockIdx.x; u < 512; u += gridDim.x) {
        const int xg = u & 7, idx = u >> 3, bh = xg * 8 + (idx >> 3), rblk = idx & 7, h = bh & 7, b = bh >> 3;
        __syncthreads();
        for (int i = tid; i < 465; i += 512) RP[(i / 31) * 80 + 24 + (i % 31)] = p.in[7][h * 465 + i];
        int tz = tid; asm volatile("" : "+v"(tz));
#pragma unroll
        for (int rep = 0; rep < 4; ++rep) {
            const int q = tz + 512 * rep;
            { const int row = q >> 3, pc = q & 7; *(LAS u32x4*)(CK + row * 128 + ((pc ^ ((row >> 1) & 7)) << 4)) = *(const u32x4*)(KA + (size_t)(NTOK + b * 256 + row) * 512 + h * 64 + pc * 8); }
            { const int row = q >> 5, pc = q & 31; const u32x4 v = *(const u32x4*)(VAT + (size_t)(h * 64 + row) * NROW + NTOK + b * 256 + pc * 8);
              const int sw = (row & 15) << 1; u32x2 lo; lo.x = v.x; lo.y = v.y; u32x2 hi; hi.x = v.z; hi.y = v.w;
              *(LAS u32x2*)(CV + row * 512 + (((2 * pc) ^ sw) << 3)) = lo; *(LAS u32x2*)(CV + row * 512 + (((2 * pc + 1) ^ sw) << 3)) = hi; }
        }
        __syncthreads();
#pragma unroll 1
        for (int qt = 0; qt < 4; ++qt) {
            int lane = (int)__builtin_amdgcn_mbcnt_hi(~0u, __builtin_amdgcn_mbcnt_lo(~0u, 0u)); asm volatile("" : "+v"(lane));
            const int w = wsg, l15 = lane & 15, fq = lane >> 4, r = rblk * 8 + w, rs = min(max(r - 4, 0), 56);
            const int kc0 = min(max(16 * qt - 8, 0), 32);
            const int c = 16 * qt + l15, cs = min(max(c - 8, 0), 48);
            const bf16_t* qp = QA + (size_t)(b * 4096 + r * 64 + c) * 512 + h * 64 + 8 * fq;
            const bf16x8 Bq0 = *(const bf16x8*)qp, Bq1 = *(const bf16x8*)(qp + 32);
            const int lo = 15 + cs - c, d00 = kc0 - 16 * qt + 4 * fq - l15 + 15;
            const LAS unsigned char* rpl = (const LAS unsigned char*)RP + ((rs - r + 7) * 80 + 24 + d00) * 4;
            const char* kbase = (const char*)(KA + (size_t)(b * 4096 + rs * 64 + kc0) * 512 + h * 64); const unsigned klane = (unsigned)(l15 * 512 + 8 * fq) * 2u;
            const char* vbase = (const char*)(VAT + (size_t)(h * 64) * NROW + b * 4096 + rs * 64 + kc0); const unsigned vlane = (unsigned)(l15 * NROW + 4 * fq) * 2u;
#define NA_SB __builtin_amdgcn_sched_barrier(0)
            f32x4 sc[16];
#pragma unroll
            for (int hb = 0; hb < 4; ++hb) {
                bf16x8 kf[4][2];
#pragma unroll
                for (int tt = 0; tt < 4; ++tt) { const int t = 4 * hb + tt, kr = t >> 1, chh = t & 1; const char* kp = (kbase + (size_t)((kr * 64 + 16 * chh) * 1024)) + klane;
                    kf[tt][0] = *(const bf16x8*)kp; kf[tt][1] = *(const bf16x8*)(kp + 64); }
                NA_SB;
#pragma unroll
                for (int tt = 0; tt < 4; ++tt) { const int t = 4 * hb + tt, kr = t >> 1, chh = t & 1;
                    f32x4 a = {0.f, 0.f, 0.f, 0.f};
                    a = __builtin_amdgcn_mfma_f32_16x16x32_bf16(kf[tt][0], Bq0, a, 0, 0, 0); a = __builtin_amdgcn_mfma_f32_16x16x32_bf16(kf[tt][1], Bq1, a, 0, 0, 0);
#pragma unroll
                    for (int j = 0; j < 4; ++j) { const float bias = *(const LAS float*)(rpl + chh * 64 + kr * 320 + j * 4); a[j] = ((unsigned)(d00 + 16 * chh + j - lo) <= 15u) ? a[j] + bias : -INFINITY; }
                    sc[t] = a; }
                NA_SB;
            }
            u32x2 va0[2][4], va1[2][4];
            auto ld_vloc = [&](int uu0) {
#pragma unroll
                for (int q = 0; q < 2; ++q)
#pragma unroll
                    for (int mt = 0; mt < 4; ++mt) { const char* vp = (vbase + (size_t)((16 * mt * NROW + (uu0 + q) * 64) * 2)) + vlane; va0[q][mt] = *(const u32x2*)vp; va1[q][mt] = *(const u32x2*)(vp + 32); } };
            ld_vloc(0);
            NA_SB;
            float mA = -INFINITY;
#pragma unroll
            for (int t = 0; t < 16; ++t) mA = fmaxf(mA, fmaxf(fmaxf(sc[t][0], sc[t][1]), fmaxf(sc[t][2], sc[t][3])));
            mA = fmaxf(mA, __shfl_xor(mA, 16)); mA = fmaxf(mA, __shfl_xor(mA, 32));
            float lA = 0.f; u32x2 pp[16];
#pragma unroll
            for (int t = 0; t < 16; ++t) { const float e0 = __expf(sc[t][0] - mA), e1 = __expf(sc[t][1] - mA), e2 = __expf(sc[t][2] - mA), e3 = __expf(sc[t][3] - mA);
                lA += (e0 + e1) + (e2 + e3); pp[t].x = pk_bf16(e0, e1); pp[t].y = pk_bf16(e2, e3); }
            NA_SB;
            f32x4 o[4];
#pragma unroll
            for (int mt = 0; mt < 4; ++mt) o[mt] = (f32x4){0.f, 0.f, 0.f, 0.f};
            auto mm_vloc = [&](int uu0) {
#pragma unroll
                for (int q = 0; q < 2; ++q) { const int t0 = 2 * (uu0 + q), t1 = t0 + 1;
                    union { u32x4 w; bf16x8 v; } P; P.w.x = pp[t0].x; P.w.y = pp[t0].y; P.w.z = pp[t1].x; P.w.w = pp[t1].y;
#pragma unroll
                    for (int mt = 0; mt < 4; ++mt) { union { u32x4 w; bf16x8 v; } A; A.w.x = va0[q][mt].x; A.w.y = va0[q][mt].y; A.w.z = va1[q][mt].x; A.w.w = va1[q][mt].y; o[mt] = __builtin_amdgcn_mfma_f32_16x16x32_bf16(A.v, P.v, o[mt], 0, 0, 0); } } };
            mm_vloc(0); NA_SB; ld_vloc(2); NA_SB; mm_vloc(2); NA_SB; ld_vloc(4); NA_SB; mm_vloc(4); NA_SB; ld_vloc(6); NA_SB; mm_vloc(6); NA_SB;
            int lane2 = (int)__builtin_amdgcn_mbcnt_hi(~0u, __builtin_amdgcn_mbcnt_lo(~0u, 0u)); asm volatile("" : "+v"(lane2));
            const int l15b = lane2 & 15, fqb = lane2 >> 4, cks = (l15b >> 1) & 7, ck0 = l15b * 128 + ((fqb ^ cks) << 4), ck1 = l15b * 128 + (((4 + fqb) ^ cks) << 4);
            {
                bf16x8 kfA[2][2];
                auto ld_ctx = [&](bf16x8 (&kf)[2][2], auto G) {
#pragma unroll
                    for (int tt = 0; tt < 2; ++tt) { constexpr int tile = 0; const int to = (2 * decltype(G)::v + tt) * 2048 + tile;
                        kf[tt][0] = *(const LAS bf16x8*)(CK + to + ck0); kf[tt][1] = *(const LAS bf16x8*)(CK + to + ck1); } };
                auto mm_ctx = [&](const bf16x8 (&kf)[2][2], auto G) {
#pragma unroll
                    for (int tt = 0; tt < 2; ++tt) { f32x4 a = {0.f, 0.f, 0.f, 0.f};
                        a = __builtin_amdgcn_mfma_f32_16x16x32_bf16(kf[tt][0], Bq0, a, 0, 0, 0); a = __builtin_amdgcn_mfma_f32_16x16x32_bf16(kf[tt][1], Bq1, a, 0, 0, 0);
                        sc[2 * decltype(G)::v + tt] = a; } };
#define NA_CC(G0) ld_ctx(kfA, IC<G0>{}); NA_SB; mm_ctx(kfA, IC<G0>{}); NA_SB;
                NA_CC(0) NA_CC(1) NA_CC(2) NA_CC(3) NA_CC(4) NA_CC(5) NA_CC(6) NA_CC(7)
#undef NA_CC
            }
            float mB = -INFINITY;
#pragma unroll
            for (int t = 0; t < 16; ++t) mB = fmaxf(mB, fmaxf(fmaxf(sc[t][0], sc[t][1]), fmaxf(sc[t][2], sc[t][3])));
            mB = fmaxf(mB, __shfl_xor(mB, 16)); mB = fmaxf(mB, __shfl_xor(mB, 32));
            const float mx = fmaxf(mA, mB), fA = __expf(mA - mx);
            float lB = 0.f;
#pragma unroll
            for (int t = 0; t < 16; ++t) { const float e0 = __expf(sc[t][0] - mx), e1 = __expf(sc[t][1] - mx), e2 = __expf(sc[t][2] - mx), e3 = __expf(sc[t][3] - mx);
                lB += (e0 + e1) + (e2 + e3); pp[t].x = pk_bf16(e0, e1); pp[t].y = pk_bf16(e2, e3); }
            float sum = lA * fA + lB;
            sum += __shfl_xor(sum, 16); sum += __shfl_xor(sum, 32);
            const float inv = 1.0f / sum;
#pragma unroll
            for (int mt = 0; mt < 4; ++mt) o[mt] = o[mt] * fA;
            NA_SB;
            int cvo[4][2];
#pragma unroll
            for (int rr = 0; rr < 4; ++rr)
#pragma unroll
                for (int dd = 0; dd < 2; ++dd) cvo[rr][dd] = l15b * 512 + ((((8 * rr + fqb + 4 * dd) ^ (l15b << 1)) & 31) << 3);
            {
                u32x4 vfA[4], vfB[4];
                auto ld_v = [&](u32x4 (&vq)[4], auto U) {
                    constexpr int uu = decltype(U)::v, q4 = uu >> 2, rr = uu & 3;
#pragma unroll
                    for (int mt = 0; mt < 4; ++mt) { const u32x2 a0 = *(const LAS u32x2*)(CV + mt * 8192 + q4 * 256 + cvo[rr][0]), a1 = *(const LAS u32x2*)(CV + mt * 8192 + q4 * 256 + cvo[rr][1]); vq[mt] = (u32x4){a0.x, a0.y, a1.x, a1.y}; } };
                auto mm_v = [&](const u32x4 (&vq)[4], auto U) {
                    constexpr int uu = decltype(U)::v, t0 = 2 * uu, t1 = 2 * uu + 1;
                    union { u32x4 w; bf16x8 v; } P; P.w.x = pp[t0].x; P.w.y = pp[t0].y; P.w.z = pp[t1].x; P.w.w = pp[t1].y;
#pragma unroll
                    for (int mt = 0; mt < 4; ++mt) { union { u32x4 w; bf16x8 v; } A; A.w = vq[mt]; o[mt] = __builtin_amdgcn_mfma_f32_16x16x32_bf16(A.v, P.v, o[mt], 0, 0, 0); } };
#define NA_PV(U0, U1, U2, U3) mm_v(vfA, IC<U0>{}); NA_SB; ld_v(vfA, IC<U2>{}); NA_SB; mm_v(vfB, IC<U1>{}); NA_SB; ld_v(vfB, IC<U3>{}); NA_SB;
                ld_v(vfA, IC<0>{}); ld_v(vfB, IC<1>{}); NA_SB;
                NA_PV(0, 1, 2, 3) NA_PV(2, 3, 4, 5) NA_PV(4, 5, 6, 7)
                mm_v(vfA, IC<6>{}); NA_SB; mm_v(vfB, IC<7>{}); NA_SB;
#undef NA_PV
            }
#undef NA_SB
            bf16_t* op = OA + (size_t)(b * 4096 + r * 64 + c) * 1536 + h * 64 + 4 * fq;
#pragma unroll
            for (int mt = 0; mt < 4; ++mt) { u32x2 wv; wv.x = pk_bf16(o[mt][0] * inv, o[mt][1] * inv); wv.y = pk_bf16(o[mt][2] * inv, o[mt][3] * inv); *(u32x2*)(op + 16 * mt) = wv; }
        }
    }
}

DEVI void phase5(const Params& p) {
    const int lane = threadIdx.x & 63, gw = blockIdx.x * 8 + (threadIdx.x >> 6), nw = gridDim.x * 8;
    const bf16_t* OF = (const bf16_t*)(p.ws + WS_OF); const bf16_t* OB = (const bf16_t*)(p.ws + WS_OB); const bf16_t* GB = (const bf16_t*)(p.ws + WS_GB); bf16_t* AP = (bf16_t*)(p.ws + WS_AP);
    for (int tok = gw; tok < NTOK; tok += nw) {
#pragma unroll
        for (int hh = 0; hh < 2; ++hh) {
            const int col = hh * 512 + lane * 8;
            const size_t o = (size_t)tok * 1024 + col;
            const u32x4 a = *(const u32x4*)(OF + o), bb = *(const u32x4*)(OB + o), g = *(const u32x4*)(GB + o);
            float v[8] = {bflo(a.x) + bflo(bb.x), bfhi(a.x) + bfhi(bb.x), bflo(a.y) + bflo(bb.y), bfhi(a.y) + bfhi(bb.y), bflo(a.z) + bflo(bb.z), bfhi(a.z) + bfhi(bb.z), bflo(a.w) + bflo(bb.w), bfhi(a.w) + bfhi(bb.w)};
            float ss = 0.f;
#pragma unroll
            for (int e = 0; e < 8; ++e) ss += v[e] * v[e];
            ss += __shfl_xor(ss, 16); ss += __shfl_xor(ss, 8); ss += __shfl_xor(ss, 4); ss += __shfl_xor(ss, 2); ss += __shfl_xor(ss, 1);
            const float rs = rsqrtf(ss * (1.0f / 256.0f) + 1e-6f);
            const f32x4 n0 = *(const f32x4*)(p.in[12] + col), n1 = *(const f32x4*)(p.in[12] + col + 4);
            const float gg[8] = {bflo(g.x), bfhi(g.x), bflo(g.y), bfhi(g.y), bflo(g.z), bfhi(g.z), bflo(g.w), bfhi(g.w)};
            float r[8];
#pragma unroll
            for (int e = 0; e < 8; ++e) r[e] = v[e] * rs * (e < 4 ? n0[e & 3] : n1[e & 3]) * (gg[e] * sigmoidf_(gg[e]));
            u32x4 wv; wv.x = pk_bf16(r[0], r[1]); wv.y = pk_bf16(r[2], r[3]); wv.z = pk_bf16(r[4], r[5]); wv.w = pk_bf16(r[6], r[7]);
            *(u32x4*)(AP + (size_t)tok * 1536 + 512 + col) = wv;
        }
    }
}

DEVI void ln_row(f32x4 (&v)[4], const float* g, const float* bta, int lane) {
    float s = 0.f;
#pragma unroll
    for (int j = 0; j < 4; ++j) s += (v[j][0] + v[j][1]) + (v[j][2] + v[j][3]);
    const float mu = wave_sum(s) * (1.0f / 1024.0f);
    float q = 0.f;
#pragma unroll
    for (int j = 0; j < 4; ++j) { v[j] = v[j] - mu; q += (v[j][0] * v[j][0] + v[j][1] * v[j][1]) + (v[j][2] * v[j][2] + v[j][3] * v[j][3]); }
    const float rstd = rsqrtf(wave_sum(q) * (1.0f / 1024.0f) + 1e-6f);
#pragma unroll
    for (int j = 0; j < 4; ++j) { const f32x4 gg = *(const f32x4*)(g + lane * 4 + 256 * j), bb = *(const f32x4*)(bta + lane * 4 + 256 * j); v[j] = v[j] * rstd * gg + bb; }
}
DEVI void phase9(const Params& p) {
    const int lane = threadIdx.x & 63, gw = blockIdx.x * 8 + (threadIdx.x >> 6), nw = gridDim.x * 8;
    const float* mod = (const float*)(p.ws + WS_MOD); const bf16_t* Z = (const bf16_t*)(p.ws + WS_Z); bf16_t* X1 = (bf16_t*)(p.ws + WS_X1); bf16_t* H2 = (bf16_t*)(p.ws + WS_H2);
    for (int tok = gw; tok < NTOK; tok += nw) {
        const float* m = mod + (size_t)(tok >> 12) * 6144; float v[2][8];
#pragma unroll
        for (int j = 0; j < 2; ++j) { const int cidx = lane * 8 + 512 * j;
            const f32x4 x0 = *(const f32x4*)(p.in[0] + (size_t)tok * 1024 + cidx), x1 = *(const f32x4*)(p.in[0] + (size_t)tok * 1024 + cidx + 4), g0 = *(const f32x4*)(m + 2048 + cidx), g1 = *(const f32x4*)(m + 2048 + cidx + 4);
            const u32x4 z = *(const u32x4*)(Z + (size_t)tok * 1024 + cidx);
            float zf[8] = {bflo(z.x), bfhi(z.x), bflo(z.y), bfhi(z.y), bflo(z.z), bfhi(z.z), bflo(z.w), bfhi(z.w)};
#if defined(DBG_NOMIX)
#pragma unroll
            for (int e = 0; e < 8; ++e) zf[e] = 0.f;
#endif
#pragma unroll
            for (int e = 0; e < 4; ++e) { v[j][e] = x0[e] * 1.189207115f + g0[e] * zf[e]; v[j][4 + e] = x1[e] * 1.189207115f + g1[e] * zf[4 + e]; }
        }
        float sm = 0.f;
#pragma unroll
        for (int j = 0; j < 2; ++j)
#pragma unroll
            for (int e = 0; e < 8; ++e) sm += v[j][e];
        const float mu = wave_sum(sm) * (1.0f / 1024.0f); float q = 0.f;
#pragma unroll
        for (int j = 0; j < 2; ++j)
#pragma unroll
            for (int e = 0; e < 8; ++e) { v[j][e] -= mu; q += v[j][e] * v[j][e]; }
        const float rstd = rsqrtf(wave_sum(q) * (1.0f / 1024.0f) + 1e-6f);
#pragma unroll
        for (int j = 0; j < 2; ++j) { const int cidx = lane * 8 + 512 * j;
            const f32x4 g0 = *(const f32x4*)(p.in[16] + cidx), g1 = *(const f32x4*)(p.in[16] + cidx + 4), b0 = *(const f32x4*)(p.in[17] + cidx), b1 = *(const f32x4*)(p.in[17] + cidx + 4);
            const f32x4 sh0 = *(const f32x4*)(m + 3072 + cidx), sh1 = *(const f32x4*)(m + 3072 + cidx + 4), sc0 = *(const f32x4*)(m + 4096 + cidx), sc1 = *(const f32x4*)(m + 4096 + cidx + 4);
            f32x4 o0, o1; float hv[8];
#pragma unroll
            for (int e = 0; e < 4; ++e) { o0[e] = v[j][e] * rstd * g0[e] + b0[e]; o1[e] = v[j][4 + e] * rstd * g1[e] + b1[e]; hv[e] = o0[e] * (sc0[e] + 1.0f) + sh0[e]; hv[4 + e] = o1[e] * (sc1[e] + 1.0f) + sh1[e]; }
            { u32x4 xv; xv.x = pk_bf16(o0[0], o0[1]); xv.y = pk_bf16(o0[2], o0[3]); xv.z = pk_bf16(o1[0], o1[1]); xv.w = pk_bf16(o1[2], o1[3]); *(u32x4*)(X1 + (size_t)tok * 1024 + cidx) = xv; }
            u32x4 wv; wv.x = pk_bf16(hv[0], hv[1]); wv.y = pk_bf16(hv[2], hv[3]); wv.z = pk_bf16(hv[4], hv[5]); wv.w = pk_bf16(hv[6], hv[7]);
            *(u32x4*)(H2 + (size_t)tok * 1024 + cidx) = wv; }
    }
}
DEVI void phase11(const Params& p, LAS unsigned char* lds) {
    const int lane = threadIdx.x & 63, gw = blockIdx.x * 8 + (threadIdx.x >> 6), nw = gridDim.x * 8, half = lane >> 5;
    LAS unsigned* LC = (LAS unsigned*)(lds + LDS_TAB); LAS unsigned* LB = LC + 256;
    if (threadIdx.x < 256) LC[threadIdx.x] = 0u;
    __syncthreads();
    const float* L0 = (const float*)(p.ws + WS_LOG0); const float* L1 = (const float*)(p.ws + WS_LOG1);
    int* TID = (int*)(p.ws + WS_TOPK_ID); float* TW = (float*)(p.ws + WS_TOPK_W); int* TP = (int*)(p.ws + WS_TOPK_POS); unsigned* CNT = (unsigned*)(p.ws + WS_CNT);
    float rb[4];
#pragma unroll
    for (int j = 0; j < 4; ++j) rb[j] = p.in[19][lane + 64 * j];
    for (int tok = gw; tok < NTOK; tok += nw) {
        float s[4], bz[4], gs[4];
#pragma unroll
        for (int j = 0; j < 4; ++j) { const float lg = L0[(size_t)tok * 256 + lane + 64 * j] + L1[(size_t)tok * 256 + lane + 64 * j]; s[j] = __builtin_amdgcn_rcpf(1.0f + __expf(-lg)); bz[j] = s[j] + rb[j]; }
#pragma unroll
        for (int j = 0; j < 4; ++j) { float m1 = bz[j], m2 = -INFINITY;
#define TOP2_STEP(P1, P2) { const float p1 = (P1), p2 = (P2); const float n1 = fmaxf(m1, p1), n2 = fmaxf(fminf(m1, p1), fmaxf(m2, p2)); m1 = n1; m2 = n2; }
            TOP2_STEP(dppf<DPP_X1>(m1), dppf<DPP_X1>(m2)) TOP2_STEP(dppf<DPP_X2>(m1), dppf<DPP_X2>(m2)) TOP2_STEP(dppf<DPP_HM>(m1), dppf<DPP_HM>(m2)) TOP2_STEP(dppf<DPP_RM>(m1), dppf<DPP_RM>(m2)) TOP2_STEP(x16f(m1, lane), x16f(m2, lane))
#undef TOP2_STEP
            gs[j] = m1 + m2; }
        float Gv[8];
#pragma unroll
        for (int j = 0; j < 4; ++j) { const float oth = x32f(gs[j], lane); Gv[2 * j] = half ? oth : gs[j]; Gv[2 * j + 1] = half ? gs[j] : oth; }
        bool keep[8];
#pragma unroll
        for (int g = 0; g < 8; ++g) { int rank = 0;
#pragma unroll
            for (int g2 = 0; g2 < 8; ++g2) rank += (Gv[g2] > Gv[g] || (Gv[g2] == Gv[g] && g2 < g)) ? 1 : 0;
            keep[g] = rank < 4; }
        unsigned key[4];
#pragma unroll
        for (int j = 0; j < 4; ++j) { const bool k = half ? keep[2 * j + 1] : keep[2 * j]; key[j] = k ? ((__float_as_uint(bz[j] + 1.0f) & 0xFFFFFF00u) | (unsigned)(255 - (lane + 64 * j))) : 0u; }
        int myE = 0;
#pragma unroll
        for (int it = 0; it < 8; ++it) {
            unsigned k = max(max(key[0], key[1]), max(key[2], key[3]));
            k = max(k, (unsigned)dppi<DPP_X1>((int)k)); k = max(k, (unsigned)dppi<DPP_X2>((int)k)); k = max(k, (unsigned)dppi<DPP_HM>((int)k)); k = max(k, (unsigned)dppi<DPP_RM>((int)k));
            k = max(k, (unsigned)x16i((int)k, lane)); k = max(k, (unsigned)x32i((int)k, lane));
#pragma unroll
            for (int j = 0; j < 4; ++j) key[j] = key[j] == k ? 0u : key[j];
            if (lane == it) myE = 255 - (int)(k & 255u);
        }
        float sv;
        { const int src = (myE & 63) << 2, jsel = myE >> 6;
          const float a0 = __builtin_bit_cast(float, __builtin_amdgcn_ds_bpermute(src, __builtin_bit_cast(int, s[0]))), a1 = __builtin_bit_cast(float, __builtin_amdgcn_ds_bpermute(src, __builtin_bit_cast(int, s[1])));
          const float a2 = __builtin_bit_cast(float, __builtin_amdgcn_ds_bpermute(src, __builtin_bit_cast(int, s[2]))), a3 = __builtin_bit_cast(float, __builtin_amdgcn_ds_bpermute(src, __builtin_bit_cast(int, s[3])));
          sv = jsel == 0 ? a0 : (jsel == 1 ? a1 : (jsel == 2 ? a2 : a3)); }
        float ssum = lane < 8 ? sv : 0.f;
        ssum += dppf<DPP_X1>(ssum); ssum += dppf<DPP_X2>(ssum); ssum += dppf<DPP_HM>(ssum);
        if (lane < 8) { const int idx = tok * 8 + lane; TID[idx] = myE; TW[idx] = sv / ssum * 2.5f; TP[idx] = (int)__hip_atomic_fetch_add(LC + myE, 1u, __ATOMIC_RELAXED, __HIP_MEMORY_SCOPE_WORKGROUP); }
    }
    __syncthreads();
    if (threadIdx.x < 256) { const unsigned cnt = LC[threadIdx.x]; LB[threadIdx.x] = cnt ? atomicAdd(&CNT[threadIdx.x], cnt) : 0u; }
    __syncthreads();
    for (int tok = gw; tok < NTOK; tok += nw) if (lane < 8) { const int idx = tok * 8 + lane; TP[idx] += (int)LB[TID[idx]]; }
}
DEVI void phase12(const Params& p, LAS unsigned char* lds, int part) {
    if (part == 0) {
    LAS int* T = (LAS int*)(lds + LDS_TAB);
    moe_tables((const unsigned*)(p.ws + WS_CNT), T);
    const int* TID = (const int*)(p.ws + WS_TOPK_ID); const int* TP = (const int*)(p.ws + WS_TOPK_POS); int* TPw = (int*)(p.ws + WS_TOPK_POS); const float* TW = (const float*)(p.ws + WS_TOPK_W); u32x2* SL = (u32x2*)(p.ws + WS_SLOT);
    for (int idx = blockIdx.x * 512 + threadIdx.x; idx < NTOK * 8; idx += gridDim.x * 512) { const int slot_ = T[256 + TID[idx]] + TP[idx]; u32x2 rec; rec.x = (unsigned)idx; rec.y = __float_as_uint(TW[idx]); SL[slot_] = rec; TPw[idx] = slot_; }
    return; }
    LAS float* tb = (LAS float*)lds;
    for (int t = blockIdx.x; t < 256 * 48; t += gridDim.x) {
        const int e = t / 48, r = t % 48;
        if (r < 16)      conv_tile(p.in[20] + (size_t)e * 262144, 256, 256, (bf16_t*)(p.ws + WS_EXPGU) + (size_t)e * 524288, 1024, r * 64, 0, 0, tb);
        else if (r < 32) conv_tile(p.in[21] + (size_t)e * 262144, 256, 256, (bf16_t*)(p.ws + WS_EXPGU) + (size_t)e * 524288, 1024, (r - 16) * 64, 0, 128, tb);
        else { const int kt = (r - 32) >> 2, nb = (r - 32) & 3; conv_tile(p.in[22] + (size_t)e * 262144 + nb * 256, 1024, 256, (bf16_t*)(p.ws + WS_EXPD) + (size_t)e * 262144, 256, kt * 64, nb * 256, -1, tb); }
    }
}
DEVI void phase15(const Params& p) {
    const int lane = threadIdx.x & 63, gw = blockIdx.x * 8 + (threadIdx.x >> 6), nw = gridDim.x * 8;
    const float* mod = (const float*)(p.ws + WS_MOD); const bf16_t* X1 = (const bf16_t*)(p.ws + WS_X1);
    for (int tok = gw; tok < NTOK; tok += nw) {
        const float* m = mod + (size_t)(tok >> 12) * 6144 + 5120; float v[2][8];
        int sl[8]; float tw[8];
        { const int* tp = (const int*)(p.ws + WS_TOPK_POS) + (size_t)tok * 8; const float* twp = (const float*)(p.ws + WS_TOPK_W) + (size_t)tok * 8;
#pragma unroll
          for (int k = 0; k < 8; ++k) { sl[k] = __builtin_amdgcn_readfirstlane(tp[k]); tw[k] = twp[k]; } }
#pragma unroll
        for (int j = 0; j < 2; ++j) { const int cidx = lane * 8 + 512 * j; float a[8];
#pragma unroll
            for (int e = 0; e < 8; ++e) a[e] = 0.f;
#pragma unroll
            for (int k = 0; k < 9; ++k) { const u32x4 y = *(const u32x4*)((k < 8 ? (const bf16_t*)(p.ws + ws_ys(sl[k])) : (const bf16_t*)(p.ws + WS_Y8) + (size_t)tok * 1024) + cidx); const float w = k < 8 ? tw[k] : 1.0f;
                a[0] += w * bflo(y.x); a[1] += w * bfhi(y.x); a[2] += w * bflo(y.y); a[3] += w * bfhi(y.y); a[4] += w * bflo(y.z); a[5] += w * bfhi(y.z); a[6] += w * bflo(y.w); a[7] += w * bfhi(y.w); }
            const u32x4 xr = *(const u32x4*)(X1 + (size_t)tok * 1024 + cidx);
            const f32x4 g0 = *(const f32x4*)(m + cidx), g1 = *(const f32x4*)(m + cidx + 4), x0 = {bflo(xr.x), bfhi(xr.x), bflo(xr.y), bfhi(xr.y)}, x1 = {bflo(xr.z), bfhi(xr.z), bflo(xr.w), bfhi(xr.w)};
#if defined(DBG_NOMOE)
#pragma unroll
            for (int e = 0; e < 8; ++e) a[e] = 0.f;
#endif
#pragma unroll
            for (int e = 0; e < 4; ++e) { v[j][e] = x0[e] * 1.189207115f + g0[e] * a[e]; v[j][4 + e] = x1[e] * 1.189207115f + g1[e] * a[4 + e]; }
        }
        float sm = 0.f;
#pragma unroll
        for (int j = 0; j < 2; ++j)
#pragma unroll
            for (int e = 0; e < 8; ++e) sm += v[j][e];
        const float mu = wave_sum(sm) * (1.0f / 1024.0f); float q = 0.f;
#pragma unroll
        for (int j = 0; j < 2; ++j)
#pragma unroll
            for (int e = 0; e < 8; ++e) { v[j][e] -= mu; q += v[j][e] * v[j][e]; }
        const float rstd = rsqrtf(wave_sum(q) * (1.0f / 1024.0f) + 1e-6f);
#pragma unroll
        for (int j = 0; j < 2; ++j) { const int cidx = lane * 8 + 512 * j;
            const f32x4 g0 = *(const f32x4*)(p.in[26] + cidx), g1 = *(const f32x4*)(p.in[26] + cidx + 4), b0 = *(const f32x4*)(p.in[27] + cidx), b1 = *(const f32x4*)(p.in[27] + cidx + 4);
            f32x4 o0, o1;
#pragma unroll
            for (int e = 0; e < 4; ++e) { o0[e] = v[j][e] * rstd * g0[e] + b0[e]; o1[e] = v[j][4 + e] * rstd * g1[e] + b1[e]; }
            *(f32x4*)(p.out + (size_t)tok * 1024 + cidx) = o0; *(f32x4*)(p.out + (size_t)tok * 1024 + cidx + 4) = o1; }
    }
}

__global__ void __launch_bounds__(512, 2) mega(Params p) {
    extern __shared__ __attribute__((aligned(16))) unsigned char shm[];
    LAS unsigned char* lds = (LAS unsigned char*)shm;
    volatile LAS unsigned* xbw = (volatile LAS unsigned*)(lds + LDS_BARW);
    if (threadIdx.x == 0) { xbw[0] = 0u; xbw[1] = 0u; xbw[2] = 0u; xbw[3] = 0u; }
    __syncthreads();
    XcdBarrier bar; bar.bar = (unsigned*)(p.ws + WS_CTL); bar.x = 0; bar.st = xbw;
    const bool multi = (p.ph_hi - p.ph_lo) > 1;
    if (multi) bar = xcd_barrier_post((unsigned*)(p.ws + WS_CTL), xbw);
    unsigned char* ws = p.ws;
    const int G = gridDim.x, c = blockIdx.x;
#ifndef PHMASK
#define PHMASK 0xFFFF
#endif
#ifndef REPMASK
#define REPMASK 0
#endif
#define RUN(n) if (((PHMASK >> (n)) & 1) && p.ph_lo <= (n) && (n) < p.ph_hi)
#define SYNC(n) if (p.ph_lo <= (n) && (n) + 1 < p.ph_hi) xcd_barrier(bar); else __syncthreads()
    RUN(0) phase0(p, lds, 0);
#if (REPMASK >> 0) & 1
    __syncthreads();
    RUN(0) phase0(p, lds, 0);
#endif
    SYNC(0);
    RUN(1) { phase1(p); phase0(p, lds, 1); }
#if (REPMASK >> 1) & 1
    __syncthreads();
    RUN(1) { phase1(p); phase0(p, lds, 1); }
#endif
    SYNC(1);
    RUN(2) { SchedInProj S{ws, G, c}; EpiBf16 E; gemm_stream<SchedInProj, EpiBf16, false>(lds, S, E); }
#if (REPMASK >> 2) & 1
    __syncthreads();
    RUN(2) { SchedInProj S{ws, G, c}; EpiBf16 E; gemm_stream<SchedInProj, EpiBf16, false>(lds, S, E); }
#endif
    SYNC(2);
    RUN(3) phase3(p, lds);
#if (REPMASK >> 3) & 1
    __syncthreads();
    RUN(3) phase3(p, lds);
#endif
    SYNC(3);
    RUN(4) { if (c & 1) { phase4_na(p, lds); __syncthreads(); phase4_gla(p, lds); } else { phase4_gla(p, lds); __syncthreads(); phase4_na(p, lds); } }
    SYNC(4);
    RUN(5) phase5(p);
#if (REPMASK >> 5) & 1
    __syncthreads();
    RUN(5) phase5(p);
#endif
    SYNC(5);
#if (REPMASK >> 6) & 1
    __syncthreads();
#endif
    RUN(7) { SchedDense S{(const char*)(ws + WS_AP), (const char*)(ws + WS_BT_BR), (char*)(ws + WS_YM), 1536, G, c, 3072u, 3072u, 24}; EpiBranchC E{(const bf16_t*)(ws + WS_SGA), (const bf16_t*)(ws + WS_SGB), (bf16_t*)(ws + WS_YM)}; gemm_stream<SchedDense, EpiBranchC, false>(lds, S, E); }
#if (REPMASK >> 7) & 1
    __syncthreads();
    RUN(7) { SchedDense S{(const char*)(ws + WS_AP), (const char*)(ws + WS_BT_BR), (char*)(ws + WS_YM), 1536, G, c, 3072u, 3072u, 24}; EpiBranchC E{(const bf16_t*)(ws + WS_SGA), (const bf16_t*)(ws + WS_SGB), (bf16_t*)(ws + WS_YM)}; gemm_stream<SchedDense, EpiBranchC, false>(lds, S, E); }
#endif
    SYNC(7);
    RUN(8) { SchedDense S{(const char*)(ws + WS_YM), (const char*)(ws + WS_BT_OUT), (char*)(ws + WS_Z), 1024, G, c, 2048u, 2048u, 16}; EpiBf16 E; gemm_stream<SchedDense, EpiBf16, false>(lds, S, E); }
#if (REPMASK >> 8) & 1
    __syncthreads();
    RUN(8) { SchedDense S{(const char*)(ws + WS_YM), (const char*)(ws + WS_BT_OUT), (char*)(ws + WS_Z), 1024, G, c, 2048u, 2048u, 16}; EpiBf16 E; gemm_stream<SchedDense, EpiBf16, false>(lds, S, E); }
#endif
    SYNC(8);
    RUN(9) phase9(p);
#if (REPMASK >> 9) & 1
    __syncthreads();
    RUN(9) phase9(p);
#endif
    SYNC(9);
    RUN(10) { SchedRouter S{ws, G, c}; EpiF32 E; gemm_stream<SchedRouter, EpiF32, false>(lds, S, E); }
#if (REPMASK >> 10) & 1
    __syncthreads();
    RUN(10) { SchedRouter S{ws, G, c}; EpiF32 E; gemm_stream<SchedRouter, EpiF32, false>(lds, S, E); }
#endif
    SYNC(10);
    RUN(11) { if (c & 1) phase12(p, lds, 1); phase11(p, lds); if (!(c & 1)) phase12(p, lds, 1); }
#if (REPMASK >> 11) & 1
    __syncthreads();
    RUN(11) { if (c & 1) phase12(p, lds, 1); phase11(p, lds); if (!(c & 1)) phase12(p, lds, 1); }
#endif
    SYNC(11);
    RUN(12) phase12(p, lds, 0);
#if (REPMASK >> 12) & 1
    __syncthreads();
    RUN(12) phase12(p, lds, 0);
#endif
    SYNC(12);
    RUN(13) { LAS int* T = (LAS int*)(lds + LDS_TAB); moe_tables((const unsigned*)(ws + WS_CNT), T); SchedGateUp S{ws, T, G, c}; EpiGateUp E{(bf16_t*)(ws + WS_HID)}; gemm_stream<SchedGateUp, EpiGateUp, true>(lds, S, E); }
#if (REPMASK >> 13) & 1
    __syncthreads();
    RUN(13) { LAS int* T = (LAS int*)(lds + LDS_TAB); moe_tables((const unsigned*)(ws + WS_CNT), T); SchedGateUp S{ws, T, G, c}; EpiGateUp E{(bf16_t*)(ws + WS_HID)}; gemm_stream<SchedGateUp, EpiGateUp, true>(lds, S, E); }
#endif
    SYNC(13);
    RUN(14) { LAS int* T = (LAS int*)(lds + LDS_TAB); moe_tables((const unsigned*)(ws + WS_CNT), T); SchedDown S{ws, T, G, c}; EpiDown E{ws}; gemm_stream<SchedDown, EpiDown, false>(lds, S, E); }
#if (REPMASK >> 14) & 1
    __syncthreads();
    RUN(14) { LAS int* T = (LAS int*)(lds + LDS_TAB); moe_tables((const unsigned*)(ws + WS_CNT), T); SchedDown S{ws, T, G, c}; EpiDown E{ws}; gemm_stream<SchedDown, EpiDown, false>(lds, S, E); }
#endif
    SYNC(14);
    RUN(15) phase15(p);
#if (REPMASK >> 15) & 1
    __syncthreads();
    RUN(15) phase15(p);
#endif
}

#ifdef DBG_STOP
__global__ void dbg_dump(const unsigned short* base, size_t nwords, float* out, int accumulate) {
    for (size_t i = (size_t)blockIdx.x * blockDim.x + threadIdx.x; i < (size_t)33554432; i += (size_t)gridDim.x * blockDim.x) {
        float s = accumulate ? out[i] : 0.f;
        for (size_t j = i; j < nwords; j += (size_t)33554432) s += (float)base[j];
        out[i] = s;
    }
}
#endif
}

extern "C" void kernel_launch(void* const* d_in, const int* in_sizes, int n_in, void* d_out, int out_size, void* d_ws, size_t ws_size, hipStream_t stream) {
    static int grid = 0;
    if (grid == 0) {
        if (n_in != 28 || out_size != NTOK * 1024 || ws_size < WS_END) { fprintf(stderr, "kernel_launch: unexpected problem (n_in %d out %d ws %zu)\n", n_in, out_size, ws_size); grid = -1; return; }
        int dev = 0, cus = 0, per_cu = 0;
        if (hipGetDevice(&dev) != hipSuccess || hipDeviceGetAttribute(&cus, hipDeviceAttributeMultiprocessorCount, dev) != hipSuccess) { grid = -1; return; }
        if (hipFuncSetAttribute((const void*)mega, hipFuncAttributeMaxDynamicSharedMemorySize, LDS_TOTAL) != hipSuccess) { fprintf(stderr, "kernel_launch: hipFuncSetAttribute failed\n"); grid = -1; return; }
        if (hipOccupancyMaxActiveBlocksPerMultiprocessor(&per_cu, (const void*)mega, 512, LDS_TOTAL) != hipSuccess || per_cu < 1) fprintf(stderr, "kernel_launch: occupancy query says %d\n", per_cu);
        (void)hipGetLastError();
        grid = cus;
    }
    if (grid < 0) return;
    (void)hipMemsetAsync((char*)d_ws + WS_CTL, 0, 32768, stream);
    Params p{};
    for (int i = 0; i < 28; ++i) p.in[i] = (const float*)d_in[i];
    p.out = (float*)d_out; p.ws = (unsigned char*)d_ws;
#ifdef DBG_STOP
    for (int ph = 0; ph <= DBG_STOP; ++ph) { p.ph_lo = ph; p.ph_hi = ph + 1; hipLaunchKernelGGL(mega, dim3(grid), dim3(512), LDS_TOTAL, stream, p); }
    { const size_t regs[][2] = { DBG_REGS }; int first = 1;
      for (auto& r : regs) { hipLaunchKernelGGL(dbg_dump, dim3(2048), dim3(256), 0, stream, (const unsigned short*)((char*)d_ws + r[0] * MiB), (size_t)(r[1] * MiB / 2), (float*)d_out, first ? 0 : 1); first = 0; } }
#elif MK_PER_PHASE
    for (int ph = 0; ph < NPH; ++ph) {
#if defined(DBG_NOMOE)
        if (ph >= 10 && ph <= 14) continue;
#endif
        p.ph_lo = ph; p.ph_hi = ph + 1; hipLaunchKernelGGL(mega, dim3(grid), dim3(512), LDS_TOTAL, stream, p); }
#else
    p.ph_lo = 0; p.ph_hi = NPH; hipLaunchKernelGGL(mega, dim3(grid), dim3(512), LDS_TOTAL, stream, p);
#endif
}
```

```cpp
#include <hip/hip_runtime.h>
#include <stdint.h>
#include <stdio.h>

#ifndef MK_PER_PHASE
#define MK_PER_PHASE 0
#endif

namespace {
typedef unsigned short bf16_t;
typedef short bf16x8 __attribute__((ext_vector_type(8)));
typedef float f32x4 __attribute__((ext_vector_type(4)));
typedef unsigned u32x4 __attribute__((ext_vector_type(4)));
typedef unsigned u32x2 __attribute__((ext_vector_type(2)));
#define LAS __attribute__((address_space(3)))
#define DEVI __device__ __forceinline__

constexpr int NTOK = 32768, NROW = 34816, NPH = 16;
constexpr size_t MiB = 1ull << 20;
constexpr int LDS_TOTAL = 160 * 1024;
constexpr int LDS_BARW = LDS_TOTAL - 16;
constexpr int LDS_TAB = 131072;

constexpr size_t WS_CTL = 0, WS_CNT = 16384, WS_MOD = 1 * MiB, WS_EE = 2 * MiB, WS_TOPK_ID = 5 * MiB, WS_TOPK_W = 6 * MiB, WS_TOPK_POS = 7 * MiB, WS_SLOT = 8 * MiB;
constexpr size_t WS_BT_IN = 10 * MiB, WS_BT_BR = 24 * MiB  , WS_BT_OUT = 27 * MiB, WS_BT_RT = 29 * MiB, WS_BT_SHGU = 30 * MiB, WS_BT_SHD = 31 * MiB;
constexpr size_t WS_H = 32 * MiB, WS_QA = 100 * MiB, WS_KA = 132 * MiB, WS_QB = 166 * MiB, WS_KB = 198 * MiB, WS_GB = 232 * MiB, WS_SGA = 296 * MiB, WS_SGB = 360 * MiB;
constexpr size_t WS_VAT = 424 * MiB, WS_VBT = 458 * MiB, WS_QTF = 526 * MiB, WS_QTB = 558 * MiB, WS_KTF = 590 * MiB, WS_KTB = 624 * MiB, WS_KTTF = 658 * MiB, WS_KTTB = 692 * MiB;
constexpr size_t WS_OF = 726 * MiB, WS_OB = 790 * MiB, WS_AP = 896 * MiB, WS_LRT = 888 * MiB;
constexpr size_t WS_YM = 424 * MiB, WS_Z = 488 * MiB;
constexpr size_t WS_X1 = 32 * MiB, WS_EXPD = 160 * MiB, WS_LOG0 = 288 * MiB, WS_LOG1 = 320 * MiB, WS_EXPGU = 352 * MiB, WS_H2 = 608 * MiB, WS_HID = 864 * MiB;
constexpr size_t WS_YS = 288 * MiB;
constexpr size_t WS_Y8 = 800 * MiB, WS_END = 1009 * MiB;
DEVI size_t ws_ys(int slot) { return WS_YS + (size_t)slot * 2048; }
DEVI size_t ws_y(int k) { return (k < 2 ? 160 + 64 * (size_t)k : (k < 6 ? 416 + 64 * (size_t)(k - 2) : 817 + 64 * (size_t)(k - 6))) * MiB; }

struct Params { const float* in[28]; float* out; unsigned char* ws; int ph_lo, ph_hi; };

typedef __bf16 bf16x2_t __attribute__((ext_vector_type(2)));
typedef float f32x2_t __attribute__((ext_vector_type(2)));
DEVI unsigned pk_bf16(float lo, float hi) { const f32x2_t v = {lo, hi}; const bf16x2_t r = __builtin_convertvector(v, bf16x2_t); return __builtin_bit_cast(unsigned, r); }
DEVI float bf2f(bf16_t b) { return __uint_as_float(((unsigned)b) << 16); }
DEVI float bflo(unsigned w) { return __uint_as_float(w << 16); }
DEVI float bfhi(unsigned w) { return __uint_as_float(w & 0xffff0000u); }
DEVI bf16_t f2bf(float f) { return (bf16_t)(pk_bf16(f, 0.f) & 0xffffu); }
DEVI float sigmoidf_(float x) { return __builtin_amdgcn_rcpf(1.0f + __expf(-x)); }
template <int N> struct IC { static constexpr int v = N; };
DEVI void lds_barrier() { asm volatile("s_waitcnt lgkmcnt(0)" ::: "memory"); __builtin_amdgcn_s_barrier(); asm volatile("" ::: "memory"); }
template <int CTRL> DEVI float dppf(float v) { return __builtin_bit_cast(float, __builtin_amdgcn_update_dpp(__builtin_bit_cast(int, v), __builtin_bit_cast(int, v), CTRL, 0xF, 0xF, false)); }
template <int CTRL> DEVI int dppi(int v) { return __builtin_amdgcn_update_dpp(v, v, CTRL, 0xF, 0xF, false); }
DEVI float x16f(float v, int lane) { const auto r = __builtin_amdgcn_permlane16_swap(__builtin_bit_cast(unsigned, v), __builtin_bit_cast(unsigned, v), false, false); return __builtin_bit_cast(float, (lane & 16) ? r[0] : r[1]); }
DEVI int   x16i(int v, int lane)   { const auto r = __builtin_amdgcn_permlane16_swap((unsigned)v, (unsigned)v, false, false); return (int)((lane & 16) ? r[0] : r[1]); }
DEVI float x32f(float v, int lane) { const auto r = __builtin_amdgcn_permlane32_swap(__builtin_bit_cast(unsigned, v), __builtin_bit_cast(unsigned, v), false, false); return __builtin_bit_cast(float, (lane & 32) ? r[0] : r[1]); }
DEVI int   x32i(int v, int lane)   { const auto r = __builtin_amdgcn_permlane32_swap((unsigned)v, (unsigned)v, false, false); return (int)((lane & 32) ? r[0] : r[1]); }
#define DPP_X1 0xB1
#define DPP_X2 0x4E
#define DPP_HM 0x141
#define DPP_RM 0x140
DEVI float wave_sum(float v) { const int lane = threadIdx.x & 63; v += dppf<DPP_X1>(v); v += dppf<DPP_X2>(v); v += dppf<DPP_HM>(v); v += dppf<DPP_RM>(v); v += x16f(v, lane); v += x32f(v, lane); return v; }

#define XB_TMO      128
#define XB_XCNT(j)  (256  + 64 * (j))
#define XB_XSUB(j)  (1280 + 64 * (j))
#define XB_XGEN(j)  (2304 + 64 * (j))
#define XB_TOP      3328
#define XB_TOPGEN   3392
#define XCD_BAR_WORDS 3456
#define XB_SPIN_CAP (1u << 22)
DEVI unsigned xb_ld(unsigned* p)              { return __hip_atomic_load(p, __ATOMIC_RELAXED, __HIP_MEMORY_SCOPE_AGENT); }
DEVI unsigned xb_add(unsigned* p, unsigned v) { return __hip_atomic_fetch_add(p, v, __ATOMIC_RELAXED, __HIP_MEMORY_SCOPE_AGENT); }
DEVI unsigned xb_xcc_id() { return (unsigned)__builtin_amdgcn_s_getreg((3 << 11) | 20) & 0xFu; }
#define XB_SPIN(cond, bar) do { unsigned _sp = 0; while (cond) { __builtin_amdgcn_s_sleep(1); \
    if ((++_sp & 255u) == 0u) { if (xb_ld(&(bar)[XB_TMO])) break; if (_sp > XB_SPIN_CAP) { atomicAdd(&(bar)[XB_TMO], 1u); break; } } } } while (0)
struct XcdBarrier { unsigned* bar; unsigned x; volatile LAS unsigned* st; };
DEVI XcdBarrier xcd_barrier_post(unsigned* bar, volatile LAS unsigned* st) {
    XcdBarrier b; b.bar = bar; b.x = xb_xcc_id(); b.st = st;
    if (threadIdx.x == 0) (void)xb_add(&bar[XB_XCNT(b.x)], 1u);
    return b;
}
DEVI void xcd_barrier_complete(unsigned* bar, unsigned x, unsigned& nloc, unsigned& nx) {
    const unsigned G = gridDim.x * gridDim.y * gridDim.z;
    unsigned sum, cnt, mine, sp = 0u;
    for (;;) {
        sum = 0u; cnt = 0u; mine = 0u;
#pragma unroll
        for (unsigned j = 0; j < 16; ++j) { const unsigned c = xb_ld(&bar[XB_XCNT(j)]); sum += c; cnt += (c > 0u) ? 1u : 0u; mine = (j == x) ? c : mine; }
        if (sum == G) break;
        __builtin_amdgcn_s_sleep(1);
        if ((++sp & 255u) == 0u) { if (xb_ld(&bar[XB_TMO])) break; if (sp > XB_SPIN_CAP) { atomicAdd(&bar[XB_TMO], 1u); break; } }
    }
    nloc = mine > 0u ? mine : 1u; nx = cnt > 0u ? cnt : 1u;
}
DEVI void xcd_barrier(const XcdBarrier& b) {
    asm volatile("s_waitcnt vmcnt(0)" ::: "memory");
    __syncthreads();
    if (threadIdx.x == 0) {
        unsigned* bar = b.bar;
        __builtin_amdgcn_s_waitcnt(0);
        unsigned nloc = b.st[0], nx = b.st[1];
        if (nloc == 0u) { xcd_barrier_complete(bar, b.x, nloc, nx); b.st[0] = nloc; b.st[1] = nx; }
        const unsigned old = xb_add(&bar[XB_XSUB(b.x)], 1u);
        const unsigned gen = old / nloc;
        if (old + 1u == (gen + 1u) * nloc) {
            __builtin_amdgcn_fence(__ATOMIC_RELEASE, "agent");
            asm volatile("s_waitcnt vmcnt(0)" ::: "memory");
            const unsigned og = xb_add(&bar[XB_TOP], 1u);
            const unsigned tg = og / nx;
            if (og + 1u == (tg + 1u) * nx) xb_add(&bar[XB_TOPGEN], 1u);
            else XB_SPIN(xb_ld(&bar[XB_TOPGEN]) == tg, bar);
            __builtin_amdgcn_fence(__ATOMIC_ACQUIRE, "agent");
            xb_add(&bar[XB_XGEN(b.x)], 1u);
            asm volatile("s_waitcnt vmcnt(0)" ::: "memory");
        } else {
            XB_SPIN(xb_ld(&bar[XB_XGEN(b.x)]) == gen, bar);
            __builtin_amdgcn_fence(__ATOMIC_ACQUIRE, "agent");
            asm volatile("s_waitcnt vmcnt(0)" ::: "memory");
        }
    }
    __syncthreads();
}

constexpr int BK = 64, HALF = 128, HTB = HALF * BK * 2;
DEVI int lds_byte(int r, int c) { const int st = (r >> 4) * 2 + (c >> 5), rr = r & 15, cc = c & 31, ob = rr * 64 + cc * 2; return st * 1024 + (ob ^ (((ob >> 9) & 1) << 5)); }
DEVI void stage_rc(int b, int& R, int& C) { const int st = b / 1024, sb = b % 1024, swz = sb ^ (((sb >> 9) & 1) << 5); R = (st >> 1) * 16 + swz / 64; C = (st & 1) * 32 + (swz % 64) / 2; }
DEVI int perm32(int rho) { const int n = rho >> 4, i = rho & 15; return 8 * (i >> 2) + 4 * n + (i & 3); }

struct GUnit {
    const char* a; const char* b;
    char* dst; int ldd; int i0, i1, i2; float f0;
};
typedef f32x4 Acc[2][2][4][2];
#define ZA1(a, b, m) acc[a][b][m][0] = z; acc[a][b][m][1] = z;
#define ZA2(a, b) ZA1(a, b, 0) ZA1(a, b, 1) ZA1(a, b, 2) ZA1(a, b, 3)
DEVI void zero_acc(Acc& acc) { f32x4 z = {0.f, 0.f, 0.f, 0.f}; asm volatile("" : "+v"(z)); ZA2(0, 0) ZA2(0, 1) ZA2(1, 0) ZA2(1, 1) }

template <class Sched, class Epi, bool GATHER>
DEVI void gemm_stream(LAS unsigned char* lds, const Sched& S, const Epi& E) {
    const int tid = threadIdx.x, wid = __builtin_amdgcn_readfirstlane(tid >> 6), lane = tid & 63, wr = wid >> 2, wc = wid & 3, fr = lane & 15, fq = lane >> 4;
    const unsigned lda = S.lda, ldb = S.ldb; const int nt = S.nt;
    unsigned voffA[2], voffB[2]; int R0 = 0;
#pragma unroll
    for (int i = 0; i < 2; ++i) { int R, C; stage_rc(tid * 16 + i * 8192, R, C); const int Rb = (R & ~31) + perm32(R & 31);
        if (i == 0) R0 = R;
        voffA[i] = GATHER ? (unsigned)(C * 2) : (unsigned)R * lda + (unsigned)(C * 2); voffB[i] = (unsigned)Rb * ldb + (unsigned)(C * 2); }
    const size_t kstep = (size_t)(BK * 2);
    const size_t hstepA = GATHER ? (size_t)0 : (size_t)HALF * lda, hstepB = (size_t)HALF * ldb;
    const unsigned ldsw = (unsigned)wid * 1024u;
    const int aoff = lds_byte(wr * 64 + fr, fq * 8), boff = lds_byte(wc * 32 + fr, fq * 8);
#define G_SA(b, h) (((b) * 2 + (h)) * HTB)
#define G_SB(b, h) ((4 + (b) * 2 + (h)) * HTB)
#define G_STAGE(bufoff, gbase, o0, o1) do { \
        __builtin_amdgcn_global_load_lds((const unsigned*)((const char*)(gbase) + (o0)), (LAS unsigned*)(lds + (bufoff) + ldsw), 16, 0, 0); \
        __builtin_amdgcn_global_load_lds((const unsigned*)((const char*)(gbase) + (o1)), (LAS unsigned*)(lds + (bufoff) + ldsw + 8192), 16, 0, 0); } while (0)
#define G_LDA(dst, b, h) do { _Pragma("unroll") for (int m = 0; m < 4; ++m) _Pragma("unroll") for (int k = 0; k < 2; ++k) dst[m][k] = *(const LAS bf16x8*)(lds + G_SA(b, h) + aoff + m * 2048 + k * 1024); } while (0)
#define G_LDB(dst, b, h) do { _Pragma("unroll") for (int n = 0; n < 2; ++n) _Pragma("unroll") for (int k = 0; k < 2; ++k) dst[n][k] = *(const LAS bf16x8*)(lds + G_SB(b, h) + boff + n * 2048 + k * 1024); } while (0)
#define G_MMA(ai, bj, At, Bt) do { __builtin_amdgcn_s_setprio(1); _Pragma("unroll") for (int m = 0; m < 4; ++m) _Pragma("unroll") for (int n = 0; n < 2; ++n) _Pragma("unroll") for (int k = 0; k < 2; ++k) \
        acc[ai][bj][m][n] = __builtin_amdgcn_mfma_f32_16x16x32_bf16(Bt[n][k], At[m][k], acc[ai][bj][m][n], 0, 0, 0); __builtin_amdgcn_s_setprio(0); } while (0)
#define G_WAIT_V(n) asm volatile("s_waitcnt vmcnt(" #n ")" ::: "memory")
#define G_WAIT_L(n) asm volatile("s_waitcnt lgkmcnt(" #n ")" ::: "memory")
#define G_BAR __builtin_amdgcn_s_barrier()
#define G_SCHED __builtin_amdgcn_sched_barrier(0)
    GUnit cur, nxt; int ui = 0;
    if (!S.next(0, cur)) return;
    unsigned gc[2][2], gn[2][2];
    gc[0][0] = voffA[0]; gc[0][1] = voffA[1]; gc[1][0] = voffA[0]; gc[1][1] = voffA[1];
    gn[0][0] = voffA[0]; gn[0][1] = voffA[1]; gn[1][0] = voffA[0]; gn[1][1] = voffA[1];
    if constexpr (GATHER) { S.gather(cur, R0, gc); gc[0][0] += voffA[0]; gc[0][1] += voffA[0]; gc[1][0] += voffA[0]; gc[1][1] += voffA[0]; }
    Acc acc; zero_acc(acc);
    typename Epi::Pre pre; E.pre(cur, wr, lane, pre);
    bf16x8 At[4][2], B0[2][2], B1[2][2];
    const char* cA = cur.a; const char* cB = cur.b;
    G_STAGE(G_SB(0, 0), cB, voffB[0], voffB[1]); G_STAGE(G_SA(0, 0), cA, gc[0][0], gc[0][1]); G_STAGE(G_SB(0, 1), cB + hstepB, voffB[0], voffB[1]); G_STAGE(G_SA(0, 1), cA + hstepA, gc[1][0], gc[1][1]);
    if (wr == 1) G_BAR;
    G_WAIT_V(4); G_BAR;
    G_STAGE(G_SB(1, 0), cB + kstep, voffB[0], voffB[1]); G_STAGE(G_SA(1, 0), cA + kstep, gc[0][0], gc[0][1]); G_STAGE(G_SB(1, 1), cB + hstepB + kstep, voffB[0], voffB[1]);
    G_WAIT_V(6); G_BAR;
    for (;;) {
        const bool has_next = S.next(ui + 1, nxt);
        const char* nA = has_next ? nxt.a : cA; const char* nB = has_next ? nxt.b : cB;
        for (int t = 0; t < nt; t += 2) {
            const bool last = (t == nt - 2);
            const char* a1 = cA + (size_t)(t + 1) * kstep;
            const char* a2 = last ? nA : cA + (size_t)(t + 2) * kstep; const char* b2 = last ? nB : cB + (size_t)(t + 2) * kstep;
            const char* a3 = a2 + kstep; const char* b3 = b2 + kstep;
            unsigned g2[2][2];
            if constexpr (GATHER) { g2[0][0] = last ? gn[0][0] : gc[0][0]; g2[0][1] = last ? gn[0][1] : gc[0][1]; g2[1][0] = last ? gn[1][0] : gc[1][0]; g2[1][1] = last ? gn[1][1] : gc[1][1]; }
            else { g2[0][0] = voffA[0]; g2[0][1] = voffA[1]; g2[1][0] = voffA[0]; g2[1][1] = voffA[1]; }
            if constexpr (GATHER) { if (t == nt - 4) {
                if (has_next) { S.gather(nxt, R0, gn); gn[0][0] += voffA[0]; gn[0][1] += voffA[0]; gn[1][0] += voffA[0]; gn[1][1] += voffA[0]; }
                else { gn[0][0] = gc[0][0]; gn[0][1] = gc[0][1]; gn[1][0] = gc[1][0]; gn[1][1] = gc[1][1]; } } }
            if constexpr (Epi::MID_T > 0) { if (t == Epi::MID_T) { int tz = threadIdx.x; asm volatile("" : "+v"(tz)); const int wz = tz >> 6, lz = tz & 63; E.mid(acc, cur, wz >> 2, wz & 3, lz & 15, lz >> 4); } }
            G_LDB(B0, 0, 0); G_SCHED; G_LDA(At, 0, 0); G_STAGE(G_SA(1, 1), a1 + hstepA, gc[1][0], gc[1][1]);
            G_WAIT_L(8); G_BAR; G_WAIT_L(0); G_MMA(0, 0, At, B0); G_BAR; G_SCHED;
            G_LDB(B1, 0, 1); G_STAGE(G_SB(0, 0), b2, voffB[0], voffB[1]);
            G_BAR; G_WAIT_L(0); G_MMA(0, 1, At, B1); G_BAR;
            G_LDA(At, 0, 1); G_STAGE(G_SA(0, 0), a2, g2[0][0], g2[0][1]);
            G_BAR; G_WAIT_L(0); G_MMA(1, 0, At, B0); G_BAR; G_SCHED;
            G_STAGE(G_SB(0, 1), b2 + hstepB, voffB[0], voffB[1]);
            G_WAIT_V(6); G_BAR; G_MMA(1, 1, At, B1); G_BAR;
            G_LDB(B0, 1, 0); G_SCHED; G_LDA(At, 1, 0); G_STAGE(G_SA(0, 1), a2 + hstepA, g2[1][0], g2[1][1]);
            G_WAIT_L(8); G_BAR; G_WAIT_L(0); G_MMA(0, 0, At, B0); G_BAR; G_SCHED;
            G_LDB(B1, 1, 1); G_STAGE(G_SB(1, 0), b3, voffB[0], voffB[1]);
            G_BAR; G_WAIT_L(0); G_MMA(0, 1, At, B1); G_BAR;
            G_LDA(At, 1, 1); G_STAGE(G_SA(1, 0), a3, g2[0][0], g2[0][1]);
            G_BAR; G_WAIT_L(0); G_MMA(1, 0, At, B0); G_BAR; G_SCHED;
            G_STAGE(G_SB(1, 1), b3 + hstepB, voffB[0], voffB[1]);
            G_WAIT_V(6); G_BAR; G_MMA(1, 1, At, B1); G_BAR;
        }
        { int tz = threadIdx.x; asm volatile("" : "+v"(tz)); const int wz = tz >> 6, lz = tz & 63; E(acc, cur, wz >> 2, wz & 3, lz & 15, lz >> 4, pre); }
        if (!has_next) break;
        zero_acc(acc);
        cur = nxt; cA = nA; cB = nB; ++ui;
        E.pre(cur, wr, lane, pre);
        if constexpr (GATHER) { gc[0][0] = gn[0][0]; gc[0][1] = gn[0][1]; gc[1][0] = gn[1][0]; gc[1][1] = gn[1][1]; }
    }
    G_WAIT_V(0);
    if (wr == 0) G_BAR;
    G_BAR;
}

struct EpiBf16 { static constexpr int MID_T = 0; DEVI void mid(Acc&, const GUnit&, int, int, int, int) const {}
    struct Pre {}; DEVI void pre(const GUnit&, int, int, Pre&) const {}
    DEVI void operator()(const Acc& acc, const GUnit& u, int wr, int wc, int fr, int fq, const Pre&) const {
        if (u.f0 < 0.f) {
            float* fb = (float*)u.dst;
#pragma unroll
            for (int m = 0; m < 4; ++m) { const int row = wr * 64 + m * 16 + fr;
                if (row < 32) { float* rp = fb + (size_t)row * u.ldd + wc * 32 + 8 * fq;
#pragma unroll
                    for (int bj = 0; bj < 2; ++bj) { *(f32x4*)(rp + bj * 128) = acc[0][bj][m][0]; *(f32x4*)(rp + bj * 128 + 4) = acc[0][bj][m][1]; } } }
            return;
        }
        bf16_t* base = (bf16_t*)u.dst; const float s = u.f0; const int act = u.i0;
#pragma unroll
        for (int ai = 0; ai < 2; ++ai)
#pragma unroll
            for (int m = 0; m < 4; ++m) {
                bf16_t* rp = base + (size_t)(ai * 128 + wr * 64 + m * 16 + fr) * u.ldd + wc * 32 + 8 * fq;
#pragma unroll
                for (int bj = 0; bj < 2; ++bj) {
                    f32x4 v0 = acc[ai][bj][m][0] * s, v1 = acc[ai][bj][m][1] * s;
                    if (act) {
#pragma unroll
                        for (int j = 0; j < 4; ++j) { v0[j] = sigmoidf_(v0[j]); v1[j] = sigmoidf_(v1[j]); }
                    }
                    u32x4 w; w.x = pk_bf16(v0[0], v0[1]); w.y = pk_bf16(v0[2], v0[3]); w.z = pk_bf16(v1[0], v1[1]); w.w = pk_bf16(v1[2], v1[3]);
                    *(u32x4*)(rp + bj * 128) = w;
                }
            }
    }
};
struct EpiF32 { static constexpr int MID_T = 0; DEVI void mid(Acc&, const GUnit&, int, int, int, int) const {}
    struct Pre {}; DEVI void pre(const GUnit&, int, int, Pre&) const {}
    DEVI void operator()(const Acc& acc, const GUnit& u, int wr, int wc, int fr, int fq, const Pre&) const {
        float* base = (float*)u.dst;
#pragma unroll
        for (int ai = 0; ai < 2; ++ai)
#pragma unroll
            for (int m = 0; m < 4; ++m) {
                float* rp = base + (size_t)(ai * 128 + wr * 64 + m * 16 + fr) * u.ldd + wc * 32 + 8 * fq;
#pragma unroll
                for (int bj = 0; bj < 2; ++bj) { *(f32x4*)(rp + bj * 128) = acc[ai][bj][m][0]; *(f32x4*)(rp + bj * 128 + 4) = acc[ai][bj][m][1]; }
            }
    }
};
struct EpiBranchC {
    static constexpr int MID_T = 8;
    const bf16_t* sga; const bf16_t* sgb; bf16_t* ym;
    struct Pre {}; DEVI void pre(const GUnit&, int, int, Pre&) const {}
    DEVI void mid(Acc& acc, const GUnit& u, int wr, int wc, int fr, int fq) const {
#pragma unroll
        for (int ai = 0; ai < 2; ++ai)
#pragma unroll
            for (int m = 0; m < 4; ++m) {
                const size_t ro = (size_t)(u.i1 + ai * 128 + wr * 64 + m * 16 + fr) * 1024 + u.i2 + wc * 32 + 8 * fq;
#pragma unroll
                for (int bj = 0; bj < 2; ++bj) {
                    const u32x4 ga = *(const u32x4*)(sga + ro + bj * 128), gb = *(const u32x4*)(sgb + ro + bj * 128);
                    f32x4 r0, r1;
                    r0[0] = bflo(ga.x) * __builtin_amdgcn_rcpf(bflo(gb.x)); r0[1] = bfhi(ga.x) * __builtin_amdgcn_rcpf(bfhi(gb.x)); r0[2] = bflo(ga.y) * __builtin_amdgcn_rcpf(bflo(gb.y)); r0[3] = bfhi(ga.y) * __builtin_amdgcn_rcpf(bfhi(gb.y));
                    r1[0] = bflo(ga.z) * __builtin_amdgcn_rcpf(bflo(gb.z)); r1[1] = bfhi(ga.z) * __builtin_amdgcn_rcpf(bfhi(gb.z)); r1[2] = bflo(ga.w) * __builtin_amdgcn_rcpf(bflo(gb.w)); r1[3] = bfhi(ga.w) * __builtin_amdgcn_rcpf(bfhi(gb.w));
                    acc[ai][bj][m][0] = acc[ai][bj][m][0] * r0; acc[ai][bj][m][1] = acc[ai][bj][m][1] * r1;
                }
            }
    }
    DEVI void operator()(const Acc& acc, const GUnit& u, int wr, int wc, int fr, int fq, const Pre&) const {
#pragma unroll
        for (int ai = 0; ai < 2; ++ai)
#pragma unroll
            for (int m = 0; m < 4; ++m) {
                const size_t ro = (size_t)(u.i1 + ai * 128 + wr * 64 + m * 16 + fr) * 1024 + u.i2 + wc * 32 + 8 * fq;
#pragma unroll
                for (int bj = 0; bj < 2; ++bj) {
                    const u32x4 gb = *(const u32x4*)(sgb + ro + bj * 128);
                    const f32x4 v0 = acc[ai][bj][m][0], v1 = acc[ai][bj][m][1];
                    u32x4 w;
                    w.x = pk_bf16(bflo(gb.x) * v0[0], bfhi(gb.x) * v0[1]); w.y = pk_bf16(bflo(gb.y) * v0[2], bfhi(gb.y) * v0[3]);
                    w.z = pk_bf16(bflo(gb.z) * v1[0], bfhi(gb.z) * v1[1]); w.w = pk_bf16(bflo(gb.w) * v1[2], bfhi(gb.w) * v1[3]);
                    *(u32x4*)(ym + ro + bj * 128) = w;
                }
            }
    }
};
struct EpiGateUp { static constexpr int MID_T = 0; DEVI void mid(Acc&, const GUnit&, int, int, int, int) const {}
    bf16_t* hid;
    struct Pre {}; DEVI void pre(const GUnit&, int, int, Pre&) const {}
    DEVI void operator()(const Acc& acc, const GUnit& u, int wr, int wc, int fr, int fq, const Pre&) const {
#pragma unroll
        for (int ai = 0; ai < 2; ++ai)
#pragma unroll
            for (int m = 0; m < 4; ++m) {
                const int row = ai * 128 + wr * 64 + m * 16 + fr;
                if (row < u.i1) {
                    const f32x4 g0 = acc[ai][0][m][0], g1 = acc[ai][0][m][1], u0 = acc[ai][1][m][0], u1 = acc[ai][1][m][1];
                    float h[8];
#pragma unroll
                    for (int j = 0; j < 4; ++j) { h[j] = g0[j] * sigmoidf_(g0[j]) * u0[j]; h[4 + j] = g1[j] * sigmoidf_(g1[j]) * u1[j]; }
                    u32x4 w; w.x = pk_bf16(h[0], h[1]); w.y = pk_bf16(h[2], h[3]); w.z = pk_bf16(h[4], h[5]); w.w = pk_bf16(h[6], h[7]);
                    *(u32x4*)(hid + (size_t)(u.i0 + row) * 256 + u.i2 * 128 + wc * 32 + 8 * fq) = w;
                }
            }
    }
};
struct EpiDown {
    static constexpr int MID_T = 0; DEVI void mid(Acc&, const GUnit&, int, int, int, int) const {}
    unsigned char* ws;
    struct Pre {}; DEVI void pre(const GUnit&, int, int, Pre&) const {}
    DEVI void operator()(const Acc& acc, const GUnit& u, int wr, int wc, int fr, int fq, const Pre&) const {
#pragma unroll
        for (int ai = 0; ai < 2; ++ai)
#pragma unroll
            for (int m = 0; m < 4; ++m) {
                const int row = ai * 128 + wr * 64 + m * 16 + fr;
                if (row < u.i1) {
                    bf16_t* rp = (u.i2 == 0 ? (bf16_t*)(ws + ws_ys(u.i0 + row)) : (bf16_t*)(ws + WS_Y8) + (size_t)(u.i0 + row) * 1024) + u.ldd + wc * 32 + 8 * fq;
#pragma unroll
                    for (int bj = 0; bj < 2; ++bj) {
                        const f32x4 v0 = acc[ai][bj][m][0], v1 = acc[ai][bj][m][1];
                        u32x4 o; o.x = pk_bf16(v0[0], v0[1]); o.y = pk_bf16(v0[2], v0[3]); o.z = pk_bf16(v1[0], v1[1]); o.w = pk_bf16(v1[2], v1[3]);
                        *(u32x4*)(rp + bj * 128) = o;
                    }
                }
            }
    }
};

struct SchedInProj {
    unsigned char* ws; int G, c;
    static constexpr unsigned lda = 2048, ldb = 2048; static constexpr int nt = 16;
    DEVI bool next(int i, GUnit& u) const {
        const int L = i * G + c; if (L >= 3544) return false;
        u.i0 = 0; u.i1 = 0; u.i2 = 0; u.f0 = 1.0f;
        const char* H = (const char*)(ws + WS_H); const char* BT = (const char*)(ws + WS_BT_IN);
        int pm, pn;
        if (L < 2592) {
            if (L < 2560) { const int x = L & 7, q = L >> 3, blk = q >> 5, w = q & 31; pm = 16 * x + 8 * (blk & 1) + (w & 7); pn = 4 * (blk >> 1) + (w >> 3); }
            else { const int j = L - 2560, jn = j >> 3; pm = 128 + (j & 7); pn = jn < 2 ? 2 + jn : 4 + jn; }
            u.a = H + (size_t)pm * 256 * 2048; u.b = BT + (size_t)pn * 256 * 2048;
            size_t base; int ld, col;
            if (pn < 2)       { base = WS_QA; ld = 512; col = pn * 256; u.f0 = 0.125f; }
            else if (pn < 4)  { base = WS_KA; ld = 512; col = (pn - 2) * 256; }
            else if (pn < 6)  { base = WS_QB; ld = 512; col = (pn - 4) * 256; }
            else if (pn < 8)  { base = WS_KB; ld = 512; col = (pn - 6) * 256; }
            else if (pn < 12) { base = WS_GB; ld = 1024; col = (pn - 8) * 256; }
            else if (pn < 16) { base = WS_SGA; ld = 1024; col = (pn - 12) * 256; u.i0 = 1; }
            else              { base = WS_SGB; ld = 1024; col = (pn - 16) * 256; u.i0 = 1; }
            u.dst = (char*)(ws + base) + ((size_t)pm * 256 * ld + col) * 2; u.ldd = ld;
        } else {
            const int j = L - 2592, x = j & 7, q = j >> 3, tn = 17 * x + q / 7, wm = q % 7;
            u.a = BT + (size_t)(5120 + wm * 256) * 2048; u.b = H + (size_t)tn * 256 * 2048;
            u.dst = (wm < 2 ? (char*)(ws + WS_VAT) + ((size_t)(wm * 256) * NROW + tn * 256) * 2 : (wm < 6 ? (char*)(ws + WS_VBT) + ((size_t)((wm - 2) * 256) * NROW + tn * 256) * 2 : (char*)(ws + WS_LRT) + (size_t)(tn * 256) * 4));
            u.ldd = NROW; if (wm == 6) u.f0 = -1.0f;
        }
        return true;
    }
};
struct SchedDense {
    const char* A; const char* Bt; char* dst; int K; int G, c; unsigned lda, ldb; int nt;
    DEVI bool next(int i, GUnit& u) const {
        const int L = i * G + c; if (L >= 512) return false;
        const int x = L & 7, q = L >> 3, blk = q >> 5, w = q & 31, pm = 16 * x + 8 * blk + (w & 7), pn = w >> 3;
        u.a = A + (size_t)pm * 256 * K * 2; u.b = Bt + (size_t)pn * 256 * K * 2;
        u.dst = dst + ((size_t)pm * 256 * 1024 + pn * 256) * 2; u.ldd = 1024; u.i0 = 0; u.i1 = pm * 256; u.i2 = pn * 256; u.f0 = 1.0f;
        return true;
    }
};
struct SchedRouter {
    unsigned char* ws; int G, c;
    static constexpr unsigned lda = 2048, ldb = 2048; static constexpr int nt = 16;
    DEVI static int panel(int c) { return 16 * (c & 7) + (c >> 3); }
    DEVI bool next(int i, GUnit& u) const {
        if (i > 0 || c >= 128) return false;
        const int pm = panel(c);
        u.a = (const char*)(ws + WS_H2) + (size_t)pm * 256 * 2048; u.b = (const char*)(ws + WS_BT_RT);
        u.dst = (char*)(ws + WS_LOG0) + (size_t)pm * 256 * 256 * 4; u.ldd = 256; u.i0 = 0; u.i1 = 0; u.i2 = 0; u.f0 = 1.0f;
        return true;
    }
};
DEVI void moe_tables(const unsigned* gcnt, LAS int* T) {
    if (threadIdx.x < 64) {
        const int l = threadIdx.x; int c[4], t[4];
#pragma unroll
        for (int k = 0; k < 4; ++k) { c[k] = (int)gcnt[4 * l + k]; t[k] = (c[k] + 255) >> 8; }
        const int sc = c[0] + c[1] + c[2] + c[3], st = t[0] + t[1] + t[2] + t[3];
        int ic = sc, it = st;
#pragma unroll
        for (int o = 1; o < 64; o <<= 1) { const int a = __shfl_up(ic, o), b = __shfl_up(it, o); if (l >= o) { ic += a; it += b; } }
        int bc = ic - sc, bt = it - st;
#pragma unroll
        for (int k = 0; k < 4; ++k) { T[4 * l + k] = c[k]; T[256 + 4 * l + k] = bc; T[513 + 4 * l + k] = bt; bc += c[k]; bt += t[k]; }
        if (l == 63) { T[256 + 256] = ic; T[513 + 256] = it; }
    }
    __syncthreads();
    {
        const int TRt = T[513 + 256];
        for (int t = threadIdx.x; t < TRt; t += 512) { int lo = 0, hi = 256; while (hi - lo > 1) { const int mid = (lo + hi) >> 1; if (T[513 + mid] <= t) lo = mid; else hi = mid; } T[770 + t] = lo; }
    }
    __syncthreads();
}
DEVI int moe_find(const LAS int* toff, int t) {
    int lo = 0, hi = 256;
#pragma unroll 1
    while (hi - lo > 1) { const int mid = (lo + hi) >> 1; if (toff[mid] <= t) lo = mid; else hi = mid; }
    return __builtin_amdgcn_readfirstlane(lo);
}
struct SchedGateUp {
    unsigned char* ws; const LAS int* T; int G, c;
    static constexpr unsigned lda = 2048, ldb = 2048; static constexpr int nt = 16;
    DEVI bool next(int i, GUnit& u) const {
        const int L = i * G + c; const int TR = __builtin_amdgcn_readfirstlane(T[513 + 256]);
        if (L >= 2 * TR + 256) return false;
        u.a = (const char*)(ws + WS_H2); u.dst = nullptr; u.ldd = 0; u.f0 = 1.0f;
        if (L < 2 * TR) {
            const int t = L >> 1, pn = L & 1, e = __builtin_amdgcn_readfirstlane(T[770 + t]), mt = t - __builtin_amdgcn_readfirstlane(T[513 + e]), cnt = __builtin_amdgcn_readfirstlane(T[e]);
            u.b = (const char*)(ws + WS_EXPGU) + ((size_t)e * 512 + pn * 256) * 2048;
            u.i0 = __builtin_amdgcn_readfirstlane(T[256 + e]) + mt * 256; u.i1 = min(256, cnt - mt * 256); u.i2 = pn;
        } else {
            const int j = L - 2 * TR, mt = j >> 1, pn = j & 1;
            u.b = (const char*)(ws + WS_BT_SHGU) + (size_t)(pn * 256) * 2048;
            u.i0 = 262144 + mt * 256; u.i1 = 256; u.i2 = pn;
        }
        return true;
    }
    DEVI void gather(const GUnit& u, int R0, unsigned (&g)[2][2]) const {
        const u32x2* slot = (const u32x2*)(ws + WS_SLOT);
#pragma unroll
        for (int h = 0; h < 2; ++h)
#pragma unroll
            for (int i = 0; i < 2; ++i) {
                const int s = u.i0 + h * 128 + R0 + 64 * i; int tok;
                if (u.i0 >= 262144) tok = s - 262144; else tok = (int)(slot[min(s, 262143)].x >> 3);
                g[h][i] = (unsigned)tok * 2048u;
            }
    }
};
struct SchedDown {
    unsigned char* ws; const LAS int* T; int G, c;
    static constexpr unsigned lda = 512, ldb = 512; static constexpr int nt = 4;
    DEVI bool next(int i, GUnit& u) const {
        const int L = i * G + c; const int TR = __builtin_amdgcn_readfirstlane(T[513 + 256]);
        if (L >= 4 * TR + 512) return false;
        u.dst = nullptr; u.f0 = 1.0f;
        if (L < 4 * TR) {
            const int t = L >> 2, pn = L & 3, e = __builtin_amdgcn_readfirstlane(T[770 + t]), mt = t - __builtin_amdgcn_readfirstlane(T[513 + e]), cnt = __builtin_amdgcn_readfirstlane(T[e]);
            const int s0 = __builtin_amdgcn_readfirstlane(T[256 + e]) + mt * 256;
            u.a = (const char*)(ws + WS_HID) + (size_t)s0 * 512; u.b = (const char*)(ws + WS_EXPD) + ((size_t)e * 1024 + pn * 256) * 512;
            u.i0 = s0; u.i1 = min(256, cnt - mt * 256); u.i2 = 0; u.ldd = pn * 256;
        } else {
            const int j = L - 4 * TR, mt = j >> 2, pn = j & 3;
            u.a = (const char*)(ws + WS_HID) + (size_t)(262144 + mt * 256) * 512; u.b = (const char*)(ws + WS_BT_SHD) + (size_t)(pn * 256) * 512;
            u.i0 = mt * 256; u.i1 = 256; u.i2 = 1; u.ldd = pn * 256;
        }
        return true;
    }
};

DEVI void conv_tile(const float* src, int ldsrc, int ncols, bf16_t* dst, int ldd, int k0, int row0, int ilv, LAS float* t) {
    const int tid = threadIdx.x;
    f32x4 v[8];
#pragma unroll
    for (int i = 0; i < 8; ++i) { const int f = tid + 512 * i, row = f >> 6, c4 = (f & 63) * 4;
        v[i] = (c4 < ncols) ? *(const f32x4*)(src + (size_t)(k0 + row) * ldsrc + c4) : (f32x4){0.f, 0.f, 0.f, 0.f}; }
#pragma unroll
    for (int i = 0; i < 8; ++i) { const int f = tid + 512 * i, row = f >> 6, c4 = (f & 63) * 4; LAS float* q = t + row * 257 + c4; q[0] = v[i][0]; q[1] = v[i][1]; q[2] = v[i][2]; q[3] = v[i][3]; }
    __syncthreads();
#pragma unroll
    for (int j = 0; j < 4; ++j) {
        const int p = tid + 512 * j, kp = p & 7, n = p >> 3;
        if (n < ncols) {
            const LAS float* q = t + (kp * 8) * 257 + n;
            u32x4 w; w.x = pk_bf16(q[0], q[257]); w.y = pk_bf16(q[2 * 257], q[3 * 257]); w.z = pk_bf16(q[4 * 257], q[5 * 257]); w.w = pk_bf16(q[6 * 257], q[7 * 257]);
            const int drow = row0 + (ilv >= 0 ? ((n >> 7) * 256 + (n & 127) + ilv) : n);
            *(u32x4*)(dst + (size_t)drow * ldd + k0 + kp * 8) = w;
        }
    }
    __syncthreads();
}

DEVI void phase0(const Params& p, LAS unsigned char* lds, int part) {
    const int tid = threadIdx.x, lane = tid & 63, wid = tid >> 6;
    unsigned char* ws = p.ws;
    const int NT_IN = 16 * (2 + 2 + 2 + 2 + 4 + 4 + 4 + 2 + 4 + 1);
    const int NT0 = NT_IN + 8 * 4 + 16 * 4 + 16 * 4 + 16 + 16 + 16 + 4 * 4;
    for (int u = (part == 0 ? (int)blockIdx.x : 192 + (int)blockIdx.x); u < (part == 0 ? 192 : 192 + NT0); u += gridDim.x) {
        if (u < 192) {
            LAS float* sc = (LAS float*)lds; LAS float* red = (LAS float*)(lds + 9 * 1024 * 4);
            for (int i = tid; i < 9216; i += 512) { const int r = i >> 10, k = i & 1023; const float v = r < 8 ? p.in[1][r * 1024 + k] : p.in[3][k]; sc[i] = v / (1.0f + __expf(-v)); }
            __syncthreads();
            const int n0 = u * 32, col = lane & 31, rsub = lane >> 5;
            float acc[9];
#pragma unroll
            for (int r = 0; r < 9; ++r) acc[r] = 0.f;
            for (int it = 0; it < 64; ++it) { const int k = it * 16 + wid * 2 + rsub; const float w = p.in[4][(size_t)k * 6144 + n0 + col];
#pragma unroll
                for (int r = 0; r < 9; ++r) acc[r] += sc[r * 1024 + k] * w; }
#pragma unroll
            for (int r = 0; r < 9; ++r) red[((wid * 2 + rsub) * 9 + r) * 32 + col] = acc[r];
            __syncthreads();
            if (tid < 288) { const int r = tid >> 5, cc = tid & 31; float s = 0.f; for (int g = 0; g < 16; ++g) s += red[(g * 9 + r) * 32 + cc];
                ((float*)(ws + WS_MOD))[r * 6144 + n0 + cc] = s + p.in[5][n0 + cc]; }
            __syncthreads();
        } else {
            int t = u - 192; LAS float* tb = (LAS float*)lds;
            if (t < NT_IN) {
                const int kt = t & 15; int jb = t >> 4;
                int c0, r0, nc = 256;
                if (jb < 2)       { c0 = 0 + jb * 256;             r0 = 0 + jb * 256; }
                else if (jb < 4)  { c0 = 512 + (jb - 2) * 256;     r0 = 512 + (jb - 2) * 256; }
                else if (jb < 6)  { c0 = 1536 + (jb - 4) * 256;    r0 = 1024 + (jb - 4) * 256; }
                else if (jb < 8)  { c0 = 2048 + (jb - 6) * 256;    r0 = 1536 + (jb - 6) * 256; }
                else if (jb < 12) { c0 = 3584 + (jb - 8) * 256;    r0 = 2048 + (jb - 8) * 256; }
                else if (jb < 16) { c0 = 4640 + (jb - 12) * 256;   r0 = 3072 + (jb - 12) * 256; }
                else if (jb < 20) { c0 = 5664 + (jb - 16) * 256;   r0 = 4096 + (jb - 16) * 256; }
                else if (jb < 22) { c0 = 1024 + (jb - 20) * 256;   r0 = 5120 + (jb - 20) * 256; }
                else if (jb < 26) { c0 = 2560 + (jb - 22) * 256;   r0 = 5632 + (jb - 22) * 256; }
                else              { c0 = 4608; r0 = 6656; nc = 32; }
                conv_tile(p.in[6] + c0, 6688, nc, (bf16_t*)(ws + WS_BT_IN), 1024, kt * 64, r0, -1, tb);
            } else {
                t -= NT_IN;
                if (t < 32)        { const int kt = t & 7, nb = t >> 3;  conv_tile(p.in[13] + nb * 256, 1024, 256, (bf16_t*)(ws + WS_BT_BR), 1536, kt * 64, nb * 256, -1, tb); }
                else if (t < 96)   { t -= 32; const int kt = t & 15, nb = t >> 4; conv_tile(p.in[14] + nb * 256, 1024, 256, (bf16_t*)(ws + WS_BT_BR) + 512, 1536, kt * 64, nb * 256, -1, tb); }
                else if (t < 160)  { t -= 96; const int kt = t & 15, nb = t >> 4; conv_tile(p.in[15] + nb * 256, 1024, 256, (bf16_t*)(ws + WS_BT_OUT), 1024, kt * 64, nb * 256, -1, tb); }
                else if (t < 176)  { t -= 160; conv_tile(p.in[18], 256, 256, (bf16_t*)(ws + WS_BT_RT), 1024, t * 64, 0, -1, tb); }
                else if (t < 192)  { t -= 176; conv_tile(p.in[23], 256, 256, (bf16_t*)(ws + WS_BT_SHGU), 1024, t * 64, 0, 0, tb); }
                else if (t < 208)  { t -= 192; conv_tile(p.in[24], 256, 256, (bf16_t*)(ws + WS_BT_SHGU), 1024, t * 64, 0, 128, tb); }
                else               { t -= 208; const int kt = t & 3, nb = t >> 2; conv_tile(p.in[25] + nb * 256, 1024, 256, (bf16_t*)(ws + WS_BT_SHD), 256, kt * 64, nb * 256, -1, tb); }
            }
        }
    }
}

DEVI void phase1(const Params& p) {
    const float* mod = (const float*)(p.ws + WS_MOD); bf16_t* H = (bf16_t*)(p.ws + WS_H);
    for (size_t idx = (size_t)blockIdx.x * 512 + threadIdx.x; idx < (size_t)NROW * 128; idx += (size_t)gridDim.x * 512) {
        const int row = (int)(idx >> 7), k = (int)(idx & 127) * 8;
        const float* src = row < NTOK ? p.in[0] + (size_t)row * 1024 + k : p.in[2] + (size_t)(row - NTOK) * 1024 + k;
        const float* m = mod + (size_t)(row < NTOK ? (row >> 12) : 8) * 6144 + k;
        const f32x4 x0 = *(const f32x4*)src, x1 = *(const f32x4*)(src + 4), h0 = *(const f32x4*)m, h1 = *(const f32x4*)(m + 4), s0 = *(const f32x4*)(m + 1024), s1 = *(const f32x4*)(m + 1028);
        const f32x4 y0 = x0 * (s0 + 1.0f) + h0, y1 = x1 * (s1 + 1.0f) + h1;
        u32x4 w; w.x = pk_bf16(y0[0], y0[1]); w.y = pk_bf16(y0[2], y0[3]); w.z = pk_bf16(y1[0], y1[1]); w.w = pk_bf16(y1[2], y1[3]);
        *(u32x4*)(H + (size_t)row * 1024 + k) = w;
    }
}

DEVI float logsig16(float z) { return -(fmaxf(-z, 0.f) + __logf(1.0f + __expf(-fabsf(z)))) * 0.0625f; }
DEVI void phase3(const Params& p, LAS unsigned char* lds) {
    const int tid = threadIdx.x;
    unsigned char* ws = p.ws;
    LAS float* LRs = (LAS float*)lds;
    LAS float* CS = (LAS float*)(lds + 8192);
    LAS float* CUM = (LAS float*)(lds + 24576);
    LAS float* TOT = (LAS float*)(lds + 24576 + 65536);
    LAS bf16_t* KTs = (LAS bf16_t*)(lds + 24576 + 65536 + 2048);
    for (int i = tid; i < 2048; i += 512) { const int pos = i >> 5, j = i & 31; const float ang = (float)pos * powf(10000.0f, -(float)j / 32.0f); CS[2 * i] = cosf(ang); CS[2 * i + 1] = sinf(ang); }
    __syncthreads();
    const float* LRT = (const float*)(ws + WS_LRT);
    const bf16_t* QB = (const bf16_t*)(ws + WS_QB); const bf16_t* KB = (const bf16_t*)(ws + WS_KB);
    bf16_t* QTF = (bf16_t*)(ws + WS_QTF); bf16_t* QTB = (bf16_t*)(ws + WS_QTB); bf16_t* KTF = (bf16_t*)(ws + WS_KTF); bf16_t* KTB = (bf16_t*)(ws + WS_KTB);
    float* EE = (float*)(ws + WS_EE);
    for (int u = blockIdx.x; u < 8 * 68 * 4; u += gridDim.x) {
        const int h = u & 3, bs = u >> 2, b = bs / 68, slot = bs % 68; const bool isctx = slot < 4; const int chunk = slot - 4;
        const int rowbase = isctx ? NTOK + b * 256 + slot * 64 : b * 4096 + chunk * 64;
        { const int r = tid >> 4, c4 = (tid & 15) * 4; const f32x4 lv = *(const f32x4*)(LRT + (size_t)r * NROW + rowbase + c4);
          LRs[(c4 + 0) * 32 + r] = lv[0]; LRs[(c4 + 1) * 32 + r] = lv[1]; LRs[(c4 + 2) * 32 + r] = lv[2]; LRs[(c4 + 3) * 32 + r] = lv[3]; }
        __syncthreads();
        {
            const int ch = tid & 127, grp = tid >> 7, dir = grp & 1, hf = grp >> 1;
            const float* w2p = p.in[dir ? 10 : 8] + h * 128 + ch; const float b2 = p.in[dir ? 11 : 9][h * 128 + ch];
            float w2[16];
#pragma unroll
            for (int r = 0; r < 16; ++r) w2[r] = w2p[r * 512];
            float run = 0.f;
            for (int k = 0; k < 32; ++k) {
                const int i = dir ? (32 * hf + 31 - k) : (32 * hf + k);
                const LAS f32x4* lp = (const LAS f32x4*)(LRs + i * 32 + 16 * dir);
                const f32x4 l0 = lp[0], l1 = lp[1], l2 = lp[2], l3 = lp[3];
                const float z0 = (l0[0] * w2[0] + l0[1] * w2[1]) + (l0[2] * w2[2] + l0[3] * w2[3]), z1 = (l1[0] * w2[4] + l1[1] * w2[5]) + (l1[2] * w2[6] + l1[3] * w2[7]);
                const float z2 = (l2[0] * w2[8] + l2[1] * w2[9]) + (l2[2] * w2[10] + l2[3] * w2[11]), z3 = (l3[0] * w2[12] + l3[1] * w2[13]) + (l3[2] * w2[14] + l3[3] * w2[15]);
                const float z = b2 + ((z0 + z1) + (z2 + z3));
                run += logsig16(z);
                CUM[(dir * 64 + i) * 128 + ch] = run;
            }
            TOT[(dir * 2 + hf) * 128 + ch] = run;
        }
        __syncthreads();
#pragma unroll
        for (int rep = 0; rep < 2; ++rep) {
            const int q = tid + 512 * rep, i = q >> 4, c8 = q & 15, ch0 = c8 * 8;
            float cf[8], cb[8];
            {
                const f32x4 a0 = *(const LAS f32x4*)(CUM + (0 * 64 + i) * 128 + ch0), a1 = *(const LAS f32x4*)(CUM + (0 * 64 + i) * 128 + ch0 + 4);
                const f32x4 b0 = *(const LAS f32x4*)(CUM + (1 * 64 + i) * 128 + ch0), b1 = *(const LAS f32x4*)(CUM + (1 * 64 + i) * 128 + ch0 + 4);
                f32x4 tf0 = {0.f, 0.f, 0.f, 0.f}, tf1 = tf0, tb0 = tf0, tb1 = tf0;
                if (i >= 32) { tf0 = *(const LAS f32x4*)(TOT + (0 * 2 + 0) * 128 + ch0); tf1 = *(const LAS f32x4*)(TOT + (0 * 2 + 0) * 128 + ch0 + 4); }
                else         { tb0 = *(const LAS f32x4*)(TOT + (1 * 2 + 1) * 128 + ch0); tb1 = *(const LAS f32x4*)(TOT + (1 * 2 + 1) * 128 + ch0 + 4); }
#pragma unroll
                for (int e = 0; e < 4; ++e) { cf[e] = a0[e] + tf0[e]; cf[4 + e] = a1[e] + tf1[e]; cb[e] = b0[e] + tb0[e]; cb[4 + e] = b1[e] + tb1[e]; }
            }
            const size_t go = (size_t)(rowbase + i) * 512 + h * 128 + ch0;
            const u32x4 kraw = *(const u32x4*)(KB + go);
            float kv[8] = {bflo(kraw.x), bfhi(kraw.x), bflo(kraw.y), bfhi(kraw.y), bflo(kraw.z), bfhi(kraw.z), bflo(kraw.w), bfhi(kraw.w)};
            float ef[8], eb[8];
#pragma unroll
            for (int e = 0; e < 8; ++e) { ef[e] = __expf(cf[e]); eb[e] = __expf(cb[e]); }
            if (!isctx) {
                const size_t gp = (size_t)(rowbase + i) * 512 + h * 128 + ((c8 ^ 4) * 8);
                const u32x4 kpr = *(const u32x4*)(KB + gp), qraw = *(const u32x4*)(QB + go), qpr = *(const u32x4*)(QB + gp);
                const float kp[8] = {bflo(kpr.x), bfhi(kpr.x), bflo(kpr.y), bfhi(kpr.y), bflo(kpr.z), bfhi(kpr.z), bflo(kpr.w), bfhi(kpr.w)};
                const float qv[8] = {bflo(qraw.x), bfhi(qraw.x), bflo(qraw.y), bfhi(qraw.y), bflo(qraw.z), bfhi(qraw.z), bflo(qraw.w), bfhi(qraw.w)};
                const float qp[8] = {bflo(qpr.x), bfhi(qpr.x), bflo(qpr.y), bfhi(qpr.y), bflo(qpr.z), bfhi(qpr.z), bflo(qpr.w), bfhi(qpr.w)};
                const int half = c8 >> 3, isx2 = (c8 >> 2) & 1, j0 = (c8 & 3) * 8, pos = half ? i : chunk;
                float qf[8], qb[8];
                const LAS f32x4* cp = (const LAS f32x4*)(CS + (pos * 32 + j0) * 2); const f32x4 c0 = cp[0], c1 = cp[1], c2 = cp[2], c3 = cp[3];
                const float csv[8] = {c0[0], c0[2], c1[0], c1[2], c2[0], c2[2], c3[0], c3[2]}, snv[8] = {c0[1], c0[3], c1[1], c1[3], c2[1], c2[3], c3[1], c3[3]};
#pragma unroll
                for (int e = 0; e < 8; ++e) {
                    const float cs = csv[e], sn = snv[e];
                    const float rq = isx2 ? qv[e] * cs + qp[e] * sn : qv[e] * cs - qp[e] * sn;
                    kv[e] = isx2 ? kv[e] * cs + kp[e] * sn : kv[e] * cs - kp[e] * sn;
                    qf[e] = rq * 0.08838834764831845f * ef[e]; qb[e] = rq * 0.08838834764831845f * eb[e];
                }
                u32x4 wq; wq.x = pk_bf16(qf[0], qf[1]); wq.y = pk_bf16(qf[2], qf[3]); wq.z = pk_bf16(qf[4], qf[5]); wq.w = pk_bf16(qf[6], qf[7]); *(u32x4*)(QTF + go) = wq;
                wq.x = pk_bf16(qb[0], qb[1]); wq.y = pk_bf16(qb[2], qb[3]); wq.z = pk_bf16(qb[4], qb[5]); wq.w = pk_bf16(qb[6], qb[7]); *(u32x4*)(QTB + go) = wq;
            }
            float kf[8], kb[8];
#pragma unroll
            for (int e = 0; e < 8; ++e) { kf[e] = kv[e] * __builtin_amdgcn_rcpf(ef[e]); kb[e] = kv[e] * __builtin_amdgcn_rcpf(eb[e]); }
            u32x4 wf; wf.x = pk_bf16(kf[0], kf[1]); wf.y = pk_bf16(kf[2], kf[3]); wf.z = pk_bf16(kf[4], kf[5]); wf.w = pk_bf16(kf[6], kf[7]);
            u32x4 wb; wb.x = pk_bf16(kb[0], kb[1]); wb.y = pk_bf16(kb[2], kb[3]); wb.z = pk_bf16(kb[4], kb[5]); wb.w = pk_bf16(kb[6], kb[7]);
            *(u32x4*)(KTF + go) = wf; *(u32x4*)(KTB + go) = wb;
            *(LAS u32x4*)(KTs + (0 * 64 + i) * 136 + ch0) = wf; *(LAS u32x4*)(KTs + (1 * 64 + i) * 136 + ch0) = wb;
            if (i == 63) { float* ep = EE + ((size_t)(0 * 8 + b) * 68 + slot) * 512 + h * 128 + ch0; *(f32x4*)ep = (f32x4){ef[0], ef[1], ef[2], ef[3]}; *(f32x4*)(ep + 4) = (f32x4){ef[4], ef[5], ef[6], ef[7]}; }
            if (i == 0)  { float* ep = EE + ((size_t)(1 * 8 + b) * 68 + slot) * 512 + h * 128 + ch0; *(f32x4*)ep = (f32x4){eb[0], eb[1], eb[2], eb[3]}; *(f32x4*)(ep + 4) = (f32x4){eb[4], eb[5], eb[6], eb[7]}; }
        }
        __syncthreads();
#pragma unroll
        for (int rep = 0; rep < 4; ++rep) {
            const int q = tid + 512 * rep, ch = q & 127, t8 = (q >> 7) & 7, dir = q >> 10;
            const LAS bf16_t* sp = KTs + (dir * 64 + t8 * 8) * 136 + ch;
            u32x4 wv; wv.x = (unsigned)sp[0] | ((unsigned)sp[136] << 16); wv.y = (unsigned)sp[2 * 136] | ((unsigned)sp[3 * 136] << 16); wv.z = (unsigned)sp[4 * 136] | ((unsigned)sp[5 * 136] << 16); wv.w = (unsigned)sp[6 * 136] | ((unsigned)sp[7 * 136] << 16);
            *(u32x4*)((bf16_t*)(ws + (dir ? WS_KTTB : WS_KTTF)) + (size_t)(h * 128 + ch) * NROW + rowbase + t8 * 8) = wv;
        }
        __syncthreads();
    }
}

DEVI int gla_slot(int dir, int n) { return dir == 0 ? n : (n < 4 ? 3 - n : 71 - n); }
DEVI int gla_rowbase(int b, int slot) { return slot >= 4 ? b * 4096 + (slot - 4) * 64 : NTOK + b * 256 + slot * 64; }
DEVI void phase4_gla(const Params& p, LAS unsigned char* lds) {
    const int tid = threadIdx.x, lane = tid & 63, w = tid >> 6, l15 = lane & 15, fq = lane >> 4;
    unsigned char* ws = p.ws;
    LAS unsigned char* TQ = lds;
    LAS unsigned char* TK = lds + 32768;
    LAS unsigned char* TV = lds + 65536;
    LAS bf16_t* PM = (LAS bf16_t*)(lds + 81920);
    LAS bf16_t* SB = (LAS bf16_t*)(lds + 81920 + 9216);
    const bf16_t* VBT = (const bf16_t*)(ws + WS_VBT);
    const float* EE = (const float*)(ws + WS_EE);
    const int qr0 = tid >> 4, qp = tid & 15, vr = tid >> 3, vp = tid & 7;
    const int qoff0 = qr0 * 256 + ((qp ^ (qr0 & 15)) << 4), qoff1 = (qr0 + 32) * 256 + ((qp ^ ((qr0 + 32) & 15)) << 4);
    const int voff = vr * 128 + ((vp ^ ((vr >> 1) & 7)) << 4);
    struct PSet { u32x4 q0, q1, k0, k1, v; };
    struct KSet { bf16x8 a, b; f32x4 e; };
    for (int u = blockIdx.x; u < 256; u += gridDim.x) {
        const int xg = u & 7, kg = u >> 3, g = xg * 8 + (kg >> 2), dvq = kg & 3, dir = g & 1, h = (g >> 1) & 3, b = g >> 3;
        const bf16_t* QT = (const bf16_t*)(ws + (dir ? WS_QTB : WS_QTF)); const bf16_t* KT = (const bf16_t*)(ws + (dir ? WS_KTB : WS_KTF)); const bf16_t* KTT = (const bf16_t*)(ws + (dir ? WS_KTTB : WS_KTTF));
        bf16_t* OUT = (bf16_t*)(ws + (dir ? WS_OB : WS_OF));
        const int vrow0 = h * 256 + dvq * 64, krow0 = h * 128, kcol0 = h * 128;
        const float* EEu = EE + (size_t)(dir * 8 + b) * 68 * 512 + h * 128 + 16 * w + 4 * fq;
        const bf16_t* vsrc = VBT + (size_t)(vrow0 + vr) * NROW + vp * 8;
        const bf16_t* ktsrc = KTT + (size_t)(krow0 + 16 * w + l15) * NROW + 8 * fq;
        const size_t qsrc = (size_t)qr0 * 512 + kcol0 + qp * 8;
        f32x4 S[4];
#pragma unroll
        for (int i = 0; i < 4; ++i) S[i] = (f32x4){0.f, 0.f, 0.f, 0.f};
        PSet P0, P1; KSet K0, K1;
        P0.q0 = P0.q1 = P0.k0 = P0.k1 = P0.v = (u32x4){0u, 0u, 0u, 0u}; P1 = P0;
        auto load_p = [&](PSet& P, int n) {
            const int slot = gla_slot(dir, n), rb = gla_rowbase(b, slot);
            P.v = *(const u32x4*)(vsrc + rb);
            if (slot >= 4) { P.q0 = *(const u32x4*)(QT + (size_t)rb * 512 + qsrc); P.q1 = *(const u32x4*)(QT + (size_t)(rb + 32) * 512 + qsrc);
                             P.k0 = *(const u32x4*)(KT + (size_t)rb * 512 + qsrc); P.k1 = *(const u32x4*)(KT + (size_t)(rb + 32) * 512 + qsrc); }
        };
        auto store_p = [&](const PSet& P, int n) {
            const int slot = gla_slot(dir, n), bufo = n & 1;
            *(LAS u32x4*)(TV + bufo * 8192 + voff) = P.v;
            if (slot >= 4) { *(LAS u32x4*)(TQ + bufo * 16384 + qoff0) = P.q0; *(LAS u32x4*)(TQ + bufo * 16384 + qoff1) = P.q1; *(LAS u32x4*)(TK + bufo * 16384 + qoff0) = P.k0; *(LAS u32x4*)(TK + bufo * 16384 + qoff1) = P.k1; }
        };
        auto load_k = [&](KSet& K, int n) {
            const int slot = gla_slot(dir, n), rb = gla_rowbase(b, slot);
            K.a = *(const bf16x8*)(ktsrc + rb); K.b = *(const bf16x8*)(ktsrc + rb + 32); K.e = *(const f32x4*)(EEu + (size_t)slot * 512);
        };
        load_p(P0, 0); load_k(K0, 0); load_k(K1, 1); load_p(P1, 1);
        __syncthreads();
        store_p(P0, 0);
        auto step = [&](int n, PSet& Pload, const PSet& Pstore, KSet& K) {
            const int slot = gla_slot(dir, n); const bool lat = slot >= 4; const int rowbase = gla_rowbase(b, slot);
            const int cur = n & 1, nxt = cur ^ 1;
            LAS unsigned char* tq = TQ + cur * 16384; LAS unsigned char* tk = TK + cur * 16384; LAS unsigned char* tv = TV + cur * 8192;
            LAS bf16_t* sbc = SB + cur * 64 * 136; LAS bf16_t* sbn = SB + nxt * 64 * 136;
            lds_barrier();
            if (n + 2 < 68) load_p(Pload, n + 2);
            if (lat) {
                const int jt = w >> 1, it0 = 2 * (w & 1);
                f32x4 c0 = {0.f, 0.f, 0.f, 0.f}, c1 = {0.f, 0.f, 0.f, 0.f};
                const int rj = 16 * jt + l15, ri0 = 16 * it0 + l15, ri1 = ri0 + 16;
                bf16x8 fa[4], fb0[4], fb1[4];
#pragma unroll
                for (int ks = 0; ks < 4; ++ks) { const int pc = 4 * ks + fq;
                    fa[ks] = *(const LAS bf16x8*)(tk + rj * 256 + ((pc ^ l15) << 4)); fb0[ks] = *(const LAS bf16x8*)(tq + ri0 * 256 + ((pc ^ l15) << 4)); fb1[ks] = *(const LAS bf16x8*)(tq + ri1 * 256 + ((pc ^ l15) << 4)); }
                __builtin_amdgcn_sched_barrier(0);
#pragma unroll
                for (int ks = 0; ks < 4; ++ks) { c0 = __builtin_amdgcn_mfma_f32_16x16x32_bf16(fa[ks], fb0[ks], c0, 0, 0, 0); c1 = __builtin_amdgcn_mfma_f32_16x16x32_bf16(fa[ks], fb1[ks], c1, 0, 0, 0); }
#pragma unroll
                for (int r = 0; r < 4; ++r) { const int j = 16 * jt + 4 * fq + r;
                    const bool k0 = dir == 0 ? (j <= ri0) : (j >= ri0), k1 = dir == 0 ? (j <= ri1) : (j >= ri1);
                    c0[r] = k0 ? c0[r] : 0.f; c1[r] = k1 ? c1[r] : 0.f; }
                u32x2 w0; w0.x = pk_bf16(c0[0], c0[1]); w0.y = pk_bf16(c0[2], c0[3]); u32x2 w1; w1.x = pk_bf16(c1[0], c1[1]); w1.y = pk_bf16(c1[2], c1[3]);
                *(LAS u32x2*)(PM + ri0 * 72 + 16 * jt + 4 * fq) = w0; *(LAS u32x2*)(PM + ri1 * 72 + 16 * jt + 4 * fq) = w1;
            }
            lds_barrier();
            bf16x8 V[4][2];
#pragma unroll
            for (int dvt = 0; dvt < 4; ++dvt)
#pragma unroll
                for (int ks = 0; ks < 2; ++ks) { const int row = 16 * dvt + l15, pc = 4 * ks + fq; V[dvt][ks] = *(const LAS bf16x8*)(tv + row * 128 + ((pc ^ ((row >> 1) & 7)) << 4)); }
            __builtin_amdgcn_sched_barrier(0);
            if (lat) {
                const int it = w >> 1, dv0 = 2 * (w & 1), ri = 16 * it + l15;
                f32x4 o0 = {0.f, 0.f, 0.f, 0.f}, o1 = {0.f, 0.f, 0.f, 0.f};
                bf16x8 pB[2], pA0[2], pA1[2], sA0[4], sA1[4], sB[4];
                const LAS bf16_t* s0 = sbc + (16 * dv0 + l15) * 136 + 8 * fq; const LAS bf16_t* s1 = s0 + 16 * 136;
#pragma unroll
                for (int ks = 0; ks < 2; ++ks) { pB[ks] = *(const LAS bf16x8*)(PM + ri * 72 + 32 * ks + 8 * fq);
                    const int r0 = 16 * dv0 + l15, r1 = r0 + 16, pc = 4 * ks + fq;
                    pA0[ks] = *(const LAS bf16x8*)(tv + r0 * 128 + ((pc ^ ((r0 >> 1) & 7)) << 4)); pA1[ks] = *(const LAS bf16x8*)(tv + r1 * 128 + ((pc ^ ((r1 >> 1) & 7)) << 4)); }
#pragma unroll
                for (int ks = 0; ks < 4; ++ks) { const int pc = 4 * ks + fq;
                    sA0[ks] = *(const LAS bf16x8*)(s0 + 32 * ks); sA1[ks] = *(const LAS bf16x8*)(s1 + 32 * ks); sB[ks] = *(const LAS bf16x8*)(tq + ri * 256 + ((pc ^ l15) << 4)); }
                __builtin_amdgcn_sched_barrier(0);
#pragma unroll
                for (int ks = 0; ks < 2; ++ks) { o0 = __builtin_amdgcn_mfma_f32_16x16x32_bf16(pA0[ks], pB[ks], o0, 0, 0, 0); o1 = __builtin_amdgcn_mfma_f32_16x16x32_bf16(pA1[ks], pB[ks], o1, 0, 0, 0); }
#pragma unroll
                for (int ks = 0; ks < 4; ++ks) { o0 = __builtin_amdgcn_mfma_f32_16x16x32_bf16(sA0[ks], sB[ks], o0, 0, 0, 0); o1 = __builtin_amdgcn_mfma_f32_16x16x32_bf16(sA1[ks], sB[ks], o1, 0, 0, 0); }
                bf16_t* op = OUT + (size_t)(rowbase + ri) * 1024 + vrow0 + 16 * dv0 + 4 * fq;
                u32x2 w0; w0.x = pk_bf16(o0[0], o0[1]); w0.y = pk_bf16(o0[2], o0[3]); u32x2 w1; w1.x = pk_bf16(o1[0], o1[1]); w1.y = pk_bf16(o1[2], o1[3]);
                *(u32x2*)op = w0; *(u32x2*)(op + 16) = w1;
            }
#pragma unroll
            for (int dvt = 0; dvt < 4; ++dvt) { S[dvt] = __builtin_amdgcn_mfma_f32_16x16x32_bf16(K.a, V[dvt][0], S[dvt], 0, 0, 0); S[dvt] = __builtin_amdgcn_mfma_f32_16x16x32_bf16(K.b, V[dvt][1], S[dvt], 0, 0, 0); }
#pragma unroll
            for (int dvt = 0; dvt < 4; ++dvt) { S[dvt] = S[dvt] * K.e;
                u32x2 o; o.x = pk_bf16(S[dvt][0], S[dvt][1]); o.y = pk_bf16(S[dvt][2], S[dvt][3]);
                *(LAS u32x2*)(sbn + (16 * dvt + l15) * 136 + 16 * w + 4 * fq) = o; }
            if (n + 2 < 68) load_k(K, n + 2);
            if (n + 1 < 68) store_p(Pstore, n + 1);
        };
#pragma unroll 1
        for (int n = 0; n < 68; n += 2) { step(n, P0, P1, K0); step(n + 1, P1, P0, K1); }
        __syncthreads();
    }
}

DEVI void phase4_na(const Params& p, LAS unsigned char* lds) {
    const int tid = threadIdx.x; const int wsg = __builtin_amdgcn_readfirstlane(tid >> 6);
    unsigned char* ws = p.ws;
    LAS unsigned char* CK = lds;
    LAS unsigned char* CV = lds + 32768;
    LAS float* RP = (LAS float*)(lds + 65536);
    const bf16_t* QA = (const bf16_t*)(ws + WS_QA); const bf16_t* KA = (const bf16_t*)(ws + WS_KA); const bf16_t* VAT = (const bf16_t*)(ws + WS_VAT);
    bf16_t* OA = (bf16_t*)(ws + WS_AP);
    for (int u = blockIdx.x; u < 512; u += gridDim.x) {
        const int xg = u & 7, idx = u >> 3, bh = xg * 8 + (idx >> 3), rblk = idx & 7, h = bh & 7, b = bh >> 3;
        __syncthreads();
        for (int i = tid; i < 465; i += 512) RP[(i / 31) * 80 + 24 + (i % 31)] = p.in[7][h * 465 + i];
        int tz = tid; asm volatile("" : "+v"(tz));
#pragma unroll
        for (int rep = 0; rep < 4; ++rep) {
            const int q = tz + 512 * rep;
            { const int row = q >> 3, pc = q & 7; *(LAS u32x4*)(CK + row * 128 + ((pc ^ ((row >> 1) & 7)) << 4)) = *(const u32x4*)(KA + (size_t)(NTOK + b * 256 + row) * 512 + h * 64 + pc * 8); }
            { const int row = q >> 5, pc = q & 31; const u32x4 v = *(const u32x4*)(VAT + (size_t)(h * 64 + row) * NROW + NTOK + b * 256 + pc * 8);
              const int sw = (row & 15) << 1; u32x2 lo; lo.x = v.x; lo.y = v.y; u32x2 hi; hi.x = v.z; hi.y = v.w;
              *(LAS u32x2*)(CV + row * 512 + (((2 * pc) ^ sw) << 3)) = lo; *(LAS u32x2*)(CV + row * 512 + (((2 * pc + 1) ^ sw) << 3)) = hi; }
        }
        __syncthreads();
#pragma unroll 1
        for (int qt = 0; qt < 4; ++qt) {
            int lane = (int)__builtin_amdgcn_mbcnt_hi(~0u, __builtin_amdgcn_mbcnt_lo(~0u, 0u)); asm volatile("" : "+v"(lane));
            const int w = wsg, l15 = lane & 15, fq = lane >> 4, r = rblk * 8 + w, rs = min(max(r - 4, 0), 56);
            const int kc0 = min(max(16 * qt - 8, 0), 32);
            const int c = 16 * qt + l15, cs = min(max(c - 8, 0), 48);
            const bf16_t* qp = QA + (size_t)(b * 4096 + r * 64 + c) * 512 + h * 64 + 8 * fq;
            const bf16x8 Bq0 = *(const bf16x8*)qp, Bq1 = *(const bf16x8*)(qp + 32);
            const int lo = 15 + cs - c, d00 = kc0 - 16 * qt + 4 * fq - l15 + 15;
            const LAS unsigned char* rpl = (const LAS unsigned char*)RP + ((rs - r + 7) * 80 + 24 + d00) * 4;
            const char* kbase = (const char*)(KA + (size_t)(b * 4096 + rs * 64 + kc0) * 512 + h * 64); const unsigned klane = (unsigned)(l15 * 512 + 8 * fq) * 2u;
            const char* vbase = (const char*)(VAT + (size_t)(h * 64) * NROW + b * 4096 + rs * 64 + kc0); const unsigned vlane = (unsigned)(l15 * NROW + 4 * fq) * 2u;
#define NA_SB __builtin_amdgcn_sched_barrier(0)
            f32x4 sc[16];
#pragma unroll
            for (int hb = 0; hb < 4; ++hb) {
                bf16x8 kf[4][2];
#pragma unroll
                for (int tt = 0; tt < 4; ++tt) { const int t = 4 * hb + tt, kr = t >> 1, chh = t & 1; const char* kp = (kbase + (size_t)((kr * 64 + 16 * chh) * 1024)) + klane;
                    kf[tt][0] = *(const bf16x8*)kp; kf[tt][1] = *(const bf16x8*)(kp + 64); }
                NA_SB;
#pragma unroll
                for (int tt = 0; tt < 4; ++tt) { const int t = 4 * hb + tt, kr = t >> 1, chh = t & 1;
                    f32x4 a = {0.f, 0.f, 0.f, 0.f};
                    a = __builtin_amdgcn_mfma_f32_16x16x32_bf16(kf[tt][0], Bq0, a, 0, 0, 0); a = __builtin_amdgcn_mfma_f32_16x16x32_bf16(kf[tt][1], Bq1, a, 0, 0, 0);
#pragma unroll
                    for (int j = 0; j < 4; ++j) { const float bias = *(const LAS float*)(rpl + chh * 64 + kr * 320 + j * 4); a[j] = ((unsigned)(d00 + 16 * chh + j - lo) <= 15u) ? a[j] + bias : -INFINITY; }
                    sc[t] = a; }
                NA_SB;
            }
            u32x2 va0[2][4], va1[2][4];
            auto ld_vloc = [&](int uu0) {
#pragma unroll
                for (int q = 0; q < 2; ++q)
#pragma unroll
                    for (int mt = 0; mt < 4; ++mt) { const char* vp = (vbase + (size_t)((16 * mt * NROW + (uu0 + q) * 64) * 2)) + vlane; va0[q][mt] = *(const u32x2*)vp; va1[q][mt] = *(const u32x2*)(vp + 32); } };
            ld_vloc(0);
            NA_SB;
            float mA = -INFINITY;
#pragma unroll
            for (int t = 0; t < 16; ++t) mA = fmaxf(mA, fmaxf(fmaxf(sc[t][0], sc[t][1]), fmaxf(sc[t][2], sc[t][3])));
            mA = fmaxf(mA, __shfl_xor(mA, 16)); mA = fmaxf(mA, __shfl_xor(mA, 32));
            float lA = 0.f; u32x2 pp[16];
#pragma unroll
            for (int t = 0; t < 16; ++t) { const float e0 = __expf(sc[t][0] - mA), e1 = __expf(sc[t][1] - mA), e2 = __expf(sc[t][2] - mA), e3 = __expf(sc[t][3] - mA);
                lA += (e0 + e1) + (e2 + e3); pp[t].x = pk_bf16(e0, e1); pp[t].y = pk_bf16(e2, e3); }
            NA_SB;
            f32x4 o[4];
#pragma unroll
            for (int mt = 0; mt < 4; ++mt) o[mt] = (f32x4){0.f, 0.f, 0.f, 0.f};
            auto mm_vloc = [&](int uu0) {
#pragma unroll
                for (int q = 0; q < 2; ++q) { const int t0 = 2 * (uu0 + q), t1 = t0 + 1;
                    union { u32x4 w; bf16x8 v; } P; P.w.x = pp[t0].x; P.w.y = pp[t0].y; P.w.z = pp[t1].x; P.w.w = pp[t1].y;
#pragma unroll
                    for (int mt = 0; mt < 4; ++mt) { union { u32x4 w; bf16x8 v; } A; A.w.x = va0[q][mt].x; A.w.y = va0[q][mt].y; A.w.z = va1[q][mt].x; A.w.w = va1[q][mt].y; o[mt] = __builtin_amdgcn_mfma_f32_16x16x32_bf16(A.v, P.v, o[mt], 0, 0, 0); } } };
            mm_vloc(0); NA_SB; ld_vloc(2); NA_SB; mm_vloc(2); NA_SB; ld_vloc(4); NA_SB; mm_vloc(4); NA_SB; ld_vloc(6); NA_SB; mm_vloc(6); NA_SB;
            int lane2 = (int)__builtin_amdgcn_mbcnt_hi(~0u, __builtin_amdgcn_mbcnt_lo(~0u, 0u)); asm volatile("" : "+v"(lane2));
            const int l15b = lane2 & 15, fqb = lane2 >> 4, cks = (l15b >> 1) & 7, ck0 = l15b * 128 + ((fqb ^ cks) << 4), ck1 = l15b * 128 + (((4 + fqb) ^ cks) << 4);
            {
                bf16x8 kfA[2][2];
                auto ld_ctx = [&](bf16x8 (&kf)[2][2], auto G) {
#pragma unroll
                    for (int tt = 0; tt < 2; ++tt) { constexpr int tile = 0; const int to = (2 * decltype(G)::v + tt) * 2048 + tile;
                        kf[tt][0] = *(const LAS bf16x8*)(CK + to + ck0); kf[tt][1] = *(const LAS bf16x8*)(CK + to + ck1); } };
                auto mm_ctx = [&](const bf16x8 (&kf)[2][2], auto G) {
#pragma unroll
                    for (int tt = 0; tt < 2; ++tt) { f32x4 a = {0.f, 0.f, 0.f, 0.f};
                        a = __builtin_amdgcn_mfma_f32_16x16x32_bf16(kf[tt][0], Bq0, a, 0, 0, 0); a = __builtin_amdgcn_mfma_f32_16x16x32_bf16(kf[tt][1], Bq1, a, 0, 0, 0);
                        sc[2 * decltype(G)::v + tt] = a; } };
#define NA_CC(G0) ld_ctx(kfA, IC<G0>{}); NA_SB; mm_ctx(kfA, IC<G0>{}); NA_SB;
                NA_CC(0) NA_CC(1) NA_CC(2) NA_CC(3) NA_CC(4) NA_CC(5) NA_CC(6) NA_CC(7)
#undef NA_CC
            }
            float mB = -INFINITY;
#pragma unroll
            for (int t = 0; t < 16; ++t) mB = fmaxf(mB, fmaxf(fmaxf(sc[t][0], sc[t][1]), fmaxf(sc[t][2], sc[t][3])));
            mB = fmaxf(mB, __shfl_xor(mB, 16)); mB = fmaxf(mB, __shfl_xor(mB, 32));
            const float mx = fmaxf(mA, mB), fA = __expf(mA - mx);
            float lB = 0.f;
#pragma unroll
            for (int t = 0; t < 16; ++t) { const float e0 = __expf(sc[t][0] - mx), e1 = __expf(sc[t][1] - mx), e2 = __expf(sc[t][2] - mx), e3 = __expf(sc[t][3] - mx);
                lB += (e0 + e1) + (e2 + e3); pp[t].x = pk_bf16(e0, e1); pp[t].y = pk_bf16(e2, e3); }
            float sum = lA * fA + lB;
            sum += __shfl_xor(sum, 16); sum += __shfl_xor(sum, 32);
            const float inv = 1.0f / sum;
#pragma unroll
            for (int mt = 0; mt < 4; ++mt) o[mt] = o[mt] * fA;
            NA_SB;
            int cvo[4][2];
#pragma unroll
            for (int rr = 0; rr < 4; ++rr)
#pragma unroll
                for (int dd = 0; dd < 2; ++dd) cvo[rr][dd] = l15b * 512 + ((((8 * rr + fqb + 4 * dd) ^ (l15b << 1)) & 31) << 3);
            {
                u32x4 vfA[4], vfB[4];
                auto ld_v = [&](u32x4 (&vq)[4], auto U) {
                    constexpr int uu = decltype(U)::v, q4 = uu >> 2, rr = uu & 3;
#pragma unroll
                    for (int mt = 0; mt < 4; ++mt) { const u32x2 a0 = *(const LAS u32x2*)(CV + mt * 8192 + q4 * 256 + cvo[rr][0]), a1 = *(const LAS u32x2*)(CV + mt * 8192 + q4 * 256 + cvo[rr][1]); vq[mt] = (u32x4){a0.x, a0.y, a1.x, a1.y}; } };
                auto mm_v = [&](const u32x4 (&vq)[4], auto U) {
                    constexpr int uu = decltype(U)::v, t0 = 2 * uu, t1 = 2 * uu + 1;
                    union { u32x4 w; bf16x8 v; } P; P.w.x = pp[t0].x; P.w.y = pp[t0].y; P.w.z = pp[t1].x; P.w.w = pp[t1].y;
#pragma unroll
                    for (int mt = 0; mt < 4; ++mt) { union { u32x4 w; bf16x8 v; } A; A.w = vq[mt]; o[mt] = __builtin_amdgcn_mfma_f32_16x16x32_bf16(A.v, P.v, o[mt], 0, 0, 0); } };
#define NA_PV(U0, U1, U2, U3) mm_v(vfA, IC<U0>{}); NA_SB; ld_v(vfA, IC<U2>{}); NA_SB; mm_v(vfB, IC<U1>{}); NA_SB; ld_v(vfB, IC<U3>{}); NA_SB;
                ld_v(vfA, IC<0>{}); ld_v(vfB, IC<1>{}); NA_SB;
                NA_PV(0, 1, 2, 3) NA_PV(2, 3, 4, 5) NA_PV(4, 5, 6, 7)
                mm_v(vfA, IC<6>{}); NA_SB; mm_v(vfB, IC<7>{}); NA_SB;
#undef NA_PV
            }
#undef NA_SB
            bf16_t* op = OA + (size_t)(b * 4096 + r * 64 + c) * 1536 + h * 64 + 4 * fq;
#pragma unroll
            for (int mt = 0; mt < 4; ++mt) { u32x2 wv; wv.x = pk_bf16(o[mt][0] * inv, o[mt][1] * inv); wv.y = pk_bf16(o[mt][2] * inv, o[mt][3] * inv); *(u32x2*)(op + 16 * mt) = wv; }
        }
    }
}

DEVI void phase5(const Params& p) {
    const int lane = threadIdx.x & 63, gw = blockIdx.x * 8 + (threadIdx.x >> 6), nw = gridDim.x * 8;
    const bf16_t* OF = (const bf16_t*)(p.ws + WS_OF); const bf16_t* OB = (const bf16_t*)(p.ws + WS_OB); const bf16_t* GB = (const bf16_t*)(p.ws + WS_GB); bf16_t* AP = (bf16_t*)(p.ws + WS_AP);
    for (int tok = gw; tok < NTOK; tok += nw) {
#pragma unroll
        for (int hh = 0; hh < 2; ++hh) {
            const int col = hh * 512 + lane * 8;
            const size_t o = (size_t)tok * 1024 + col;
            const u32x4 a = *(const u32x4*)(OF + o), bb = *(const u32x4*)(OB + o), g = *(const u32x4*)(GB + o);
            float v[8] = {bflo(a.x) + bflo(bb.x), bfhi(a.x) + bfhi(bb.x), bflo(a.y) + bflo(bb.y), bfhi(a.y) + bfhi(bb.y), bflo(a.z) + bflo(bb.z), bfhi(a.z) + bfhi(bb.z), bflo(a.w) + bflo(bb.w), bfhi(a.w) + bfhi(bb.w)};
            float ss = 0.f;
#pragma unroll
            for (int e = 0; e < 8; ++e) ss += v[e] * v[e];
            ss += __shfl_xor(ss, 16); ss += __shfl_xor(ss, 8); ss += __shfl_xor(ss, 4); ss += __shfl_xor(ss, 2); ss += __shfl_xor(ss, 1);
            const float rs = rsqrtf(ss * (1.0f / 256.0f) + 1e-6f);
            const f32x4 n0 = *(const f32x4*)(p.in[12] + col), n1 = *(const f32x4*)(p.in[12] + col + 4);
            const float gg[8] = {bflo(g.x), bfhi(g.x), bflo(g.y), bfhi(g.y), bflo(g.z), bfhi(g.z), bflo(g.w), bfhi(g.w)};
            float r[8];
#pragma unroll
            for (int e = 0; e < 8; ++e) r[e] = v[e] * rs * (e < 4 ? n0[e & 3] : n1[e & 3]) * (gg[e] * sigmoidf_(gg[e]));
            u32x4 wv; wv.x = pk_bf16(r[0], r[1]); wv.y = pk_bf16(r[2], r[3]); wv.z = pk_bf16(r[4], r[5]); wv.w = pk_bf16(r[6], r[7]);
            *(u32x4*)(AP + (size_t)tok * 1536 + 512 + col) = wv;
        }
    }
}

DEVI void ln_row(f32x4 (&v)[4], const float* g, const float* bta, int lane) {
    float s = 0.f;
#pragma unroll
    for (int j = 0; j < 4; ++j) s += (v[j][0] + v[j][1]) + (v[j][2] + v[j][3]);
    const float mu = wave_sum(s) * (1.0f / 1024.0f);
    float q = 0.f;
#pragma unroll
    for (int j = 0; j < 4; ++j) { v[j] = v[j] - mu; q += (v[j][0] * v[j][0] + v[j][1] * v[j][1]) + (v[j][2] * v[j][2] + v[j][3] * v[j][3]); }
    const float rstd = rsqrtf(wave_sum(q) * (1.0f / 1024.0f) + 1e-6f);
#pragma unroll
    for (int j = 0; j < 4; ++j) { const f32x4 gg = *(const f32x4*)(g + lane * 4 + 256 * j), bb = *(const f32x4*)(bta + lane * 4 + 256 * j); v[j] = v[j] * rstd * gg + bb; }
}
DEVI void phase9(const Params& p) {
    const int lane = threadIdx.x & 63, gw = blockIdx.x * 8 + (threadIdx.x >> 6), nw = gridDim.x * 8;
    const float* mod = (const float*)(p.ws + WS_MOD); const bf16_t* Z = (const bf16_t*)(p.ws + WS_Z); bf16_t* X1 = (bf16_t*)(p.ws + WS_X1); bf16_t* H2 = (bf16_t*)(p.ws + WS_H2);
    for (int tok = gw; tok < NTOK; tok += nw) {
        const float* m = mod + (size_t)(tok >> 12) * 6144; float v[2][8];
#pragma unroll
        for (int j = 0; j < 2; ++j) { const int cidx = lane * 8 + 512 * j;
            const f32x4 x0 = *(const f32x4*)(p.in[0] + (size_t)tok * 1024 + cidx), x1 = *(const f32x4*)(p.in[0] + (size_t)tok * 1024 + cidx + 4), g0 = *(const f32x4*)(m + 2048 + cidx), g1 = *(const f32x4*)(m + 2048 + cidx + 4);
            const u32x4 z = *(const u32x4*)(Z + (size_t)tok * 1024 + cidx);
            float zf[8] = {bflo(z.x), bfhi(z.x), bflo(z.y), bfhi(z.y), bflo(z.z), bfhi(z.z), bflo(z.w), bfhi(z.w)};
#if defined(DBG_NOMIX)
#pragma unroll
            for (int e = 0; e < 8; ++e) zf[e] = 0.f;
#endif
#pragma unroll
            for (int e = 0; e < 4; ++e) { v[j][e] = x0[e] * 1.189207115f + g0[e] * zf[e]; v[j][4 + e] = x1[e] * 1.189207115f + g1[e] * zf[4 + e]; }
        }
        float sm = 0.f;
#pragma unroll
        for (int j = 0; j < 2; ++j)
#pragma unroll
            for (int e = 0; e < 8; ++e) sm += v[j][e];
        const float mu = wave_sum(sm) * (1.0f / 1024.0f); float q = 0.f;
#pragma unroll
        for (int j = 0; j < 2; ++j)
#pragma unroll
            for (int e = 0; e < 8; ++e) { v[j][e] -= mu; q += v[j][e] * v[j][e]; }
        const float rstd = rsqrtf(wave_sum(q) * (1.0f / 1024.0f) + 1e-6f);
#pragma unroll
        for (int j = 0; j < 2; ++j) { const int cidx = lane * 8 + 512 * j;
            const f32x4 g0 = *(const f32x4*)(p.in[16] + cidx), g1 = *(const f32x4*)(p.in[16] + cidx + 4), b0 = *(const f32x4*)(p.in[17] + cidx), b1 = *(const f32x4*)(p.in[17] + cidx + 4);
            const f32x4 sh0 = *(const f32x4*)(m + 3072 + cidx), sh1 = *(const f32x4*)(m + 3072 + cidx + 4), sc0 = *(const f32x4*)(m + 4096 + cidx), sc1 = *(const f32x4*)(m + 4096 + cidx + 4);
            f32x4 o0, o1; float hv[8];
#pragma unroll
            for (int e = 0; e < 4; ++e) { o0[e] = v[j][e] * rstd * g0[e] + b0[e]; o1[e] = v[j][4 + e] * rstd * g1[e] + b1[e]; hv[e] = o0[e] * (sc0[e] + 1.0f) + sh0[e]; hv[4 + e] = o1[e] * (sc1[e] + 1.0f) + sh1[e]; }
            { u32x4 xv; xv.x = pk_bf16(o0[0], o0[1]); xv.y = pk_bf16(o0[2], o0[3]); xv.z = pk_bf16(o1[0], o1[1]); xv.w = pk_bf16(o1[2], o1[3]); *(u32x4*)(X1 + (size_t)tok * 1024 + cidx) = xv; }
            u32x4 wv; wv.x = pk_bf16(hv[0], hv[1]); wv.y = pk_bf16(hv[2], hv[3]); wv.z = pk_bf16(hv[4], hv[5]); wv.w = pk_bf16(hv[6], hv[7]);
            *(u32x4*)(H2 + (size_t)tok * 1024 + cidx) = wv; }
    }
}
DEVI void phase11(const Params& p, LAS unsigned char* lds, int tok_begin) {
    const int lane = threadIdx.x & 63, half = lane >> 5, tw0 = tok_begin + (threadIdx.x >> 6) * 32;
    LAS unsigned* LC = (LAS unsigned*)(lds + LDS_TAB); LAS unsigned* LB = LC + 256;
    if (threadIdx.x < 256) LC[threadIdx.x] = 0u;
    __syncthreads();
    const float* L0 = (const float*)(p.ws + WS_LOG0);
    int* TID = (int*)(p.ws + WS_TOPK_ID); float* TW = (float*)(p.ws + WS_TOPK_W); int* TP = (int*)(p.ws + WS_TOPK_POS); unsigned* CNT = (unsigned*)(p.ws + WS_CNT);
    float rb[4];
#pragma unroll
    for (int j = 0; j < 4; ++j) rb[j] = p.in[19][lane + 64 * j];
    for (int tok = tw0; tok < tw0 + 32; ++tok) {
        float s[4], bz[4], gs[4];
#pragma unroll
        for (int j = 0; j < 4; ++j) { const float lg = L0[(size_t)tok * 256 + lane + 64 * j]; s[j] = __builtin_amdgcn_rcpf(1.0f + __expf(-lg)); bz[j] = s[j] + rb[j]; }
#pragma unroll
        for (int j = 0; j < 4; ++j) { float m1 = bz[j], m2 = -INFINITY;
#define TOP2_STEP(P1, P2) { const float p1 = (P1), p2 = (P2); const float n1 = fmaxf(m1, p1), n2 = fmaxf(fminf(m1, p1), fmaxf(m2, p2)); m1 = n1; m2 = n2; }
            TOP2_STEP(dppf<DPP_X1>(m1), dppf<DPP_X1>(m2)) TOP2_STEP(dppf<DPP_X2>(m1), dppf<DPP_X2>(m2)) TOP2_STEP(dppf<DPP_HM>(m1), dppf<DPP_HM>(m2)) TOP2_STEP(dppf<DPP_RM>(m1), dppf<DPP_RM>(m2)) TOP2_STEP(x16f(m1, lane), x16f(m2, lane))
#undef TOP2_STEP
            gs[j] = m1 + m2; }
        float Gv[8];
#pragma unroll
        for (int j = 0; j < 4; ++j) { const float oth = x32f(gs[j], lane); Gv[2 * j] = half ? oth : gs[j]; Gv[2 * j + 1] = half ? gs[j] : oth; }
        bool keep[8];
#pragma unroll
        for (int g = 0; g < 8; ++g) { int rank = 0;
#pragma unroll
            for (int g2 = 0; g2 < 8; ++g2) rank += (Gv[g2] > Gv[g] || (Gv[g2] == Gv[g] && g2 < g)) ? 1 : 0;
            keep[g] = rank < 4; }
        unsigned key[4];
#pragma unroll
        for (int j = 0; j < 4; ++j) { const bool k = half ? keep[2 * j + 1] : keep[2 * j]; key[j] = k ? ((__float_as_uint(bz[j] + 1.0f) & 0xFFFFFF00u) | (unsigned)(255 - (lane + 64 * j))) : 0u; }
        int myE = 0;
#pragma unroll
        for (int it = 0; it < 8; ++it) {
            unsigned k = max(max(key[0], key[1]), max(key[2], key[3]));
            k = max(k, (unsigned)dppi<DPP_X1>((int)k)); k = max(k, (unsigned)dppi<DPP_X2>((int)k)); k = max(k, (unsigned)dppi<DPP_HM>((int)k)); k = max(k, (unsigned)dppi<DPP_RM>((int)k));
            k = max(k, (unsigned)x16i((int)k, lane)); k = max(k, (unsigned)x32i((int)k, lane));
#pragma unroll
            for (int j = 0; j < 4; ++j) key[j] = key[j] == k ? 0u : key[j];
            if (lane == it) myE = 255 - (int)(k & 255u);
        }
        float sv;
        { const int src = (myE & 63) << 2, jsel = myE >> 6;
          const float a0 = __builtin_bit_cast(float, __builtin_amdgcn_ds_bpermute(src, __builtin_bit_cast(int, s[0]))), a1 = __builtin_bit_cast(float, __builtin_amdgcn_ds_bpermute(src, __builtin_bit_cast(int, s[1])));
          const float a2 = __builtin_bit_cast(float, __builtin_amdgcn_ds_bpermute(src, __builtin_bit_cast(int, s[2]))), a3 = __builtin_bit_cast(float, __builtin_amdgcn_ds_bpermute(src, __builtin_bit_cast(int, s[3])));
          sv = jsel == 0 ? a0 : (jsel == 1 ? a1 : (jsel == 2 ? a2 : a3)); }
        float ssum = lane < 8 ? sv : 0.f;
        ssum += dppf<DPP_X1>(ssum); ssum += dppf<DPP_X2>(ssum); ssum += dppf<DPP_HM>(ssum);
        if (lane < 8) { const int idx = tok * 8 + lane; TID[idx] = myE; TW[idx] = sv / ssum * 2.5f; TP[idx] = (int)__hip_atomic_fetch_add(LC + myE, 1u, __ATOMIC_RELAXED, __HIP_MEMORY_SCOPE_WORKGROUP); }
    }
    __syncthreads();
    if (threadIdx.x < 256) { const unsigned cnt = LC[threadIdx.x]; LB[threadIdx.x] = cnt ? atomicAdd(&CNT[threadIdx.x], cnt) : 0u; }
    __syncthreads();
    for (int tok = tw0; tok < tw0 + 32; ++tok) if (lane < 8) { const int idx = tok * 8 + lane; TP[idx] += (int)LB[TID[idx]]; }
}
DEVI void phase12(const Params& p, LAS unsigned char* lds, int part) {
    if (part == 0) {
    LAS int* T = (LAS int*)(lds + LDS_TAB);
    moe_tables((const unsigned*)(p.ws + WS_CNT), T);
    const int* TID = (const int*)(p.ws + WS_TOPK_ID); const int* TP = (const int*)(p.ws + WS_TOPK_POS); int* TPw = (int*)(p.ws + WS_TOPK_POS); const float* TW = (const float*)(p.ws + WS_TOPK_W); u32x2* SL = (u32x2*)(p.ws + WS_SLOT);
    for (int idx = blockIdx.x * 512 + threadIdx.x; idx < NTOK * 8; idx += gridDim.x * 512) { const int slot_ = T[256 + TID[idx]] + TP[idx]; u32x2 rec; rec.x = (unsigned)idx; rec.y = __float_as_uint(TW[idx]); SL[slot_] = rec; TPw[idx] = slot_; }
    return; }
    LAS float* tb = (LAS float*)lds;
    const bool even_split = gridDim.x == 256; const int cb = blockIdx.x;
    const int t_lo = even_split ? (cb < 128 ? cb * 36 : 4608 + (cb - 128) * 60) : cb, t_hi = even_split ? t_lo + (cb < 128 ? 36 : 60) : 256 * 48, t_st = even_split ? 1 : (int)gridDim.x;
    for (int t = t_lo; t < t_hi; t += t_st) {
        const int e = t / 48, r = t % 48;
        if (r < 16)      conv_tile(p.in[20] + (size_t)e * 262144, 256, 256, (bf16_t*)(p.ws + WS_EXPGU) + (size_t)e * 524288, 1024, r * 64, 0, 0, tb);
        else if (r < 32) conv_tile(p.in[21] + (size_t)e * 262144, 256, 256, (bf16_t*)(p.ws + WS_EXPGU) + (size_t)e * 524288, 1024, (r - 16) * 64, 0, 128, tb);
        else { const int kt = (r - 32) >> 2, nb = (r - 32) & 3; conv_tile(p.in[22] + (size_t)e * 262144 + nb * 256, 1024, 256, (bf16_t*)(p.ws + WS_EXPD) + (size_t)e * 262144, 256, kt * 64, nb * 256, -1, tb); }
    }
}
DEVI void phase15(const Params& p) {
    const int lane = threadIdx.x & 63, gw = blockIdx.x * 8 + (threadIdx.x >> 6), nw = gridDim.x * 8;
    const float* mod = (const float*)(p.ws + WS_MOD); const bf16_t* X1 = (const bf16_t*)(p.ws + WS_X1);
    for (int tok = gw; tok < NTOK; tok += nw) {
        const float* m = mod + (size_t)(tok >> 12) * 6144 + 5120; float v[2][8];
        int sl[8]; float tw[8];
        { const int* tp = (const int*)(p.ws + WS_TOPK_POS) + (size_t)tok * 8; const float* twp = (const float*)(p.ws + WS_TOPK_W) + (size_t)tok * 8;
#pragma unroll
          for (int k = 0; k < 8; ++k) { sl[k] = __builtin_amdgcn_readfirstlane(tp[k]); tw[k] = twp[k]; } }
#pragma unroll
        for (int j = 0; j < 2; ++j) { const int cidx = lane * 8 + 512 * j; float a[8];
#pragma unroll
            for (int e = 0; e < 8; ++e) a[e] = 0.f;
#pragma unroll
            for (int k = 0; k < 9; ++k) { const u32x4 y = *(const u32x4*)((k < 8 ? (const bf16_t*)(p.ws + ws_ys(sl[k])) : (const bf16_t*)(p.ws + WS_Y8) + (size_t)tok * 1024) + cidx); const float w = k < 8 ? tw[k] : 1.0f;
                a[0] += w * bflo(y.x); a[1] += w * bfhi(y.x); a[2] += w * bflo(y.y); a[3] += w * bfhi(y.y); a[4] += w * bflo(y.z); a[5] += w * bfhi(y.z); a[6] += w * bflo(y.w); a[7] += w * bfhi(y.w); }
            const u32x4 xr = *(const u32x4*)(X1 + (size_t)tok * 1024 + cidx);
            const f32x4 g0 = *(const f32x4*)(m + cidx), g1 = *(const f32x4*)(m + cidx + 4), x0 = {bflo(xr.x), bfhi(xr.x), bflo(xr.y), bfhi(xr.y)}, x1 = {bflo(xr.z), bfhi(xr.z), bflo(xr.w), bfhi(xr.w)};
#if defined(DBG_NOMOE)
#pragma unroll
            for (int e = 0; e < 8; ++e) a[e] = 0.f;
#endif
#pragma unroll
            for (int e = 0; e < 4; ++e) { v[j][e] = x0[e] * 1.189207115f + g0[e] * a[e]; v[j][4 + e] = x1[e] * 1.189207115f + g1[e] * a[4 + e]; }
        }
        float sm = 0.f;
#pragma unroll
        for (int j = 0; j < 2; ++j)
#pragma unroll
            for (int e = 0; e < 8; ++e) sm += v[j][e];
        const float mu = wave_sum(sm) * (1.0f / 1024.0f); float q = 0.f;
#pragma unroll
        for (int j = 0; j < 2; ++j)
#pragma unroll
            for (int e = 0; e < 8; ++e) { v[j][e] -= mu; q += v[j][e] * v[j][e]; }
        const float rstd = rsqrtf(wave_sum(q) * (1.0f / 1024.0f) + 1e-6f);
#pragma unroll
        for (int j = 0; j < 2; ++j) { const int cidx = lane * 8 + 512 * j;
            const f32x4 g0 = *(const f32x4*)(p.in[26] + cidx), g1 = *(const f32x4*)(p.in[26] + cidx + 4), b0 = *(const f32x4*)(p.in[27] + cidx), b1 = *(const f32x4*)(p.in[27] + cidx + 4);
            f32x4 o0, o1;
#pragma unroll
            for (int e = 0; e < 4; ++e) { o0[e] = v[j][e] * rstd * g0[e] + b0[e]; o1[e] = v[j][4 + e] * rstd * g1[e] + b1[e]; }
            *(f32x4*)(p.out + (size_t)tok * 1024 + cidx) = o0; *(f32x4*)(p.out + (size_t)tok * 1024 + cidx + 4) = o1; }
    }
}

__global__ void __launch_bounds__(512, 2) mega(Params p) {
    extern __shared__ __attribute__((aligned(16))) unsigned char shm[];
    LAS unsigned char* lds = (LAS unsigned char*)shm;
    volatile LAS unsigned* xbw = (volatile LAS unsigned*)(lds + LDS_BARW);
    if (threadIdx.x == 0) { xbw[0] = 0u; xbw[1] = 0u; xbw[2] = 0u; xbw[3] = 0u; }
    __syncthreads();
    XcdBarrier bar; bar.bar = (unsigned*)(p.ws + WS_CTL); bar.x = 0; bar.st = xbw;
    const bool multi = (p.ph_hi - p.ph_lo) > 1;
    if (multi) bar = xcd_barrier_post((unsigned*)(p.ws + WS_CTL), xbw);
    unsigned char* ws = p.ws;
    const int G = gridDim.x, c = blockIdx.x;
#ifndef PHMASK
#define PHMASK 0xFFFF
#endif
#ifndef REPMASK
#define REPMASK 0
#endif
#define RUN(n) if (((PHMASK >> (n)) & 1) && p.ph_lo <= (n) && (n) < p.ph_hi)
#define SYNC(n) if (p.ph_lo <= (n) && (n) + 1 < p.ph_hi) xcd_barrier(bar); else __syncthreads()
    RUN(0) phase0(p, lds, 0);
#if (REPMASK >> 0) & 1
    __syncthreads();
    RUN(0) phase0(p, lds, 0);
#endif
    SYNC(0);
    RUN(1) { phase1(p); phase0(p, lds, 1); }
#if (REPMASK >> 1) & 1
    __syncthreads();
    RUN(1) { phase1(p); phase0(p, lds, 1); }
#endif
    SYNC(1);
    RUN(2) { SchedInProj S{ws, G, c}; EpiBf16 E; gemm_stream<SchedInProj, EpiBf16, false>(lds, S, E); }
#if (REPMASK >> 2) & 1
    __syncthreads();
    RUN(2) { SchedInProj S{ws, G, c}; EpiBf16 E; gemm_stream<SchedInProj, EpiBf16, false>(lds, S, E); }
#endif
    SYNC(2);
    RUN(3) phase3(p, lds);
#if (REPMASK >> 3) & 1
    __syncthreads();
    RUN(3) phase3(p, lds);
#endif
    SYNC(3);
    RUN(4) { if (c & 1) { phase4_na(p, lds); __syncthreads(); phase4_gla(p, lds); } else { phase4_gla(p, lds); __syncthreads(); phase4_na(p, lds); } }
    SYNC(4);
    RUN(5) phase5(p);
#if (REPMASK >> 5) & 1
    __syncthreads();
    RUN(5) phase5(p);
#endif
    SYNC(5);
#if (REPMASK >> 6) & 1
    __syncthreads();
#endif
    RUN(7) { SchedDense S{(const char*)(ws + WS_AP), (const char*)(ws + WS_BT_BR), (char*)(ws + WS_YM), 1536, G, c, 3072u, 3072u, 24}; EpiBranchC E{(const bf16_t*)(ws + WS_SGA), (const bf16_t*)(ws + WS_SGB), (bf16_t*)(ws + WS_YM)}; gemm_stream<SchedDense, EpiBranchC, false>(lds, S, E); }
#if (REPMASK >> 7) & 1
    __syncthreads();
    RUN(7) { SchedDense S{(const char*)(ws + WS_AP), (const char*)(ws + WS_BT_BR), (char*)(ws + WS_YM), 1536, G, c, 3072u, 3072u, 24}; EpiBranchC E{(const bf16_t*)(ws + WS_SGA), (const bf16_t*)(ws + WS_SGB), (bf16_t*)(ws + WS_YM)}; gemm_stream<SchedDense, EpiBranchC, false>(lds, S, E); }
#endif
    SYNC(7);
    RUN(8) { SchedDense S{(const char*)(ws + WS_YM), (const char*)(ws + WS_BT_OUT), (char*)(ws + WS_Z), 1024, G, c, 2048u, 2048u, 16}; EpiBf16 E; gemm_stream<SchedDense, EpiBf16, false>(lds, S, E); }
#if (REPMASK >> 8) & 1
    __syncthreads();
    RUN(8) { SchedDense S{(const char*)(ws + WS_YM), (const char*)(ws + WS_BT_OUT), (char*)(ws + WS_Z), 1024, G, c, 2048u, 2048u, 16}; EpiBf16 E; gemm_stream<SchedDense, EpiBf16, false>(lds, S, E); }
#endif
    SYNC(8);
    RUN(9) phase9(p);
#if (REPMASK >> 9) & 1
    __syncthreads();
    RUN(9) phase9(p);
#endif
    SYNC(9);
    RUN(10) { if (c < 128) { SchedRouter S{ws, G, c}; EpiF32 E; gemm_stream<SchedRouter, EpiF32, false>(lds, S, E); asm volatile("s_waitcnt vmcnt(0)" ::: "memory"); __syncthreads(); phase11(p, lds, SchedRouter::panel(c) * 256); }
              phase12(p, lds, 1); }
    SYNC(10);
    RUN(12) phase12(p, lds, 0);
#if (REPMASK >> 12) & 1
    __syncthreads();
    RUN(12) phase12(p, lds, 0);
#endif
    SYNC(12);
    RUN(13) { LAS int* T = (LAS int*)(lds + LDS_TAB); moe_tables((const unsigned*)(ws + WS_CNT), T); SchedGateUp S{ws, T, G, c}; EpiGateUp E{(bf16_t*)(ws + WS_HID)}; gemm_stream<SchedGateUp, EpiGateUp, true>(lds, S, E); }
#if (REPMASK >> 13) & 1
    __syncthreads();
    RUN(13) { LAS int* T = (LAS int*)(lds + LDS_TAB); moe_tables((const unsigned*)(ws + WS_CNT), T); SchedGateUp S{ws, T, G, c}; EpiGateUp E{(bf16_t*)(ws + WS_HID)}; gemm_stream<SchedGateUp, EpiGateUp, true>(lds, S, E); }
#endif
    SYNC(13);
    RUN(14) { LAS int* T = (LAS int*)(lds + LDS_TAB); moe_tables((const unsigned*)(ws + WS_CNT), T); SchedDown S{ws, T, G, c}; EpiDown E{ws}; gemm_stream<SchedDown, EpiDown, false>(lds, S, E); }
#if (REPMASK >> 14) & 1
    __syncthreads();
    RUN(14) { LAS int* T = (LAS int*)(lds + LDS_TAB); moe_tables((const unsigned*)(ws + WS_CNT), T); SchedDown S{ws, T, G, c}; EpiDown E{ws}; gemm_stream<SchedDown, EpiDown, false>(lds, S, E); }
#endif
    SYNC(14);
    RUN(15) phase15(p);
#if (REPMASK >> 15) & 1
    __syncthreads();
    RUN(15) phase15(p);
#endif
}

#ifdef DBG_STOP
__global__ void dbg_dump(const unsigned short* base, size_t nwords, float* out, int accumulate) {
    for (size_t i = (size_t)blockIdx.x * blockDim.x + threadIdx.x; i < (size_t)33554432; i += (size_t)gridDim.x * blockDim.x) {
        float s = accumulate ? out[i] : 0.f;
        for (size_t j = i; j < nwords; j += (size_t)33554432) s += (float)base[j];
        out[i] = s;
    }
}
#endif
}

extern "C" void kernel_launch(void* const* d_in, const int* in_sizes, int n_in, void* d_out, int out_size, void* d_ws, size_t ws_size, hipStream_t stream) {
    static int grid = 0;
    if (grid == 0) {
        if (n_in != 28 || out_size != NTOK * 1024 || ws_size < WS_END) { fprintf(stderr, "kernel_launch: unexpected problem (n_in %d out %d ws %zu)\n", n_in, out_size, ws_size); grid = -1; return; }
        int dev = 0, cus = 0, per_cu = 0;
        if (hipGetDevice(&dev) != hipSuccess || hipDeviceGetAttribute(&cus, hipDeviceAttributeMultiprocessorCount, dev) != hipSuccess) { grid = -1; return; }
        if (hipFuncSetAttribute((const void*)mega, hipFuncAttributeMaxDynamicSharedMemorySize, LDS_TOTAL) != hipSuccess) { fprintf(stderr, "kernel_launch: hipFuncSetAttribute failed\n"); grid = -1; return; }
        if (hipOccupancyMaxActiveBlocksPerMultiprocessor(&per_cu, (const void*)mega, 512, LDS_TOTAL) != hipSuccess || per_cu < 1) fprintf(stderr, "kernel_launch: occupancy query says %d\n", per_cu);
        (void)hipGetLastError();
        grid = cus;
    }
    if (grid < 0) return;
    (void)hipMemsetAsync((char*)d_ws + WS_CTL, 0, 32768, stream);
    Params p{};
    for (int i = 0; i < 28; ++i) p.in[i] = (const float*)d_in[i];
    p.out = (float*)d_out; p.ws = (unsigned char*)d_ws;
#ifdef DBG_STOP
    for (int ph = 0; ph <= DBG_STOP; ++ph) { p.ph_lo = ph; p.ph_hi = ph + 1; hipLaunchKernelGGL(mega, dim3(grid), dim3(512), LDS_TOTAL, stream, p); }
    { const size_t regs[][2] = { DBG_REGS }; int first = 1;
      for (auto& r : regs) { hipLaunchKernelGGL(dbg_dump, dim3(2048), dim3(256), 0, stream, (const unsigned short*)((char*)d_ws + r[0] * MiB), (size_t)(r[1] * MiB / 2), (float*)d_out, first ? 0 : 1); first = 0; } }
#elif MK_PER_PHASE
    for (int ph = 0; ph < NPH; ++ph) {
#if defined(DBG_NOMOE)
        if (ph >= 10 && ph <= 14) continue;
#endif
        p.ph_lo = ph; p.ph_hi = ph + 1; hipLaunchKernelGGL(mega, dim3(grid), dim3(512), LDS_TOTAL, stream, p); }
#else
    p.ph_lo = 0; p.ph_hi = NPH; hipLaunchKernelGGL(mega, dim3(grid), dim3(512), LDS_TOTAL, stream, p);
#endif
}
```

```cpp
#include <hip/hip_runtime.h>
#include <stdint.h>
#include <stdio.h>

#ifndef MK_PER_PHASE
#define MK_PER_PHASE 0
#endif

namespace {
typedef unsigned short bf16_t;
typedef short bf16x8 __attribute__((ext_vector_type(8)));
typedef float f32x4 __attribute__((ext_vector_type(4)));
typedef unsigned u32x4 __attribute__((ext_vector_type(4)));
typedef unsigned u32x2 __attribute__((ext_vector_type(2)));
typedef int i32x4 __attribute__((ext_vector_type(4)));
typedef int i32x8 __attribute__((ext_vector_type(8)));
#define LAS __attribute__((address_space(3)))
#define DEVI __device__ __forceinline__

constexpr int NTOK = 32768, NROW = 34816, NPH = 16;
constexpr size_t MiB = 1ull << 20;
constexpr int LDS_TOTAL = 160 * 1024;
constexpr int LDS_BARW = LDS_TOTAL - 16;
constexpr int LDS_TAB = 131072;

constexpr size_t WS_CTL = 0, WS_CNT = 16384, WS_MOD = 1 * MiB, WS_EE = 2 * MiB, WS_TOPK_ID = 5 * MiB, WS_TOPK_W = 6 * MiB, WS_TOPK_POS = 7 * MiB, WS_SLOT = 8 * MiB;
constexpr size_t WS_BT_IN = 10 * MiB, WS_BT_BR = 24 * MiB  , WS_BT_OUT = 27 * MiB, WS_BT_RT = 29 * MiB, WS_BT_SHGU = 30 * MiB, WS_BT_SHD = 31 * MiB;
constexpr size_t WS_H = 32 * MiB, WS_QA = 100 * MiB, WS_KA = 132 * MiB, WS_QB = 166 * MiB, WS_KB = 198 * MiB, WS_GB = 232 * MiB, WS_SGA = 296 * MiB, WS_SGB = 360 * MiB;
constexpr size_t WS_VAT = 424 * MiB, WS_VBT = 458 * MiB, WS_QTF = 526 * MiB, WS_QTB = 558 * MiB, WS_KTF = 590 * MiB, WS_KTB = 624 * MiB, WS_KTTF = 658 * MiB, WS_KTTB = 692 * MiB;
constexpr size_t WS_OF = 726 * MiB, WS_OB = 790 * MiB, WS_AP = 896 * MiB, WS_LRT = 888 * MiB;
constexpr size_t WS_YM = 424 * MiB, WS_Z = 488 * MiB;
constexpr size_t WS_X1 = 32 * MiB, WS_EXPD = 160 * MiB, WS_LOG0 = 288 * MiB, WS_LOG1 = 320 * MiB, WS_EXPGU = 352 * MiB, WS_H2 = 608 * MiB, WS_HID = 864 * MiB;
constexpr size_t WS_H2F8 = 96 * MiB;
constexpr size_t WS_YS = 288 * MiB;
constexpr size_t WS_Y8 = 800 * MiB, WS_END = 1009 * MiB;
DEVI size_t ws_ys(int slot) { return WS_YS + (size_t)slot * 2048; }
DEVI size_t ws_y(int k) { return (k < 2 ? 160 + 64 * (size_t)k : (k < 6 ? 416 + 64 * (size_t)(k - 2) : 817 + 64 * (size_t)(k - 6))) * MiB; }

struct Params { const float* in[28]; float* out; unsigned char* ws; int ph_lo, ph_hi; };

typedef __bf16 bf16x2_t __attribute__((ext_vector_type(2)));
typedef float f32x2_t __attribute__((ext_vector_type(2)));
DEVI unsigned pk_bf16(float lo, float hi) { const f32x2_t v = {lo, hi}; const bf16x2_t r = __builtin_convertvector(v, bf16x2_t); return __builtin_bit_cast(unsigned, r); }
DEVI float bf2f(bf16_t b) { return __uint_as_float(((unsigned)b) << 16); }
DEVI float bflo(unsigned w) { return __uint_as_float(w << 16); }
DEVI float bfhi(unsigned w) { return __uint_as_float(w & 0xffff0000u); }
DEVI float clamp8(float v) { return __builtin_amdgcn_fmed3f(v, -448.0f, 448.0f); }
DEVI unsigned pk4_fp8(float a, float b, float c, float d) { unsigned w = 0u; w = (unsigned)__builtin_amdgcn_cvt_pk_fp8_f32(clamp8(a), clamp8(b), (int)w, false); w = (unsigned)__builtin_amdgcn_cvt_pk_fp8_f32(clamp8(c), clamp8(d), (int)w, true); return w; }
DEVI i32x8 cat8(bf16x8 a, bf16x8 b) { const i32x4 x = __builtin_bit_cast(i32x4, a), y = __builtin_bit_cast(i32x4, b); return __builtin_shufflevector(x, y, 0, 1, 2, 3, 4, 5, 6, 7); }
DEVI void mfma8(f32x4& acc, i32x8 a, i32x8 b) { asm volatile("v_mfma_f32_16x16x128_f8f6f4 %0, %1, %2, %0" : "+v"(acc) : "v"(a), "v"(b)); }
constexpr float F8_X = 4.0f, F8_WGU = 256.0f, F8_H = 4.0f, F8_WD = 128.0f;
DEVI bf16_t f2bf(float f) { return (bf16_t)(pk_bf16(f, 0.f) & 0xffffu); }
DEVI float sigmoidf_(float x) { return __builtin_amdgcn_rcpf(1.0f + __expf(-x)); }
template <int N> struct IC { static constexpr int v = N; };
DEVI void lds_barrier() { asm volatile("s_waitcnt lgkmcnt(0)" ::: "memory"); __builtin_amdgcn_s_barrier(); asm volatile("" ::: "memory"); }
template <int CTRL> DEVI float dppf(float v) { return __builtin_bit_cast(float, __builtin_amdgcn_update_dpp(__builtin_bit_cast(int, v), __builtin_bit_cast(int, v), CTRL, 0xF, 0xF, false)); }
template <int CTRL> DEVI int dppi(int v) { return __builtin_amdgcn_update_dpp(v, v, CTRL, 0xF, 0xF, false); }
DEVI float x16f(float v, int lane) { const auto r = __builtin_amdgcn_permlane16_swap(__builtin_bit_cast(unsigned, v), __builtin_bit_cast(unsigned, v), false, false); return __builtin_bit_cast(float, (lane & 16) ? r[0] : r[1]); }
DEVI int   x16i(int v, int lane)   { const auto r = __builtin_amdgcn_permlane16_swap((unsigned)v, (unsigned)v, false, false); return (int)((lane & 16) ? r[0] : r[1]); }
DEVI float x32f(float v, int lane) { const auto r = __builtin_amdgcn_permlane32_swap(__builtin_bit_cast(unsigned, v), __builtin_bit_cast(unsigned, v), false, false); return __builtin_bit_cast(float, (lane & 32) ? r[0] : r[1]); }
DEVI int   x32i(int v, int lane)   { const auto r = __builtin_amdgcn_permlane32_swap((unsigned)v, (unsigned)v, false, false); return (int)((lane & 32) ? r[0] : r[1]); }
#define DPP_X1 0xB1
#define DPP_X2 0x4E
#define DPP_HM 0x141
#define DPP_RM 0x140
DEVI float wave_sum(float v) { const int lane = threadIdx.x & 63; v += dppf<DPP_X1>(v); v += dppf<DPP_X2>(v); v += dppf<DPP_HM>(v); v += dppf<DPP_RM>(v); v += x16f(v, lane); v += x32f(v, lane); return v; }

#define XB_TMO      128
#define XB_XCNT(j)  (256  + 64 * (j))
#define XB_XSUB(j)  (1280 + 64 * (j))
#define XB_XGEN(j)  (2304 + 64 * (j))
#define XB_TOP      3328
#define XB_TOPGEN   3392
#define XCD_BAR_WORDS 3456
#define XB_SPIN_CAP (1u << 22)
DEVI unsigned xb_ld(unsigned* p)              { return __hip_atomic_load(p, __ATOMIC_RELAXED, __HIP_MEMORY_SCOPE_AGENT); }
DEVI unsigned xb_add(unsigned* p, unsigned v) { return __hip_atomic_fetch_add(p, v, __ATOMIC_RELAXED, __HIP_MEMORY_SCOPE_AGENT); }
DEVI unsigned xb_xcc_id() { return (unsigned)__builtin_amdgcn_s_getreg((3 << 11) | 20) & 0xFu; }
#define XB_SPIN(cond, bar) do { unsigned _sp = 0; while (cond) { __builtin_amdgcn_s_sleep(1); \
    if ((++_sp & 255u) == 0u) { if (xb_ld(&(bar)[XB_TMO])) break; if (_sp > XB_SPIN_CAP) { atomicAdd(&(bar)[XB_TMO], 1u); break; } } } } while (0)
struct XcdBarrier { unsigned* bar; unsigned x; volatile LAS unsigned* st; };
DEVI XcdBarrier xcd_barrier_post(unsigned* bar, volatile LAS unsigned* st) {
    XcdBarrier b; b.bar = bar; b.x = xb_xcc_id(); b.st = st;
    if (threadIdx.x == 0) (void)xb_add(&bar[XB_XCNT(b.x)], 1u);
    return b;
}
DEVI void xcd_barrier_complete(unsigned* bar, unsigned x, unsigned& nloc, unsigned& nx) {
    const unsigned G = gridDim.x * gridDim.y * gridDim.z;
    unsigned sum, cnt, mine, sp = 0u;
    for (;;) {
        sum = 0u; cnt = 0u; mine = 0u;
#pragma unroll
        for (unsigned j = 0; j < 16; ++j) { const unsigned c = xb_ld(&bar[XB_XCNT(j)]); sum += c; cnt += (c > 0u) ? 1u : 0u; mine = (j == x) ? c : mine; }
        if (sum == G) break;
        __builtin_amdgcn_s_sleep(1);
        if ((++sp & 255u) == 0u) { if (xb_ld(&bar[XB_TMO])) break; if (sp > XB_SPIN_CAP) { atomicAdd(&bar[XB_TMO], 1u); break; } }
    }
    nloc = mine > 0u ? mine : 1u; nx = cnt > 0u ? cnt : 1u;
}
DEVI void xcd_barrier(const XcdBarrier& b) {
    asm volatile("s_waitcnt vmcnt(0)" ::: "memory");
    __syncthreads();
    if (threadIdx.x == 0) {
        unsigned* bar = b.bar;
        __builtin_amdgcn_s_waitcnt(0);
        unsigned nloc = b.st[0], nx = b.st[1];
        if (nloc == 0u) { xcd_barrier_complete(bar, b.x, nloc, nx); b.st[0] = nloc; b.st[1] = nx; }
        const unsigned old = xb_add(&bar[XB_XSUB(b.x)], 1u);
        const unsigned gen = old / nloc;
        if (old + 1u == (gen + 1u) * nloc) {
            __builtin_amdgcn_fence(__ATOMIC_RELEASE, "agent");
            asm volatile("s_waitcnt vmcnt(0)" ::: "memory");
            const unsigned og = xb_add(&bar[XB_TOP], 1u);
            const unsigned tg = og / nx;
            if (og + 1u == (tg + 1u) * nx) xb_add(&bar[XB_TOPGEN], 1u);
            else XB_SPIN(xb_ld(&bar[XB_TOPGEN]) == tg, bar);
            __builtin_amdgcn_fence(__ATOMIC_ACQUIRE, "agent");
            xb_add(&bar[XB_XGEN(b.x)], 1u);
            asm volatile("s_waitcnt vmcnt(0)" ::: "memory");
        } else {
            XB_SPIN(xb_ld(&bar[XB_XGEN(b.x)]) == gen, bar);
            __builtin_amdgcn_fence(__ATOMIC_ACQUIRE, "agent");
            asm volatile("s_waitcnt vmcnt(0)" ::: "memory");
        }
    }
    __syncthreads();
}

constexpr int BK = 64, HALF = 128, HTB = HALF * BK * 2;
DEVI int lds_byte(int r, int c) { const int st = (r >> 4) * 2 + (c >> 5), rr = r & 15, cc = c & 31, ob = rr * 64 + cc * 2; return st * 1024 + (ob ^ (((ob >> 9) & 1) << 5)); }
DEVI void stage_rc(int b, int& R, int& C) { const int st = b / 1024, sb = b % 1024, swz = sb ^ (((sb >> 9) & 1) << 5); R = (st >> 1) * 16 + swz / 64; C = (st & 1) * 32 + (swz % 64) / 2; }
DEVI int perm32(int rho) { const int n = rho >> 4, i = rho & 15; return 8 * (i >> 2) + 4 * n + (i & 3); }

struct GUnit {
    const char* a; const char* b;
    char* dst; int ldd; int i0, i1, i2; float f0;
};
typedef f32x4 Acc[2][2][4][2];
#define ZA1(a, b, m) acc[a][b][m][0] = z; acc[a][b][m][1] = z;
#define ZA2(a, b) ZA1(a, b, 0) ZA1(a, b, 1) ZA1(a, b, 2) ZA1(a, b, 3)
DEVI void zero_acc(Acc& acc) { f32x4 z = {0.f, 0.f, 0.f, 0.f}; asm volatile("" : "+v"(z)); ZA2(0, 0) ZA2(0, 1) ZA2(1, 0) ZA2(1, 1) }

template <class Sched, class Epi, bool GATHER>
DEVI void gemm_stream(LAS unsigned char* lds, const Sched& S, const Epi& E) {
    const int tid = threadIdx.x, wid = __builtin_amdgcn_readfirstlane(tid >> 6), lane = tid & 63, wr = wid >> 2, wc = wid & 3, fr = lane & 15, fq = lane >> 4;
    const unsigned lda = S.lda, ldb = S.ldb; const int nt = S.nt;
    unsigned voffA[2], voffB[2]; int R0 = 0;
#pragma unroll
    for (int i = 0; i < 2; ++i) { int R, C; stage_rc(tid * 16 + i * 8192, R, C); const int Rb = (R & ~31) + perm32(R & 31);
        if (i == 0) R0 = R;
        voffA[i] = GATHER ? (unsigned)(C * 2) : (unsigned)R * lda + (unsigned)(C * 2); voffB[i] = (unsigned)Rb * ldb + (unsigned)(C * 2); }
    const size_t kstep = (size_t)(BK * 2);
    const size_t hstepA = GATHER ? (size_t)0 : (size_t)HALF * lda, hstepB = (size_t)HALF * ldb;
    const unsigned ldsw = (unsigned)wid * 1024u;
    const int aoff = lds_byte(wr * 64 + fr, fq * 8), boff = lds_byte(wc * 32 + fr, fq * 8);
#define G_SA(b, h) (((b) * 2 + (h)) * HTB)
#define G_SB(b, h) ((4 + (b) * 2 + (h)) * HTB)
#define G_STAGE(bufoff, gbase, o0, o1) do { \
        __builtin_amdgcn_global_load_lds((const unsigned*)((const char*)(gbase) + (o0)), (LAS unsigned*)(lds + (bufoff) + ldsw), 16, 0, 0); \
        __builtin_amdgcn_global_load_lds((const unsigned*)((const char*)(gbase) + (o1)), (LAS unsigned*)(lds + (bufoff) + ldsw + 8192), 16, 0, 0); } while (0)
#define G_LDA(dst, b, h) do { _Pragma("unroll") for (int m = 0; m < 4; ++m) _Pragma("unroll") for (int k = 0; k < 2; ++k) dst[m][k] = *(const LAS bf16x8*)(lds + G_SA(b, h) + aoff + m * 2048 + k * 1024); } while (0)
#define G_LDB(dst, b, h) do { _Pragma("unroll") for (int n = 0; n < 2; ++n) _Pragma("unroll") for (int k = 0; k < 2; ++k) dst[n][k] = *(const LAS bf16x8*)(lds + G_SB(b, h) + boff + n * 2048 + k * 1024); } while (0)
#define G_MMA(ai, bj, At, Bt) do { __builtin_amdgcn_s_setprio(1); \
        if constexpr (Sched::F8) { _Pragma("unroll") for (int m = 0; m < 4; ++m) _Pragma("unroll") for (int n = 0; n < 2; ++n) \
            mfma8(acc[ai][bj][m][n], cat8(Bt[n][0], Bt[n][1]), cat8(At[m][0], At[m][1])); } \
        else { _Pragma("unroll") for (int m = 0; m < 4; ++m) _Pragma("unroll") for (int n = 0; n < 2; ++n) _Pragma("unroll") for (int k = 0; k < 2; ++k) \
            acc[ai][bj][m][n] = __builtin_amdgcn_mfma_f32_16x16x32_bf16(Bt[n][k], At[m][k], acc[ai][bj][m][n], 0, 0, 0); } \
        __builtin_amdgcn_s_setprio(0); } while (0)
#define G_WAIT_V(n) asm volatile("s_waitcnt vmcnt(" #n ")" ::: "memory")
#define G_WAIT_L(n) asm volatile("s_waitcnt lgkmcnt(" #n ")" ::: "memory")
#define G_BAR __builtin_amdgcn_s_barrier()
#define G_SCHED __builtin_amdgcn_sched_barrier(0)
    GUnit cur, nxt; int ui = 0;
    if (!S.next(0, cur)) return;
    unsigned gc[2][2], gn[2][2];
    gc[0][0] = voffA[0]; gc[0][1] = voffA[1]; gc[1][0] = voffA[0]; gc[1][1] = voffA[1];
    gn[0][0] = voffA[0]; gn[0][1] = voffA[1]; gn[1][0] = voffA[0]; gn[1][1] = voffA[1];
    if constexpr (GATHER) { S.gather(cur, R0, gc); gc[0][0] += voffA[0]; gc[0][1] += voffA[0]; gc[1][0] += voffA[0]; gc[1][1] += voffA[0]; }
    Acc acc; zero_acc(acc);
    typename Epi::Pre pre; E.pre(cur, wr, lane, pre);
    bf16x8 At[4][2], B0[2][2], B1[2][2];
    const char* cA = cur.a; const char* cB = cur.b;
    G_STAGE(G_SB(0, 0), cB, voffB[0], voffB[1]); G_STAGE(G_SA(0, 0), cA, gc[0][0], gc[0][1]); G_STAGE(G_SB(0, 1), cB + hstepB, voffB[0], voffB[1]); G_STAGE(G_SA(0, 1), cA + hstepA, gc[1][0], gc[1][1]);
    if (wr == 1) G_BAR;
    G_WAIT_V(4); G_BAR;
    G_STAGE(G_SB(1, 0), cB + kstep, voffB[0], voffB[1]); G_STAGE(G_SA(1, 0), cA + kstep, gc[0][0], gc[0][1]); G_STAGE(G_SB(1, 1), cB + hstepB + kstep, voffB[0], voffB[1]);
    G_WAIT_V(6); G_BAR;
    for (;;) {
        const bool has_next = S.next(ui + 1, nxt);
        const char* nA = has_next ? nxt.a : cA; const char* nB = has_next ? nxt.b : cB;
        for (int t = 0; t < nt; t += 2) {
            const bool last = (t == nt - 2);
            const char* a1 = cA + (size_t)(t + 1) * kstep;
            const char* a2 = last ? nA : cA + (size_t)(t + 2) * kstep; const char* b2 = last ? nB : cB + (size_t)(t + 2) * kstep;
            const char* a3 = a2 + kstep; const char* b3 = b2 + kstep;
            unsigned g2[2][2];
            if constexpr (GATHER) { g2[0][0] = last ? gn[0][0] : gc[0][0]; g2[0][1] = last ? gn[0][1] : gc[0][1]; g2[1][0] = last ? gn[1][0] : gc[1][0]; g2[1][1] = last ? gn[1][1] : gc[1][1]; }
            else { g2[0][0] = voffA[0]; g2[0][1] = voffA[1]; g2[1][0] = voffA[0]; g2[1][1] = voffA[1]; }
            if constexpr (GATHER) { if (t == nt - 4) {
                if (has_next) { S.gather(nxt, R0, gn); gn[0][0] += voffA[0]; gn[0][1] += voffA[0]; gn[1][0] += voffA[0]; gn[1][1] += voffA[0]; }
                else { gn[0][0] = gc[0][0]; gn[0][1] = gc[0][1]; gn[1][0] = gc[1][0]; gn[1][1] = gc[1][1]; } } }
            if constexpr (Epi::MID_T > 0) { if (t == Epi::MID_T) { int tz = threadIdx.x; asm volatile("" : "+v"(tz)); const int wz = tz >> 6, lz = tz & 63; E.mid(acc, cur, wz >> 2, wz & 3, lz & 15, lz >> 4); } }
            G_LDB(B0, 0, 0); G_SCHED; G_LDA(At, 0, 0); G_STAGE(G_SA(1, 1), a1 + hstepA, gc[1][0], gc[1][1]);
            G_WAIT_L(8); G_BAR; G_WAIT_L(0); G_MMA(0, 0, At, B0); G_BAR; G_SCHED;
            G_LDB(B1, 0, 1); G_STAGE(G_SB(0, 0), b2, voffB[0], voffB[1]);
            G_BAR; G_WAIT_L(0); G_MMA(0, 1, At, B1); G_BAR;
            G_LDA(At, 0, 1); G_STAGE(G_SA(0, 0), a2, g2[0][0], g2[0][1]);
            G_BAR; G_WAIT_L(0); G_MMA(1, 0, At, B0); G_BAR; G_SCHED;
            G_STAGE(G_SB(0, 1), b2 + hstepB, voffB[0], voffB[1]);
            G_WAIT_V(6); G_BAR; G_MMA(1, 1, At, B1); G_BAR;
            G_LDB(B0, 1, 0); G_SCHED; G_LDA(At, 1, 0); G_STAGE(G_SA(0, 1), a2 + hstepA, g2[1][0], g2[1][1]);
            G_WAIT_L(8); G_BAR; G_WAIT_L(0); G_MMA(0, 0, At, B0); G_BAR; G_SCHED;
            G_LDB(B1, 1, 1); G_STAGE(G_SB(1, 0), b3, voffB[0], voffB[1]);
            G_BAR; G_WAIT_L(0); G_MMA(0, 1, At, B1); G_BAR;
            G_LDA(At, 1, 1); G_STAGE(G_SA(1, 0), a3, g2[0][0], g2[0][1]);
            G_BAR; G_WAIT_L(0); G_MMA(1, 0, At, B0); G_BAR; G_SCHED;
            G_STAGE(G_SB(1, 1), b3 + hstepB, voffB[0], voffB[1]);
            G_WAIT_V(6); G_BAR; G_MMA(1, 1, At, B1); G_BAR;
        }
        if constexpr (Sched::F8) asm volatile("s_nop 15\n\ts_nop 15\n\ts_nop 15" ::: "memory");
        { int tz = threadIdx.x; asm volatile("" : "+v"(tz)); const int wz = tz >> 6, lz = tz & 63; E(acc, cur, wz >> 2, wz & 3, lz & 15, lz >> 4, pre); }
        if (!has_next) break;
        zero_acc(acc);
        cur = nxt; cA = nA; cB = nB; ++ui;
        E.pre(cur, wr, lane, pre);
        if constexpr (GATHER) { gc[0][0] = gn[0][0]; gc[0][1] = gn[0][1]; gc[1][0] = gn[1][0]; gc[1][1] = gn[1][1]; }
    }
    G_WAIT_V(0);
    if (wr == 0) G_BAR;
    G_BAR;
}

struct EpiBf16 { static constexpr int MID_T = 0; DEVI void mid(Acc&, const GUnit&, int, int, int, int) const {}
    struct Pre {}; DEVI void pre(const GUnit&, int, int, Pre&) const {}
    DEVI void operator()(const Acc& acc, const GUnit& u, int wr, int wc, int fr, int fq, const Pre&) const {
        if (u.f0 < 0.f) {
            float* fb = (float*)u.dst;
#pragma unroll
            for (int m = 0; m < 4; ++m) { const int row = wr * 64 + m * 16 + fr;
                if (row < 32) { float* rp = fb + (size_t)row * u.ldd + wc * 32 + 8 * fq;
#pragma unroll
                    for (int bj = 0; bj < 2; ++bj) { *(f32x4*)(rp + bj * 128) = acc[0][bj][m][0]; *(f32x4*)(rp + bj * 128 + 4) = acc[0][bj][m][1]; } } }
            return;
        }
        bf16_t* base = (bf16_t*)u.dst; const float s = u.f0; const int act = u.i0;
#pragma unroll
        for (int ai = 0; ai < 2; ++ai)
#pragma unroll
            for (int m = 0; m < 4; ++m) {
                bf16_t* rp = base + (size_t)(ai * 128 + wr * 64 + m * 16 + fr) * u.ldd + wc * 32 + 8 * fq;
#pragma unroll
                for (int bj = 0; bj < 2; ++bj) {
                    f32x4 v0 = acc[ai][bj][m][0] * s, v1 = acc[ai][bj][m][1] * s;
                    if (act) {
#pragma unroll
                        for (int j = 0; j < 4; ++j) { v0[j] = sigmoidf_(v0[j]); v1[j] = sigmoidf_(v1[j]); }
                    }
                    u32x4 w; w.x = pk_bf16(v0[0], v0[1]); w.y = pk_bf16(v0[2], v0[3]); w.z = pk_bf16(v1[0], v1[1]); w.w = pk_bf16(v1[2], v1[3]);
                    *(u32x4*)(rp + bj * 128) = w;
                }
            }
    }
};
struct EpiF32 { static constexpr int MID_T = 0; DEVI void mid(Acc&, const GUnit&, int, int, int, int) const {}
    struct Pre {}; DEVI void pre(const GUnit&, int, int, Pre&) const {}
    DEVI void operator()(const Acc& acc, const GUnit& u, int wr, int wc, int fr, int fq, const Pre&) const {
        float* base = (float*)u.dst;
#pragma unroll
        for (int ai = 0; ai < 2; ++ai)
#pragma unroll
            for (int m = 0; m < 4; ++m) {
                float* rp = base + (size_t)(ai * 128 + wr * 64 + m * 16 + fr) * u.ldd + wc * 32 + 8 * fq;
#pragma unroll
                for (int bj = 0; bj < 2; ++bj) { *(f32x4*)(rp + bj * 128) = acc[ai][bj][m][0]; *(f32x4*)(rp + bj * 128 + 4) = acc[ai][bj][m][1]; }
            }
    }
};
struct EpiBranchC {
    static constexpr int MID_T = 8;
    const bf16_t* sga; const bf16_t* sgb; bf16_t* ym;
    struct Pre {}; DEVI void pre(const GUnit&, int, int, Pre&) const {}
    DEVI void mid(Acc& acc, const GUnit& u, int wr, int wc, int fr, int fq) const {
#pragma unroll
        for (int ai = 0; ai < 2; ++ai)
#pragma unroll
            for (int m = 0; m < 4; ++m) {
                const size_t ro = (size_t)(u.i1 + ai * 128 + wr * 64 + m * 16 + fr) * 1024 + u.i2 + wc * 32 + 8 * fq;
#pragma unroll
                for (int bj = 0; bj < 2; ++bj) {
                    const u32x4 ga = *(const u32x4*)(sga + ro + bj * 128), gb = *(const u32x4*)(sgb + ro + bj * 128);
                    f32x4 r0, r1;
                    r0[0] = bflo(ga.x) * __builtin_amdgcn_rcpf(bflo(gb.x)); r0[1] = bfhi(ga.x) * __builtin_amdgcn_rcpf(bfhi(gb.x)); r0[2] = bflo(ga.y) * __builtin_amdgcn_rcpf(bflo(gb.y)); r0[3] = bfhi(ga.y) * __builtin_amdgcn_rcpf(bfhi(gb.y));
                    r1[0] = bflo(ga.z) * __builtin_amdgcn_rcpf(bflo(gb.z)); r1[1] = bfhi(ga.z) * __builtin_amdgcn_rcpf(bfhi(gb.z)); r1[2] = bflo(ga.w) * __builtin_amdgcn_rcpf(bflo(gb.w)); r1[3] = bfhi(ga.w) * __builtin_amdgcn_rcpf(bfhi(gb.w));
                    acc[ai][bj][m][0] = acc[ai][bj][m][0] * r0; acc[ai][bj][m][1] = acc[ai][bj][m][1] * r1;
                }
            }
    }
    DEVI void operator()(const Acc& acc, const GUnit& u, int wr, int wc, int fr, int fq, const Pre&) const {
#pragma unroll
        for (int ai = 0; ai < 2; ++ai)
#pragma unroll
            for (int m = 0; m < 4; ++m) {
                const size_t ro = (size_t)(u.i1 + ai * 128 + wr * 64 + m * 16 + fr) * 1024 + u.i2 + wc * 32 + 8 * fq;
#pragma unroll
                for (int bj = 0; bj < 2; ++bj) {
                    const u32x4 gb = *(const u32x4*)(sgb + ro + bj * 128);
                    const f32x4 v0 = acc[ai][bj][m][0], v1 = acc[ai][bj][m][1];
                    u32x4 w;
                    w.x = pk_bf16(bflo(gb.x) * v0[0], bfhi(gb.x) * v0[1]); w.y = pk_bf16(bflo(gb.y) * v0[2], bfhi(gb.y) * v0[3]);
                    w.z = pk_bf16(bflo(gb.z) * v1[0], bfhi(gb.z) * v1[1]); w.w = pk_bf16(bflo(gb.w) * v1[2], bfhi(gb.w) * v1[3]);
                    *(u32x4*)(ym + ro + bj * 128) = w;
                }
            }
    }
};
struct EpiGateUp { static constexpr int MID_T = 0; DEVI void mid(Acc&, const GUnit&, int, int, int, int) const {}
    unsigned char* hid;
    struct Pre {}; DEVI void pre(const GUnit&, int, int, Pre&) const {}
    DEVI void operator()(const Acc& acc, const GUnit& u, int wr, int wc, int fr, int fq, const Pre&) const {
#pragma unroll
        for (int ai = 0; ai < 2; ++ai)
#pragma unroll
            for (int m = 0; m < 4; ++m) {
                const int row = ai * 128 + wr * 64 + m * 16 + fr;
                if (row < u.i1) {
                    constexpr float si = 1.0f / (F8_X * F8_WGU), so = F8_H * si;
                    const f32x4 g0 = acc[ai][0][m][0] * si, g1 = acc[ai][0][m][1] * si, u0 = acc[ai][1][m][0] * so, u1 = acc[ai][1][m][1] * so;
                    float h[8];
#pragma unroll
                    for (int j = 0; j < 4; ++j) { h[j] = g0[j] * sigmoidf_(g0[j]) * u0[j]; h[4 + j] = g1[j] * sigmoidf_(g1[j]) * u1[j]; }
                    u32x2 w; w.x = pk4_fp8(h[0], h[1], h[2], h[3]); w.y = pk4_fp8(h[4], h[5], h[6], h[7]);
                    *(u32x2*)(hid + (size_t)(u.i0 + row) * 256 + u.i2 * 128 + wc * 32 + 8 * fq) = w;
                }
            }
    }
};
struct EpiDown {
    static constexpr int MID_T = 0; DEVI void mid(Acc&, const GUnit&, int, int, int, int) const {}
    unsigned char* ws;
    struct Pre {}; DEVI void pre(const GUnit&, int, int, Pre&) const {}
    DEVI void operator()(const Acc& acc, const GUnit& u, int wr, int wc, int fr, int fq, const Pre&) const {
#pragma unroll
        for (int ai = 0; ai < 2; ++ai)
#pragma unroll
            for (int m = 0; m < 4; ++m) {
                const int row = ai * 128 + wr * 64 + m * 16 + fr;
                if (row < u.i1) {
                    bf16_t* rp = (u.i2 == 0 ? (bf16_t*)(ws + ws_ys(u.i0 + row)) : (bf16_t*)(ws + WS_Y8) + (size_t)(u.i0 + row) * 1024) + u.ldd + wc * 32 + 8 * fq;
#pragma unroll
                    for (int bj = 0; bj < 2; ++bj) {
                        constexpr float sd = 1.0f / (F8_H * F8_WD);
                        const f32x4 v0 = acc[ai][bj][m][0] * sd, v1 = acc[ai][bj][m][1] * sd;
                        u32x4 o; o.x = pk_bf16(v0[0], v0[1]); o.y = pk_bf16(v0[2], v0[3]); o.z = pk_bf16(v1[0], v1[1]); o.w = pk_bf16(v1[2], v1[3]);
                        *(u32x4*)(rp + bj * 128) = o;
                    }
                }
            }
    }
};

struct SchedInProj {
    unsigned char* ws; int G, c;
    static constexpr unsigned lda = 2048, ldb = 2048; static constexpr int nt = 16; static constexpr bool F8 = false;
    DEVI bool next(int i, GUnit& u) const {
        const int L = i * G + c; if (L >= 3544) return false;
        u.i0 = 0; u.i1 = 0; u.i2 = 0; u.f0 = 1.0f;
        const char* H = (const char*)(ws + WS_H); const char* BT = (const char*)(ws + WS_BT_IN);
        int pm, pn;
        if (L < 2592) {
            if (L < 2560) { const int x = L & 7, q = L >> 3, blk = q >> 5, w = q & 31; pm = 16 * x + 8 * (blk & 1) + (w & 7); pn = 4 * (blk >> 1) + (w >> 3); }
            else { const int j = L - 2560, jn = j >> 3; pm = 128 + (j & 7); pn = jn < 2 ? 2 + jn : 4 + jn; }
            u.a = H + (size_t)pm * 256 * 2048; u.b = BT + (size_t)pn * 256 * 2048;
            size_t base; int ld, col;
            if (pn < 2)       { base = WS_QA; ld = 512; col = pn * 256; u.f0 = 0.125f; }
            else if (pn < 4)  { base = WS_KA; ld = 512; col = (pn - 2) * 256; }
            else if (pn < 6)  { base = WS_QB; ld = 512; col = (pn - 4) * 256; }
            else if (pn < 8)  { base = WS_KB; ld = 512; col = (pn - 6) * 256; }
            else if (pn < 12) { base = WS_GB; ld = 1024; col = (pn - 8) * 256; }
            else if (pn < 16) { base = WS_SGA; ld = 1024; col = (pn - 12) * 256; u.i0 = 1; }
            else              { base = WS_SGB; ld = 1024; col = (pn - 16) * 256; u.i0 = 1; }
            u.dst = (char*)(ws + base) + ((size_t)pm * 256 * ld + col) * 2; u.ldd = ld;
        } else {
            const int j = L - 2592, x = j & 7, q = j >> 3, tn = 17 * x + q / 7, wm = q % 7;
            u.a = BT + (size_t)(5120 + wm * 256) * 2048; u.b = H + (size_t)tn * 256 * 2048;
            u.dst = (wm < 2 ? (char*)(ws + WS_VAT) + ((size_t)(wm * 256) * NROW + tn * 256) * 2 : (wm < 6 ? (char*)(ws + WS_VBT) + ((size_t)((wm - 2) * 256) * NROW + tn * 256) * 2 : (char*)(ws + WS_LRT) + (size_t)(tn * 256) * 4));
            u.ldd = NROW; if (wm == 6) u.f0 = -1.0f;
        }
        return true;
    }
};
struct SchedDense {
    const char* A; const char* Bt; char* dst; int K; int G, c; unsigned lda, ldb; int nt; static constexpr bool F8 = false;
    DEVI bool next(int i, GUnit& u) const {
        const int L = i * G + c; if (L >= 512) return false;
        const int x = L & 7, q = L >> 3, blk = q >> 5, w = q & 31, pm = 16 * x + 8 * blk + (w & 7), pn = w >> 3;
        u.a = A + (size_t)pm * 256 * K * 2; u.b = Bt + (size_t)pn * 256 * K * 2;
        u.dst = dst + ((size_t)pm * 256 * 1024 + pn * 256) * 2; u.ldd = 1024; u.i0 = 0; u.i1 = pm * 256; u.i2 = pn * 256; u.f0 = 1.0f;
        return true;
    }
};
struct SchedRouter {
    unsigned char* ws; int G, c;
    static constexpr unsigned lda = 2048, ldb = 2048; static constexpr int nt = 16; static constexpr bool F8 = false;
    DEVI static int panel(int c) { return 16 * (c & 7) + (c >> 3); }
    DEVI bool next(int i, GUnit& u) const {
        if (i > 0 || c >= 128) return false;
        const int pm = panel(c);
        u.a = (const char*)(ws + WS_H2) + (size_t)pm * 256 * 2048; u.b = (const char*)(ws + WS_BT_RT);
        u.dst = (char*)(ws + WS_LOG0) + (size_t)pm * 256 * 256 * 4; u.ldd = 256; u.i0 = 0; u.i1 = 0; u.i2 = 0; u.f0 = 1.0f;
        return true;
    }
};
DEVI void moe_tables(const unsigned* gcnt, LAS int* T) {
    if (threadIdx.x < 64) {
        const int l = threadIdx.x; int c[4], t[4];
#pragma unroll
        for (int k = 0; k < 4; ++k) { c[k] = (int)gcnt[4 * l + k]; t[k] = (c[k] + 255) >> 8; }
        const int sc = c[0] + c[1] + c[2] + c[3], st = t[0] + t[1] + t[2] + t[3];
        int ic = sc, it = st;
#pragma unroll
        for (int o = 1; o < 64; o <<= 1) { const int a = __shfl_up(ic, o), b = __shfl_up(it, o); if (l >= o) { ic += a; it += b; } }
        int bc = ic - sc, bt = it - st;
#pragma unroll
        for (int k = 0; k < 4; ++k) { T[4 * l + k] = c[k]; T[256 + 4 * l + k] = bc; T[513 + 4 * l + k] = bt; bc += c[k]; bt += t[k]; }
        if (l == 63) { T[256 + 256] = ic; T[513 + 256] = it; }
    }
    __syncthreads();
    {
        const int TRt = T[513 + 256];
        for (int t = threadIdx.x; t < TRt; t += 512) { int lo = 0, hi = 256; while (hi - lo > 1) { const int mid = (lo + hi) >> 1; if (T[513 + mid] <= t) lo = mid; else hi = mid; } T[770 + t] = lo; }
    }
    __syncthreads();
}
DEVI int moe_find(const LAS int* toff, int t) {
    int lo = 0, hi = 256;
#pragma unroll 1
    while (hi - lo > 1) { const int mid = (lo + hi) >> 1; if (toff[mid] <= t) lo = mid; else hi = mid; }
    return __builtin_amdgcn_readfirstlane(lo);
}
struct SchedGateUp {
    unsigned char* ws; const LAS int* T; int G, c;
    static constexpr unsigned lda = 1024, ldb = 1024; static constexpr int nt = 8; static constexpr bool F8 = true;
    DEVI bool next(int i, GUnit& u) const {
        const int L = i * G + c; const int TR = __builtin_amdgcn_readfirstlane(T[513 + 256]);
        if (L >= 2 * TR + 256) return false;
        u.a = (const char*)(ws + WS_H2F8); u.dst = nullptr; u.ldd = 0; u.f0 = 1.0f;
        if (L < 2 * TR) {
            const int t = L >> 1, pn = L & 1, e = __builtin_amdgcn_readfirstlane(T[770 + t]), mt = t - __builtin_amdgcn_readfirstlane(T[513 + e]), cnt = __builtin_amdgcn_readfirstlane(T[e]);
            u.b = (const char*)(ws + WS_EXPGU) + ((size_t)e * 512 + pn * 256) * 1024;
            u.i0 = __builtin_amdgcn_readfirstlane(T[256 + e]) + mt * 256; u.i1 = min(256, cnt - mt * 256); u.i2 = pn;
        } else {
            const int j = L - 2 * TR, mt = j >> 1, pn = j & 1;
            u.b = (const char*)(ws + WS_BT_SHGU) + (size_t)(pn * 256) * 1024;
            u.i0 = 262144 + mt * 256; u.i1 = 256; u.i2 = pn;
        }
        return true;
    }
    DEVI void gather(const GUnit& u, int R0, unsigned (&g)[2][2]) const {
        const u32x2* slot = (const u32x2*)(ws + WS_SLOT);
#pragma unroll
        for (int h = 0; h < 2; ++h)
#pragma unroll
            for (int i = 0; i < 2; ++i) {
                const int s = u.i0 + h * 128 + R0 + 64 * i; int tok;
                if (u.i0 >= 262144) tok = s - 262144; else tok = (int)(slot[min(s, 262143)].x >> 3);
                g[h][i] = (unsigned)tok * 1024u;
            }
    }
};
struct SchedDown {
    unsigned char* ws; const LAS int* T; int G, c;
    static constexpr unsigned lda = 256, ldb = 256; static constexpr int nt = 2; static constexpr bool F8 = true;
    DEVI bool next(int i, GUnit& u) const {
        const int L = i * G + c; const int TR = __builtin_amdgcn_readfirstlane(T[513 + 256]);
        if (L >= 4 * TR + 512) return false;
        u.dst = nullptr; u.f0 = 1.0f;
        if (L < 4 * TR) {
            const int t = L >> 2, pn = L & 3, e = __builtin_amdgcn_readfirstlane(T[770 + t]), mt = t - __builtin_amdgcn_readfirstlane(T[513 + e]), cnt = __builtin_amdgcn_readfirstlane(T[e]);
            const int s0 = __builtin_amdgcn_readfirstlane(T[256 + e]) + mt * 256;
            u.a = (const char*)(ws + WS_HID) + (size_t)s0 * 256; u.b = (const char*)(ws + WS_EXPD) + ((size_t)e * 1024 + pn * 256) * 256;
            u.i0 = s0; u.i1 = min(256, cnt - mt * 256); u.i2 = 0; u.ldd = pn * 256;
        } else {
            const int j = L - 4 * TR, mt = j >> 2, pn = j & 3;
            u.a = (const char*)(ws + WS_HID) + (size_t)(262144 + mt * 256) * 256; u.b = (const char*)(ws + WS_BT_SHD) + (size_t)(pn * 256) * 256;
            u.i0 = mt * 256; u.i1 = 256; u.i2 = 1; u.ldd = pn * 256;
        }
        return true;
    }
};

DEVI void conv_tile(const float* src, int ldsrc, int ncols, bf16_t* dst, int ldd, int k0, int row0, int ilv, LAS float* t) {
    const int tid = threadIdx.x;
    f32x4 v[8];
#pragma unroll
    for (int i = 0; i < 8; ++i) { const int f = tid + 512 * i, row = f >> 6, c4 = (f & 63) * 4;
        v[i] = (c4 < ncols) ? *(const f32x4*)(src + (size_t)(k0 + row) * ldsrc + c4) : (f32x4){0.f, 0.f, 0.f, 0.f}; }
#pragma unroll
    for (int i = 0; i < 8; ++i) { const int f = tid + 512 * i, row = f >> 6, c4 = (f & 63) * 4; LAS float* q = t + row * 257 + c4; q[0] = v[i][0]; q[1] = v[i][1]; q[2] = v[i][2]; q[3] = v[i][3]; }
    __syncthreads();
#pragma unroll
    for (int j = 0; j < 4; ++j) {
        const int p = tid + 512 * j, kp = p & 7, n = p >> 3;
        if (n < ncols) {
            const LAS float* q = t + (kp * 8) * 257 + n;
            u32x4 w; w.x = pk_bf16(q[0], q[257]); w.y = pk_bf16(q[2 * 257], q[3 * 257]); w.z = pk_bf16(q[4 * 257], q[5 * 257]); w.w = pk_bf16(q[6 * 257], q[7 * 257]);
            const int drow = row0 + (ilv >= 0 ? ((n >> 7) * 256 + (n & 127) + ilv) : n);
            *(u32x4*)(dst + (size_t)drow * ldd + k0 + kp * 8) = w;
        }
    }
    __syncthreads();
}

DEVI void conv_tile8(const float* src, int ldsrc, unsigned char* dst, int ldd, int k0, int row0, int ilv, float scale, LAS float* t) {
    const int tid = threadIdx.x;
    f32x4 v[16];
#pragma unroll
    for (int i = 0; i < 16; ++i) { const int f = tid + 512 * i, row = f >> 6, c4 = (f & 63) * 4; v[i] = *(const f32x4*)(src + (size_t)(k0 + row) * ldsrc + c4); }
#pragma unroll
    for (int i = 0; i < 16; ++i) { const int f = tid + 512 * i, row = f >> 6, c4 = (f & 63) * 4; LAS float* q = t + row * 257 + c4; q[0] = v[i][0] * scale; q[1] = v[i][1] * scale; q[2] = v[i][2] * scale; q[3] = v[i][3] * scale; }
    __syncthreads();
#pragma unroll
    for (int j = 0; j < 4; ++j) {
        const int p = tid + 512 * j, kp = p & 7, n = p >> 3;
        const LAS float* q = t + (kp * 16) * 257 + n;
        u32x4 w;
        w.x = pk4_fp8(q[0], q[257], q[2 * 257], q[3 * 257]);             w.y = pk4_fp8(q[4 * 257], q[5 * 257], q[6 * 257], q[7 * 257]);
        w.z = pk4_fp8(q[8 * 257], q[9 * 257], q[10 * 257], q[11 * 257]); w.w = pk4_fp8(q[12 * 257], q[13 * 257], q[14 * 257], q[15 * 257]);
        const int drow = row0 + (ilv >= 0 ? ((n >> 7) * 256 + (n & 127) + ilv) : n);
        *(u32x4*)(dst + (size_t)drow * ldd + k0 + kp * 16) = w;
    }
    __syncthreads();
}

DEVI void phase0(const Params& p, LAS unsigned char* lds, int part) {
    const int tid = threadIdx.x, lane = tid & 63, wid = tid >> 6;
    unsigned char* ws = p.ws;
    const int NT_IN = 16 * (2 + 2 + 2 + 2 + 4 + 4 + 4 + 2 + 4 + 1);
    const int NT0 = NT_IN + 8 * 4 + 16 * 4 + 16 * 4 + 16 + 8 + 8 + 8;
    for (int u = (part == 0 ? (int)blockIdx.x : 192 + (int)blockIdx.x); u < (part == 0 ? 192 : 192 + NT0); u += gridDim.x) {
        if (u < 192) {
            LAS float* sc = (LAS float*)lds; LAS float* red = (LAS float*)(lds + 9 * 1024 * 4);
            for (int i = tid; i < 9216; i += 512) { const int r = i >> 10, k = i & 1023; const float v = r < 8 ? p.in[1][r * 1024 + k] : p.in[3][k]; sc[i] = v / (1.0f + __expf(-v)); }
            __syncthreads();
            const int n0 = u * 32, col = lane & 31, rsub = lane >> 5;
            float acc[9];
#pragma unroll
            for (int r = 0; r < 9; ++r) acc[r] = 0.f;
            for (int it = 0; it < 64; ++it) { const int k = it * 16 + wid * 2 + rsub; const float w = p.in[4][(size_t)k * 6144 + n0 + col];
#pragma unroll
                for (int r = 0; r < 9; ++r) acc[r] += sc[r * 1024 + k] * w; }
#pragma unroll
            for (int r = 0; r < 9; ++r) red[((wid * 2 + rsub) * 9 + r) * 32 + col] = acc[r];
            __syncthreads();
            if (tid < 288) { const int r = tid >> 5, cc = tid & 31; float s = 0.f; for (int g = 0; g < 16; ++g) s += red[(g * 9 + r) * 32 + cc];
                ((float*)(ws + WS_MOD))[r * 6144 + n0 + cc] = s + p.in[5][n0 + cc]; }
            __syncthreads();
        } else {
            int t = u - 192; LAS float* tb = (LAS float*)lds;
            if (t < NT_IN) {
                const int kt = t & 15; int jb = t >> 4;
                int c0, r0, nc = 256;
                if (jb < 2)       { c0 = 0 + jb * 256;             r0 = 0 + jb * 256; }
                else if (jb < 4)  { c0 = 512 + (jb - 2) * 256;     r0 = 512 + (jb - 2) * 256; }
                else if (jb < 6)  { c0 = 1536 + (jb - 4) * 256;    r0 = 1024 + (jb - 4) * 256; }
                else if (jb < 8)  { c0 = 2048 + (jb - 6) * 256;    r0 = 1536 + (jb - 6) * 256; }
                else if (jb < 12) { c0 = 3584 + (jb - 8) * 256;    r0 = 2048 + (jb - 8) * 256; }
                else if (jb < 16) { c0 = 4640 + (jb - 12) * 256;   r0 = 3072 + (jb - 12) * 256; }
                else if (jb < 20) { c0 = 5664 + (jb - 16) * 256;   r0 = 4096 + (jb - 16) * 256; }
                else if (jb < 22) { c0 = 1024 + (jb - 20) * 256;   r0 = 5120 + (jb - 20) * 256; }
                else if (jb < 26) { c0 = 2560 + (jb - 22) * 256;   r0 = 5632 + (jb - 22) * 256; }
                else              { c0 = 4608; r0 = 6656; nc = 32; }
                conv_tile(p.in[6] + c0, 6688, nc, (bf16_t*)(ws + WS_BT_IN), 1024, kt * 64, r0, -1, tb);
            } else {
                t -= NT_IN;
                if (t < 32)        { const int kt = t & 7, nb = t >> 3;  conv_tile(p.in[13] + nb * 256, 1024, 256, (bf16_t*)(ws + WS_BT_BR), 1536, kt * 64, nb * 256, -1, tb); }
                else if (t < 96)   { t -= 32; const int kt = t & 15, nb = t >> 4; conv_tile(p.in[14] + nb * 256, 1024, 256, (bf16_t*)(ws + WS_BT_BR) + 512, 1536, kt * 64, nb * 256, -1, tb); }
                else if (t < 160)  { t -= 96; const int kt = t & 15, nb = t >> 4; conv_tile(p.in[15] + nb * 256, 1024, 256, (bf16_t*)(ws + WS_BT_OUT), 1024, kt * 64, nb * 256, -1, tb); }
                else if (t < 176)  { t -= 160; conv_tile(p.in[18], 256, 256, (bf16_t*)(ws + WS_BT_RT), 1024, t * 64, 0, -1, tb); }
                else if (t < 184)  { t -= 176; conv_tile8(p.in[23], 256, ws + WS_BT_SHGU, 1024, t * 128, 0, 0, F8_WGU, tb); }
                else if (t < 192)  { t -= 184; conv_tile8(p.in[24], 256, ws + WS_BT_SHGU, 1024, t * 128, 0, 128, F8_WGU, tb); }
                else               { t -= 192; const int kt = t & 1, nb = t >> 1; conv_tile8(p.in[25] + nb * 256, 1024, ws + WS_BT_SHD, 256, kt * 128, nb * 256, -1, F8_WD, tb); }
            }
        }
    }
}

DEVI void phase1(const Params& p) {
    const float* mod = (const float*)(p.ws + WS_MOD); bf16_t* H = (bf16_t*)(p.ws + WS_H);
    for (size_t idx = (size_t)blockIdx.x * 512 + threadIdx.x; idx < (size_t)NROW * 128; idx += (size_t)gridDim.x * 512) {
        const int row = (int)(idx >> 7), k = (int)(idx & 127) * 8;
        const float* src = row < NTOK ? p.in[0] + (size_t)row * 1024 + k : p.in[2] + (size_t)(row - NTOK) * 1024 + k;
        const float* m = mod + (size_t)(row < NTOK ? (row >> 12) : 8) * 6144 + k;
        const f32x4 x0 = *(const f32x4*)src, x1 = *(const f32x4*)(src + 4), h0 = *(const f32x4*)m, h1 = *(const f32x4*)(m + 4), s0 = *(const f32x4*)(m + 1024), s1 = *(const f32x4*)(m + 1028);
        const f32x4 y0 = x0 * (s0 + 1.0f) + h0, y1 = x1 * (s1 + 1.0f) + h1;
        u32x4 w; w.x = pk_bf16(y0[0], y0[1]); w.y = pk_bf16(y0[2], y0[3]); w.z = pk_bf16(y1[0], y1[1]); w.w = pk_bf16(y1[2], y1[3]);
        *(u32x4*)(H + (size_t)row * 1024 + k) = w;
    }
}

DEVI float logsig16(float z) { return -(fmaxf(-z, 0.f) + __logf(1.0f + __expf(-fabsf(z)))) * 0.0625f; }
DEVI void phase3(const Params& p, LAS unsigned char* lds) {
    const int tid = threadIdx.x;
    unsigned char* ws = p.ws;
    LAS float* LRs = (LAS float*)lds;
    LAS float* CS = (LAS float*)(lds + 8192);
    LAS float* CUM = (LAS float*)(lds + 24576);
    LAS float* TOT = (LAS float*)(lds + 24576 + 65536);
    LAS bf16_t* KTs = (LAS bf16_t*)(lds + 24576 + 65536 + 2048);
    for (int i = tid; i < 2048; i += 512) { const int pos = i >> 5, j = i & 31; const float ang = (float)pos * powf(10000.0f, -(float)j / 32.0f); CS[2 * i] = cosf(ang); CS[2 * i + 1] = sinf(ang); }
    __syncthreads();
    const float* LRT = (const float*)(ws + WS_LRT);
    const bf16_t* QB = (const bf16_t*)(ws + WS_QB); const bf16_t* KB = (const bf16_t*)(ws + WS_KB);
    bf16_t* QTF = (bf16_t*)(ws + WS_QTF); bf16_t* QTB = (bf16_t*)(ws + WS_QTB); bf16_t* KTF = (bf16_t*)(ws + WS_KTF); bf16_t* KTB = (bf16_t*)(ws + WS_KTB);
    float* EE = (float*)(ws + WS_EE);
    for (int u = blockIdx.x; u < 8 * 68 * 4; u += gridDim.x) {
        const int h = u & 3, bs = u >> 2, b = bs / 68, slot = bs % 68; const bool isctx = slot < 4; const int chunk = slot - 4;
        const int rowbase = isctx ? NTOK + b * 256 + slot * 64 : b * 4096 + chunk * 64;
        { const int r = tid >> 4, c4 = (tid & 15) * 4; const f32x4 lv = *(const f32x4*)(LRT + (size_t)r * NROW + rowbase + c4);
          LRs[(c4 + 0) * 32 + r] = lv[0]; LRs[(c4 + 1) * 32 + r] = lv[1]; LRs[(c4 + 2) * 32 + r] = lv[2]; LRs[(c4 + 3) * 32 + r] = lv[3]; }
        __syncthreads();
        {
            const int ch = tid & 127, grp = tid >> 7, dir = grp & 1, hf = grp >> 1;
            const float* w2p = p.in[dir ? 10 : 8] + h * 128 + ch; const float b2 = p.in[dir ? 11 : 9][h * 128 + ch];
            float w2[16];
#pragma unroll
            for (int r = 0; r < 16; ++r) w2[r] = w2p[r * 512];
            float run = 0.f;
            for (int k = 0; k < 32; ++k) {
                const int i = dir ? (32 * hf + 31 - k) : (32 * hf + k);
                const LAS f32x4* lp = (const LAS f32x4*)(LRs + i * 32 + 16 * dir);
                const f32x4 l0 = lp[0], l1 = lp[1], l2 = lp[2], l3 = lp[3];
                const float z0 = (l0[0] * w2[0] + l0[1] * w2[1]) + (l0[2] * w2[2] + l0[3] * w2[3]), z1 = (l1[0] * w2[4] + l1[1] * w2[5]) + (l1[2] * w2[6] + l1[3] * w2[7]);
                const float z2 = (l2[0] * w2[8] + l2[1] * w2[9]) + (l2[2] * w2[10] + l2[3] * w2[11]), z3 = (l3[0] * w2[12] + l3[1] * w2[13]) + (l3[2] * w2[14] + l3[3] * w2[15]);
                const float z = b2 + ((z0 + z1) + (z2 + z3));
                run += logsig16(z);
                CUM[(dir * 64 + i) * 128 + ch] = run;
            }
            TOT[(dir * 2 + hf) * 128 + ch] = run;
        }
        __syncthreads();
#pragma unroll
        for (int rep = 0; rep < 2; ++rep) {
            const int q = tid + 512 * rep, i = q >> 4, c8 = q & 15, ch0 = c8 * 8;
            float cf[8], cb[8];
            {
                const f32x4 a0 = *(const LAS f32x4*)(CUM + (0 * 64 + i) * 128 + ch0), a1 = *(const LAS f32x4*)(CUM + (0 * 64 + i) * 128 + ch0 + 4);
                const f32x4 b0 = *(const LAS f32x4*)(CUM + (1 * 64 + i) * 128 + ch0), b1 = *(const LAS f32x4*)(CUM + (1 * 64 + i) * 128 + ch0 + 4);
                f32x4 tf0 = {0.f, 0.f, 0.f, 0.f}, tf1 = tf0, tb0 = tf0, tb1 = tf0;
                if (i >= 32) { tf0 = *(const LAS f32x4*)(TOT + (0 * 2 + 0) * 128 + ch0); tf1 = *(const LAS f32x4*)(TOT + (0 * 2 + 0) * 128 + ch0 + 4); }
                else         { tb0 = *(const LAS f32x4*)(TOT + (1 * 2 + 1) * 128 + ch0); tb1 = *(const LAS f32x4*)(TOT + (1 * 2 + 1) * 128 + ch0 + 4); }
#pragma unroll
                for (int e = 0; e < 4; ++e) { cf[e] = a0[e] + tf0[e]; cf[4 + e] = a1[e] + tf1[e]; cb[e] = b0[e] + tb0[e]; cb[4 + e] = b1[e] + tb1[e]; }
            }
            const size_t go = (size_t)(rowbase + i) * 512 + h * 128 + ch0;
            const u32x4 kraw = *(const u32x4*)(KB + go);
            float kv[8] = {bflo(kraw.x), bfhi(kraw.x), bflo(kraw.y), bfhi(kraw.y), bflo(kraw.z), bfhi(kraw.z), bflo(kraw.w), bfhi(kraw.w)};
            float ef[8], eb[8];
#pragma unroll
            for (int e = 0; e < 8; ++e) { ef[e] = __expf(cf[e]); eb[e] = __expf(cb[e]); }
            if (!isctx) {
                const size_t gp = (size_t)(rowbase + i) * 512 + h * 128 + ((c8 ^ 4) * 8);
                const u32x4 kpr = *(const u32x4*)(KB + gp), qraw = *(const u32x4*)(QB + go), qpr = *(const u32x4*)(QB + gp);
                const float kp[8] = {bflo(kpr.x), bfhi(kpr.x), bflo(kpr.y), bfhi(kpr.y), bflo(kpr.z), bfhi(kpr.z), bflo(kpr.w), bfhi(kpr.w)};
                const float qv[8] = {bflo(qraw.x), bfhi(qraw.x), bflo(qraw.y), bfhi(qraw.y), bflo(qraw.z), bfhi(qraw.z), bflo(qraw.w), bfhi(qraw.w)};
                const float qp[8] = {bflo(qpr.x), bfhi(qpr.x), bflo(qpr.y), bfhi(qpr.y), bflo(qpr.z), bfhi(qpr.z), bflo(qpr.w), bfhi(qpr.w)};
                const int half = c8 >> 3, isx2 = (c8 >> 2) & 1, j0 = (c8 & 3) * 8, pos = half ? i : chunk;
                float qf[8], qb[8];
                const LAS f32x4* cp = (const LAS f32x4*)(CS + (pos * 32 + j0) * 2); const f32x4 c0 = cp[0], c1 = cp[1], c2 = cp[2], c3 = cp[3];
                const float csv[8] = {c0[0], c0[2], c1[0], c1[2], c2[0], c2[2], c3[0], c3[2]}, snv[8] = {c0[1], c0[3], c1[1], c1[3], c2[1], c2[3], c3[1], c3[3]};
#pragma unroll
                for (int e = 0; e < 8; ++e) {
                    const float cs = csv[e], sn = snv[e];
                    const float rq = isx2 ? qv[e] * cs + qp[e] * sn : qv[e] * cs - qp[e] * sn;
                    kv[e] = isx2 ? kv[e] * cs + kp[e] * sn : kv[e] * cs - kp[e] * sn;
                    qf[e] = rq * 0.08838834764831845f * ef[e]; qb[e] = rq * 0.08838834764831845f * eb[e];
                }
                u32x4 wq; wq.x = pk_bf16(qf[0], qf[1]); wq.y = pk_bf16(qf[2], qf[3]); wq.z = pk_bf16(qf[4], qf[5]); wq.w = pk_bf16(qf[6], qf[7]); *(u32x4*)(QTF + go) = wq;
                wq.x = pk_bf16(qb[0], qb[1]); wq.y = pk_bf16(qb[2], qb[3]); wq.z = pk_bf16(qb[4], qb[5]); wq.w = pk_bf16(qb[6], qb[7]); *(u32x4*)(QTB + go) = wq;
            }
            float kf[8], kb[8];
#pragma unroll
            for (int e = 0; e < 8; ++e) { kf[e] = kv[e] * __builtin_amdgcn_rcpf(ef[e]); kb[e] = kv[e] * __builtin_amdgcn_rcpf(eb[e]); }
            u32x4 wf; wf.x = pk_bf16(kf[0], kf[1]); wf.y = pk_bf16(kf[2], kf[3]); wf.z = pk_bf16(kf[4], kf[5]); wf.w = pk_bf16(kf[6], kf[7]);
            u32x4 wb; wb.x = pk_bf16(kb[0], kb[1]); wb.y = pk_bf16(kb[2], kb[3]); wb.z = pk_bf16(kb[4], kb[5]); wb.w = pk_bf16(kb[6], kb[7]);
            *(u32x4*)(KTF + go) = wf; *(u32x4*)(KTB + go) = wb;
            *(LAS u32x4*)(KTs + (0 * 64 + i) * 136 + ch0) = wf; *(LAS u32x4*)(KTs + (1 * 64 + i) * 136 + ch0) = wb;
            if (i == 63) { float* ep = EE + ((size_t)(0 * 8 + b) * 68 + slot) * 512 + h * 128 + ch0; *(f32x4*)ep = (f32x4){ef[0], ef[1], ef[2], ef[3]}; *(f32x4*)(ep + 4) = (f32x4){ef[4], ef[5], ef[6], ef[7]}; }
            if (i == 0)  { float* ep = EE + ((size_t)(1 * 8 + b) * 68 + slot) * 512 + h * 128 + ch0; *(f32x4*)ep = (f32x4){eb[0], eb[1], eb[2], eb[3]}; *(f32x4*)(ep + 4) = (f32x4){eb[4], eb[5], eb[6], eb[7]}; }
        }
        __syncthreads();
#pragma unroll
        for (int rep = 0; rep < 4; ++rep) {
            const int q = tid + 512 * rep, ch = q & 127, t8 = (q >> 7) & 7, dir = q >> 10;
            const LAS bf16_t* sp = KTs + (dir * 64 + t8 * 8) * 136 + ch;
            u32x4 wv; wv.x = (unsigned)sp[0] | ((unsigned)sp[136] << 16); wv.y = (unsigned)sp[2 * 136] | ((unsigned)sp[3 * 136] << 16); wv.z = (unsigned)sp[4 * 136] | ((unsigned)sp[5 * 136] << 16); wv.w = (unsigned)sp[6 * 136] | ((unsigned)sp[7 * 136] << 16);
            *(u32x4*)((bf16_t*)(ws + (dir ? WS_KTTB : WS_KTTF)) + (size_t)(h * 128 + ch) * NROW + rowbase + t8 * 8) = wv;
        }
        __syncthreads();
    }
}

DEVI int gla_slot(int dir, int n) { return dir == 0 ? n : (n < 4 ? 3 - n : 71 - n); }
DEVI int gla_rowbase(int b, int slot) { return slot >= 4 ? b * 4096 + (slot - 4) * 64 : NTOK + b * 256 + slot * 64; }
DEVI void phase4_gla(const Params& p, LAS unsigned char* lds) {
    const int tid = threadIdx.x, lane = tid & 63, w = tid >> 6, l15 = lane & 15, fq = lane >> 4;
    unsigned char* ws = p.ws;
    LAS unsigned char* TQ = lds;
    LAS unsigned char* TK = lds + 32768;
    LAS unsigned char* TV = lds + 65536;
    LAS bf16_t* PM = (LAS bf16_t*)(lds + 81920);
    LAS bf16_t* SB = (LAS bf16_t*)(lds + 81920 + 9216);
    const bf16_t* VBT = (const bf16_t*)(ws + WS_VBT);
    const float* EE = (const float*)(ws + WS_EE);
    const int qr0 = tid >> 4, qp = tid & 15, vr = tid >> 3, vp = tid & 7;
    const int qoff0 = qr0 * 256 + ((qp ^ (qr0 & 15)) << 4), qoff1 = (qr0 + 32) * 256 + ((qp ^ ((qr0 + 32) & 15)) << 4);
    const int voff = vr * 128 + ((vp ^ ((vr >> 1) & 7)) << 4);
    struct PSet { u32x4 q0, q1, k0, k1, v; };
    struct KSet { bf16x8 a, b; f32x4 e; };
    for (int u = blockIdx.x; u < 256; u += gridDim.x) {
        const int xg = u & 7, kg = u >> 3, g = xg * 8 + (kg >> 2), dvq = kg & 3, dir = g & 1, h = (g >> 1) & 3, b = g >> 3;
        const bf16_t* QT = (const bf16_t*)(ws + (dir ? WS_QTB : WS_QTF)); const bf16_t* KT = (const bf16_t*)(ws + (dir ? WS_KTB : WS_KTF)); const bf16_t* KTT = (const bf16_t*)(ws + (dir ? WS_KTTB : WS_KTTF));
        bf16_t* OUT = (bf16_t*)(ws + (dir ? WS_OB : WS_OF));
        const int vrow0 = h * 256 + dvq * 64, krow0 = h * 128, kcol0 = h * 128;
        const float* EEu = EE + (size_t)(dir * 8 + b) * 68 * 512 + h * 128 + 16 * w + 4 * fq;
        const bf16_t* vsrc = VBT + (size_t)(vrow0 + vr) * NROW + vp * 8;
        const bf16_t* ktsrc = KTT + (size_t)(krow0 + 16 * w + l15) * NROW + 8 * fq;
        const size_t qsrc = (size_t)qr0 * 512 + kcol0 + qp * 8;
        f32x4 S[4];
#pragma unroll
        for (int i = 0; i < 4; ++i) S[i] = (f32x4){0.f, 0.f, 0.f, 0.f};
        PSet P0, P1; KSet K0, K1;
        P0.q0 = P0.q1 = P0.k0 = P0.k1 = P0.v = (u32x4){0u, 0u, 0u, 0u}; P1 = P0;
        auto load_p = [&](PSet& P, int n) {
            const int slot = gla_slot(dir, n), rb = gla_rowbase(b, slot);
            P.v = *(const u32x4*)(vsrc + rb);
            if (slot >= 4) { P.q0 = *(const u32x4*)(QT + (size_t)rb * 512 + qsrc); P.q1 = *(const u32x4*)(QT + (size_t)(rb + 32) * 512 + qsrc);
                             P.k0 = *(const u32x4*)(KT + (size_t)rb * 512 + qsrc); P.k1 = *(const u32x4*)(KT + (size_t)(rb + 32) * 512 + qsrc); }
        };
        auto store_p = [&](const PSet& P, int n) {
            const int slot = gla_slot(dir, n), bufo = n & 1;
            *(LAS u32x4*)(TV + bufo * 8192 + voff) = P.v;
            if (slot >= 4) { *(LAS u32x4*)(TQ + bufo * 16384 + qoff0) = P.q0; *(LAS u32x4*)(TQ + bufo * 16384 + qoff1) = P.q1; *(LAS u32x4*)(TK + bufo * 16384 + qoff0) = P.k0; *(LAS u32x4*)(TK + bufo * 16384 + qoff1) = P.k1; }
        };
        auto load_k = [&](KSet& K, int n) {
            const int slot = gla_slot(dir, n), rb = gla_rowbase(b, slot);
            K.a = *(const bf16x8*)(ktsrc + rb); K.b = *(const bf16x8*)(ktsrc + rb + 32); K.e = *(const f32x4*)(EEu + (size_t)slot * 512);
        };
        load_p(P0, 0); load_k(K0, 0); load_k(K1, 1); load_p(P1, 1);
        __syncthreads();
        store_p(P0, 0);
        auto step = [&](int n, PSet& Pload, const PSet& Pstore, KSet& K) {
            const int slot = gla_slot(dir, n); const bool lat = slot >= 4; const int rowbase = gla_rowbase(b, slot);
            const int cur = n & 1, nxt = cur ^ 1;
            LAS unsigned char* tq = TQ + cur * 16384; LAS unsigned char* tk = TK + cur * 16384; LAS unsigned char* tv = TV + cur * 8192;
            LAS bf16_t* sbc = SB + cur * 64 * 136; LAS bf16_t* sbn = SB + nxt * 64 * 136;
            lds_barrier();
            if (n + 2 < 68) load_p(Pload, n + 2);
            if (lat) {
                const int jt = w >> 1, it0 = 2 * (w & 1);
                f32x4 c0 = {0.f, 0.f, 0.f, 0.f}, c1 = {0.f, 0.f, 0.f, 0.f};
                const int rj = 16 * jt + l15, ri0 = 16 * it0 + l15, ri1 = ri0 + 16;
                bf16x8 fa[4], fb0[4], fb1[4];
#pragma unroll
                for (int ks = 0; ks < 4; ++ks) { const int pc = 4 * ks + fq;
                    fa[ks] = *(const LAS bf16x8*)(tk + rj * 256 + ((pc ^ l15) << 4)); fb0[ks] = *(const LAS bf16x8*)(tq + ri0 * 256 + ((pc ^ l15) << 4)); fb1[ks] = *(const LAS bf16x8*)(tq + ri1 * 256 + ((pc ^ l15) << 4)); }
                __builtin_amdgcn_sched_barrier(0);
#pragma unroll
                for (int ks = 0; ks < 4; ++ks) { c0 = __builtin_amdgcn_mfma_f32_16x16x32_bf16(fa[ks], fb0[ks], c0, 0, 0, 0); c1 = __builtin_amdgcn_mfma_f32_16x16x32_bf16(fa[ks], fb1[ks], c1, 0, 0, 0); }
#pragma unroll
                for (int r = 0; r < 4; ++r) { const int j = 16 * jt + 4 * fq + r;
                    const bool k0 = dir == 0 ? (j <= ri0) : (j >= ri0), k1 = dir == 0 ? (j <= ri1) : (j >= ri1);
                    c0[r] = k0 ? c0[r] : 0.f; c1[r] = k1 ? c1[r] : 0.f; }
                u32x2 w0; w0.x = pk_bf16(c0[0], c0[1]); w0.y = pk_bf16(c0[2], c0[3]); u32x2 w1; w1.x = pk_bf16(c1[0], c1[1]); w1.y = pk_bf16(c1[2], c1[3]);
                *(LAS u32x2*)(PM + ri0 * 72 + 16 * jt + 4 * fq) = w0; *(LAS u32x2*)(PM + ri1 * 72 + 16 * jt + 4 * fq) = w1;
            }
            lds_barrier();
            bf16x8 V[4][2];
#pragma unroll
            for (int dvt = 0; dvt < 4; ++dvt)
#pragma unroll
                for (int ks = 0; ks < 2; ++ks) { const int row = 16 * dvt + l15, pc = 4 * ks + fq; V[dvt][ks] = *(const LAS bf16x8*)(tv + row * 128 + ((pc ^ ((row >> 1) & 7)) << 4)); }
            __builtin_amdgcn_sched_barrier(0);
            if (lat) {
                const int it = w >> 1, dv0 = 2 * (w & 1), ri = 16 * it + l15;
                f32x4 o0 = {0.f, 0.f, 0.f, 0.f}, o1 = {0.f, 0.f, 0.f, 0.f};
                bf16x8 pB[2], pA0[2], pA1[2], sA0[4], sA1[4], sB[4];
                const LAS bf16_t* s0 = sbc + (16 * dv0 + l15) * 136 + 8 * fq; const LAS bf16_t* s1 = s0 + 16 * 136;
#pragma unroll
                for (int ks = 0; ks < 2; ++ks) { pB[ks] = *(const LAS bf16x8*)(PM + ri * 72 + 32 * ks + 8 * fq);
                    const int r0 = 16 * dv0 + l15, r1 = r0 + 16, pc = 4 * ks + fq;
                    pA0[ks] = *(const LAS bf16x8*)(tv + r0 * 128 + ((pc ^ ((r0 >> 1) & 7)) << 4)); pA1[ks] = *(const LAS bf16x8*)(tv + r1 * 128 + ((pc ^ ((r1 >> 1) & 7)) << 4)); }
#pragma unroll
                for (int ks = 0; ks < 4; ++ks) { const int pc = 4 * ks + fq;
                    sA0[ks] = *(const LAS bf16x8*)(s0 + 32 * ks); sA1[ks] = *(const LAS bf16x8*)(s1 + 32 * ks); sB[ks] = *(const LAS bf16x8*)(tq + ri * 256 + ((pc ^ l15) << 4)); }
                __builtin_amdgcn_sched_barrier(0);
#pragma unroll
                for (int ks = 0; ks < 2; ++ks) { o0 = __builtin_amdgcn_mfma_f32_16x16x32_bf16(pA0[ks], pB[ks], o0, 0, 0, 0); o1 = __builtin_amdgcn_mfma_f32_16x16x32_bf16(pA1[ks], pB[ks], o1, 0, 0, 0); }
#pragma unroll
                for (int ks = 0; ks < 4; ++ks) { o0 = __builtin_amdgcn_mfma_f32_16x16x32_bf16(sA0[ks], sB[ks], o0, 0, 0, 0); o1 = __builtin_amdgcn_mfma_f32_16x16x32_bf16(sA1[ks], sB[ks], o1, 0, 0, 0); }
                bf16_t* op = OUT + (size_t)(rowbase + ri) * 1024 + vrow0 + 16 * dv0 + 4 * fq;
                u32x2 w0; w0.x = pk_bf16(o0[0], o0[1]); w0.y = pk_bf16(o0[2], o0[3]); u32x2 w1; w1.x = pk_bf16(o1[0], o1[1]); w1.y = pk_bf16(o1[2], o1[3]);
                *(u32x2*)op = w0; *(u32x2*)(op + 16) = w1;
            }
#pragma unroll
            for (int dvt = 0; dvt < 4; ++dvt) { S[dvt] = __builtin_amdgcn_mfma_f32_16x16x32_bf16(K.a, V[dvt][0], S[dvt], 0, 0, 0); S[dvt] = __builtin_amdgcn_mfma_f32_16x16x32_bf16(K.b, V[dvt][1], S[dvt], 0, 0, 0); }
#pragma unroll
            for (int dvt = 0; dvt < 4; ++dvt) { S[dvt] = S[dvt] * K.e;
                u32x2 o; o.x = pk_bf16(S[dvt][0], S[dvt][1]); o.y = pk_bf16(S[dvt][2], S[dvt][3]);
                *(LAS u32x2*)(sbn + (16 * dvt + l15) * 136 + 16 * w + 4 * fq) = o; }
            if (n + 2 < 68) load_k(K, n + 2);
            if (n + 1 < 68) store_p(Pstore, n + 1);
        };
#pragma unroll 1
        for (int n = 0; n < 68; n += 2) { step(n, P0, P1, K0); step(n + 1, P1, P0, K1); }
        __syncthreads();
    }
}

DEVI void phase4_na(const Params& p, LAS unsigned char* lds) {
    const int tid = threadIdx.x; const int wsg = __builtin_amdgcn_readfirstlane(tid >> 6);
    unsigned char* ws = p.ws;
    LAS unsigned char* CK = lds;
    LAS unsigned char* CV = lds + 32768;
    LAS float* RP = (LAS float*)(lds + 65536);
    const bf16_t* QA = (const bf16_t*)(ws + WS_QA); const bf16_t* KA = (const bf16_t*)(ws + WS_KA); const bf16_t* VAT = (const bf16_t*)(ws + WS_VAT);
    bf16_t* OA = (bf16_t*)(ws + WS_AP);
    for (int u = blockIdx.x; u < 512; u += gridDim.x) {
        const int xg = u & 7, idx = u >> 3, bh = xg * 8 + (idx >> 3), rblk = idx & 7, h = bh & 7, b = bh >> 3;
        __syncthreads();
        for (int i = tid; i < 465; i += 512) RP[(i / 31) * 80 + 24 + (i % 31)] = p.in[7][h * 465 + i];
        int tz = tid; asm volatile("" : "+v"(tz));
#pragma unroll
        for (int rep = 0; rep < 4; ++rep) {
            const int q = tz + 512 * rep;
            { const int row = q >> 3, pc = q & 7; *(LAS u32x4*)(CK + row * 128 + ((pc ^ ((row >> 1) & 7)) << 4)) = *(const u32x4*)(KA + (size_t)(NTOK + b * 256 + row) * 512 + h * 64 + pc * 8); }
            { const int row = q >> 5, pc = q & 31; const u32x4 v = *(const u32x4*)(VAT + (size_t)(h * 64 + row) * NROW + NTOK + b * 256 + pc * 8);
              const int sw = (row & 15) << 1; u32x2 lo; lo.x = v.x; lo.y = v.y; u32x2 hi; hi.x = v.z; hi.y = v.w;
              *(LAS u32x2*)(CV + row * 512 + (((2 * pc) ^ sw) << 3)) = lo; *(LAS u32x2*)(CV + row * 512 + (((2 * pc + 1) ^ sw) << 3)) = hi; }
        }
        __syncthreads();
#pragma unroll 1
        for (int qt = 0; qt < 4; ++qt) {
            int lane = (int)__builtin_amdgcn_mbcnt_hi(~0u, __builtin_amdgcn_mbcnt_lo(~0u, 0u)); asm volatile("" : "+v"(lane));
            const int w = wsg, l15 = lane & 15, fq = lane >> 4, r = rblk * 8 + w, rs = min(max(r - 4, 0), 56);
            const int kc0 = min(max(16 * qt - 8, 0), 32);
            const int c = 16 * qt + l15, cs = min(max(c - 8, 0), 48);
            const bf16_t* qp = QA + (size_t)(b * 4096 + r * 64 + c) * 512 + h * 64 + 8 * fq;
            const bf16x8 Bq0 = *(const bf16x8*)qp, Bq1 = *(const bf16x8*)(qp + 32);
            const int lo = 15 + cs - c, d00 = kc0 - 16 * qt + 4 * fq - l15 + 15;
            const LAS unsigned char* rpl = (const LAS unsigned char*)RP + ((rs - r + 7) * 80 + 24 + d00) * 4;
            const char* kbase = (const char*)(KA + (size_t)(b * 4096 + rs * 64 + kc0) * 512 + h * 64); const unsigned klane = (unsigned)(l15 * 512 + 8 * fq) * 2u;
            const char* vbase = (const char*)(VAT + (size_t)(h * 64) * NROW + b * 4096 + rs * 64 + kc0); const unsigned vlane = (unsigned)(l15 * NROW + 4 * fq) * 2u;
#define NA_SB __builtin_amdgcn_sched_barrier(0)
            f32x4 sc[16];
#pragma unroll
            for (int hb = 0; hb < 4; ++hb) {
                bf16x8 kf[4][2];
#pragma unroll
                for (int tt = 0; tt < 4; ++tt) { const int t = 4 * hb + tt, kr = t >> 1, chh = t & 1; const char* kp = (kbase + (size_t)((kr * 64 + 16 * chh) * 1024)) + klane;
                    kf[tt][0] = *(const bf16x8*)kp; kf[tt][1] = *(const bf16x8*)(kp + 64); }
                NA_SB;
#pragma unroll
                for (int tt = 0; tt < 4; ++tt) { const int t = 4 * hb + tt, kr = t >> 1, chh = t & 1;
                    f32x4 a = {0.f, 0.f, 0.f, 0.f};
                    a = __builtin_amdgcn_mfma_f32_16x16x32_bf16(kf[tt][0], Bq0, a, 0, 0, 0); a = __builtin_amdgcn_mfma_f32_16x16x32_bf16(kf[tt][1], Bq1, a, 0, 0, 0);
#pragma unroll
                    for (int j = 0; j < 4; ++j) { const float bias = *(const LAS float*)(rpl + chh * 64 + kr * 320 + j * 4); a[j] = ((unsigned)(d00 + 16 * chh + j - lo) <= 15u) ? a[j] + bias : -INFINITY; }
                    sc[t] = a; }
                NA_SB;
            }
            u32x2 va0[2][4], va1[2][4];
            auto ld_vloc = [&](int uu0) {
#pragma unroll
                for (int q = 0; q < 2; ++q)
#pragma unroll
                    for (int mt = 0; mt < 4; ++mt) { const char* vp = (vbase + (size_t)((16 * mt * NROW + (uu0 + q) * 64) * 2)) + vlane; va0[q][mt] = *(const u32x2*)vp; va1[q][mt] = *(const u32x2*)(vp + 32); } };
            ld_vloc(0);
            NA_SB;
            float mA = -INFINITY;
#pragma unroll
            for (int t = 0; t < 16; ++t) mA = fmaxf(mA, fmaxf(fmaxf(sc[t][0], sc[t][1]), fmaxf(sc[t][2], sc[t][3])));
            mA = fmaxf(mA, __shfl_xor(mA, 16)); mA = fmaxf(mA, __shfl_xor(mA, 32));
            float lA = 0.f; u32x2 pp[16];
#pragma unroll
            for (int t = 0; t < 16; ++t) { const float e0 = __expf(sc[t][0] - mA), e1 = __expf(sc[t][1] - mA), e2 = __expf(sc[t][2] - mA), e3 = __expf(sc[t][3] - mA);
                lA += (e0 + e1) + (e2 + e3); pp[t].x = pk_bf16(e0, e1); pp[t].y = pk_bf16(e2, e3); }
            NA_SB;
            f32x4 o[4];
#pragma unroll
            for (int mt = 0; mt < 4; ++mt) o[mt] = (f32x4){0.f, 0.f, 0.f, 0.f};
            auto mm_vloc = [&](int uu0) {
#pragma unroll
                for (int q = 0; q < 2; ++q) { const int t0 = 2 * (uu0 + q), t1 = t0 + 1;
                    union { u32x4 w; bf16x8 v; } P; P.w.x = pp[t0].x; P.w.y = pp[t0].y; P.w.z = pp[t1].x; P.w.w = pp[t1].y;
#pragma unroll
                    for (int mt = 0; mt < 4; ++mt) { union { u32x4 w; bf16x8 v; } A; A.w.x = va0[q][mt].x; A.w.y = va0[q][mt].y; A.w.z = va1[q][mt].x; A.w.w = va1[q][mt].y; o[mt] = __builtin_amdgcn_mfma_f32_16x16x32_bf16(A.v, P.v, o[mt], 0, 0, 0); } } };
            mm_vloc(0); NA_SB; ld_vloc(2); NA_SB; mm_vloc(2); NA_SB; ld_vloc(4); NA_SB; mm_vloc(4); NA_SB; ld_vloc(6); NA_SB; mm_vloc(6); NA_SB;
            int lane2 = (int)__builtin_amdgcn_mbcnt_hi(~0u, __builtin_amdgcn_mbcnt_lo(~0u, 0u)); asm volatile("" : "+v"(lane2));
            const int l15b = lane2 & 15, fqb = lane2 >> 4, cks = (l15b >> 1) & 7, ck0 = l15b * 128 + ((fqb ^ cks) << 4), ck1 = l15b * 128 + (((4 + fqb) ^ cks) << 4);
            {
                bf16x8 kfA[2][2];
                auto ld_ctx = [&](bf16x8 (&kf)[2][2], auto G) {
#pragma unroll
                    for (int tt = 0; tt < 2; ++tt) { constexpr int tile = 0; const int to = (2 * decltype(G)::v + tt) * 2048 + tile;
                        kf[tt][0] = *(const LAS bf16x8*)(CK + to + ck0); kf[tt][1] = *(const LAS bf16x8*)(CK + to + ck1); } };
                auto mm_ctx = [&](const bf16x8 (&kf)[2][2], auto G) {
#pragma unroll
                    for (int tt = 0; tt < 2; ++tt) { f32x4 a = {0.f, 0.f, 0.f, 0.f};
                        a = __builtin_amdgcn_mfma_f32_16x16x32_bf16(kf[tt][0], Bq0, a, 0, 0, 0); a = __builtin_amdgcn_mfma_f32_16x16x32_bf16(kf[tt][1], Bq1, a, 0, 0, 0);
                        sc[2 * decltype(G)::v + tt] = a; } };
#define NA_CC(G0) ld_ctx(kfA, IC<G0>{}); NA_SB; mm_ctx(kfA, IC<G0>{}); NA_SB;
                NA_CC(0) NA_CC(1) NA_CC(2) NA_CC(3) NA_CC(4) NA_CC(5) NA_CC(6) NA_CC(7)
#undef NA_CC
            }
            float mB = -INFINITY;
#pragma unroll
            for (int t = 0; t < 16; ++t) mB = fmaxf(mB, fmaxf(fmaxf(sc[t][0], sc[t][1]), fmaxf(sc[t][2], sc[t][3])));
            mB = fmaxf(mB, __shfl_xor(mB, 16)); mB = fmaxf(mB, __shfl_xor(mB, 32));
            const float mx = fmaxf(mA, mB), fA = __expf(mA - mx);
            float lB = 0.f;
#pragma unroll
            for (int t = 0; t < 16; ++t) { const float e0 = __expf(sc[t][0] - mx), e1 = __expf(sc[t][1] - mx), e2 = __expf(sc[t][2] - mx), e3 = __expf(sc[t][3] - mx);
                lB += (e0 + e1) + (e2 + e3); pp[t].x = pk_bf16(e0, e1); pp[t].y = pk_bf16(e2, e3); }
            float sum = lA * fA + lB;
            sum += __shfl_xor(sum, 16); sum += __shfl_xor(sum, 32);
            const float inv = 1.0f / sum;
#pragma unroll
            for (int mt = 0; mt < 4; ++mt) o[mt] = o[mt] * fA;
            NA_SB;
            int cvo[4][2];
#pragma unroll
            for (int rr = 0; rr < 4; ++rr)
#pragma unroll
                for (int dd = 0; dd < 2; ++dd) cvo[rr][dd] = l15b * 512 + ((((8 * rr + fqb + 4 * dd) ^ (l15b << 1)) & 31) << 3);
            {
                u32x4 vfA[4], vfB[4];
                auto ld_v = [&](u32x4 (&vq)[4], auto U) {
                    constexpr int uu = decltype(U)::v, q4 = uu >> 2, rr = uu & 3;
#pragma unroll
                    for (int mt = 0; mt < 4; ++mt) { const u32x2 a0 = *(const LAS u32x2*)(CV + mt * 8192 + q4 * 256 + cvo[rr][0]), a1 = *(const LAS u32x2*)(CV + mt * 8192 + q4 * 256 + cvo[rr][1]); vq[mt] = (u32x4){a0.x, a0.y, a1.x, a1.y}; } };
                auto mm_v = [&](const u32x4 (&vq)[4], auto U) {
                    constexpr int uu = decltype(U)::v, t0 = 2 * uu, t1 = 2 * uu + 1;
                    union { u32x4 w; bf16x8 v; } P; P.w.x = pp[t0].x; P.w.y = pp[t0].y; P.w.z = pp[t1].x; P.w.w = pp[t1].y;
#pragma unroll
                    for (int mt = 0; mt < 4; ++mt) { union { u32x4 w; bf16x8 v; } A; A.w = vq[mt]; o[mt] = __builtin_amdgcn_mfma_f32_16x16x32_bf16(A.v, P.v, o[mt], 0, 0, 0); } };
#define NA_PV(U0, U1, U2, U3) mm_v(vfA, IC<U0>{}); NA_SB; ld_v(vfA, IC<U2>{}); NA_SB; mm_v(vfB, IC<U1>{}); NA_SB; ld_v(vfB, IC<U3>{}); NA_SB;
                ld_v(vfA, IC<0>{}); ld_v(vfB, IC<1>{}); NA_SB;
                NA_PV(0, 1, 2, 3) NA_PV(2, 3, 4, 5) NA_PV(4, 5, 6, 7)
                mm_v(vfA, IC<6>{}); NA_SB; mm_v(vfB, IC<7>{}); NA_SB;
#undef NA_PV
            }
#undef NA_SB
            bf16_t* op = OA + (size_t)(b * 4096 + r * 64 + c) * 1536 + h * 64 + 4 * fq;
#pragma unroll
            for (int mt = 0; mt < 4; ++mt) { u32x2 wv; wv.x = pk_bf16(o[mt][0] * inv, o[mt][1] * inv); wv.y = pk_bf16(o[mt][2] * inv, o[mt][3] * inv); *(u32x2*)(op + 16 * mt) = wv; }
        }
    }
}

DEVI void phase5(const Params& p) {
    const int lane = threadIdx.x & 63, gw = blockIdx.x * 8 + (threadIdx.x >> 6), nw = gridDim.x * 8;
    const bf16_t* OF = (const bf16_t*)(p.ws + WS_OF); const bf16_t* OB = (const bf16_t*)(p.ws + WS_OB); const bf16_t* GB = (const bf16_t*)(p.ws + WS_GB); bf16_t* AP = (bf16_t*)(p.ws + WS_AP);
    for (int tok = gw; tok < NTOK; tok += nw) {
#pragma unroll
        for (int hh = 0; hh < 2; ++hh) {
            const int col = hh * 512 + lane * 8;
            const size_t o = (size_t)tok * 1024 + col;
            const u32x4 a = *(const u32x4*)(OF + o), bb = *(const u32x4*)(OB + o), g = *(const u32x4*)(GB + o);
            float v[8] = {bflo(a.x) + bflo(bb.x), bfhi(a.x) + bfhi(bb.x), bflo(a.y) + bflo(bb.y), bfhi(a.y) + bfhi(bb.y), bflo(a.z) + bflo(bb.z), bfhi(a.z) + bfhi(bb.z), bflo(a.w) + bflo(bb.w), bfhi(a.w) + bfhi(bb.w)};
            float ss = 0.f;
#pragma unroll
            for (int e = 0; e < 8; ++e) ss += v[e] * v[e];
            ss += __shfl_xor(ss, 16); ss += __shfl_xor(ss, 8); ss += __shfl_xor(ss, 4); ss += __shfl_xor(ss, 2); ss += __shfl_xor(ss, 1);
            const float rs = rsqrtf(ss * (1.0f / 256.0f) + 1e-6f);
            const f32x4 n0 = *(const f32x4*)(p.in[12] + col), n1 = *(const f32x4*)(p.in[12] + col + 4);
            const float gg[8] = {bflo(g.x), bfhi(g.x), bflo(g.y), bfhi(g.y), bflo(g.z), bfhi(g.z), bflo(g.w), bfhi(g.w)};
            float r[8];
#pragma unroll
            for (int e = 0; e < 8; ++e) r[e] = v[e] * rs * (e < 4 ? n0[e & 3] : n1[e & 3]) * (gg[e] * sigmoidf_(gg[e]));
            u32x4 wv; wv.x = pk_bf16(r[0], r[1]); wv.y = pk_bf16(r[2], r[3]); wv.z = pk_bf16(r[4], r[5]); wv.w = pk_bf16(r[6], r[7]);
            *(u32x4*)(AP + (size_t)tok * 1536 + 512 + col) = wv;
        }
    }
}

DEVI void ln_row(f32x4 (&v)[4], const float* g, const float* bta, int lane) {
    float s = 0.f;
#pragma unroll
    for (int j = 0; j < 4; ++j) s += (v[j][0] + v[j][1]) + (v[j][2] + v[j][3]);
    const float mu = wave_sum(s) * (1.0f / 1024.0f);
    float q = 0.f;
#pragma unroll
    for (int j = 0; j < 4; ++j) { v[j] = v[j] - mu; q += (v[j][0] * v[j][0] + v[j][1] * v[j][1]) + (v[j][2] * v[j][2] + v[j][3] * v[j][3]); }
    const float rstd = rsqrtf(wave_sum(q) * (1.0f / 1024.0f) + 1e-6f);
#pragma unroll
    for (int j = 0; j < 4; ++j) { const f32x4 gg = *(const f32x4*)(g + lane * 4 + 256 * j), bb = *(const f32x4*)(bta + lane * 4 + 256 * j); v[j] = v[j] * rstd * gg + bb; }
}
DEVI void phase9(const Params& p) {
    const int lane = threadIdx.x & 63, gw = blockIdx.x * 8 + (threadIdx.x >> 6), nw = gridDim.x * 8;
    const float* mod = (const float*)(p.ws + WS_MOD); const bf16_t* Z = (const bf16_t*)(p.ws + WS_Z); bf16_t* X1 = (bf16_t*)(p.ws + WS_X1); bf16_t* H2 = (bf16_t*)(p.ws + WS_H2); unsigned char* H8 = p.ws + WS_H2F8;
    for (int tok = gw; tok < NTOK; tok += nw) {
        const float* m = mod + (size_t)(tok >> 12) * 6144; float v[2][8];
#pragma unroll
        for (int j = 0; j < 2; ++j) { const int cidx = lane * 8 + 512 * j;
            const f32x4 x0 = *(const f32x4*)(p.in[0] + (size_t)tok * 1024 + cidx), x1 = *(const f32x4*)(p.in[0] + (size_t)tok * 1024 + cidx + 4), g0 = *(const f32x4*)(m + 2048 + cidx), g1 = *(const f32x4*)(m + 2048 + cidx + 4);
            const u32x4 z = *(const u32x4*)(Z + (size_t)tok * 1024 + cidx);
            float zf[8] = {bflo(z.x), bfhi(z.x), bflo(z.y), bfhi(z.y), bflo(z.z), bfhi(z.z), bflo(z.w), bfhi(z.w)};
#if defined(DBG_NOMIX)
#pragma unroll
            for (int e = 0; e < 8; ++e) zf[e] = 0.f;
#endif
#pragma unroll
            for (int e = 0; e < 4; ++e) { v[j][e] = x0[e] * 1.189207115f + g0[e] * zf[e]; v[j][4 + e] = x1[e] * 1.189207115f + g1[e] * zf[4 + e]; }
        }
        float sm = 0.f;
#pragma unroll
        for (int j = 0; j < 2; ++j)
#pragma unroll
            for (int e = 0; e < 8; ++e) sm += v[j][e];
        const float mu = wave_sum(sm) * (1.0f / 1024.0f); float q = 0.f;
#pragma unroll
        for (int j = 0; j < 2; ++j)
#pragma unroll
            for (int e = 0; e < 8; ++e) { v[j][e] -= mu; q += v[j][e] * v[j][e]; }
        const float rstd = rsqrtf(wave_sum(q) * (1.0f / 1024.0f) + 1e-6f);
#pragma unroll
        for (int j = 0; j < 2; ++j) { const int cidx = lane * 8 + 512 * j;
            const f32x4 g0 = *(const f32x4*)(p.in[16] + cidx), g1 = *(const f32x4*)(p.in[16] + cidx + 4), b0 = *(const f32x4*)(p.in[17] + cidx), b1 = *(const f32x4*)(p.in[17] + cidx + 4);
            const f32x4 sh0 = *(const f32x4*)(m + 3072 + cidx), sh1 = *(const f32x4*)(m + 3072 + cidx + 4), sc0 = *(const f32x4*)(m + 4096 + cidx), sc1 = *(const f32x4*)(m + 4096 + cidx + 4);
            f32x4 o0, o1; float hv[8];
#pragma unroll
            for (int e = 0; e < 4; ++e) { o0[e] = v[j][e] * rstd * g0[e] + b0[e]; o1[e] = v[j][4 + e] * rstd * g1[e] + b1[e]; hv[e] = o0[e] * (sc0[e] + 1.0f) + sh0[e]; hv[4 + e] = o1[e] * (sc1[e] + 1.0f) + sh1[e]; }
            { u32x4 xv; xv.x = pk_bf16(o0[0], o0[1]); xv.y = pk_bf16(o0[2], o0[3]); xv.z = pk_bf16(o1[0], o1[1]); xv.w = pk_bf16(o1[2], o1[3]); *(u32x4*)(X1 + (size_t)tok * 1024 + cidx) = xv; }
            u32x4 wv; wv.x = pk_bf16(hv[0], hv[1]); wv.y = pk_bf16(hv[2], hv[3]); wv.z = pk_bf16(hv[4], hv[5]); wv.w = pk_bf16(hv[6], hv[7]);
            *(u32x4*)(H2 + (size_t)tok * 1024 + cidx) = wv;
            u32x2 w8; w8.x = pk4_fp8(hv[0] * F8_X, hv[1] * F8_X, hv[2] * F8_X, hv[3] * F8_X); w8.y = pk4_fp8(hv[4] * F8_X, hv[5] * F8_X, hv[6] * F8_X, hv[7] * F8_X);
            *(u32x2*)(H8 + (size_t)tok * 1024 + cidx) = w8; }
    }
}
DEVI void phase11(const Params& p, LAS unsigned char* lds, int tok_begin) {
    const int lane = threadIdx.x & 63, half = lane >> 5, tw0 = tok_begin + (threadIdx.x >> 6) * 32;
    LAS unsigned* LC = (LAS unsigned*)(lds + LDS_TAB); LAS unsigned* LB = LC + 256;
    if (threadIdx.x < 256) LC[threadIdx.x] = 0u;
    __syncthreads();
    const float* L0 = (const float*)(p.ws + WS_LOG0);
    int* TID = (int*)(p.ws + WS_TOPK_ID); float* TW = (float*)(p.ws + WS_TOPK_W); int* TP = (int*)(p.ws + WS_TOPK_POS); unsigned* CNT = (unsigned*)(p.ws + WS_CNT);
    float rb[4];
#pragma unroll
    for (int j = 0; j < 4; ++j) rb[j] = p.in[19][lane + 64 * j];
    for (int tok = tw0; tok < tw0 + 32; ++tok) {
        float s[4], bz[4], gs[4];
#pragma unroll
        for (int j = 0; j < 4; ++j) { const float lg = L0[(size_t)tok * 256 + lane + 64 * j]; s[j] = __builtin_amdgcn_rcpf(1.0f + __expf(-lg)); bz[j] = s[j] + rb[j]; }
#pragma unroll
        for (int j = 0; j < 4; ++j) { float m1 = bz[j], m2 = -INFINITY;
#define TOP2_STEP(P1, P2) { const float p1 = (P1), p2 = (P2); const float n1 = fmaxf(m1, p1), n2 = fmaxf(fminf(m1, p1), fmaxf(m2, p2)); m1 = n1; m2 = n2; }
            TOP2_STEP(dppf<DPP_X1>(m1), dppf<DPP_X1>(m2)) TOP2_STEP(dppf<DPP_X2>(m1), dppf<DPP_X2>(m2)) TOP2_STEP(dppf<DPP_HM>(m1), dppf<DPP_HM>(m2)) TOP2_STEP(dppf<DPP_RM>(m1), dppf<DPP_RM>(m2)) TOP2_STEP(x16f(m1, lane), x16f(m2, lane))
#undef TOP2_STEP
            gs[j] = m1 + m2; }
        float Gv[8];
#pragma unroll
        for (int j = 0; j < 4; ++j) { const float oth = x32f(gs[j], lane); Gv[2 * j] = half ? oth : gs[j]; Gv[2 * j + 1] = half ? gs[j] : oth; }
        bool keep[8];
#pragma unroll
        for (int g = 0; g < 8; ++g) { int rank = 0;
#pragma unroll
            for (int g2 = 0; g2 < 8; ++g2) rank += (Gv[g2] > Gv[g] || (Gv[g2] == Gv[g] && g2 < g)) ? 1 : 0;
            keep[g] = rank < 4; }
        unsigned key[4];
#pragma unroll
        for (int j = 0; j < 4; ++j) { const bool k = half ? keep[2 * j + 1] : keep[2 * j]; key[j] = k ? ((__float_as_uint(bz[j] + 1.0f) & 0xFFFFFF00u) | (unsigned)(255 - (lane + 64 * j))) : 0u; }
        int myE = 0;
#pragma unroll
        for (int it = 0; it < 8; ++it) {
            unsigned k = max(max(key[0], key[1]), max(key[2], key[3]));
            k = max(k, (unsigned)dppi<DPP_X1>((int)k)); k = max(k, (unsigned)dppi<DPP_X2>((int)k)); k = max(k, (unsigned)dppi<DPP_HM>((int)k)); k = max(k, (unsigned)dppi<DPP_RM>((int)k));
            k = max(k, (unsigned)x16i((int)k, lane)); k = max(k, (unsigned)x32i((int)k, lane));
#pragma unroll
            for (int j = 0; j < 4; ++j) key[j] = key[j] == k ? 0u : key[j];
            if (lane == it) myE = 255 - (int)(k & 255u);
        }
        float sv;
        { const int src = (myE & 63) << 2, jsel = myE >> 6;
          const float a0 = __builtin_bit_cast(float, __builtin_amdgcn_ds_bpermute(src, __builtin_bit_cast(int, s[0]))), a1 = __builtin_bit_cast(float, __builtin_amdgcn_ds_bpermute(src, __builtin_bit_cast(int, s[1])));
          const float a2 = __builtin_bit_cast(float, __builtin_amdgcn_ds_bpermute(src, __builtin_bit_cast(int, s[2]))), a3 = __builtin_bit_cast(float, __builtin_amdgcn_ds_bpermute(src, __builtin_bit_cast(int, s[3])));
          sv = jsel == 0 ? a0 : (jsel == 1 ? a1 : (jsel == 2 ? a2 : a3)); }
        float ssum = lane < 8 ? sv : 0.f;
        ssum += dppf<DPP_X1>(ssum); ssum += dppf<DPP_X2>(ssum); ssum += dppf<DPP_HM>(ssum);
        if (lane < 8) { const int idx = tok * 8 + lane; TID[idx] = myE; TW[idx] = sv / ssum * 2.5f; TP[idx] = (int)__hip_atomic_fetch_add(LC + myE, 1u, __ATOMIC_RELAXED, __HIP_MEMORY_SCOPE_WORKGROUP); }
    }
    __syncthreads();
    if (threadIdx.x < 256) { const unsigned cnt = LC[threadIdx.x]; LB[threadIdx.x] = cnt ? atomicAdd(&CNT[threadIdx.x], cnt) : 0u; }
    __syncthreads();
    for (int tok = tw0; tok < tw0 + 32; ++tok) if (lane < 8) { const int idx = tok * 8 + lane; TP[idx] += (int)LB[TID[idx]]; }
}
DEVI void phase12(const Params& p, LAS unsigned char* lds, int part) {
    if (part == 0) {
    LAS int* T = (LAS int*)(lds + LDS_TAB);
    moe_tables((const unsigned*)(p.ws + WS_CNT), T);
    const int* TID = (const int*)(p.ws + WS_TOPK_ID); const int* TP = (const int*)(p.ws + WS_TOPK_POS); int* TPw = (int*)(p.ws + WS_TOPK_POS); const float* TW = (const float*)(p.ws + WS_TOPK_W); u32x2* SL = (u32x2*)(p.ws + WS_SLOT);
    for (int idx = blockIdx.x * 512 + threadIdx.x; idx < NTOK * 8; idx += gridDim.x * 512) { const int slot_ = T[256 + TID[idx]] + TP[idx]; u32x2 rec; rec.x = (unsigned)idx; rec.y = __float_as_uint(TW[idx]); SL[slot_] = rec; TPw[idx] = slot_; }
    return; }
    LAS float* tb = (LAS float*)lds;
    __syncthreads();
    const bool even_split = gridDim.x == 256; const int cb = blockIdx.x;
    const int t_lo = even_split ? (cb < 128 ? cb * 18 : 2304 + (cb - 128) * 30) : cb, t_hi = even_split ? t_lo + (cb < 128 ? 18 : 30) : 256 * 24, t_st = even_split ? 1 : (int)gridDim.x;
    for (int t = t_lo; t < t_hi; t += t_st) {
        const int e = t / 24, r = t % 24;
        if (r < 8)       conv_tile8(p.in[20] + (size_t)e * 262144, 256, p.ws + WS_EXPGU + (size_t)e * 524288, 1024, r * 128, 0, 0, F8_WGU, tb);
        else if (r < 16) conv_tile8(p.in[21] + (size_t)e * 262144, 256, p.ws + WS_EXPGU + (size_t)e * 524288, 1024, (r - 8) * 128, 0, 128, F8_WGU, tb);
        else { const int kt = (r - 16) >> 2, nb = (r - 16) & 3; conv_tile8(p.in[22] + (size_t)e * 262144 + nb * 256, 1024, p.ws + WS_EXPD + (size_t)e * 262144, 256, kt * 128, nb * 256, -1, F8_WD, tb); }
    }
}
DEVI void phase15(const Params& p) {
    const int lane = threadIdx.x & 63, gw = blockIdx.x * 8 + (threadIdx.x >> 6), nw = gridDim.x * 8;
    const float* mod = (const float*)(p.ws + WS_MOD); const bf16_t* X1 = (const bf16_t*)(p.ws + WS_X1);
    for (int tok = gw; tok < NTOK; tok += nw) {
        const float* m = mod + (size_t)(tok >> 12) * 6144 + 5120; float v[2][8];
        int sl[8]; float tw[8];
        { const int* tp = (const int*)(p.ws + WS_TOPK_POS) + (size_t)tok * 8; const float* twp = (const float*)(p.ws + WS_TOPK_W) + (size_t)tok * 8;
#pragma unroll
          for (int k = 0; k < 8; ++k) { sl[k] = __builtin_amdgcn_readfirstlane(tp[k]); tw[k] = twp[k]; } }
#pragma unroll
        for (int j = 0; j < 2; ++j) { const int cidx = lane * 8 + 512 * j; float a[8];
#pragma unroll
            for (int e = 0; e < 8; ++e) a[e] = 0.f;
#pragma unroll
            for (int k = 0; k < 9; ++k) { const u32x4 y = *(const u32x4*)((k < 8 ? (const bf16_t*)(p.ws + ws_ys(sl[k])) : (const bf16_t*)(p.ws + WS_Y8) + (size_t)tok * 1024) + cidx); const float w = k < 8 ? tw[k] : 1.0f;
                a[0] += w * bflo(y.x); a[1] += w * bfhi(y.x); a[2] += w * bflo(y.y); a[3] += w * bfhi(y.y); a[4] += w * bflo(y.z); a[5] += w * bfhi(y.z); a[6] += w * bflo(y.w); a[7] += w * bfhi(y.w); }
            const u32x4 xr = *(const u32x4*)(X1 + (size_t)tok * 1024 + cidx);
            const f32x4 g0 = *(const f32x4*)(m + cidx), g1 = *(const f32x4*)(m + cidx + 4), x0 = {bflo(xr.x), bfhi(xr.x), bflo(xr.y), bfhi(xr.y)}, x1 = {bflo(xr.z), bfhi(xr.z), bflo(xr.w), bfhi(xr.w)};
#if defined(DBG_NOMOE)
#pragma unroll
            for (int e = 0; e < 8; ++e) a[e] = 0.f;
#endif
#pragma unroll
            for (int e = 0; e < 4; ++e) { v[j][e] = x0[e] * 1.189207115f + g0[e] * a[e]; v[j][4 + e] = x1[e] * 1.189207115f + g1[e] * a[4 + e]; }
        }
        float sm = 0.f;
#pragma unroll
        for (int j = 0; j < 2; ++j)
#pragma unroll
            for (int e = 0; e < 8; ++e) sm += v[j][e];
        const float mu = wave_sum(sm) * (1.0f / 1024.0f); float q = 0.f;
#pragma unroll
        for (int j = 0; j < 2; ++j)
#pragma unroll
            for (int e = 0; e < 8; ++e) { v[j][e] -= mu; q += v[j][e] * v[j][e]; }
        const float rstd = rsqrtf(wave_sum(q) * (1.0f / 1024.0f) + 1e-6f);
#pragma unroll
        for (int j = 0; j < 2; ++j) { const int cidx = lane * 8 + 512 * j;
            const f32x4 g0 = *(const f32x4*)(p.in[26] + cidx), g1 = *(const f32x4*)(p.in[26] + cidx + 4), b0 = *(const f32x4*)(p.in[27] + cidx), b1 = *(const f32x4*)(p.in[27] + cidx + 4);
            f32x4 o0, o1;
#pragma unroll
            for (int e = 0; e < 4; ++e) { o0[e] = v[j][e] * rstd * g0[e] + b0[e]; o1[e] = v[j][4 + e] * rstd * g1[e] + b1[e]; }
            *(f32x4*)(p.out + (size_t)tok * 1024 + cidx) = o0; *(f32x4*)(p.out + (size_t)tok * 1024 + cidx + 4) = o1; }
    }
}

__global__ void __launch_bounds__(512, 2) mega(Params p) {
    extern __shared__ __attribute__((aligned(16))) unsigned char shm[];
    LAS unsigned char* lds = (LAS unsigned char*)shm;
    volatile LAS unsigned* xbw = (volatile LAS unsigned*)(lds + LDS_BARW);
    if (threadIdx.x == 0) { xbw[0] = 0u; xbw[1] = 0u; xbw[2] = 0u; xbw[3] = 0u; }
    __syncthreads();
    XcdBarrier bar; bar.bar = (unsigned*)(p.ws + WS_CTL); bar.x = 0; bar.st = xbw;
    const bool multi = (p.ph_hi - p.ph_lo) > 1;
    if (multi) bar = xcd_barrier_post((unsigned*)(p.ws + WS_CTL), xbw);
    unsigned char* ws = p.ws;
    const int G = gridDim.x, c = blockIdx.x;
#ifndef PHMASK
#define PHMASK 0xFFFF
#endif
#ifndef REPMASK
#define REPMASK 0
#endif
#define RUN(n) if (((PHMASK >> (n)) & 1) && p.ph_lo <= (n) && (n) < p.ph_hi)
#define SYNC(n) if (p.ph_lo <= (n) && (n) + 1 < p.ph_hi) xcd_barrier(bar); else __syncthreads()
    RUN(0) phase0(p, lds, 0);
#if (REPMASK >> 0) & 1
    __syncthreads();
    RUN(0) phase0(p, lds, 0);
#endif
    SYNC(0);
    RUN(1) { phase1(p); phase0(p, lds, 1); }
#if (REPMASK >> 1) & 1
    __syncthreads();
    RUN(1) { phase1(p); phase0(p, lds, 1); }
#endif
    SYNC(1);
    RUN(2) { SchedInProj S{ws, G, c}; EpiBf16 E; gemm_stream<SchedInProj, EpiBf16, false>(lds, S, E); }
#if (REPMASK >> 2) & 1
    __syncthreads();
    RUN(2) { SchedInProj S{ws, G, c}; EpiBf16 E; gemm_stream<SchedInProj, EpiBf16, false>(lds, S, E); }
#endif
    SYNC(2);
    RUN(3) phase3(p, lds);
#if (REPMASK >> 3) & 1
    __syncthreads();
    RUN(3) phase3(p, lds);
#endif
    SYNC(3);
    RUN(4) { if (c & 1) { phase4_na(p, lds); __syncthreads(); phase4_gla(p, lds); } else { phase4_gla(p, lds); __syncthreads(); phase4_na(p, lds); } }
    SYNC(4);
    RUN(5) phase5(p);
#if (REPMASK >> 5) & 1
    __syncthreads();
    RUN(5) phase5(p);
#endif
    SYNC(5);
#if (REPMASK >> 6) & 1
    __syncthreads();
#endif
    RUN(7) { SchedDense S{(const char*)(ws + WS_AP), (const char*)(ws + WS_BT_BR), (char*)(ws + WS_YM), 1536, G, c, 3072u, 3072u, 24}; EpiBranchC E{(const bf16_t*)(ws + WS_SGA), (const bf16_t*)(ws + WS_SGB), (bf16_t*)(ws + WS_YM)}; gemm_stream<SchedDense, EpiBranchC, false>(lds, S, E); }
#if (REPMASK >> 7) & 1
    __syncthreads();
    RUN(7) { SchedDense S{(const char*)(ws + WS_AP), (const char*)(ws + WS_BT_BR), (char*)(ws + WS_YM), 1536, G, c, 3072u, 3072u, 24}; EpiBranchC E{(const bf16_t*)(ws + WS_SGA), (const bf16_t*)(ws + WS_SGB), (bf16_t*)(ws + WS_YM)}; gemm_stream<SchedDense, EpiBranchC, false>(lds, S, E); }
#endif
    SYNC(7);
    RUN(8) { SchedDense S{(const char*)(ws + WS_YM), (const char*)(ws + WS_BT_OUT), (char*)(ws + WS_Z), 1024, G, c, 2048u, 2048u, 16}; EpiBf16 E; gemm_stream<SchedDense, EpiBf16, false>(lds, S, E); }
#if (REPMASK >> 8) & 1
    __syncthreads();
    RUN(8) { SchedDense S{(const char*)(ws + WS_YM), (const char*)(ws + WS_BT_OUT), (char*)(ws + WS_Z), 1024, G, c, 2048u, 2048u, 16}; EpiBf16 E; gemm_stream<SchedDense, EpiBf16, false>(lds, S, E); }
#endif
    SYNC(8);
    RUN(9) phase9(p);
#if (REPMASK >> 9) & 1
    __syncthreads();
    RUN(9) phase9(p);
#endif
    SYNC(9);
    RUN(10) { if (c < 128) { SchedRouter S{ws, G, c}; EpiF32 E; gemm_stream<SchedRouter, EpiF32, false>(lds, S, E); asm volatile("s_waitcnt vmcnt(0)" ::: "memory"); __syncthreads(); phase11(p, lds, SchedRouter::panel(c) * 256); }
              phase12(p, lds, 1); }
    SYNC(10);
    RUN(12) phase12(p, lds, 0);
#if (REPMASK >> 12) & 1
    __syncthreads();
    RUN(12) phase12(p, lds, 0);
#endif
    SYNC(12);
    RUN(13) { LAS int* T = (LAS int*)(lds + LDS_TAB); moe_tables((const unsigned*)(ws + WS_CNT), T); SchedGateUp S{ws, T, G, c}; EpiGateUp E{ws + WS_HID}; gemm_stream<SchedGateUp, EpiGateUp, true>(lds, S, E); }
#if (REPMASK >> 13) & 1
    __syncthreads();
    RUN(13) { LAS int* T = (LAS int*)(lds + LDS_TAB); moe_tables((const unsigned*)(ws + WS_CNT), T); SchedGateUp S{ws, T, G, c}; EpiGateUp E{ws + WS_HID}; gemm_stream<SchedGateUp, EpiGateUp, true>(lds, S, E); }
#endif
    SYNC(13);
    RUN(14) { LAS int* T = (LAS int*)(lds + LDS_TAB); moe_tables((const unsigned*)(ws + WS_CNT), T); SchedDown S{ws, T, G, c}; EpiDown E{ws}; gemm_stream<SchedDown, EpiDown, false>(lds, S, E); }
#if (REPMASK >> 14) & 1
    __syncthreads();
    RUN(14) { LAS int* T = (LAS int*)(lds + LDS_TAB); moe_tables((const unsigned*)(ws + WS_CNT), T); SchedDown S{ws, T, G, c}; EpiDown E{ws}; gemm_stream<SchedDown, EpiDown, false>(lds, S, E); }
#endif
    SYNC(14);
    RUN(15) phase15(p);
#if (REPMASK >> 15) & 1
    __syncthreads();
    RUN(15) phase15(p);
#endif
}

#ifdef DBG_STOP
__global__ void dbg_dump(const unsigned short* base, size_t nwords, float* out, int accumulate) {
    for (size_t i = (size_t)blockIdx.x * blockDim.x + threadIdx.x; i < (size_t)33554432; i += (size_t)gridDim.x * blockDim.x) {
        float s = accumulate ? out[i] : 0.f;
        for (size_t j = i; j < nwords; j += (size_t)33554432) s += (float)base[j];
        out[i] = s;
    }
}
#endif
}

extern "C" void kernel_launch(void* const* d_in, const int* in_sizes, int n_in, void* d_out, int out_size, void* d_ws, size_t ws_size, hipStream_t stream) {
    static int grid = 0;
    if (grid == 0) {
        if (n_in != 28 || out_size != NTOK * 1024 || ws_size < WS_END) { fprintf(stderr, "kernel_launch: unexpected problem (n_in %d out %d ws %zu)\n", n_in, out_size, ws_size); grid = -1; return; }
        int dev = 0, cus = 0, per_cu = 0;
        if (hipGetDevice(&dev) != hipSuccess || hipDeviceGetAttribute(&cus, hipDeviceAttributeMultiprocessorCount, dev) != hipSuccess) { grid = -1; return; }
        if (hipFuncSetAttribute((const void*)mega, hipFuncAttributeMaxDynamicSharedMemorySize, LDS_TOTAL) != hipSuccess) { fprintf(stderr, "kernel_launch: hipFuncSetAttribute failed\n"); grid = -1; return; }
        if (hipOccupancyMaxActiveBlocksPerMultiprocessor(&per_cu, (const void*)mega, 512, LDS_TOTAL) != hipSuccess || per_cu < 1) fprintf(stderr, "kernel_launch: occupancy query says %d\n", per_cu);
        (void)hipGetLastError();
        grid = cus;
    }
    if (grid < 0) return;
    (void)hipMemsetAsync((char*)d_ws + WS_CTL, 0, 32768, stream);
    Params p{};
    for (int i = 0; i < 28; ++i) p.in[i] = (const float*)d_in[i];
    p.out = (float*)d_out; p.ws = (unsigned char*)d_ws;
#ifdef DBG_STOP
    for (int ph = 0; ph <= DBG_STOP; ++ph) { p.ph_lo = ph; p.ph_hi = ph + 1; hipLaunchKernelGGL(mega, dim3(grid), dim3(512), LDS_TOTAL, stream, p); }
    { const size_t regs[][2] = { DBG_REGS }; int first = 1;
      for (auto& r : regs) { hipLaunchKernelGGL(dbg_dump, dim3(2048), dim3(256), 0, stream, (const unsigned short*)((char*)d_ws + r[0] * MiB), (size_t)(r[1] * MiB / 2), (float*)d_out, first ? 0 : 1); first = 0; } }
#elif MK_PER_PHASE
    for (int ph = 0; ph < NPH; ++ph) {
#if defined(DBG_NOMOE)
        if (ph >= 10 && ph <= 14) continue;
#endif
        p.ph_lo = ph; p.ph_hi = ph + 1; hipLaunchKernelGGL(mega, dim3(grid), dim3(512), LDS_TOTAL, stream, p); }
#else
    p.ph_lo = 0; p.ph_hi = NPH; hipLaunchKernelGGL(mega, dim3(grid), dim3(512), LDS_TOTAL, stream, p);
#endif
}
```

```cpp
#include <hip/hip_runtime.h>
#include <stdint.h>
#include <stdio.h>

#ifndef MK_PER_PHASE
#define MK_PER_PHASE 0
#endif

namespace {
typedef unsigned short bf16_t;
typedef short bf16x8 __attribute__((ext_vector_type(8)));
typedef float f32x4 __attribute__((ext_vector_type(4)));
typedef unsigned u32x4 __attribute__((ext_vector_type(4)));
typedef unsigned u32x2 __attribute__((ext_vector_type(2)));
typedef int i32x4 __attribute__((ext_vector_type(4)));
typedef int i32x8 __attribute__((ext_vector_type(8)));
#define LAS __attribute__((address_space(3)))
#define DEVI __device__ __forceinline__

constexpr int NTOK = 32768, NROW = 34816, NPH = 16;
constexpr size_t MiB = 1ull << 20;
constexpr int LDS_TOTAL = 160 * 1024;
constexpr int LDS_BARW = LDS_TOTAL - 16;
constexpr int LDS_TAB = 131072;

constexpr size_t WS_CTL = 0, WS_CNT = 16384, WS_MOD = 1 * MiB, WS_EE = 2 * MiB, WS_TOPK_ID = 5 * MiB, WS_TOPK_W = 6 * MiB, WS_TOPK_POS = 7 * MiB, WS_SLOT = 8 * MiB;
constexpr size_t WS_BT_IN = 10 * MiB, WS_BT_BR = 24 * MiB  , WS_BT_OUT = 27 * MiB, WS_BT_RT = 29 * MiB, WS_BT_SHGU = 30 * MiB, WS_BT_SHD = 31 * MiB;
constexpr size_t WS_H = 32 * MiB, WS_QA = 100 * MiB, WS_KA = 132 * MiB, WS_QB = 166 * MiB, WS_KB = 198 * MiB, WS_GB = 232 * MiB, WS_SGA = 296 * MiB, WS_SGB = 360 * MiB;
constexpr size_t WS_VAT = 424 * MiB, WS_VBT = 458 * MiB, WS_QTF = 526 * MiB, WS_QTB = 558 * MiB, WS_KTF = 590 * MiB, WS_KTB = 624 * MiB, WS_KTTF = 658 * MiB, WS_KTTB = 692 * MiB;
constexpr size_t WS_OF = 726 * MiB, WS_OB = 790 * MiB, WS_AP = 896 * MiB, WS_LRT = 888 * MiB;
constexpr size_t WS_YM = 424 * MiB, WS_Z = 488 * MiB;
constexpr size_t WS_X1 = 32 * MiB, WS_EXPD = 160 * MiB, WS_LOG0 = 288 * MiB, WS_LOG1 = 320 * MiB, WS_EXPGU = 352 * MiB, WS_H2 = 608 * MiB, WS_HID = 864 * MiB;
constexpr size_t WS_H2F8 = 96 * MiB;
constexpr size_t WS_YS = 288 * MiB;
constexpr size_t WS_Y8 = 800 * MiB, WS_END = 1009 * MiB;
DEVI size_t ws_ys(int slot) { return WS_YS + (size_t)slot * 2048; }
DEVI size_t ws_y(int k) { return (k < 2 ? 160 + 64 * (size_t)k : (k < 6 ? 416 + 64 * (size_t)(k - 2) : 817 + 64 * (size_t)(k - 6))) * MiB; }

struct Params { const float* in[28]; float* out; unsigned char* ws; int ph_lo, ph_hi; };

typedef __bf16 bf16x2_t __attribute__((ext_vector_type(2)));
typedef float f32x2_t __attribute__((ext_vector_type(2)));
DEVI unsigned pk_bf16(float lo, float hi) { const f32x2_t v = {lo, hi}; const bf16x2_t r = __builtin_convertvector(v, bf16x2_t); return __builtin_bit_cast(unsigned, r); }
DEVI float bf2f(bf16_t b) { return __uint_as_float(((unsigned)b) << 16); }
DEVI float bflo(unsigned w) { return __uint_as_float(w << 16); }
DEVI float bfhi(unsigned w) { return __uint_as_float(w & 0xffff0000u); }
DEVI float clamp8(float v) { return __builtin_amdgcn_fmed3f(v, -448.0f, 448.0f); }
DEVI unsigned pk4_fp8(float a, float b, float c, float d) { unsigned w = 0u; w = (unsigned)__builtin_amdgcn_cvt_pk_fp8_f32(clamp8(a), clamp8(b), (int)w, false); w = (unsigned)__builtin_amdgcn_cvt_pk_fp8_f32(clamp8(c), clamp8(d), (int)w, true); return w; }
DEVI i32x8 cat8(bf16x8 a, bf16x8 b) { const i32x4 x = __builtin_bit_cast(i32x4, a), y = __builtin_bit_cast(i32x4, b); return __builtin_shufflevector(x, y, 0, 1, 2, 3, 4, 5, 6, 7); }
DEVI void mfma8(f32x4& acc, i32x8 a, i32x8 b) { asm volatile("v_mfma_f32_16x16x128_f8f6f4 %0, %1, %2, %0" : "+v"(acc) : "v"(a), "v"(b)); }
constexpr float F8_X = 4.0f, F8_WGU = 256.0f, F8_H = 4.0f, F8_WD = 128.0f;
constexpr float F8_HIN = 4.0f, F8_WIN = 256.0f;
DEVI bf16_t f2bf(float f) { return (bf16_t)(pk_bf16(f, 0.f) & 0xffffu); }
DEVI float sigmoidf_(float x) { return __builtin_amdgcn_rcpf(1.0f + __expf(-x)); }
template <int N> struct IC { static constexpr int v = N; };
DEVI void lds_barrier() { asm volatile("s_waitcnt lgkmcnt(0)" ::: "memory"); __builtin_amdgcn_s_barrier(); asm volatile("" ::: "memory"); }
template <int CTRL> DEVI float dppf(float v) { return __builtin_bit_cast(float, __builtin_amdgcn_update_dpp(__builtin_bit_cast(int, v), __builtin_bit_cast(int, v), CTRL, 0xF, 0xF, false)); }
template <int CTRL> DEVI int dppi(int v) { return __builtin_amdgcn_update_dpp(v, v, CTRL, 0xF, 0xF, false); }
DEVI float x16f(float v, int lane) { const auto r = __builtin_amdgcn_permlane16_swap(__builtin_bit_cast(unsigned, v), __builtin_bit_cast(unsigned, v), false, false); return __builtin_bit_cast(float, (lane & 16) ? r[0] : r[1]); }
DEVI int   x16i(int v, int lane)   { const auto r = __builtin_amdgcn_permlane16_swap((unsigned)v, (unsigned)v, false, false); return (int)((lane & 16) ? r[0] : r[1]); }
DEVI float x32f(float v, int lane) { const auto r = __builtin_amdgcn_permlane32_swap(__builtin_bit_cast(unsigned, v), __builtin_bit_cast(unsigned, v), false, false); return __builtin_bit_cast(float, (lane & 32) ? r[0] : r[1]); }
DEVI int   x32i(int v, int lane)   { const auto r = __builtin_amdgcn_permlane32_swap((unsigned)v, (unsigned)v, false, false); return (int)((lane & 32) ? r[0] : r[1]); }
#define DPP_X1 0xB1
#define DPP_X2 0x4E
#define DPP_HM 0x141
#define DPP_RM 0x140
DEVI float wave_sum(float v) { const int lane = threadIdx.x & 63; v += dppf<DPP_X1>(v); v += dppf<DPP_X2>(v); v += dppf<DPP_HM>(v); v += dppf<DPP_RM>(v); v += x16f(v, lane); v += x32f(v, lane); return v; }

#define XB_TMO      128
#define XB_XCNT(j)  (256  + 64 * (j))
#define XB_XSUB(j)  (1280 + 64 * (j))
#define XB_XGEN(j)  (2304 + 64 * (j))
#define XB_TOP      3328
#define XB_TOPGEN   3392
#define XCD_BAR_WORDS 3456
#define XB_SPIN_CAP (1u << 22)
DEVI unsigned xb_ld(unsigned* p)              { return __hip_atomic_load(p, __ATOMIC_RELAXED, __HIP_MEMORY_SCOPE_AGENT); }
DEVI unsigned xb_add(unsigned* p, unsigned v) { return __hip_atomic_fetch_add(p, v, __ATOMIC_RELAXED, __HIP_MEMORY_SCOPE_AGENT); }
DEVI unsigned xb_xcc_id() { return (unsigned)__builtin_amdgcn_s_getreg((3 << 11) | 20) & 0xFu; }
#define XB_SPIN(cond, bar) do { unsigned _sp = 0; while (cond) { __builtin_amdgcn_s_sleep(1); \
    if ((++_sp & 255u) == 0u) { if (xb_ld(&(bar)[XB_TMO])) break; if (_sp > XB_SPIN_CAP) { atomicAdd(&(bar)[XB_TMO], 1u); break; } } } } while (0)
struct XcdBarrier { unsigned* bar; unsigned x; volatile LAS unsigned* st; };
DEVI XcdBarrier xcd_barrier_post(unsigned* bar, volatile LAS unsigned* st) {
    XcdBarrier b; b.bar = bar; b.x = xb_xcc_id(); b.st = st;
    if (threadIdx.x == 0) (void)xb_add(&bar[XB_XCNT(b.x)], 1u);
    return b;
}
DEVI void xcd_barrier_complete(unsigned* bar, unsigned x, unsigned& nloc, unsigned& nx) {
    const unsigned G = gridDim.x * gridDim.y * gridDim.z;
    unsigned sum, cnt, mine, sp = 0u;
    for (;;) {
        sum = 0u; cnt = 0u; mine = 0u;
#pragma unroll
        for (unsigned j = 0; j < 16; ++j) { const unsigned c = xb_ld(&bar[XB_XCNT(j)]); sum += c; cnt += (c > 0u) ? 1u : 0u; mine = (j == x) ? c : mine; }
        if (sum == G) break;
        __builtin_amdgcn_s_sleep(1);
        if ((++sp & 255u) == 0u) { if (xb_ld(&bar[XB_TMO])) break; if (sp > XB_SPIN_CAP) { atomicAdd(&bar[XB_TMO], 1u); break; } }
    }
    nloc = mine > 0u ? mine : 1u; nx = cnt > 0u ? cnt : 1u;
}
DEVI void xcd_barrier(const XcdBarrier& b) {
    asm volatile("s_waitcnt vmcnt(0)" ::: "memory");
    __syncthreads();
    if (threadIdx.x == 0) {
        unsigned* bar = b.bar;
        __builtin_amdgcn_s_waitcnt(0);
        unsigned nloc = b.st[0], nx = b.st[1];
        if (nloc == 0u) { xcd_barrier_complete(bar, b.x, nloc, nx); b.st[0] = nloc; b.st[1] = nx; }
        const unsigned old = xb_add(&bar[XB_XSUB(b.x)], 1u);
        const unsigned gen = old / nloc;
        if (old + 1u == (gen + 1u) * nloc) {
            __builtin_amdgcn_fence(__ATOMIC_RELEASE, "agent");
            asm volatile("s_waitcnt vmcnt(0)" ::: "memory");
            const unsigned og = xb_add(&bar[XB_TOP], 1u);
            const unsigned tg = og / nx;
            if (og + 1u == (tg + 1u) * nx) xb_add(&bar[XB_TOPGEN], 1u);
            else XB_SPIN(xb_ld(&bar[XB_TOPGEN]) == tg, bar);
            __builtin_amdgcn_fence(__ATOMIC_ACQUIRE, "agent");
            xb_add(&bar[XB_XGEN(b.x)], 1u);
            asm volatile("s_waitcnt vmcnt(0)" ::: "memory");
        } else {
            XB_SPIN(xb_ld(&bar[XB_XGEN(b.x)]) == gen, bar);
            __builtin_amdgcn_fence(__ATOMIC_ACQUIRE, "agent");
            asm volatile("s_waitcnt vmcnt(0)" ::: "memory");
        }
    }
    __syncthreads();
}

constexpr int BK = 64, HALF = 128, HTB = HALF * BK * 2;
DEVI int lds_byte(int r, int c) { const int st = (r >> 4) * 2 + (c >> 5), rr = r & 15, cc = c & 31, ob = rr * 64 + cc * 2; return st * 1024 + (ob ^ (((ob >> 9) & 1) << 5)); }
DEVI void stage_rc(int b, int& R, int& C) { const int st = b / 1024, sb = b % 1024, swz = sb ^ (((sb >> 9) & 1) << 5); R = (st >> 1) * 16 + swz / 64; C = (st & 1) * 32 + (swz % 64) / 2; }
DEVI int perm32(int rho) { const int n = rho >> 4, i = rho & 15; return 8 * (i >> 2) + 4 * n + (i & 3); }

struct GUnit {
    const char* a; const char* b;
    char* dst; int ldd; int i0, i1, i2; float f0;
};
typedef f32x4 Acc[2][2][4][2];
#define ZA1(a, b, m) acc[a][b][m][0] = z; acc[a][b][m][1] = z;
#define ZA2(a, b) ZA1(a, b, 0) ZA1(a, b, 1) ZA1(a, b, 2) ZA1(a, b, 3)
DEVI void zero_acc(Acc& acc) { f32x4 z = {0.f, 0.f, 0.f, 0.f}; asm volatile("" : "+v"(z)); ZA2(0, 0) ZA2(0, 1) ZA2(1, 0) ZA2(1, 1) }

template <class Sched, class Epi, bool GATHER>
DEVI void gemm_stream(LAS unsigned char* lds, const Sched& S, const Epi& E) {
    const int tid = threadIdx.x, wid = __builtin_amdgcn_readfirstlane(tid >> 6), lane = tid & 63, wr = wid >> 2, wc = wid & 3, fr = lane & 15, fq = lane >> 4;
    const unsigned lda = S.lda, ldb = S.ldb; const int nt = S.nt;
    unsigned voffA[2], voffB[2]; int R0 = 0;
#pragma unroll
    for (int i = 0; i < 2; ++i) { int R, C; stage_rc(tid * 16 + i * 8192, R, C); const int Rb = (R & ~31) + perm32(R & 31);
        if (i == 0) R0 = R;
        voffA[i] = GATHER ? (unsigned)(C * 2) : (unsigned)R * lda + (unsigned)(C * 2); voffB[i] = (unsigned)Rb * ldb + (unsigned)(C * 2); }
    const size_t kstep = (size_t)(BK * 2);
    const size_t hstepA = GATHER ? (size_t)0 : (size_t)HALF * lda, hstepB = (size_t)HALF * ldb;
    const unsigned ldsw = (unsigned)wid * 1024u;
    const int aoff = lds_byte(wr * 64 + fr, fq * 8), boff = lds_byte(wc * 32 + fr, fq * 8);
#define G_SA(b, h) (((b) * 2 + (h)) * HTB)
#define G_SB(b, h) ((4 + (b) * 2 + (h)) * HTB)
#define G_STAGE(bufoff, gbase, o0, o1) do { \
        __builtin_amdgcn_global_load_lds((const unsigned*)((const char*)(gbase) + (o0)), (LAS unsigned*)(lds + (bufoff) + ldsw), 16, 0, 0); \
        __builtin_amdgcn_global_load_lds((const unsigned*)((const char*)(gbase) + (o1)), (LAS unsigned*)(lds + (bufoff) + ldsw + 8192), 16, 0, 0); } while (0)
#define G_LDA(dst, b, h) do { _Pragma("unroll") for (int m = 0; m < 4; ++m) _Pragma("unroll") for (int k = 0; k < 2; ++k) dst[m][k] = *(const LAS bf16x8*)(lds + G_SA(b, h) + aoff + m * 2048 + k * 1024); } while (0)
#define G_LDB(dst, b, h) do { _Pragma("unroll") for (int n = 0; n < 2; ++n) _Pragma("unroll") for (int k = 0; k < 2; ++k) dst[n][k] = *(const LAS bf16x8*)(lds + G_SB(b, h) + boff + n * 2048 + k * 1024); } while (0)
#define G_MMA(ai, bj, At, Bt) do { __builtin_amdgcn_s_setprio(1); \
        if constexpr (Sched::F8) { _Pragma("unroll") for (int m = 0; m < 4; ++m) _Pragma("unroll") for (int n = 0; n < 2; ++n) \
            mfma8(acc[ai][bj][m][n], cat8(Bt[n][0], Bt[n][1]), cat8(At[m][0], At[m][1])); } \
        else { _Pragma("unroll") for (int m = 0; m < 4; ++m) _Pragma("unroll") for (int n = 0; n < 2; ++n) _Pragma("unroll") for (int k = 0; k < 2; ++k) \
            acc[ai][bj][m][n] = __builtin_amdgcn_mfma_f32_16x16x32_bf16(Bt[n][k], At[m][k], acc[ai][bj][m][n], 0, 0, 0); } \
        __builtin_amdgcn_s_setprio(0); } while (0)
#define G_WAIT_V(n) asm volatile("s_waitcnt vmcnt(" #n ")" ::: "memory")
#define G_WAIT_L(n) asm volatile("s_waitcnt lgkmcnt(" #n ")" ::: "memory")
#define G_BAR __builtin_amdgcn_s_barrier()
#define G_SCHED __builtin_amdgcn_sched_barrier(0)
    GUnit cur, nxt; int ui = 0;
    if (!S.next(0, cur)) return;
    unsigned gc[2][2], gn[2][2];
    gc[0][0] = voffA[0]; gc[0][1] = voffA[1]; gc[1][0] = voffA[0]; gc[1][1] = voffA[1];
    gn[0][0] = voffA[0]; gn[0][1] = voffA[1]; gn[1][0] = voffA[0]; gn[1][1] = voffA[1];
    if constexpr (GATHER) { S.gather(cur, R0, gc); gc[0][0] += voffA[0]; gc[0][1] += voffA[0]; gc[1][0] += voffA[0]; gc[1][1] += voffA[0]; }
    Acc acc; zero_acc(acc);
    typename Epi::Pre pre; E.pre(cur, wr, lane, pre);
    bf16x8 At[4][2], B0[2][2], B1[2][2];
    const char* cA = cur.a; const char* cB = cur.b;
    G_STAGE(G_SB(0, 0), cB, voffB[0], voffB[1]); G_STAGE(G_SA(0, 0), cA, gc[0][0], gc[0][1]); G_STAGE(G_SB(0, 1), cB + hstepB, voffB[0], voffB[1]); G_STAGE(G_SA(0, 1), cA + hstepA, gc[1][0], gc[1][1]);
    if (wr == 1) G_BAR;
    G_WAIT_V(4); G_BAR;
    G_STAGE(G_SB(1, 0), cB + kstep, voffB[0], voffB[1]); G_STAGE(G_SA(1, 0), cA + kstep, gc[0][0], gc[0][1]); G_STAGE(G_SB(1, 1), cB + hstepB + kstep, voffB[0], voffB[1]);
    G_WAIT_V(6); G_BAR;
    for (;;) {
        const bool has_next = S.next(ui + 1, nxt);
        const char* nA = has_next ? nxt.a : cA; const char* nB = has_next ? nxt.b : cB;
        for (int t = 0; t < nt; t += 2) {
            const bool last = (t == nt - 2);
            const char* a1 = cA + (size_t)(t + 1) * kstep;
            const char* a2 = last ? nA : cA + (size_t)(t + 2) * kstep; const char* b2 = last ? nB : cB + (size_t)(t + 2) * kstep;
            const char* a3 = a2 + kstep; const char* b3 = b2 + kstep;
            unsigned g2[2][2];
            if constexpr (GATHER) { g2[0][0] = last ? gn[0][0] : gc[0][0]; g2[0][1] = last ? gn[0][1] : gc[0][1]; g2[1][0] = last ? gn[1][0] : gc[1][0]; g2[1][1] = last ? gn[1][1] : gc[1][1]; }
            else { g2[0][0] = voffA[0]; g2[0][1] = voffA[1]; g2[1][0] = voffA[0]; g2[1][1] = voffA[1]; }
            if constexpr (GATHER) { if (t == nt - 4) {
                if (has_next) { S.gather(nxt, R0, gn); gn[0][0] += voffA[0]; gn[0][1] += voffA[0]; gn[1][0] += voffA[0]; gn[1][1] += voffA[0]; }
                else { gn[0][0] = gc[0][0]; gn[0][1] = gc[0][1]; gn[1][0] = gc[1][0]; gn[1][1] = gc[1][1]; } } }
            if constexpr (Epi::MID_T > 0) { if (t == Epi::MID_T) { int tz = threadIdx.x; asm volatile("" : "+v"(tz)); const int wz = tz >> 6, lz = tz & 63; E.mid(acc, cur, wz >> 2, wz & 3, lz & 15, lz >> 4); } }
            G_LDB(B0, 0, 0); G_SCHED; G_LDA(At, 0, 0); G_STAGE(G_SA(1, 1), a1 + hstepA, gc[1][0], gc[1][1]);
            G_WAIT_L(8); G_BAR; G_WAIT_L(0); G_MMA(0, 0, At, B0); G_BAR; G_SCHED;
            G_LDB(B1, 0, 1); G_STAGE(G_SB(0, 0), b2, voffB[0], voffB[1]);
            G_BAR; G_WAIT_L(0); G_MMA(0, 1, At, B1); G_BAR;
            G_LDA(At, 0, 1); G_STAGE(G_SA(0, 0), a2, g2[0][0], g2[0][1]);
            G_BAR; G_WAIT_L(0); G_MMA(1, 0, At, B0); G_BAR; G_SCHED;
            G_STAGE(G_SB(0, 1), b2 + hstepB, voffB[0], voffB[1]);
            G_WAIT_V(6); G_BAR; G_MMA(1, 1, At, B1); G_BAR;
            G_LDB(B0, 1, 0); G_SCHED; G_LDA(At, 1, 0); G_STAGE(G_SA(0, 1), a2 + hstepA, g2[1][0], g2[1][1]);
            G_WAIT_L(8); G_BAR; G_WAIT_L(0); G_MMA(0, 0, At, B0); G_BAR; G_SCHED;
            G_LDB(B1, 1, 1); G_STAGE(G_SB(1, 0), b3, voffB[0], voffB[1]);
            G_BAR; G_WAIT_L(0); G_MMA(0, 1, At, B1); G_BAR;
            G_LDA(At, 1, 1); G_STAGE(G_SA(1, 0), a3, g2[0][0], g2[0][1]);
            G_BAR; G_WAIT_L(0); G_MMA(1, 0, At, B0); G_BAR; G_SCHED;
            G_STAGE(G_SB(1, 1), b3 + hstepB, voffB[0], voffB[1]);
            G_WAIT_V(6); G_BAR; G_MMA(1, 1, At, B1); G_BAR;
        }
        if constexpr (Sched::F8) asm volatile("s_nop 15\n\ts_nop 15\n\ts_nop 15" ::: "memory");
        { int tz = threadIdx.x; asm volatile("" : "+v"(tz)); const int wz = tz >> 6, lz = tz & 63; E(acc, cur, wz >> 2, wz & 3, lz & 15, lz >> 4, pre); }
        if (!has_next) break;
        zero_acc(acc);
        cur = nxt; cA = nA; cB = nB; ++ui;
        E.pre(cur, wr, lane, pre);
        if constexpr (GATHER) { gc[0][0] = gn[0][0]; gc[0][1] = gn[0][1]; gc[1][0] = gn[1][0]; gc[1][1] = gn[1][1]; }
    }
    G_WAIT_V(0);
    if (wr == 0) G_BAR;
    G_BAR;
}

struct EpiBf16 { static constexpr int MID_T = 0; DEVI void mid(Acc&, const GUnit&, int, int, int, int) const {}
    struct Pre {}; DEVI void pre(const GUnit&, int, int, Pre&) const {}
    DEVI void operator()(const Acc& acc, const GUnit& u, int wr, int wc, int fr, int fq, const Pre&) const {
        if (u.f0 < 0.f) {
            float* fb = (float*)u.dst; const float sn = -u.f0;
#pragma unroll
            for (int m = 0; m < 4; ++m) { const int row = wr * 64 + m * 16 + fr;
                if (row < 32) { float* rp = fb + (size_t)row * u.ldd + wc * 32 + 8 * fq;
#pragma unroll
                    for (int bj = 0; bj < 2; ++bj) { *(f32x4*)(rp + bj * 128) = acc[0][bj][m][0] * sn; *(f32x4*)(rp + bj * 128 + 4) = acc[0][bj][m][1] * sn; } } }
            return;
        }
        bf16_t* base = (bf16_t*)u.dst; const float s = u.f0; const int act = u.i0;
#pragma unroll
        for (int ai = 0; ai < 2; ++ai)
#pragma unroll
            for (int m = 0; m < 4; ++m) {
                bf16_t* rp = base + (size_t)(ai * 128 + wr * 64 + m * 16 + fr) * u.ldd + wc * 32 + 8 * fq;
#pragma unroll
                for (int bj = 0; bj < 2; ++bj) {
                    f32x4 v0 = acc[ai][bj][m][0] * s, v1 = acc[ai][bj][m][1] * s;
                    if (act) {
#pragma unroll
                        for (int j = 0; j < 4; ++j) { v0[j] = sigmoidf_(v0[j]); v1[j] = sigmoidf_(v1[j]); }
                    }
                    u32x4 w; w.x = pk_bf16(v0[0], v0[1]); w.y = pk_bf16(v0[2], v0[3]); w.z = pk_bf16(v1[0], v1[1]); w.w = pk_bf16(v1[2], v1[3]);
                    *(u32x4*)(rp + bj * 128) = w;
                }
            }
    }
};
struct EpiF32 { static constexpr int MID_T = 0; DEVI void mid(Acc&, const GUnit&, int, int, int, int) const {}
    struct Pre {}; DEVI void pre(const GUnit&, int, int, Pre&) const {}
    DEVI void operator()(const Acc& acc, const GUnit& u, int wr, int wc, int fr, int fq, const Pre&) const {
        float* base = (float*)u.dst;
#pragma unroll
        for (int ai = 0; ai < 2; ++ai)
#pragma unroll
            for (int m = 0; m < 4; ++m) {
                float* rp = base + (size_t)(ai * 128 + wr * 64 + m * 16 + fr) * u.ldd + wc * 32 + 8 * fq;
#pragma unroll
                for (int bj = 0; bj < 2; ++bj) { *(f32x4*)(rp + bj * 128) = acc[ai][bj][m][0]; *(f32x4*)(rp + bj * 128 + 4) = acc[ai][bj][m][1]; }
            }
    }
};
struct EpiBranchC {
    static constexpr int MID_T = 8;
    const bf16_t* sga; const bf16_t* sgb; bf16_t* ym;
    struct Pre {}; DEVI void pre(const GUnit&, int, int, Pre&) const {}
    DEVI void mid(Acc& acc, const GUnit& u, int wr, int wc, int fr, int fq) const {
#pragma unroll
        for (int ai = 0; ai < 2; ++ai)
#pragma unroll
            for (int m = 0; m < 4; ++m) {
                const size_t ro = (size_t)(u.i1 + ai * 128 + wr * 64 + m * 16 + fr) * 1024 + u.i2 + wc * 32 + 8 * fq;
#pragma unroll
                for (int bj = 0; bj < 2; ++bj) {
                    const u32x4 ga = *(const u32x4*)(sga + ro + bj * 128), gb = *(const u32x4*)(sgb + ro + bj * 128);
                    f32x4 r0, r1;
                    r0[0] = bflo(ga.x) * __builtin_amdgcn_rcpf(bflo(gb.x)); r0[1] = bfhi(ga.x) * __builtin_amdgcn_rcpf(bfhi(gb.x)); r0[2] = bflo(ga.y) * __builtin_amdgcn_rcpf(bflo(gb.y)); r0[3] = bfhi(ga.y) * __builtin_amdgcn_rcpf(bfhi(gb.y));
                    r1[0] = bflo(ga.z) * __builtin_amdgcn_rcpf(bflo(gb.z)); r1[1] = bfhi(ga.z) * __builtin_amdgcn_rcpf(bfhi(gb.z)); r1[2] = bflo(ga.w) * __builtin_amdgcn_rcpf(bflo(gb.w)); r1[3] = bfhi(ga.w) * __builtin_amdgcn_rcpf(bfhi(gb.w));
                    acc[ai][bj][m][0] = acc[ai][bj][m][0] * r0; acc[ai][bj][m][1] = acc[ai][bj][m][1] * r1;
                }
            }
    }
    DEVI void operator()(const Acc& acc, const GUnit& u, int wr, int wc, int fr, int fq, const Pre&) const {
#pragma unroll
        for (int ai = 0; ai < 2; ++ai)
#pragma unroll
            for (int m = 0; m < 4; ++m) {
                const size_t ro = (size_t)(u.i1 + ai * 128 + wr * 64 + m * 16 + fr) * 1024 + u.i2 + wc * 32 + 8 * fq;
#pragma unroll
                for (int bj = 0; bj < 2; ++bj) {
                    const u32x4 gb = *(const u32x4*)(sgb + ro + bj * 128);
                    const f32x4 v0 = acc[ai][bj][m][0], v1 = acc[ai][bj][m][1];
                    u32x4 w;
                    w.x = pk_bf16(bflo(gb.x) * v0[0], bfhi(gb.x) * v0[1]); w.y = pk_bf16(bflo(gb.y) * v0[2], bfhi(gb.y) * v0[3]);
                    w.z = pk_bf16(bflo(gb.z) * v1[0], bfhi(gb.z) * v1[1]); w.w = pk_bf16(bflo(gb.w) * v1[2], bfhi(gb.w) * v1[3]);
                    *(u32x4*)(ym + ro + bj * 128) = w;
                }
            }
    }
};
struct EpiGateUp { static constexpr int MID_T = 0; DEVI void mid(Acc&, const GUnit&, int, int, int, int) const {}
    unsigned char* hid;
    struct Pre {}; DEVI void pre(const GUnit&, int, int, Pre&) const {}
    DEVI void operator()(const Acc& acc, const GUnit& u, int wr, int wc, int fr, int fq, const Pre&) const {
#pragma unroll
        for (int ai = 0; ai < 2; ++ai)
#pragma unroll
            for (int m = 0; m < 4; ++m) {
                const int row = ai * 128 + wr * 64 + m * 16 + fr;
                if (row < u.i1) {
                    constexpr float si = 1.0f / (F8_X * F8_WGU), so = F8_H * si;
                    const f32x4 g0 = acc[ai][0][m][0] * si, g1 = acc[ai][0][m][1] * si, u0 = acc[ai][1][m][0] * so, u1 = acc[ai][1][m][1] * so;
                    float h[8];
#pragma unroll
                    for (int j = 0; j < 4; ++j) { h[j] = g0[j] * sigmoidf_(g0[j]) * u0[j]; h[4 + j] = g1[j] * sigmoidf_(g1[j]) * u1[j]; }
                    u32x2 w; w.x = pk4_fp8(h[0], h[1], h[2], h[3]); w.y = pk4_fp8(h[4], h[5], h[6], h[7]);
                    *(u32x2*)(hid + (size_t)(u.i0 + row) * 256 + u.i2 * 128 + wc * 32 + 8 * fq) = w;
                }
            }
    }
};
struct EpiDown {
    static constexpr int MID_T = 0; DEVI void mid(Acc&, const GUnit&, int, int, int, int) const {}
    unsigned char* ws;
    struct Pre {}; DEVI void pre(const GUnit&, int, int, Pre&) const {}
    DEVI void operator()(const Acc& acc, const GUnit& u, int wr, int wc, int fr, int fq, const Pre&) const {
#pragma unroll
        for (int ai = 0; ai < 2; ++ai)
#pragma unroll
            for (int m = 0; m < 4; ++m) {
                const int row = ai * 128 + wr * 64 + m * 16 + fr;
                if (row < u.i1) {
                    bf16_t* rp = (u.i2 == 0 ? (bf16_t*)(ws + ws_ys(u.i0 + row)) : (bf16_t*)(ws + WS_Y8) + (size_t)(u.i0 + row) * 1024) + u.ldd + wc * 32 + 8 * fq;
#pragma unroll
                    for (int bj = 0; bj < 2; ++bj) {
                        constexpr float sd = 1.0f / (F8_H * F8_WD);
                        const f32x4 v0 = acc[ai][bj][m][0] * sd, v1 = acc[ai][bj][m][1] * sd;
                        u32x4 o; o.x = pk_bf16(v0[0], v0[1]); o.y = pk_bf16(v0[2], v0[3]); o.z = pk_bf16(v1[0], v1[1]); o.w = pk_bf16(v1[2], v1[3]);
                        *(u32x4*)(rp + bj * 128) = o;
                    }
                }
            }
    }
};

struct SchedInProj {
    unsigned char* ws; int G, c;
    static constexpr unsigned lda = 1024, ldb = 1024; static constexpr int nt = 8; static constexpr bool F8 = true;
    DEVI bool next(int i, GUnit& u) const {
        const int L = i * G + c; if (L >= 3544) return false;
        constexpr float us = 1.0f / (F8_HIN * F8_WIN);
        u.i0 = 0; u.i1 = 0; u.i2 = 0; u.f0 = us;
        const char* H = (const char*)(ws + WS_H); const char* BT = (const char*)(ws + WS_BT_IN);
        int pm, pn;
        if (L < 2592) {
            if (L < 2560) { const int x = L & 7, q = L >> 3, blk = q >> 5, w = q & 31; pm = 16 * x + 8 * (blk & 1) + (w & 7); pn = 4 * (blk >> 1) + (w >> 3); }
            else { const int j = L - 2560, jn = j >> 3; pm = 128 + (j & 7); pn = jn < 2 ? 2 + jn : 4 + jn; }
            u.a = H + (size_t)pm * 256 * 1024; u.b = BT + (size_t)pn * 256 * 1024;
            size_t base; int ld, col;
            if (pn < 2)       { base = WS_QA; ld = 512; col = pn * 256; u.f0 = 0.125f * us; }
            else if (pn < 4)  { base = WS_KA; ld = 512; col = (pn - 2) * 256; }
            else if (pn < 6)  { base = WS_QB; ld = 512; col = (pn - 4) * 256; }
            else if (pn < 8)  { base = WS_KB; ld = 512; col = (pn - 6) * 256; }
            else if (pn < 12) { base = WS_GB; ld = 1024; col = (pn - 8) * 256; }
            else if (pn < 16) { base = WS_SGA; ld = 1024; col = (pn - 12) * 256; u.i0 = 1; }
            else              { base = WS_SGB; ld = 1024; col = (pn - 16) * 256; u.i0 = 1; }
            u.dst = (char*)(ws + base) + ((size_t)pm * 256 * ld + col) * 2; u.ldd = ld;
        } else {
            const int j = L - 2592, x = j & 7, q = j >> 3, tn = 17 * x + q / 7, wm = q % 7;
            u.a = BT + (size_t)(5120 + wm * 256) * 1024; u.b = H + (size_t)tn * 256 * 1024;
            u.dst = (wm < 2 ? (char*)(ws + WS_VAT) + ((size_t)(wm * 256) * NROW + tn * 256) * 2 : (wm < 6 ? (char*)(ws + WS_VBT) + ((size_t)((wm - 2) * 256) * NROW + tn * 256) * 2 : (char*)(ws + WS_LRT) + (size_t)(tn * 256) * 4));
            u.ldd = NROW; if (wm == 6) u.f0 = -us;
        }
        return true;
    }
};
struct SchedDense {
    const char* A; const char* Bt; char* dst; int K; int G, c; unsigned lda, ldb; int nt; static constexpr bool F8 = false;
    DEVI bool next(int i, GUnit& u) const {
        const int L = i * G + c; if (L >= 512) return false;
        const int x = L & 7, q = L >> 3, blk = q >> 5, w = q & 31, pm = 16 * x + 8 * blk + (w & 7), pn = w >> 3;
        u.a = A + (size_t)pm * 256 * K * 2; u.b = Bt + (size_t)pn * 256 * K * 2;
        u.dst = dst + ((size_t)pm * 256 * 1024 + pn * 256) * 2; u.ldd = 1024; u.i0 = 0; u.i1 = pm * 256; u.i2 = pn * 256; u.f0 = 1.0f;
        return true;
    }
};
struct SchedRouter {
    unsigned char* ws; int G, c;
    static constexpr unsigned lda = 2048, ldb = 2048; static constexpr int nt = 16; static constexpr bool F8 = false;
    DEVI static int panel(int c) { return 16 * (c & 7) + (c >> 3); }
    DEVI bool next(int i, GUnit& u) const {
        if (i > 0 || c >= 128) return false;
        const int pm = panel(c);
        u.a = (const char*)(ws + WS_H2) + (size_t)pm * 256 * 2048; u.b = (const char*)(ws + WS_BT_RT);
        u.dst = (char*)(ws + WS_LOG0) + (size_t)pm * 256 * 256 * 4; u.ldd = 256; u.i0 = 0; u.i1 = 0; u.i2 = 0; u.f0 = 1.0f;
        return true;
    }
};
DEVI void moe_tables(const unsigned* gcnt, LAS int* T) {
    if (threadIdx.x < 64) {
        const int l = threadIdx.x; int c[4], t[4];
#pragma unroll
        for (int k = 0; k < 4; ++k) { c[k] = (int)gcnt[4 * l + k]; t[k] = (c[k] + 255) >> 8; }
        const int sc = c[0] + c[1] + c[2] + c[3], st = t[0] + t[1] + t[2] + t[3];
        int ic = sc, it = st;
#pragma unroll
        for (int o = 1; o < 64; o <<= 1) { const int a = __shfl_up(ic, o), b = __shfl_up(it, o); if (l >= o) { ic += a; it += b; } }
        int bc = ic - sc, bt = it - st;
#pragma unroll
        for (int k = 0; k < 4; ++k) { T[4 * l + k] = c[k]; T[256 + 4 * l + k] = bc; T[513 + 4 * l + k] = bt; bc += c[k]; bt += t[k]; }
        if (l == 63) { T[256 + 256] = ic; T[513 + 256] = it; }
    }
    __syncthreads();
    {
        const int TRt = T[513 + 256];
        for (int t = threadIdx.x; t < TRt; t += 512) { int lo = 0, hi = 256; while (hi - lo > 1) { const int mid = (lo + hi) >> 1; if (T[513 + mid] <= t) lo = mid; else hi = mid; } T[770 + t] = lo; }
    }
    __syncthreads();
}
DEVI int moe_find(const LAS int* toff, int t) {
    int lo = 0, hi = 256;
#pragma unroll 1
    while (hi - lo > 1) { const int mid = (lo + hi) >> 1; if (toff[mid] <= t) lo = mid; else hi = mid; }
    return __builtin_amdgcn_readfirstlane(lo);
}
struct SchedGateUp {
    unsigned char* ws; const LAS int* T; int G, c;
    static constexpr unsigned lda = 1024, ldb = 1024; static constexpr int nt = 8; static constexpr bool F8 = true;
    DEVI bool next(int i, GUnit& u) const {
        const int L = i * G + c; const int TR = __builtin_amdgcn_readfirstlane(T[513 + 256]);
        if (L >= 2 * TR + 256) return false;
        u.a = (const char*)(ws + WS_H2F8); u.dst = nullptr; u.ldd = 0; u.f0 = 1.0f;
        if (L < 2 * TR) {
            const int t = L >> 1, pn = L & 1, e = __builtin_amdgcn_readfirstlane(T[770 + t]), mt = t - __builtin_amdgcn_readfirstlane(T[513 + e]), cnt = __builtin_amdgcn_readfirstlane(T[e]);
            u.b = (const char*)(ws + WS_EXPGU) + ((size_t)e * 512 + pn * 256) * 1024;
            u.i0 = __builtin_amdgcn_readfirstlane(T[256 + e]) + mt * 256; u.i1 = min(256, cnt - mt * 256); u.i2 = pn;
        } else {
            const int j = L - 2 * TR, mt = j >> 1, pn = j & 1;
            u.b = (const char*)(ws + WS_BT_SHGU) + (size_t)(pn * 256) * 1024;
            u.i0 = 262144 + mt * 256; u.i1 = 256; u.i2 = pn;
        }
        return true;
    }
    DEVI void gather(const GUnit& u, int R0, unsigned (&g)[2][2]) const {
        const u32x2* slot = (const u32x2*)(ws + WS_SLOT);
#pragma unroll
        for (int h = 0; h < 2; ++h)
#pragma unroll
            for (int i = 0; i < 2; ++i) {
                const int s = u.i0 + h * 128 + R0 + 64 * i; int tok;
                if (u.i0 >= 262144) tok = s - 262144; else tok = (int)(slot[min(s, 262143)].x >> 3);
                g[h][i] = (unsigned)tok * 1024u;
            }
    }
};
struct SchedDown {
    unsigned char* ws; const LAS int* T; int G, c;
    static constexpr unsigned lda = 256, ldb = 256; static constexpr int nt = 2; static constexpr bool F8 = true;
    DEVI bool next(int i, GUnit& u) const {
        const int L = i * G + c; const int TR = __builtin_amdgcn_readfirstlane(T[513 + 256]);
        if (L >= 4 * TR + 512) return false;
        u.dst = nullptr; u.f0 = 1.0f;
        if (L < 4 * TR) {
            const int t = L >> 2, pn = L & 3, e = __builtin_amdgcn_readfirstlane(T[770 + t]), mt = t - __builtin_amdgcn_readfirstlane(T[513 + e]), cnt = __builtin_amdgcn_readfirstlane(T[e]);
            const int s0 = __builtin_amdgcn_readfirstlane(T[256 + e]) + mt * 256;
            u.a = (const char*)(ws + WS_HID) + (size_t)s0 * 256; u.b = (const char*)(ws + WS_EXPD) + ((size_t)e * 1024 + pn * 256) * 256;
            u.i0 = s0; u.i1 = min(256, cnt - mt * 256); u.i2 = 0; u.ldd = pn * 256;
        } else {
            const int j = L - 4 * TR, mt = j >> 2, pn = j & 3;
            u.a = (const char*)(ws + WS_HID) + (size_t)(262144 + mt * 256) * 256; u.b = (const char*)(ws + WS_BT_SHD) + (size_t)(pn * 256) * 256;
            u.i0 = mt * 256; u.i1 = 256; u.i2 = 1; u.ldd = pn * 256;
        }
        return true;
    }
};

DEVI void conv_tile(const float* src, int ldsrc, int ncols, bf16_t* dst, int ldd, int k0, int row0, int ilv, LAS float* t) {
    const int tid = threadIdx.x;
    f32x4 v[8];
#pragma unroll
    for (int i = 0; i < 8; ++i) { const int f = tid + 512 * i, row = f >> 6, c4 = (f & 63) * 4;
        v[i] = (c4 < ncols) ? *(const f32x4*)(src + (size_t)(k0 + row) * ldsrc + c4) : (f32x4){0.f, 0.f, 0.f, 0.f}; }
#pragma unroll
    for (int i = 0; i < 8; ++i) { const int f = tid + 512 * i, row = f >> 6, c4 = (f & 63) * 4; LAS float* q = t + row * 257 + c4; q[0] = v[i][0]; q[1] = v[i][1]; q[2] = v[i][2]; q[3] = v[i][3]; }
    __syncthreads();
#pragma unroll
    for (int j = 0; j < 4; ++j) {
        const int p = tid + 512 * j, kp = p & 7, n = p >> 3;
        if (n < ncols) {
            const LAS float* q = t + (kp * 8) * 257 + n;
            u32x4 w; w.x = pk_bf16(q[0], q[257]); w.y = pk_bf16(q[2 * 257], q[3 * 257]); w.z = pk_bf16(q[4 * 257], q[5 * 257]); w.w = pk_bf16(q[6 * 257], q[7 * 257]);
            const int drow = row0 + (ilv >= 0 ? ((n >> 7) * 256 + (n & 127) + ilv) : n);
            *(u32x4*)(dst + (size_t)drow * ldd + k0 + kp * 8) = w;
        }
    }
    __syncthreads();
}

DEVI void conv_tile8(const float* src, int ldsrc, unsigned char* dst, int ldd, int k0, int row0, int ilv, float scale, LAS float* t, int ncols = 256) {
    const int tid = threadIdx.x;
    f32x4 v[16];
#pragma unroll
    for (int i = 0; i < 16; ++i) { const int f = tid + 512 * i, row = f >> 6, c4 = (f & 63) * 4; v[i] = (c4 < ncols) ? *(const f32x4*)(src + (size_t)(k0 + row) * ldsrc + c4) : (f32x4){0.f, 0.f, 0.f, 0.f}; }
#pragma unroll
    for (int i = 0; i < 16; ++i) { const int f = tid + 512 * i, row = f >> 6, c4 = (f & 63) * 4; LAS float* q = t + row * 257 + c4; q[0] = v[i][0] * scale; q[1] = v[i][1] * scale; q[2] = v[i][2] * scale; q[3] = v[i][3] * scale; }
    __syncthreads();
#pragma unroll
    for (int j = 0; j < 4; ++j) {
        const int p = tid + 512 * j, kp = p & 7, n = p >> 3;
        if (n >= ncols) continue;
        const LAS float* q = t + (kp * 16) * 257 + n;
        u32x4 w;
        w.x = pk4_fp8(q[0], q[257], q[2 * 257], q[3 * 257]);             w.y = pk4_fp8(q[4 * 257], q[5 * 257], q[6 * 257], q[7 * 257]);
        w.z = pk4_fp8(q[8 * 257], q[9 * 257], q[10 * 257], q[11 * 257]); w.w = pk4_fp8(q[12 * 257], q[13 * 257], q[14 * 257], q[15 * 257]);
        const int drow = row0 + (ilv >= 0 ? ((n >> 7) * 256 + (n & 127) + ilv) : n);
        *(u32x4*)(dst + (size_t)drow * ldd + k0 + kp * 16) = w;
    }
    __syncthreads();
}

DEVI void phase0(const Params& p, LAS unsigned char* lds, int part) {
    const int tid = threadIdx.x, lane = tid & 63, wid = tid >> 6;
    unsigned char* ws = p.ws;
    const int NT_IN = 8 * (2 + 2 + 2 + 2 + 4 + 4 + 4 + 2 + 4 + 1);
    const int NT0 = NT_IN + 8 * 4 + 16 * 4 + 16 * 4 + 16 + 8 + 8 + 8;
    for (int u = (part == 0 ? (int)blockIdx.x : 192 + (int)blockIdx.x); u < (part == 0 ? 192 : 192 + NT0); u += gridDim.x) {
        if (u < 192) {
            LAS float* sc = (LAS float*)lds; LAS float* red = (LAS float*)(lds + 9 * 1024 * 4);
            for (int i = tid; i < 9216; i += 512) { const int r = i >> 10, k = i & 1023; const float v = r < 8 ? p.in[1][r * 1024 + k] : p.in[3][k]; sc[i] = v / (1.0f + __expf(-v)); }
            __syncthreads();
            const int n0 = u * 32, col = lane & 31, rsub = lane >> 5;
            float acc[9];
#pragma unroll
            for (int r = 0; r < 9; ++r) acc[r] = 0.f;
            for (int it = 0; it < 64; ++it) { const int k = it * 16 + wid * 2 + rsub; const float w = p.in[4][(size_t)k * 6144 + n0 + col];
#pragma unroll
                for (int r = 0; r < 9; ++r) acc[r] += sc[r * 1024 + k] * w; }
#pragma unroll
            for (int r = 0; r < 9; ++r) red[((wid * 2 + rsub) * 9 + r) * 32 + col] = acc[r];
            __syncthreads();
            if (tid < 288) { const int r = tid >> 5, cc = tid & 31; float s = 0.f; for (int g = 0; g < 16; ++g) s += red[(g * 9 + r) * 32 + cc];
                ((float*)(ws + WS_MOD))[r * 6144 + n0 + cc] = s + p.in[5][n0 + cc]; }
            __syncthreads();
        } else {
            int t = u - 192; LAS float* tb = (LAS float*)lds;
            if (t < NT_IN) {
                const int kt = t & 7; int jb = t >> 3;
                int c0, r0, nc = 256;
                if (jb < 2)       { c0 = 0 + jb * 256;             r0 = 0 + jb * 256; }
                else if (jb < 4)  { c0 = 512 + (jb - 2) * 256;     r0 = 512 + (jb - 2) * 256; }
                else if (jb < 6)  { c0 = 1536 + (jb - 4) * 256;    r0 = 1024 + (jb - 4) * 256; }
                else if (jb < 8)  { c0 = 2048 + (jb - 6) * 256;    r0 = 1536 + (jb - 6) * 256; }
                else if (jb < 12) { c0 = 3584 + (jb - 8) * 256;    r0 = 2048 + (jb - 8) * 256; }
                else if (jb < 16) { c0 = 4640 + (jb - 12) * 256;   r0 = 3072 + (jb - 12) * 256; }
                else if (jb < 20) { c0 = 5664 + (jb - 16) * 256;   r0 = 4096 + (jb - 16) * 256; }
                else if (jb < 22) { c0 = 1024 + (jb - 20) * 256;   r0 = 5120 + (jb - 20) * 256; }
                else if (jb < 26) { c0 = 2560 + (jb - 22) * 256;   r0 = 5632 + (jb - 22) * 256; }
                else              { c0 = 4608; r0 = 6656; nc = 32; }
                conv_tile8(p.in[6] + c0, 6688, ws + WS_BT_IN, 1024, kt * 128, r0, -1, F8_WIN, tb, nc);
            } else {
                t -= NT_IN;
                if (t < 32)        { const int kt = t & 7, nb = t >> 3;  conv_tile(p.in[13] + nb * 256, 1024, 256, (bf16_t*)(ws + WS_BT_BR), 1536, kt * 64, nb * 256, -1, tb); }
                else if (t < 96)   { t -= 32; const int kt = t & 15, nb = t >> 4; conv_tile(p.in[14] + nb * 256, 1024, 256, (bf16_t*)(ws + WS_BT_BR) + 512, 1536, kt * 64, nb * 256, -1, tb); }
                else if (t < 160)  { t -= 96; const int kt = t & 15, nb = t >> 4; conv_tile(p.in[15] + nb * 256, 1024, 256, (bf16_t*)(ws + WS_BT_OUT), 1024, kt * 64, nb * 256, -1, tb); }
                else if (t < 176)  { t -= 160; conv_tile(p.in[18], 256, 256, (bf16_t*)(ws + WS_BT_RT), 1024, t * 64, 0, -1, tb); }
                else if (t < 184)  { t -= 176; conv_tile8(p.in[23], 256, ws + WS_BT_SHGU, 1024, t * 128, 0, 0, F8_WGU, tb); }
                else if (t < 192)  { t -= 184; conv_tile8(p.in[24], 256, ws + WS_BT_SHGU, 1024, t * 128, 0, 128, F8_WGU, tb); }
                else               { t -= 192; const int kt = t & 1, nb = t >> 1; conv_tile8(p.in[25] + nb * 256, 1024, ws + WS_BT_SHD, 256, kt * 128, nb * 256, -1, F8_WD, tb); }
            }
        }
    }
}

DEVI void phase1(const Params& p) {
    const float* mod = (const float*)(p.ws + WS_MOD); unsigned char* H = p.ws + WS_H;
    for (size_t idx = (size_t)blockIdx.x * 512 + threadIdx.x; idx < (size_t)NROW * 128; idx += (size_t)gridDim.x * 512) {
        const int row = (int)(idx >> 7), k = (int)(idx & 127) * 8;
        const float* src = row < NTOK ? p.in[0] + (size_t)row * 1024 + k : p.in[2] + (size_t)(row - NTOK) * 1024 + k;
        const float* m = mod + (size_t)(row < NTOK ? (row >> 12) : 8) * 6144 + k;
        const f32x4 x0 = *(const f32x4*)src, x1 = *(const f32x4*)(src + 4), h0 = *(const f32x4*)m, h1 = *(const f32x4*)(m + 4), s0 = *(const f32x4*)(m + 1024), s1 = *(const f32x4*)(m + 1028);
        const f32x4 y0 = x0 * (s0 + 1.0f) + h0, y1 = x1 * (s1 + 1.0f) + h1;
        u32x2 w; w.x = pk4_fp8(y0[0] * F8_HIN, y0[1] * F8_HIN, y0[2] * F8_HIN, y0[3] * F8_HIN); w.y = pk4_fp8(y1[0] * F8_HIN, y1[1] * F8_HIN, y1[2] * F8_HIN, y1[3] * F8_HIN);
        *(u32x2*)(H + (size_t)row * 1024 + k) = w;
    }
}

DEVI float logsig16(float z) { return -(fmaxf(-z, 0.f) + __logf(1.0f + __expf(-fabsf(z)))) * 0.0625f; }
DEVI void phase3(const Params& p, LAS unsigned char* lds) {
    const int tid = threadIdx.x;
    unsigned char* ws = p.ws;
    LAS float* LRs = (LAS float*)lds;
    LAS float* CS = (LAS float*)(lds + 8192);
    LAS float* CUM = (LAS float*)(lds + 24576);
    LAS float* TOT = (LAS float*)(lds + 24576 + 65536);
    LAS bf16_t* KTs = (LAS bf16_t*)(lds + 24576 + 65536 + 2048);
    for (int i = tid; i < 2048; i += 512) { const int pos = i >> 5, j = i & 31; const float ang = (float)pos * powf(10000.0f, -(float)j / 32.0f); CS[2 * i] = cosf(ang); CS[2 * i + 1] = sinf(ang); }
    __syncthreads();
    const float* LRT = (const float*)(ws + WS_LRT);
    const bf16_t* QB = (const bf16_t*)(ws + WS_QB); const bf16_t* KB = (const bf16_t*)(ws + WS_KB);
    bf16_t* QTF = (bf16_t*)(ws + WS_QTF); bf16_t* QTB = (bf16_t*)(ws + WS_QTB); bf16_t* KTF = (bf16_t*)(ws + WS_KTF); bf16_t* KTB = (bf16_t*)(ws + WS_KTB);
    float* EE = (float*)(ws + WS_EE);
    for (int u = blockIdx.x; u < 8 * 68 * 4; u += gridDim.x) {
        const int h = u & 3, bs = u >> 2, b = bs / 68, slot = bs % 68; const bool isctx = slot < 4; const int chunk = slot - 4;
        const int rowbase = isctx ? NTOK + b * 256 + slot * 64 : b * 4096 + chunk * 64;
        { const int r = tid >> 4, c4 = (tid & 15) * 4; const f32x4 lv = *(const f32x4*)(LRT + (size_t)r * NROW + rowbase + c4);
          LRs[(c4 + 0) * 32 + r] = lv[0]; LRs[(c4 + 1) * 32 + r] = lv[1]; LRs[(c4 + 2) * 32 + r] = lv[2]; LRs[(c4 + 3) * 32 + r] = lv[3]; }
        __syncthreads();
        {
            const int ch = tid & 127, grp = tid >> 7, dir = grp & 1, hf = grp >> 1;
            const float* w2p = p.in[dir ? 10 : 8] + h * 128 + ch; const float b2 = p.in[dir ? 11 : 9][h * 128 + ch];
            float w2[16];
#pragma unroll
            for (int r = 0; r < 16; ++r) w2[r] = w2p[r * 512];
            float run = 0.f;
            for (int k = 0; k < 32; ++k) {
                const int i = dir ? (32 * hf + 31 - k) : (32 * hf + k);
                const LAS f32x4* lp = (const LAS f32x4*)(LRs + i * 32 + 16 * dir);
                const f32x4 l0 = lp[0], l1 = lp[1], l2 = lp[2], l3 = lp[3];
                const float z0 = (l0[0] * w2[0] + l0[1] * w2[1]) + (l0[2] * w2[2] + l0[3] * w2[3]), z1 = (l1[0] * w2[4] + l1[1] * w2[5]) + (l1[2] * w2[6] + l1[3] * w2[7]);
                const float z2 = (l2[0] * w2[8] + l2[1] * w2[9]) + (l2[2] * w2[10] + l2[3] * w2[11]), z3 = (l3[0] * w2[12] + l3[1] * w2[13]) + (l3[2] * w2[14] + l3[3] * w2[15]);
                const float z = b2 + ((z0 + z1) + (z2 + z3));
                run += logsig16(z);
                CUM[(dir * 64 + i) * 128 + ch] = run;
            }
            TOT[(dir * 2 + hf) * 128 + ch] = run;
        }
        __syncthreads();
#pragma unroll
        for (int rep = 0; rep < 2; ++rep) {
            const int q = tid + 512 * rep, i = q >> 4, c8 = q & 15, ch0 = c8 * 8;
            float cf[8], cb[8];
            {
                const f32x4 a0 = *(const LAS f32x4*)(CUM + (0 * 64 + i) * 128 + ch0), a1 = *(const LAS f32x4*)(CUM + (0 * 64 + i) * 128 + ch0 + 4);
                const f32x4 b0 = *(const LAS f32x4*)(CUM + (1 * 64 + i) * 128 + ch0), b1 = *(const LAS f32x4*)(CUM + (1 * 64 + i) * 128 + ch0 + 4);
                f32x4 tf0 = {0.f, 0.f, 0.f, 0.f}, tf1 = tf0, tb0 = tf0, tb1 = tf0;
                if (i >= 32) { tf0 = *(const LAS f32x4*)(TOT + (0 * 2 + 0) * 128 + ch0); tf1 = *(const LAS f32x4*)(TOT + (0 * 2 + 0) * 128 + ch0 + 4); }
                else         { tb0 = *(const LAS f32x4*)(TOT + (1 * 2 + 1) * 128 + ch0); tb1 = *(const LAS f32x4*)(TOT + (1 * 2 + 1) * 128 + ch0 + 4); }
#pragma unroll
                for (int e = 0; e < 4; ++e) { cf[e] = a0[e] + tf0[e]; cf[4 + e] = a1[e] + tf1[e]; cb[e] = b0[e] + tb0[e]; cb[4 + e] = b1[e] + tb1[e]; }
            }
            const size_t go = (size_t)(rowbase + i) * 512 + h * 128 + ch0;
            const u32x4 kraw = *(const u32x4*)(KB + go);
            float kv[8] = {bflo(kraw.x), bfhi(kraw.x), bflo(kraw.y), bfhi(kraw.y), bflo(kraw.z), bfhi(kraw.z), bflo(kraw.w), bfhi(kraw.w)};
            float ef[8], eb[8];
#pragma unroll
            for (int e = 0; e < 8; ++e) { ef[e] = __expf(cf[e]); eb[e] = __expf(cb[e]); }
            if (!isctx) {
                const size_t gp = (size_t)(rowbase + i) * 512 + h * 128 + ((c8 ^ 4) * 8);
                const u32x4 kpr = *(const u32x4*)(KB + gp), qraw = *(const u32x4*)(QB + go), qpr = *(const u32x4*)(QB + gp);
                const float kp[8] = {bflo(kpr.x), bfhi(kpr.x), bflo(kpr.y), bfhi(kpr.y), bflo(kpr.z), bfhi(kpr.z), bflo(kpr.w), bfhi(kpr.w)};
                const float qv[8] = {bflo(qraw.x), bfhi(qraw.x), bflo(qraw.y), bfhi(qraw.y), bflo(qraw.z), bfhi(qraw.z), bflo(qraw.w), bfhi(qraw.w)};
                const float qp[8] = {bflo(qpr.x), bfhi(qpr.x), bflo(qpr.y), bfhi(qpr.y), bflo(qpr.z), bfhi(qpr.z), bflo(qpr.w), bfhi(qpr.w)};
                const int half = c8 >> 3, isx2 = (c8 >> 2) & 1, j0 = (c8 & 3) * 8, pos = half ? i : chunk;
                float qf[8], qb[8];
                const LAS f32x4* cp = (const LAS f32x4*)(CS + (pos * 32 + j0) * 2); const f32x4 c0 = cp[0], c1 = cp[1], c2 = cp[2], c3 = cp[3];
                const float csv[8] = {c0[0], c0[2], c1[0], c1[2], c2[0], c2[2], c3[0], c3[2]}, snv[8] = {c0[1], c0[3], c1[1], c1[3], c2[1], c2[3], c3[1], c3[3]};
#pragma unroll
                for (int e = 0; e < 8; ++e) {
                    const float cs = csv[e], sn = snv[e];
                    const float rq = isx2 ? qv[e] * cs + qp[e] * sn : qv[e] * cs - qp[e] * sn;
                    kv[e] = isx2 ? kv[e] * cs + kp[e] * sn : kv[e] * cs - kp[e] * sn;
                    qf[e] = rq * 0.08838834764831845f * ef[e]; qb[e] = rq * 0.08838834764831845f * eb[e];
                }
                u32x4 wq; wq.x = pk_bf16(qf[0], qf[1]); wq.y = pk_bf16(qf[2], qf[3]); wq.z = pk_bf16(qf[4], qf[5]); wq.w = pk_bf16(qf[6], qf[7]); *(u32x4*)(QTF + go) = wq;
                wq.x = pk_bf16(qb[0], qb[1]); wq.y = pk_bf16(qb[2], qb[3]); wq.z = pk_bf16(qb[4], qb[5]); wq.w = pk_bf16(qb[6], qb[7]); *(u32x4*)(QTB + go) = wq;
            }
            float kf[8], kb[8];
#pragma unroll
            for (int e = 0; e < 8; ++e) { kf[e] = kv[e] * __builtin_amdgcn_rcpf(ef[e]); kb[e] = kv[e] * __builtin_amdgcn_rcpf(eb[e]); }
            u32x4 wf; wf.x = pk_bf16(kf[0], kf[1]); wf.y = pk_bf16(kf[2], kf[3]); wf.z = pk_bf16(kf[4], kf[5]); wf.w = pk_bf16(kf[6], kf[7]);
            u32x4 wb; wb.x = pk_bf16(kb[0], kb[1]); wb.y = pk_bf16(kb[2], kb[3]); wb.z = pk_bf16(kb[4], kb[5]); wb.w = pk_bf16(kb[6], kb[7]);
            *(u32x4*)(KTF + go) = wf; *(u32x4*)(KTB + go) = wb;
            *(LAS u32x4*)(KTs + (0 * 64 + i) * 136 + ch0) = wf; *(LAS u32x4*)(KTs + (1 * 64 + i) * 136 + ch0) = wb;
            if (i == 63) { float* ep = EE + ((size_t)(0 * 8 + b) * 68 + slot) * 512 + h * 128 + ch0; *(f32x4*)ep = (f32x4){ef[0], ef[1], ef[2], ef[3]}; *(f32x4*)(ep + 4) = (f32x4){ef[4], ef[5], ef[6], ef[7]}; }
            if (i == 0)  { float* ep = EE + ((size_t)(1 * 8 + b) * 68 + slot) * 512 + h * 128 + ch0; *(f32x4*)ep = (f32x4){eb[0], eb[1], eb[2], eb[3]}; *(f32x4*)(ep + 4) = (f32x4){eb[4], eb[5], eb[6], eb[7]}; }
        }
        __syncthreads();
#pragma unroll
        for (int rep = 0; rep < 4; ++rep) {
            const int q = tid + 512 * rep, ch = q & 127, t8 = (q >> 7) & 7, dir = q >> 10;
            const LAS bf16_t* sp = KTs + (dir * 64 + t8 * 8) * 136 + ch;
            u32x4 wv; wv.x = (unsigned)sp[0] | ((unsigned)sp[136] << 16); wv.y = (unsigned)sp[2 * 136] | ((unsigned)sp[3 * 136] << 16); wv.z = (unsigned)sp[4 * 136] | ((unsigned)sp[5 * 136] << 16); wv.w = (unsigned)sp[6 * 136] | ((unsigned)sp[7 * 136] << 16);
            *(u32x4*)((bf16_t*)(ws + (dir ? WS_KTTB : WS_KTTF)) + (size_t)(h * 128 + ch) * NROW + rowbase + t8 * 8) = wv;
        }
        __syncthreads();
    }
}

DEVI int gla_slot(int dir, int n) { return dir == 0 ? n : (n < 4 ? 3 - n : 71 - n); }
DEVI int gla_rowbase(int b, int slot) { return slot >= 4 ? b * 4096 + (slot - 4) * 64 : NTOK + b * 256 + slot * 64; }
DEVI void phase4_gla(const Params& p, LAS unsigned char* lds) {
    const int tid = threadIdx.x, lane = tid & 63, w = tid >> 6, l15 = lane & 15, fq = lane >> 4;
    unsigned char* ws = p.ws;
    LAS unsigned char* TQ = lds;
    LAS unsigned char* TK = lds + 32768;
    LAS unsigned char* TV = lds + 65536;
    LAS bf16_t* PM = (LAS bf16_t*)(lds + 81920);
    LAS bf16_t* SB = (LAS bf16_t*)(lds + 81920 + 9216);
    const bf16_t* VBT = (const bf16_t*)(ws + WS_VBT);
    const float* EE = (const float*)(ws + WS_EE);
    const int qr0 = tid >> 4, qp = tid & 15, vr = tid >> 3, vp = tid & 7;
    const int qoff0 = qr0 * 256 + ((qp ^ (qr0 & 15)) << 4), qoff1 = (qr0 + 32) * 256 + ((qp ^ ((qr0 + 32) & 15)) << 4);
    const int voff = vr * 128 + ((vp ^ ((vr >> 1) & 7)) << 4);
    struct PSet { u32x4 q0, q1, k0, k1, v; };
    struct KSet { bf16x8 a, b; f32x4 e; };
    for (int u = blockIdx.x; u < 256; u += gridDim.x) {
        const int xg = u & 7, kg = u >> 3, g = xg * 8 + (kg >> 2), dvq = kg & 3, dir = g & 1, h = (g >> 1) & 3, b = g >> 3;
        const bf16_t* QT = (const bf16_t*)(ws + (dir ? WS_QTB : WS_QTF)); const bf16_t* KT = (const bf16_t*)(ws + (dir ? WS_KTB : WS_KTF)); const bf16_t* KTT = (const bf16_t*)(ws + (dir ? WS_KTTB : WS_KTTF));
        bf16_t* OUT = (bf16_t*)(ws + (dir ? WS_OB : WS_OF));
        const int vrow0 = h * 256 + dvq * 64, krow0 = h * 128, kcol0 = h * 128;
        const float* EEu = EE + (size_t)(dir * 8 + b) * 68 * 512 + h * 128 + 16 * w + 4 * fq;
        const bf16_t* vsrc = VBT + (size_t)(vrow0 + vr) * NROW + vp * 8;
        const bf16_t* ktsrc = KTT + (size_t)(krow0 + 16 * w + l15) * NROW + 8 * fq;
        const size_t qsrc = (size_t)qr0 * 512 + kcol0 + qp * 8;
        f32x4 S[4];
#pragma unroll
        for (int i = 0; i < 4; ++i) S[i] = (f32x4){0.f, 0.f, 0.f, 0.f};
        PSet P0, P1; KSet K0, K1;
        P0.q0 = P0.q1 = P0.k0 = P0.k1 = P0.v = (u32x4){0u, 0u, 0u, 0u}; P1 = P0;
        auto load_p = [&](PSet& P, int n) {
            const int slot = gla_slot(dir, n), rb = gla_rowbase(b, slot);
            P.v = *(const u32x4*)(vsrc + rb);
            if (slot >= 4) { P.q0 = *(const u32x4*)(QT + (size_t)rb * 512 + qsrc); P.q1 = *(const u32x4*)(QT + (size_t)(rb + 32) * 512 + qsrc);
                             P.k0 = *(const u32x4*)(KT + (size_t)rb * 512 + qsrc); P.k1 = *(const u32x4*)(KT + (size_t)(rb + 32) * 512 + qsrc); }
        };
        auto store_p = [&](const PSet& P, int n) {
            const int slot = gla_slot(dir, n), bufo = n & 1;
            *(LAS u32x4*)(TV + bufo * 8192 + voff) = P.v;
            if (slot >= 4) { *(LAS u32x4*)(TQ + bufo * 16384 + qoff0) = P.q0; *(LAS u32x4*)(TQ + bufo * 16384 + qoff1) = P.q1; *(LAS u32x4*)(TK + bufo * 16384 + qoff0) = P.k0; *(LAS u32x4*)(TK + bufo * 16384 + qoff1) = P.k1; }
        };
        auto load_k = [&](KSet& K, int n) {
            const int slot = gla_slot(dir, n), rb = gla_rowbase(b, slot);
            K.a = *(const bf16x8*)(ktsrc + rb); K.b = *(const bf16x8*)(ktsrc + rb + 32); K.e = *(const f32x4*)(EEu + (size_t)slot * 512);
        };
        load_p(P0, 0); load_k(K0, 0); load_k(K1, 1); load_p(P1, 1);
        __syncthreads();
        store_p(P0, 0);
        auto step = [&](int n, PSet& Pload, const PSet& Pstore, KSet& K) {
            const int slot = gla_slot(dir, n); const bool lat = slot >= 4; const int rowbase = gla_rowbase(b, slot);
            const int cur = n & 1, nxt = cur ^ 1;
            LAS unsigned char* tq = TQ + cur * 16384; LAS unsigned char* tk = TK + cur * 16384; LAS unsigned char* tv = TV + cur * 8192;
            LAS bf16_t* sbc = SB + cur * 64 * 136; LAS bf16_t* sbn = SB + nxt * 64 * 136;
            lds_barrier();
            if (n + 2 < 68) load_p(Pload, n + 2);
            if (lat) {
                const int jt = w >> 1, it0 = 2 * (w & 1);
                f32x4 c0 = {0.f, 0.f, 0.f, 0.f}, c1 = {0.f, 0.f, 0.f, 0.f};
                const int rj = 16 * jt + l15, ri0 = 16 * it0 + l15, ri1 = ri0 + 16;
                bf16x8 fa[4], fb0[4], fb1[4];
#pragma unroll
                for (int ks = 0; ks < 4; ++ks) { const int pc = 4 * ks + fq;
                    fa[ks] = *(const LAS bf16x8*)(tk + rj * 256 + ((pc ^ l15) << 4)); fb0[ks] = *(const LAS bf16x8*)(tq + ri0 * 256 + ((pc ^ l15) << 4)); fb1[ks] = *(const LAS bf16x8*)(tq + ri1 * 256 + ((pc ^ l15) << 4)); }
                __builtin_amdgcn_sched_barrier(0);
#pragma unroll
                for (int ks = 0; ks < 4; ++ks) { c0 = __builtin_amdgcn_mfma_f32_16x16x32_bf16(fa[ks], fb0[ks], c0, 0, 0, 0); c1 = __builtin_amdgcn_mfma_f32_16x16x32_bf16(fa[ks], fb1[ks], c1, 0, 0, 0); }
#pragma unroll
                for (int r = 0; r < 4; ++r) { const int j = 16 * jt + 4 * fq + r;
                    const bool k0 = dir == 0 ? (j <= ri0) : (j >= ri0), k1 = dir == 0 ? (j <= ri1) : (j >= ri1);
                    c0[r] = k0 ? c0[r] : 0.f; c1[r] = k1 ? c1[r] : 0.f; }
                u32x2 w0; w0.x = pk_bf16(c0[0], c0[1]); w0.y = pk_bf16(c0[2], c0[3]); u32x2 w1; w1.x = pk_bf16(c1[0], c1[1]); w1.y = pk_bf16(c1[2], c1[3]);
                *(LAS u32x2*)(PM + ri0 * 72 + 16 * jt + 4 * fq) = w0; *(LAS u32x2*)(PM + ri1 * 72 + 16 * jt + 4 * fq) = w1;
            }
            lds_barrier();
            bf16x8 V[4][2];
#pragma unroll
            for (int dvt = 0; dvt < 4; ++dvt)
#pragma unroll
                for (int ks = 0; ks < 2; ++ks) { const int row = 16 * dvt + l15, pc = 4 * ks + fq; V[dvt][ks] = *(const LAS bf16x8*)(tv + row * 128 + ((pc ^ ((row >> 1) & 7)) << 4)); }
            __builtin_amdgcn_sched_barrier(0);
            if (lat) {
                const int it = w >> 1, dv0 = 2 * (w & 1), ri = 16 * it + l15;
                f32x4 o0 = {0.f, 0.f, 0.f, 0.f}, o1 = {0.f, 0.f, 0.f, 0.f};
                bf16x8 pB[2], pA0[2], pA1[2], sA0[4], sA1[4], sB[4];
                const LAS bf16_t* s0 = sbc + (16 * dv0 + l15) * 136 + 8 * fq; const LAS bf16_t* s1 = s0 + 16 * 136;
#pragma unroll
                for (int ks = 0; ks < 2; ++ks) { pB[ks] = *(const LAS bf16x8*)(PM + ri * 72 + 32 * ks + 8 * fq);
                    const int r0 = 16 * dv0 + l15, r1 = r0 + 16, pc = 4 * ks + fq;
                    pA0[ks] = *(const LAS bf16x8*)(tv + r0 * 128 + ((pc ^ ((r0 >> 1) & 7)) << 4)); pA1[ks] = *(const LAS bf16x8*)(tv + r1 * 128 + ((pc ^ ((r1 >> 1) & 7)) << 4)); }
#pragma unroll
                for (int ks = 0; ks < 4; ++ks) { const int pc = 4 * ks + fq;
                    sA0[ks] = *(const LAS bf16x8*)(s0 + 32 * ks); sA1[ks] = *(const LAS bf16x8*)(s1 + 32 * ks); sB[ks] = *(const LAS bf16x8*)(tq + ri * 256 + ((pc ^ l15) << 4)); }
                __builtin_amdgcn_sched_barrier(0);
#pragma unroll
                for (int ks = 0; ks < 2; ++ks) { o0 = __builtin_amdgcn_mfma_f32_16x16x32_bf16(pA0[ks], pB[ks], o0, 0, 0, 0); o1 = __builtin_amdgcn_mfma_f32_16x16x32_bf16(pA1[ks], pB[ks], o1, 0, 0, 0); }
#pragma unroll
                for (int ks = 0; ks < 4; ++ks) { o0 = __builtin_amdgcn_mfma_f32_16x16x32_bf16(sA0[ks], sB[ks], o0, 0, 0, 0); o1 = __builtin_amdgcn_mfma_f32_16x16x32_bf16(sA1[ks], sB[ks], o1, 0, 0, 0); }
                bf16_t* op = OUT + (size_t)(rowbase + ri) * 1024 + vrow0 + 16 * dv0 + 4 * fq;
                u32x2 w0; w0.x = pk_bf16(o0[0], o0[1]); w0.y = pk_bf16(o0[2], o0[3]); u32x2 w1; w1.x = pk_bf16(o1[0], o1[1]); w1.y = pk_bf16(o1[2], o1[3]);
                *(u32x2*)op = w0; *(u32x2*)(op + 16) = w1;
            }
#pragma unroll
            for (int dvt = 0; dvt < 4; ++dvt) { S[dvt] = __builtin_amdgcn_mfma_f32_16x16x32_bf16(K.a, V[dvt][0], S[dvt], 0, 0, 0); S[dvt] = __builtin_amdgcn_mfma_f32_16x16x32_bf16(K.b, V[dvt][1], S[dvt], 0, 0, 0); }
#pragma unroll
            for (int dvt = 0; dvt < 4; ++dvt) { S[dvt] = S[dvt] * K.e;
                u32x2 o; o.x = pk_bf16(S[dvt][0], S[dvt][1]); o.y = pk_bf16(S[dvt][2], S[dvt][3]);
                *(LAS u32x2*)(sbn + (16 * dvt + l15) * 136 + 16 * w + 4 * fq) = o; }
            if (n + 2 < 68) load_k(K, n + 2);
            if (n + 1 < 68) store_p(Pstore, n + 1);
        };
#pragma unroll 1
        for (int n = 0; n < 68; n += 2) { step(n, P0, P1, K0); step(n + 1, P1, P0, K1); }
        __syncthreads();
    }
}

DEVI void phase4_na(const Params& p, LAS unsigned char* lds) {
    const int tid = threadIdx.x; const int wsg = __builtin_amdgcn_readfirstlane(tid >> 6);
    unsigned char* ws = p.ws;
    LAS unsigned char* CK = lds;
    LAS unsigned char* CV = lds + 32768;
    LAS float* RP = (LAS float*)(lds + 65536);
    const bf16_t* QA = (const bf16_t*)(ws + WS_QA); const bf16_t* KA = (const bf16_t*)(ws + WS_KA); const bf16_t* VAT = (const bf16_t*)(ws + WS_VAT);
    bf16_t* OA = (bf16_t*)(ws + WS_AP);
    for (int u = blockIdx.x; u < 512; u += gridDim.x) {
        const int xg = u & 7, idx = u >> 3, bh = xg * 8 + (idx >> 3), rblk = idx & 7, h = bh & 7, b = bh >> 3;
        __syncthreads();
        for (int i = tid; i < 465; i += 512) RP[(i / 31) * 80 + 24 + (i % 31)] = p.in[7][h * 465 + i];
        int tz = tid; asm volatile("" : "+v"(tz));
#pragma unroll
        for (int rep = 0; rep < 4; ++rep) {
            const int q = tz + 512 * rep;
            { const int row = q >> 3, pc = q & 7; *(LAS u32x4*)(CK + row * 128 + ((pc ^ ((row >> 1) & 7)) << 4)) = *(const u32x4*)(KA + (size_t)(NTOK + b * 256 + row) * 512 + h * 64 + pc * 8); }
            { const int row = q >> 5, pc = q & 31; const u32x4 v = *(const u32x4*)(VAT + (size_t)(h * 64 + row) * NROW + NTOK + b * 256 + pc * 8);
              const int sw = (row & 15) << 1; u32x2 lo; lo.x = v.x; lo.y = v.y; u32x2 hi; hi.x = v.z; hi.y = v.w;
              *(LAS u32x2*)(CV + row * 512 + (((2 * pc) ^ sw) << 3)) = lo; *(LAS u32x2*)(CV + row * 512 + (((2 * pc + 1) ^ sw) << 3)) = hi; }
        }
        __syncthreads();
#pragma unroll 1
        for (int qt = 0; qt < 4; ++qt) {
            int lane = (int)__builtin_amdgcn_mbcnt_hi(~0u, __builtin_amdgcn_mbcnt_lo(~0u, 0u)); asm volatile("" : "+v"(lane));
            const int w = wsg, l15 = lane & 15, fq = lane >> 4, r = rblk * 8 + w, rs = min(max(r - 4, 0), 56);
            const int kc0 = min(max(16 * qt - 8, 0), 32);
            const int c = 16 * qt + l15, cs = min(max(c - 8, 0), 48);
            const bf16_t* qp = QA + (size_t)(b * 4096 + r * 64 + c) * 512 + h * 64 + 8 * fq;
            const bf16x8 Bq0 = *(const bf16x8*)qp, Bq1 = *(const bf16x8*)(qp + 32);
            const int lo = 15 + cs - c, d00 = kc0 - 16 * qt + 4 * fq - l15 + 15;
            const LAS unsigned char* rpl = (const LAS unsigned char*)RP + ((rs - r + 7) * 80 + 24 + d00) * 4;
            const char* kbase = (const char*)(KA + (size_t)(b * 4096 + rs * 64 + kc0) * 512 + h * 64); const unsigned klane = (unsigned)(l15 * 512 + 8 * fq) * 2u;
            const char* vbase = (const char*)(VAT + (size_t)(h * 64) * NROW + b * 4096 + rs * 64 + kc0); const unsigned vlane = (unsigned)(l15 * NROW + 4 * fq) * 2u;
#define NA_SB __builtin_amdgcn_sched_barrier(0)
            f32x4 sc[16];
#pragma unroll
            for (int hb = 0; hb < 4; ++hb) {
                bf16x8 kf[4][2];
#pragma unroll
                for (int tt = 0; tt < 4; ++tt) { const int t = 4 * hb + tt, kr = t >> 1, chh = t & 1; const char* kp = (kbase + (size_t)((kr * 64 + 16 * chh) * 1024)) + klane;
                    kf[tt][0] = *(const bf16x8*)kp; kf[tt][1] = *(const bf16x8*)(kp + 64); }
                NA_SB;
#pragma unroll
                for (int tt = 0; tt < 4; ++tt) { const int t = 4 * hb + tt, kr = t >> 1, chh = t & 1;
                    f32x4 a = {0.f, 0.f, 0.f, 0.f};
                    a = __builtin_amdgcn_mfma_f32_16x16x32_bf16(kf[tt][0], Bq0, a, 0, 0, 0); a = __builtin_amdgcn_mfma_f32_16x16x32_bf16(kf[tt][1], Bq1, a, 0, 0, 0);
#pragma unroll
                    for (int j = 0; j < 4; ++j) { const float bias = *(const LAS float*)(rpl + chh * 64 + kr * 320 + j * 4); a[j] = ((unsigned)(d00 + 16 * chh + j - lo) <= 15u) ? a[j] + bias : -INFINITY; }
                    sc[t] = a; }
                NA_SB;
            }
            u32x2 va0[2][4], va1[2][4];
            auto ld_vloc = [&](int uu0) {
#pragma unroll
                for (int q = 0; q < 2; ++q)
#pragma unroll
                    for (int mt = 0; mt < 4; ++mt) { const char* vp = (vbase + (size_t)((16 * mt * NROW + (uu0 + q) * 64) * 2)) + vlane; va0[q][mt] = *(const u32x2*)vp; va1[q][mt] = *(const u32x2*)(vp + 32); } };
            ld_vloc(0);
            NA_SB;
            float mA = -INFINITY;
#pragma unroll
            for (int t = 0; t < 16; ++t) mA = fmaxf(mA, fmaxf(fmaxf(sc[t][0], sc[t][1]), fmaxf(sc[t][2], sc[t][3])));
            mA = fmaxf(mA, __shfl_xor(mA, 16)); mA = fmaxf(mA, __shfl_xor(mA, 32));
            float lA = 0.f; u32x2 pp[16];
#pragma unroll
            for (int t = 0; t < 16; ++t) { const float e0 = __expf(sc[t][0] - mA), e1 = __expf(sc[t][1] - mA), e2 = __expf(sc[t][2] - mA), e3 = __expf(sc[t][3] - mA);
                lA += (e0 + e1) + (e2 + e3); pp[t].x = pk_bf16(e0, e1); pp[t].y = pk_bf16(e2, e3); }
            NA_SB;
            f32x4 o[4];
#pragma unroll
            for (int mt = 0; mt < 4; ++mt) o[mt] = (f32x4){0.f, 0.f, 0.f, 0.f};
            auto mm_vloc = [&](int uu0) {
#pragma unroll
                for (int q = 0; q < 2; ++q) { const int t0 = 2 * (uu0 + q), t1 = t0 + 1;
                    union { u32x4 w; bf16x8 v; } P; P.w.x = pp[t0].x; P.w.y = pp[t0].y; P.w.z = pp[t1].x; P.w.w = pp[t1].y;
#pragma unroll
                    for (int mt = 0; mt < 4; ++mt) { union { u32x4 w; bf16x8 v; } A; A.w.x = va0[q][mt].x; A.w.y = va0[q][mt].y; A.w.z = va1[q][mt].x; A.w.w = va1[q][mt].y; o[mt] = __builtin_amdgcn_mfma_f32_16x16x32_bf16(A.v, P.v, o[mt], 0, 0, 0); } } };
            mm_vloc(0); NA_SB; ld_vloc(2); NA_SB; mm_vloc(2); NA_SB; ld_vloc(4); NA_SB; mm_vloc(4); NA_SB; ld_vloc(6); NA_SB; mm_vloc(6); NA_SB;
            int lane2 = (int)__builtin_amdgcn_mbcnt_hi(~0u, __builtin_amdgcn_mbcnt_lo(~0u, 0u)); asm volatile("" : "+v"(lane2));
            const int l15b = lane2 & 15, fqb = lane2 >> 4, cks = (l15b >> 1) & 7, ck0 = l15b * 128 + ((fqb ^ cks) << 4), ck1 = l15b * 128 + (((4 + fqb) ^ cks) << 4);
            {
                bf16x8 kfA[2][2];
                auto ld_ctx = [&](bf16x8 (&kf)[2][2], auto G) {
#pragma unroll
                    for (int tt = 0; tt < 2; ++tt) { constexpr int tile = 0; const int to = (2 * decltype(G)::v + tt) * 2048 + tile;
                        kf[tt][0] = *(const LAS bf16x8*)(CK + to + ck0); kf[tt][1] = *(const LAS bf16x8*)(CK + to + ck1); } };
                auto mm_ctx = [&](const bf16x8 (&kf)[2][2], auto G) {
#pragma unroll
                    for (int tt = 0; tt < 2; ++tt) { f32x4 a = {0.f, 0.f, 0.f, 0.f};
                        a = __builtin_amdgcn_mfma_f32_16x16x32_bf16(kf[tt][0], Bq0, a, 0, 0, 0); a = __builtin_amdgcn_mfma_f32_16x16x32_bf16(kf[tt][1], Bq1, a, 0, 0, 0);
                        sc[2 * decltype(G)::v + tt] = a; } };
#define NA_CC(G0) ld_ctx(kfA, IC<G0>{}); NA_SB; mm_ctx(kfA, IC<G0>{}); NA_SB;
                NA_CC(0) NA_CC(1) NA_CC(2) NA_CC(3) NA_CC(4) NA_CC(5) NA_CC(6) NA_CC(7)
#undef NA_CC
            }
            float mB = -INFINITY;
#pragma unroll
            for (int t = 0; t < 16; ++t) mB = fmaxf(mB, fmaxf(fmaxf(sc[t][0], sc[t][1]), fmaxf(sc[t][2], sc[t][3])));
            mB = fmaxf(mB, __shfl_xor(mB, 16)); mB = fmaxf(mB, __shfl_xor(mB, 32));
            const float mx = fmaxf(mA, mB), fA = __expf(mA - mx);
            float lB = 0.f;
#pragma unroll
            for (int t = 0; t < 16; ++t) { const float e0 = __expf(sc[t][0] - mx), e1 = __expf(sc[t][1] - mx), e2 = __expf(sc[t][2] - mx), e3 = __expf(sc[t][3] - mx);
                lB += (e0 + e1) + (e2 + e3); pp[t].x = pk_bf16(e0, e1); pp[t].y = pk_bf16(e2, e3); }
            float sum = lA * fA + lB;
            sum += __shfl_xor(sum, 16); sum += __shfl_xor(sum, 32);
            const float inv = 1.0f / sum;
#pragma unroll
            for (int mt = 0; mt < 4; ++mt) o[mt] = o[mt] * fA;
            NA_SB;
            int cvo[4][2];
#pragma unroll
            for (int rr = 0; rr < 4; ++rr)
#pragma unroll
                for (int dd = 0; dd < 2; ++dd) cvo[rr][dd] = l15b * 512 + ((((8 * rr + fqb + 4 * dd) ^ (l15b << 1)) & 31) << 3);
            {
                u32x4 vfA[4], vfB[4];
                auto ld_v = [&](u32x4 (&vq)[4], auto U) {
                    constexpr int uu = decltype(U)::v, q4 = uu >> 2, rr = uu & 3;
#pragma unroll
                    for (int mt = 0; mt < 4; ++mt) { const u32x2 a0 = *(const LAS u32x2*)(CV + mt * 8192 + q4 * 256 + cvo[rr][0]), a1 = *(const LAS u32x2*)(CV + mt * 8192 + q4 * 256 + cvo[rr][1]); vq[mt] = (u32x4){a0.x, a0.y, a1.x, a1.y}; } };
                auto mm_v = [&](const u32x4 (&vq)[4], auto U) {
                    constexpr int uu = decltype(U)::v, t0 = 2 * uu, t1 = 2 * uu + 1;
                    union { u32x4 w; bf16x8 v; } P; P.w.x = pp[t0].x; P.w.y = pp[t0].y; P.w.z = pp[t1].x; P.w.w = pp[t1].y;
#pragma unroll
                    for (int mt = 0; mt < 4; ++mt) { union { u32x4 w; bf16x8 v; } A; A.w = vq[mt]; o[mt] = __builtin_amdgcn_mfma_f32_16x16x32_bf16(A.v, P.v, o[mt], 0, 0, 0); } };
#define NA_PV(U0, U1, U2, U3) mm_v(vfA, IC<U0>{}); NA_SB; ld_v(vfA, IC<U2>{}); NA_SB; mm_v(vfB, IC<U1>{}); NA_SB; ld_v(vfB, IC<U3>{}); NA_SB;
                ld_v(vfA, IC<0>{}); ld_v(vfB, IC<1>{}); NA_SB;
                NA_PV(0, 1, 2, 3) NA_PV(2, 3, 4, 5) NA_PV(4, 5, 6, 7)
                mm_v(vfA, IC<6>{}); NA_SB; mm_v(vfB, IC<7>{}); NA_SB;
#undef NA_PV
            }
#undef NA_SB
            bf16_t* op = OA + (size_t)(b * 4096 + r * 64 + c) * 1536 + h * 64 + 4 * fq;
#pragma unroll
            for (int mt = 0; mt < 4; ++mt) { u32x2 wv; wv.x = pk_bf16(o[mt][0] * inv, o[mt][1] * inv); wv.y = pk_bf16(o[mt][2] * inv, o[mt][3] * inv); *(u32x2*)(op + 16 * mt) = wv; }
        }
    }
}

DEVI void phase5(const Params& p) {
    const int lane = threadIdx.x & 63, gw = blockIdx.x * 8 + (threadIdx.x >> 6), nw = gridDim.x * 8;
    const bf16_t* OF = (const bf16_t*)(p.ws + WS_OF); const bf16_t* OB = (const bf16_t*)(p.ws + WS_OB); const bf16_t* GB = (const bf16_t*)(p.ws + WS_GB); bf16_t* AP = (bf16_t*)(p.ws + WS_AP);
    for (int tok = gw; tok < NTOK; tok += nw) {
#pragma unroll
        for (int hh = 0; hh < 2; ++hh) {
            const int col = hh * 512 + lane * 8;
            const size_t o = (size_t)tok * 1024 + col;
            const u32x4 a = *(const u32x4*)(OF + o), bb = *(const u32x4*)(OB + o), g = *(const u32x4*)(GB + o);
            float v[8] = {bflo(a.x) + bflo(bb.x), bfhi(a.x) + bfhi(bb.x), bflo(a.y) + bflo(bb.y), bfhi(a.y) + bfhi(bb.y), bflo(a.z) + bflo(bb.z), bfhi(a.z) + bfhi(bb.z), bflo(a.w) + bflo(bb.w), bfhi(a.w) + bfhi(bb.w)};
            float ss = 0.f;
#pragma unroll
            for (int e = 0; e < 8; ++e) ss += v[e] * v[e];
            ss += __shfl_xor(ss, 16); ss += __shfl_xor(ss, 8); ss += __shfl_xor(ss, 4); ss += __shfl_xor(ss, 2); ss += __shfl_xor(ss, 1);
            const float rs = rsqrtf(ss * (1.0f / 256.0f) + 1e-6f);
            const f32x4 n0 = *(const f32x4*)(p.in[12] + col), n1 = *(const f32x4*)(p.in[12] + col + 4);
            const float gg[8] = {bflo(g.x), bfhi(g.x), bflo(g.y), bfhi(g.y), bflo(g.z), bfhi(g.z), bflo(g.w), bfhi(g.w)};
            float r[8];
#pragma unroll
            for (int e = 0; e < 8; ++e) r[e] = v[e] * rs * (e < 4 ? n0[e & 3] : n1[e & 3]) * (gg[e] * sigmoidf_(gg[e]));
            u32x4 wv; wv.x = pk_bf16(r[0], r[1]); wv.y = pk_bf16(r[2], r[3]); wv.z = pk_bf16(r[4], r[5]); wv.w = pk_bf16(r[6], r[7]);
            *(u32x4*)(AP + (size_t)tok * 1536 + 512 + col) = wv;
        }
    }
}

DEVI void ln_row(f32x4 (&v)[4], const float* g, const float* bta, int lane) {
    float s = 0.f;
#pragma unroll
    for (int j = 0; j < 4; ++j) s += (v[j][0] + v[j][1]) + (v[j][2] + v[j][3]);
    const float mu = wave_sum(s) * (1.0f / 1024.0f);
    float q = 0.f;
#pragma unroll
    for (int j = 0; j < 4; ++j) { v[j] = v[j] - mu; q += (v[j][0] * v[j][0] + v[j][1] * v[j][1]) + (v[j][2] * v[j][2] + v[j][3] * v[j][3]); }
    const float rstd = rsqrtf(wave_sum(q) * (1.0f / 1024.0f) + 1e-6f);
#pragma unroll
    for (int j = 0; j < 4; ++j) { const f32x4 gg = *(const f32x4*)(g + lane * 4 + 256 * j), bb = *(const f32x4*)(bta + lane * 4 + 256 * j); v[j] = v[j] * rstd * gg + bb; }
}
DEVI void phase9(const Params& p) {
    const int lane = threadIdx.x & 63, gw = blockIdx.x * 8 + (threadIdx.x >> 6), nw = gridDim.x * 8;
    const float* mod = (const float*)(p.ws + WS_MOD); const bf16_t* Z = (const bf16_t*)(p.ws + WS_Z); bf16_t* X1 = (bf16_t*)(p.ws + WS_X1); bf16_t* H2 = (bf16_t*)(p.ws + WS_H2); unsigned char* H8 = p.ws + WS_H2F8;
    for (int tok = gw; tok < NTOK; tok += nw) {
        const float* m = mod + (size_t)(tok >> 12) * 6144; float v[2][8];
#pragma unroll
        for (int j = 0; j < 2; ++j) { const int cidx = lane * 8 + 512 * j;
            const f32x4 x0 = *(const f32x4*)(p.in[0] + (size_t)tok * 1024 + cidx), x1 = *(const f32x4*)(p.in[0] + (size_t)tok * 1024 + cidx + 4), g0 = *(const f32x4*)(m + 2048 + cidx), g1 = *(const f32x4*)(m + 2048 + cidx + 4);
            const u32x4 z = *(const u32x4*)(Z + (size_t)tok * 1024 + cidx);
            float zf[8] = {bflo(z.x), bfhi(z.x), bflo(z.y), bfhi(z.y), bflo(z.z), bfhi(z.z), bflo(z.w), bfhi(z.w)};
#if defined(DBG_NOMIX)
#pragma unroll
            for (int e = 0; e < 8; ++e) zf[e] = 0.f;
#endif
#pragma unroll
            for (int e = 0; e < 4; ++e) { v[j][e] = x0[e] * 1.189207115f + g0[e] * zf[e]; v[j][4 + e] = x1[e] * 1.189207115f + g1[e] * zf[4 + e]; }
        }
        float sm = 0.f;
#pragma unroll
        for (int j = 0; j < 2; ++j)
#pragma unroll
            for (int e = 0; e < 8; ++e) sm += v[j][e];
        const float mu = wave_sum(sm) * (1.0f / 1024.0f); float q = 0.f;
#pragma unroll
        for (int j = 0; j < 2; ++j)
#pragma unroll
            for (int e = 0; e < 8; ++e) { v[j][e] -= mu; q += v[j][e] * v[j][e]; }
        const float rstd = rsqrtf(wave_sum(q) * (1.0f / 1024.0f) + 1e-6f);
#pragma unroll
        for (int j = 0; j < 2; ++j) { const int cidx = lane * 8 + 512 * j;
            const f32x4 g0 = *(const f32x4*)(p.in[16] + cidx), g1 = *(const f32x4*)(p.in[16] + cidx + 4), b0 = *(const f32x4*)(p.in[17] + cidx), b1 = *(const f32x4*)(p.in[17] + cidx + 4);
            const f32x4 sh0 = *(const f32x4*)(m + 3072 + cidx), sh1 = *(const f32x4*)(m + 3072 + cidx + 4), sc0 = *(const f32x4*)(m + 4096 + cidx), sc1 = *(const f32x4*)(m + 4096 + cidx + 4);
            f32x4 o0, o1; float hv[8];
#pragma unroll
            for (int e = 0; e < 4; ++e) { o0[e] = v[j][e] * rstd * g0[e] + b0[e]; o1[e] = v[j][4 + e] * rstd * g1[e] + b1[e]; hv[e] = o0[e] * (sc0[e] + 1.0f) + sh0[e]; hv[4 + e] = o1[e] * (sc1[e] + 1.0f) + sh1[e]; }
            { u32x4 xv; xv.x = pk_bf16(o0[0], o0[1]); xv.y = pk_bf16(o0[2], o0[3]); xv.z = pk_bf16(o1[0], o1[1]); xv.w = pk_bf16(o1[2], o1[3]); *(u32x4*)(X1 + (size_t)tok * 1024 + cidx) = xv; }
            u32x4 wv; wv.x = pk_bf16(hv[0], hv[1]); wv.y = pk_bf16(hv[2], hv[3]); wv.z = pk_bf16(hv[4], hv[5]); wv.w = pk_bf16(hv[6], hv[7]);
            *(u32x4*)(H2 + (size_t)tok * 1024 + cidx) = wv;
            u32x2 w8; w8.x = pk4_fp8(hv[0] * F8_X, hv[1] * F8_X, hv[2] * F8_X, hv[3] * F8_X); w8.y = pk4_fp8(hv[4] * F8_X, hv[5] * F8_X, hv[6] * F8_X, hv[7] * F8_X);
            *(u32x2*)(H8 + (size_t)tok * 1024 + cidx) = w8; }
    }
}
DEVI void phase11(const Params& p, LAS unsigned char* lds, int tok_begin) {
    const int lane = threadIdx.x & 63, half = lane >> 5, tw0 = tok_begin + (threadIdx.x >> 6) * 32;
    LAS unsigned* LC = (LAS unsigned*)(lds + LDS_TAB); LAS unsigned* LB = LC + 256;
    if (threadIdx.x < 256) LC[threadIdx.x] = 0u;
    __syncthreads();
    const float* L0 = (const float*)(p.ws + WS_LOG0);
    int* TID = (int*)(p.ws + WS_TOPK_ID); float* TW = (float*)(p.ws + WS_TOPK_W); int* TP = (int*)(p.ws + WS_TOPK_POS); unsigned* CNT = (unsigned*)(p.ws + WS_CNT);
    float rb[4];
#pragma unroll
    for (int j = 0; j < 4; ++j) rb[j] = p.in[19][lane + 64 * j];
    for (int tok = tw0; tok < tw0 + 32; ++tok) {
        float s[4], bz[4], gs[4];
#pragma unroll
        for (int j = 0; j < 4; ++j) { const float lg = L0[(size_t)tok * 256 + lane + 64 * j]; s[j] = __builtin_amdgcn_rcpf(1.0f + __expf(-lg)); bz[j] = s[j] + rb[j]; }
#pragma unroll
        for (int j = 0; j < 4; ++j) { float m1 = bz[j], m2 = -INFINITY;
#define TOP2_STEP(P1, P2) { const float p1 = (P1), p2 = (P2); const float n1 = fmaxf(m1, p1), n2 = fmaxf(fminf(m1, p1), fmaxf(m2, p2)); m1 = n1; m2 = n2; }
            TOP2_STEP(dppf<DPP_X1>(m1), dppf<DPP_X1>(m2)) TOP2_STEP(dppf<DPP_X2>(m1), dppf<DPP_X2>(m2)) TOP2_STEP(dppf<DPP_HM>(m1), dppf<DPP_HM>(m2)) TOP2_STEP(dppf<DPP_RM>(m1), dppf<DPP_RM>(m2)) TOP2_STEP(x16f(m1, lane), x16f(m2, lane))
#undef TOP2_STEP
            gs[j] = m1 + m2; }
        float Gv[8];
#pragma unroll
        for (int j = 0; j < 4; ++j) { const float oth = x32f(gs[j], lane); Gv[2 * j] = half ? oth : gs[j]; Gv[2 * j + 1] = half ? gs[j] : oth; }
        bool keep[8];
#pragma unroll
        for (int g = 0; g < 8; ++g) { int rank = 0;
#pragma unroll
            for (int g2 = 0; g2 < 8; ++g2) rank += (Gv[g2] > Gv[g] || (Gv[g2] == Gv[g] && g2 < g)) ? 1 : 0;
            keep[g] = rank < 4; }
        unsigned key[4];
#pragma unroll
        for (int j = 0; j < 4; ++j) { const bool k = half ? keep[2 * j + 1] : keep[2 * j]; key[j] = k ? ((__float_as_uint(bz[j] + 1.0f) & 0xFFFFFF00u) | (unsigned)(255 - (lane + 64 * j))) : 0u; }
        int myE = 0;
#pragma unroll
        for (int it = 0; it < 8; ++it) {
            unsigned k = max(max(key[0], key[1]), max(key[2], key[3]));
            k = max(k, (unsigned)dppi<DPP_X1>((int)k)); k = max(k, (unsigned)dppi<DPP_X2>((int)k)); k = max(k, (unsigned)dppi<DPP_HM>((int)k)); k = max(k, (unsigned)dppi<DPP_RM>((int)k));
            k = max(k, (unsigned)x16i((int)k, lane)); k = max(k, (unsigned)x32i((int)k, lane));
#pragma unroll
            for (int j = 0; j < 4; ++j) key[j] = key[j] == k ? 0u : key[j];
            if (lane == it) myE = 255 - (int)(k & 255u);
        }
        float sv;
        { const int src = (myE & 63) << 2, jsel = myE >> 6;
          const float a0 = __builtin_bit_cast(float, __builtin_amdgcn_ds_bpermute(src, __builtin_bit_cast(int, s[0]))), a1 = __builtin_bit_cast(float, __builtin_amdgcn_ds_bpermute(src, __builtin_bit_cast(int, s[1])));
          const float a2 = __builtin_bit_cast(float, __builtin_amdgcn_ds_bpermute(src, __builtin_bit_cast(int, s[2]))), a3 = __builtin_bit_cast(float, __builtin_amdgcn_ds_bpermute(src, __builtin_bit_cast(int, s[3])));
          sv = jsel == 0 ? a0 : (jsel == 1 ? a1 : (jsel == 2 ? a2 : a3)); }
        float ssum = lane < 8 ? sv : 0.f;
        ssum += dppf<DPP_X1>(ssum); ssum += dppf<DPP_X2>(ssum); ssum += dppf<DPP_HM>(ssum);
        if (lane < 8) { const int idx = tok * 8 + lane; TID[idx] = myE; TW[idx] = sv / ssum * 2.5f; TP[idx] = (int)__hip_atomic_fetch_add(LC + myE, 1u, __ATOMIC_RELAXED, __HIP_MEMORY_SCOPE_WORKGROUP); }
    }
    __syncthreads();
    if (threadIdx.x < 256) { const unsigned cnt = LC[threadIdx.x]; LB[threadIdx.x] = cnt ? atomicAdd(&CNT[threadIdx.x], cnt) : 0u; }
    __syncthreads();
    for (int tok = tw0; tok < tw0 + 32; ++tok) if (lane < 8) { const int idx = tok * 8 + lane; TP[idx] += (int)LB[TID[idx]]; }
}
DEVI void phase12(const Params& p, LAS unsigned char* lds, int part) {
    if (part == 0) {
    LAS int* T = (LAS int*)(lds + LDS_TAB);
    moe_tables((const unsigned*)(p.ws + WS_CNT), T);
    const int* TID = (const int*)(p.ws + WS_TOPK_ID); const int* TP = (const int*)(p.ws + WS_TOPK_POS); int* TPw = (int*)(p.ws + WS_TOPK_POS); const float* TW = (const float*)(p.ws + WS_TOPK_W); u32x2* SL = (u32x2*)(p.ws + WS_SLOT);
    for (int idx = blockIdx.x * 512 + threadIdx.x; idx < NTOK * 8; idx += gridDim.x * 512) { const int slot_ = T[256 + TID[idx]] + TP[idx]; u32x2 rec; rec.x = (unsigned)idx; rec.y = __float_as_uint(TW[idx]); SL[slot_] = rec; TPw[idx] = slot_; }
    return; }
    LAS float* tb = (LAS float*)lds;
    __syncthreads();
    const bool even_split = gridDim.x == 256; const int cb = blockIdx.x;
    const int t_lo = even_split ? (cb < 128 ? cb * 18 : 2304 + (cb - 128) * 30) : cb, t_hi = even_split ? t_lo + (cb < 128 ? 18 : 30) : 256 * 24, t_st = even_split ? 1 : (int)gridDim.x;
    for (int t = t_lo; t < t_hi; t += t_st) {
        const int e = t / 24, r = t % 24;
        if (r < 8)       conv_tile8(p.in[20] + (size_t)e * 262144, 256, p.ws + WS_EXPGU + (size_t)e * 524288, 1024, r * 128, 0, 0, F8_WGU, tb);
        else if (r < 16) conv_tile8(p.in[21] + (size_t)e * 262144, 256, p.ws + WS_EXPGU + (size_t)e * 524288, 1024, (r - 8) * 128, 0, 128, F8_WGU, tb);
        else { const int kt = (r - 16) >> 2, nb = (r - 16) & 3; conv_tile8(p.in[22] + (size_t)e * 262144 + nb * 256, 1024, p.ws + WS_EXPD + (size_t)e * 262144, 256, kt * 128, nb * 256, -1, F8_WD, tb); }
    }
}
DEVI void phase15(const Params& p) {
    const int lane = threadIdx.x & 63, gw = blockIdx.x * 8 + (threadIdx.x >> 6), nw = gridDim.x * 8;
    const float* mod = (const float*)(p.ws + WS_MOD); const bf16_t* X1 = (const bf16_t*)(p.ws + WS_X1);
    for (int tok = gw; tok < NTOK; tok += nw) {
        const float* m = mod + (size_t)(tok >> 12) * 6144 + 5120; float v[2][8];
        int sl[8]; float tw[8];
        { const int* tp = (const int*)(p.ws + WS_TOPK_POS) + (size_t)tok * 8; const float* twp = (const float*)(p.ws + WS_TOPK_W) + (size_t)tok * 8;
#pragma unroll
          for (int k = 0; k < 8; ++k) { sl[k] = __builtin_amdgcn_readfirstlane(tp[k]); tw[k] = twp[k]; } }
#pragma unroll
        for (int j = 0; j < 2; ++j) { const int cidx = lane * 8 + 512 * j; float a[8];
#pragma unroll
            for (int e = 0; e < 8; ++e) a[e] = 0.f;
#pragma unroll
            for (int k = 0; k < 9; ++k) { const u32x4 y = *(const u32x4*)((k < 8 ? (const bf16_t*)(p.ws + ws_ys(sl[k])) : (const bf16_t*)(p.ws + WS_Y8) + (size_t)tok * 1024) + cidx); const float w = k < 8 ? tw[k] : 1.0f;
                a[0] += w * bflo(y.x); a[1] += w * bfhi(y.x); a[2] += w * bflo(y.y); a[3] += w * bfhi(y.y); a[4] += w * bflo(y.z); a[5] += w * bfhi(y.z); a[6] += w * bflo(y.w); a[7] += w * bfhi(y.w); }
            const u32x4 xr = *(const u32x4*)(X1 + (size_t)tok * 1024 + cidx);
            const f32x4 g0 = *(const f32x4*)(m + cidx), g1 = *(const f32x4*)(m + cidx + 4), x0 = {bflo(xr.x), bfhi(xr.x), bflo(xr.y), bfhi(xr.y)}, x1 = {bflo(xr.z), bfhi(xr.z), bflo(xr.w), bfhi(xr.w)};
#if defined(DBG_NOMOE)
#pragma unroll
            for (int e = 0; e < 8; ++e) a[e] = 0.f;
#endif
#pragma unroll
            for (int e = 0; e < 4; ++e) { v[j][e] = x0[e] * 1.189207115f + g0[e] * a[e]; v[j][4 + e] = x1[e] * 1.189207115f + g1[e] * a[4 + e]; }
        }
        float sm = 0.f;
#pragma unroll
        for (int j = 0; j < 2; ++j)
#pragma unroll
            for (int e = 0; e < 8; ++e) sm += v[j][e];
        const float mu = wave_sum(sm) * (1.0f / 1024.0f); float q = 0.f;
#pragma unroll
        for (int j = 0; j < 2; ++j)
#pragma unroll
            for (int e = 0; e < 8; ++e) { v[j][e] -= mu; q += v[j][e] * v[j][e]; }
        const float rstd = rsqrtf(wave_sum(q) * (1.0f / 1024.0f) + 1e-6f);
#pragma unroll
        for (int j = 0; j < 2; ++j) { const int cidx = lane * 8 + 512 * j;
            const f32x4 g0 = *(const f32x4*)(p.in[26] + cidx), g1 = *(const f32x4*)(p.in[26] + cidx + 4), b0 = *(const f32x4*)(p.in[27] + cidx), b1 = *(const f32x4*)(p.in[27] + cidx + 4);
            f32x4 o0, o1;
#pragma unroll
            for (int e = 0; e < 4; ++e) { o0[e] = v[j][e] * rstd * g0[e] + b0[e]; o1[e] = v[j][4 + e] * rstd * g1[e] + b1[e]; }
            *(f32x4*)(p.out + (size_t)tok * 1024 + cidx) = o0; *(f32x4*)(p.out + (size_t)tok * 1024 + cidx + 4) = o1; }
    }
}

__global__ void __launch_bounds__(512, 2) mega(Params p) {
    extern __shared__ __attribute__((aligned(16))) unsigned char shm[];
    LAS unsigned char* lds = (LAS unsigned char*)shm;
    volatile LAS unsigned* xbw = (volatile LAS unsigned*)(lds + LDS_BARW);
    if (threadIdx.x == 0) { xbw[0] = 0u; xbw[1] = 0u; xbw[2] = 0u; xbw[3] = 0u; }
    __syncthreads();
    XcdBarrier bar; bar.bar = (unsigned*)(p.ws + WS_CTL); bar.x = 0; bar.st = xbw;
    const bool multi = (p.ph_hi - p.ph_lo) > 1;
    if (multi) bar = xcd_barrier_post((unsigned*)(p.ws + WS_CTL), xbw);
    unsigned char* ws = p.ws;
    const int G = gridDim.x, c = blockIdx.x;
#ifndef PHMASK
#define PHMASK 0xFFFF
#endif
#ifndef REPMASK
#define REPMASK 0
#endif
#define RUN(n) if (((PHMASK >> (n)) & 1) && p.ph_lo <= (n) && (n) < p.ph_hi)
#define SYNC(n) if (p.ph_lo <= (n) && (n) + 1 < p.ph_hi) xcd_barrier(bar); else __syncthreads()
    RUN(0) phase0(p, lds, 0);
#if (REPMASK >> 0) & 1
    __syncthreads();
    RUN(0) phase0(p, lds, 0);
#endif
    SYNC(0);
    RUN(1) { phase1(p); phase0(p, lds, 1); }
#if (REPMASK >> 1) & 1
    __syncthreads();
    RUN(1) { phase1(p); phase0(p, lds, 1); }
#endif
    SYNC(1);
    RUN(2) { SchedInProj S{ws, G, c}; EpiBf16 E; gemm_stream<SchedInProj, EpiBf16, false>(lds, S, E); }
#if (REPMASK >> 2) & 1
    __syncthreads();
    RUN(2) { SchedInProj S{ws, G, c}; EpiBf16 E; gemm_stream<SchedInProj, EpiBf16, false>(lds, S, E); }
#endif
    SYNC(2);
    RUN(3) phase3(p, lds);
#if (REPMASK >> 3) & 1
    __syncthreads();
    RUN(3) phase3(p, lds);
#endif
    SYNC(3);
    RUN(4) { if (c & 1) { phase4_na(p, lds); __syncthreads(); phase4_gla(p, lds); } else { phase4_gla(p, lds); __syncthreads(); phase4_na(p, lds); } }
    SYNC(4);
    RUN(5) phase5(p);
#if (REPMASK >> 5) & 1
    __syncthreads();
    RUN(5) phase5(p);
#endif
    SYNC(5);
#if (REPMASK >> 6) & 1
    __syncthreads();
#endif
    RUN(7) { SchedDense S{(const char*)(ws + WS_AP), (const char*)(ws + WS_BT_BR), (char*)(ws + WS_YM), 1536, G, c, 3072u, 3072u, 24}; EpiBranchC E{(const bf16_t*)(ws + WS_SGA), (const bf16_t*)(ws + WS_SGB), (bf16_t*)(ws + WS_YM)}; gemm_stream<SchedDense, EpiBranchC, false>(lds, S, E); }
#if (REPMASK >> 7) & 1
    __syncthreads();
    RUN(7) { SchedDense S{(const char*)(ws + WS_AP), (const char*)(ws + WS_BT_BR), (char*)(ws + WS_YM), 1536, G, c, 3072u, 3072u, 24}; EpiBranchC E{(const bf16_t*)(ws + WS_SGA), (const bf16_t*)(ws + WS_SGB), (bf16_t*)(ws + WS_YM)}; gemm_stream<SchedDense, EpiBranchC, false>(lds, S, E); }
#endif
    SYNC(7);
    RUN(8) { SchedDense S{(const char*)(ws + WS_YM), (const char*)(ws + WS_BT_OUT), (char*)(ws + WS_Z), 1024, G, c, 2048u, 2048u, 16}; EpiBf16 E; gemm_stream<SchedDense, EpiBf16, false>(lds, S, E); }
#if (REPMASK >> 8) & 1
    __syncthreads();
    RUN(8) { SchedDense S{(const char*)(ws + WS_YM), (const char*)(ws + WS_BT_OUT), (char*)(ws + WS_Z), 1024, G, c, 2048u, 2048u, 16}; EpiBf16 E; gemm_stream<SchedDense, EpiBf16, false>(lds, S, E); }
#endif
    SYNC(8);
    RUN(9) phase9(p);
#if (REPMASK >> 9) & 1
    __syncthreads();
    RUN(9) phase9(p);
#endif
    SYNC(9);
    RUN(10) { if (c < 128) { SchedRouter S{ws, G, c}; EpiF32 E; gemm_stream<SchedRouter, EpiF32, false>(lds, S, E); asm volatile("s_waitcnt vmcnt(0)" ::: "memory"); __syncthreads(); phase11(p, lds, SchedRouter::panel(c) * 256); }
              phase12(p, lds, 1); }
    SYNC(10);
    RUN(12) phase12(p, lds, 0);
#if (REPMASK >> 12) & 1
    __syncthreads();
    RUN(12) phase12(p, lds, 0);
#endif
    SYNC(12);
    RUN(13) { LAS int* T = (LAS int*)(lds + LDS_TAB); moe_tables((const unsigned*)(ws + WS_CNT), T); SchedGateUp S{ws, T, G, c}; EpiGateUp E{ws + WS_HID}; gemm_stream<SchedGateUp, EpiGateUp, true>(lds, S, E); }
#if (REPMASK >> 13) & 1
    __syncthreads();
    RUN(13) { LAS int* T = (LAS int*)(lds + LDS_TAB); moe_tables((const unsigned*)(ws + WS_CNT), T); SchedGateUp S{ws, T, G, c}; EpiGateUp E{ws + WS_HID}; gemm_stream<SchedGateUp, EpiGateUp, true>(lds, S, E); }
#endif
    SYNC(13);
    RUN(14) { LAS int* T = (LAS int*)(lds + LDS_TAB); moe_tables((const unsigned*)(ws + WS_CNT), T); SchedDown S{ws, T, G, c}; EpiDown E{ws}; gemm_stream<SchedDown, EpiDown, false>(lds, S, E); }
#if (REPMASK >> 14) & 1
    __syncthreads();
    RUN(14) { LAS int* T = (LAS int*)(lds + LDS_TAB); moe_tables((const unsigned*)(ws + WS_CNT), T); SchedDown S{ws, T, G, c}; EpiDown E{ws}; gemm_stream<SchedDown, EpiDown, false>(lds, S, E); }
#endif
    SYNC(14);
    RUN(15) phase15(p);
#if (REPMASK >> 15) & 1
    __syncthreads();
    RUN(15) phase15(p);
#endif
}

#ifdef DBG_STOP
__global__ void dbg_dump(const unsigned short* base, size_t nwords, float* out, int accumulate) {
    for (size_t i = (size_t)blockIdx.x * blockDim.x + threadIdx.x; i < (size_t)33554432; i += (size_t)gridDim.x * blockDim.x) {
        float s = accumulate ? out[i] : 0.f;
        for (size_t j = i; j < nwords; j += (size_t)33554432) s += (float)base[j];
        out[i] = s;
    }
}
#endif
}

extern "C" void kernel_launch(void* const* d_in, const int* in_sizes, int n_in, void* d_out, int out_size, void* d_ws, size_t ws_size, hipStream_t stream) {
    static int grid = 0;
    if (grid == 0) {
        if (n_in != 28 || out_size != NTOK * 1024 || ws_size < WS_END) { fprintf(stderr, "kernel_launch: unexpected problem (n_in %d out %d ws %zu)\n", n_in, out_size, ws_size); grid = -1; return; }
        int dev = 0, cus = 0, per_cu = 0;
        if (hipGetDevice(&dev) != hipSuccess || hipDeviceGetAttribute(&cus, hipDeviceAttributeMultiprocessorCount, dev) != hipSuccess) { grid = -1; return; }
        if (hipFuncSetAttribute((const void*)mega, hipFuncAttributeMaxDynamicSharedMemorySize, LDS_TOTAL) != hipSuccess) { fprintf(stderr, "kernel_launch: hipFuncSetAttribute failed\n"); grid = -1; return; }
        if (hipOccupancyMaxActiveBlocksPerMultiprocessor(&per_cu, (const void*)mega, 512, LDS_TOTAL) != hipSuccess || per_cu < 1) fprintf(stderr, "kernel_launch: occupancy query says %d\n", per_cu);
        (void)hipGetLastError();
        grid = cus;
    }
    if (grid < 0) return;
    (void)hipMemsetAsync((char*)d_ws + WS_CTL, 0, 32768, stream);
    Params p{};
    for (int i = 0; i < 28; ++i) p.in[i] = (const float*)d_in[i];
    p.out = (float*)d_out; p.ws = (unsigned char*)d_ws;
#ifdef DBG_STOP
    for (int ph = 0; ph <= DBG_STOP; ++ph) { p.ph_lo = ph; p.ph_hi = ph + 1; hipLaunchKernelGGL(mega, dim3(grid), dim3(512), LDS_TOTAL, stream, p); }
    { const size_t regs[][2] = { DBG_REGS }; int first = 1;
      for (auto& r : regs) { hipLaunchKernelGGL(dbg_dump, dim3(2048), dim3(256), 0, stream, (const unsigned short*)((char*)d_ws + r[0] * MiB), (size_t)(r[1] * MiB / 2), (float*)d_out, first ? 0 : 1); first = 0; } }
#elif MK_PER_PHASE
    for (int ph = 0; ph < NPH; ++ph) {
#if defined(DBG_NOMOE)
        if (ph >= 10 && ph <= 14) continue;
#endif
        p.ph_lo = ph; p.ph_hi = ph + 1; hipLaunchKernelGGL(mega, dim3(grid), dim3(512), LDS_TOTAL, stream, p); }
#else
    p.ph_lo = 0; p.ph_hi = NPH; hipLaunchKernelGGL(mega, dim3(grid), dim3(512), LDS_TOTAL, stream, p);
#endif
}
```

```cpp
#include <hip/hip_runtime.h>
#include <stdint.h>
#include <stdio.h>

#ifndef MK_PER_PHASE
#define MK_PER_PHASE 0
#endif

namespace {
typedef unsigned short bf16_t;
typedef short bf16x8 __attribute__((ext_vector_type(8)));
typedef float f32x4 __attribute__((ext_vector_type(4)));
typedef unsigned u32x4 __attribute__((ext_vector_type(4)));
typedef unsigned u32x2 __attribute__((ext_vector_type(2)));
typedef int i32x4 __attribute__((ext_vector_type(4)));
typedef int i32x8 __attribute__((ext_vector_type(8)));
#define LAS __attribute__((address_space(3)))
#define DEVI __device__ __forceinline__

constexpr int NTOK = 32768, NROW = 34816, NPH = 16;
constexpr size_t MiB = 1ull << 20;
constexpr int LDS_TOTAL = 160 * 1024;
constexpr int LDS_BARW = LDS_TOTAL - 16;
constexpr int LDS_TAB = 131072;

constexpr size_t WS_CTL = 0, WS_CNT = 16384, WS_MOD = 1 * MiB, WS_EE = 2 * MiB, WS_TOPK_ID = 5 * MiB, WS_TOPK_W = 6 * MiB, WS_TOPK_POS = 7 * MiB, WS_SLOT = 8 * MiB;
constexpr size_t WS_BT_IN = 10 * MiB, WS_BT_BR = 24 * MiB  , WS_BT_OUT = 27 * MiB, WS_BT_RT = 29 * MiB, WS_BT_SHGU = 30 * MiB, WS_BT_SHD = 31 * MiB;
constexpr size_t WS_H = 32 * MiB, WS_QA = 100 * MiB, WS_KA = 132 * MiB, WS_QB = 166 * MiB, WS_KB = 198 * MiB, WS_GB = 232 * MiB, WS_SGA = 296 * MiB, WS_SGB = 360 * MiB;
constexpr size_t WS_VAT = 424 * MiB, WS_VBT = 458 * MiB, WS_QTF = 526 * MiB, WS_QTB = 558 * MiB, WS_KTF = 590 * MiB, WS_KTB = 624 * MiB, WS_KTTF = 658 * MiB, WS_KTTB = 692 * MiB;
constexpr size_t WS_OF = 726 * MiB, WS_OB = 790 * MiB, WS_AP = 896 * MiB, WS_LRT = 888 * MiB;
constexpr size_t WS_YM = 424 * MiB, WS_Z = 488 * MiB;
constexpr size_t WS_X1 = 32 * MiB, WS_EXPD = 160 * MiB, WS_LOG0 = 288 * MiB, WS_LOG1 = 320 * MiB, WS_EXPGU = 352 * MiB, WS_H2 = 608 * MiB, WS_HID = 864 * MiB;
constexpr size_t WS_H2F8 = 96 * MiB;
constexpr size_t WS_YS = 288 * MiB;
constexpr size_t WS_Y8 = 800 * MiB, WS_END = 1009 * MiB;
DEVI size_t ws_ys(int slot) { return WS_YS + (size_t)slot * 1024; }
DEVI size_t ws_y(int k) { return (k < 2 ? 160 + 64 * (size_t)k : (k < 6 ? 416 + 64 * (size_t)(k - 2) : 817 + 64 * (size_t)(k - 6))) * MiB; }

struct Params { const float* in[28]; float* out; unsigned char* ws; int ph_lo, ph_hi; };

typedef __bf16 bf16x2_t __attribute__((ext_vector_type(2)));
typedef float f32x2_t __attribute__((ext_vector_type(2)));
DEVI unsigned pk_bf16(float lo, float hi) { const f32x2_t v = {lo, hi}; const bf16x2_t r = __builtin_convertvector(v, bf16x2_t); return __builtin_bit_cast(unsigned, r); }
DEVI float bf2f(bf16_t b) { return __uint_as_float(((unsigned)b) << 16); }
DEVI float bflo(unsigned w) { return __uint_as_float(w << 16); }
DEVI float bfhi(unsigned w) { return __uint_as_float(w & 0xffff0000u); }
DEVI float clamp8(float v) { return __builtin_amdgcn_fmed3f(v, -448.0f, 448.0f); }
DEVI unsigned pk4_fp8(float a, float b, float c, float d) { unsigned w = 0u; w = (unsigned)__builtin_amdgcn_cvt_pk_fp8_f32(clamp8(a), clamp8(b), (int)w, false); w = (unsigned)__builtin_amdgcn_cvt_pk_fp8_f32(clamp8(c), clamp8(d), (int)w, true); return w; }
DEVI i32x8 cat8(bf16x8 a, bf16x8 b) { const i32x4 x = __builtin_bit_cast(i32x4, a), y = __builtin_bit_cast(i32x4, b); return __builtin_shufflevector(x, y, 0, 1, 2, 3, 4, 5, 6, 7); }
DEVI void mfma8(f32x4& acc, i32x8 a, i32x8 b) { asm volatile("v_mfma_f32_16x16x128_f8f6f4 %0, %1, %2, %0" : "+v"(acc) : "v"(a), "v"(b)); }
constexpr float F8_X = 4.0f, F8_WGU = 256.0f, F8_H = 4.0f, F8_WD = 128.0f;
constexpr float F8_Y = 64.0f;
constexpr float F8_HIN = 4.0f, F8_WIN = 256.0f;
DEVI bf16_t f2bf(float f) { return (bf16_t)(pk_bf16(f, 0.f) & 0xffffu); }
DEVI float sigmoidf_(float x) { return __builtin_amdgcn_rcpf(1.0f + __expf(-x)); }
template <int N> struct IC { static constexpr int v = N; };
DEVI void lds_barrier() { asm volatile("s_waitcnt lgkmcnt(0)" ::: "memory"); __builtin_amdgcn_s_barrier(); asm volatile("" ::: "memory"); }
template <int CTRL> DEVI float dppf(float v) { return __builtin_bit_cast(float, __builtin_amdgcn_update_dpp(__builtin_bit_cast(int, v), __builtin_bit_cast(int, v), CTRL, 0xF, 0xF, false)); }
template <int CTRL> DEVI int dppi(int v) { return __builtin_amdgcn_update_dpp(v, v, CTRL, 0xF, 0xF, false); }
DEVI float x16f(float v, int lane) { const auto r = __builtin_amdgcn_permlane16_swap(__builtin_bit_cast(unsigned, v), __builtin_bit_cast(unsigned, v), false, false); return __builtin_bit_cast(float, (lane & 16) ? r[0] : r[1]); }
DEVI int   x16i(int v, int lane)   { const auto r = __builtin_amdgcn_permlane16_swap((unsigned)v, (unsigned)v, false, false); return (int)((lane & 16) ? r[0] : r[1]); }
DEVI float x32f(float v, int lane) { const auto r = __builtin_amdgcn_permlane32_swap(__builtin_bit_cast(unsigned, v), __builtin_bit_cast(unsigned, v), false, false); return __builtin_bit_cast(float, (lane & 32) ? r[0] : r[1]); }
DEVI int   x32i(int v, int lane)   { const auto r = __builtin_amdgcn_permlane32_swap((unsigned)v, (unsigned)v, false, false); return (int)((lane & 32) ? r[0] : r[1]); }
#define DPP_X1 0xB1
#define DPP_X2 0x4E
#define DPP_HM 0x141
#define DPP_RM 0x140
DEVI float wave_sum(float v) { const int lane = threadIdx.x & 63; v += dppf<DPP_X1>(v); v += dppf<DPP_X2>(v); v += dppf<DPP_HM>(v); v += dppf<DPP_RM>(v); v += x16f(v, lane); v += x32f(v, lane); return v; }

#define XB_TMO      128
#define XB_XCNT(j)  (256  + 64 * (j))
#define XB_XSUB(j)  (1280 + 64 * (j))
#define XB_XGEN(j)  (2304 + 64 * (j))
#define XB_TOP      3328
#define XB_TOPGEN   3392
#define XCD_BAR_WORDS 3456
#define XB_SPIN_CAP (1u << 22)
DEVI unsigned xb_ld(unsigned* p)              { return __hip_atomic_load(p, __ATOMIC_RELAXED, __HIP_MEMORY_SCOPE_AGENT); }
DEVI unsigned xb_add(unsigned* p, unsigned v) { return __hip_atomic_fetch_add(p, v, __ATOMIC_RELAXED, __HIP_MEMORY_SCOPE_AGENT); }
DEVI unsigned xb_xcc_id() { return (unsigned)__builtin_amdgcn_s_getreg((3 << 11) | 20) & 0xFu; }
#define XB_SPIN(cond, bar) do { unsigned _sp = 0; while (cond) { __builtin_amdgcn_s_sleep(1); \
    if ((++_sp & 255u) == 0u) { if (xb_ld(&(bar)[XB_TMO])) break; if (_sp > XB_SPIN_CAP) { atomicAdd(&(bar)[XB_TMO], 1u); break; } } } } while (0)
struct XcdBarrier { unsigned* bar; unsigned x; volatile LAS unsigned* st; };
DEVI XcdBarrier xcd_barrier_post(unsigned* bar, volatile LAS unsigned* st) {
    XcdBarrier b; b.bar = bar; b.x = xb_xcc_id(); b.st = st;
    if (threadIdx.x == 0) (void)xb_add(&bar[XB_XCNT(b.x)], 1u);
    return b;
}
DEVI void xcd_barrier_complete(unsigned* bar, unsigned x, unsigned& nloc, unsigned& nx) {
    const unsigned G = gridDim.x * gridDim.y * gridDim.z;
    unsigned sum, cnt, mine, sp = 0u;
    for (;;) {
        sum = 0u; cnt = 0u; mine = 0u;
#pragma unroll
        for (unsigned j = 0; j < 16; ++j) { const unsigned c = xb_ld(&bar[XB_XCNT(j)]); sum += c; cnt += (c > 0u) ? 1u : 0u; mine = (j == x) ? c : mine; }
        if (sum == G) break;
        __builtin_amdgcn_s_sleep(1);
        if ((++sp & 255u) == 0u) { if (xb_ld(&bar[XB_TMO])) break; if (sp > XB_SPIN_CAP) { atomicAdd(&bar[XB_TMO], 1u); break; } }
    }
    nloc = mine > 0u ? mine : 1u; nx = cnt > 0u ? cnt : 1u;
}
DEVI void xcd_barrier(const XcdBarrier& b) {
    asm volatile("s_waitcnt vmcnt(0)" ::: "memory");
    __syncthreads();
    if (threadIdx.x == 0) {
        unsigned* bar = b.bar;
        __builtin_amdgcn_s_waitcnt(0);
        unsigned nloc = b.st[0], nx = b.st[1];
        if (nloc == 0u) { xcd_barrier_complete(bar, b.x, nloc, nx); b.st[0] = nloc; b.st[1] = nx; }
        const unsigned old = xb_add(&bar[XB_XSUB(b.x)], 1u);
        const unsigned gen = old / nloc;
        if (old + 1u == (gen + 1u) * nloc) {
            __builtin_amdgcn_fence(__ATOMIC_RELEASE, "agent");
            asm volatile("s_waitcnt vmcnt(0)" ::: "memory");
            const unsigned og = xb_add(&bar[XB_TOP], 1u);
            const unsigned tg = og / nx;
            if (og + 1u == (tg + 1u) * nx) xb_add(&bar[XB_TOPGEN], 1u);
            else XB_SPIN(xb_ld(&bar[XB_TOPGEN]) == tg, bar);
            __builtin_amdgcn_fence(__ATOMIC_ACQUIRE, "agent");
            xb_add(&bar[XB_XGEN(b.x)], 1u);
            asm volatile("s_waitcnt vmcnt(0)" ::: "memory");
        } else {
            XB_SPIN(xb_ld(&bar[XB_XGEN(b.x)]) == gen, bar);
            __builtin_amdgcn_fence(__ATOMIC_ACQUIRE, "agent");
            asm volatile("s_waitcnt vmcnt(0)" ::: "memory");
        }
    }
    __syncthreads();
}

constexpr int BK = 64, HALF = 128, HTB = HALF * BK * 2;
DEVI int lds_byte(int r, int c) { const int st = (r >> 4) * 2 + (c >> 5), rr = r & 15, cc = c & 31, ob = rr * 64 + cc * 2; return st * 1024 + (ob ^ (((ob >> 9) & 1) << 5)); }
DEVI void stage_rc(int b, int& R, int& C) { const int st = b / 1024, sb = b % 1024, swz = sb ^ (((sb >> 9) & 1) << 5); R = (st >> 1) * 16 + swz / 64; C = (st & 1) * 32 + (swz % 64) / 2; }
DEVI int perm32(int rho) { const int n = rho >> 4, i = rho & 15; return 8 * (i >> 2) + 4 * n + (i & 3); }

struct GUnit {
    const char* a; const char* b;
    char* dst; int ldd; int i0, i1, i2; float f0;
};
typedef f32x4 Acc[2][2][4][2];
#define ZA1(a, b, m) acc[a][b][m][0] = z; acc[a][b][m][1] = z;
#define ZA2(a, b) ZA1(a, b, 0) ZA1(a, b, 1) ZA1(a, b, 2) ZA1(a, b, 3)
DEVI void zero_acc(Acc& acc) { f32x4 z = {0.f, 0.f, 0.f, 0.f}; asm volatile("" : "+v"(z)); ZA2(0, 0) ZA2(0, 1) ZA2(1, 0) ZA2(1, 1) }

template <class Sched, class Epi, bool GATHER>
DEVI void gemm_stream(LAS unsigned char* lds, const Sched& S, const Epi& E) {
    const int tid = threadIdx.x, wid = __builtin_amdgcn_readfirstlane(tid >> 6), lane = tid & 63, wr = wid >> 2, wc = wid & 3, fr = lane & 15, fq = lane >> 4;
    const unsigned lda = S.lda, ldb = S.ldb; const int nt = S.nt;
    unsigned voffA[2], voffB[2]; int R0 = 0;
#pragma unroll
    for (int i = 0; i < 2; ++i) { int R, C; stage_rc(tid * 16 + i * 8192, R, C); const int Rb = (R & ~31) + perm32(R & 31);
        if (i == 0) R0 = R;
        voffA[i] = GATHER ? (unsigned)(C * 2) : (unsigned)R * lda + (unsigned)(C * 2); voffB[i] = (unsigned)Rb * ldb + (unsigned)(C * 2); }
    const size_t kstep = (size_t)(BK * 2);
    const size_t hstepA = GATHER ? (size_t)0 : (size_t)HALF * lda, hstepB = (size_t)HALF * ldb;
    const unsigned ldsw = (unsigned)wid * 1024u;
    const int aoff = lds_byte(wr * 64 + fr, fq * 8), boff = lds_byte(wc * 32 + fr, fq * 8);
#define G_SA(b, h) (((b) * 2 + (h)) * HTB)
#define G_SB(b, h) ((4 + (b) * 2 + (h)) * HTB)
#define G_STAGE(bufoff, gbase, o0, o1) do { \
        __builtin_amdgcn_global_load_lds((const unsigned*)((const char*)(gbase) + (o0)), (LAS unsigned*)(lds + (bufoff) + ldsw), 16, 0, 0); \
        __builtin_amdgcn_global_load_lds((const unsigned*)((const char*)(gbase) + (o1)), (LAS unsigned*)(lds + (bufoff) + ldsw + 8192), 16, 0, 0); } while (0)
#define G_LDA(dst, b, h) do { _Pragma("unroll") for (int m = 0; m < 4; ++m) _Pragma("unroll") for (int k = 0; k < 2; ++k) dst[m][k] = *(const LAS bf16x8*)(lds + G_SA(b, h) + aoff + m * 2048 + k * 1024); } while (0)
#define G_LDB(dst, b, h) do { _Pragma("unroll") for (int n = 0; n < 2; ++n) _Pragma("unroll") for (int k = 0; k < 2; ++k) dst[n][k] = *(const LAS bf16x8*)(lds + G_SB(b, h) + boff + n * 2048 + k * 1024); } while (0)
#define G_MMA(ai, bj, At, Bt) do { __builtin_amdgcn_s_setprio(1); \
        if constexpr (Sched::F8) { _Pragma("unroll") for (int m = 0; m < 4; ++m) _Pragma("unroll") for (int n = 0; n < 2; ++n) \
            mfma8(acc[ai][bj][m][n], cat8(Bt[n][0], Bt[n][1]), cat8(At[m][0], At[m][1])); } \
        else { _Pragma("unroll") for (int m = 0; m < 4; ++m) _Pragma("unroll") for (int n = 0; n < 2; ++n) _Pragma("unroll") for (int k = 0; k < 2; ++k) \
            acc[ai][bj][m][n] = __builtin_amdgcn_mfma_f32_16x16x32_bf16(Bt[n][k], At[m][k], acc[ai][bj][m][n], 0, 0, 0); } \
        __builtin_amdgcn_s_setprio(0); } while (0)
#define G_WAIT_V(n) asm volatile("s_waitcnt vmcnt(" #n ")" ::: "memory")
#define G_WAIT_L(n) asm volatile("s_waitcnt lgkmcnt(" #n ")" ::: "memory")
#define G_BAR __builtin_amdgcn_s_barrier()
#define G_SCHED __builtin_amdgcn_sched_barrier(0)
    GUnit cur, nxt; int ui = 0;
    if (!S.next(0, cur)) return;
    unsigned gc[2][2], gn[2][2];
    gc[0][0] = voffA[0]; gc[0][1] = voffA[1]; gc[1][0] = voffA[0]; gc[1][1] = voffA[1];
    gn[0][0] = voffA[0]; gn[0][1] = voffA[1]; gn[1][0] = voffA[0]; gn[1][1] = voffA[1];
    if constexpr (GATHER) { S.gather(cur, R0, gc); gc[0][0] += voffA[0]; gc[0][1] += voffA[0]; gc[1][0] += voffA[0]; gc[1][1] += voffA[0]; }
    Acc acc; zero_acc(acc);
    typename Epi::Pre pre; E.pre(cur, wr, lane, pre);
    bf16x8 At[4][2], B0[2][2], B1[2][2];
    const char* cA = cur.a; const char* cB = cur.b;
    G_STAGE(G_SB(0, 0), cB, voffB[0], voffB[1]); G_STAGE(G_SA(0, 0), cA, gc[0][0], gc[0][1]); G_STAGE(G_SB(0, 1), cB + hstepB, voffB[0], voffB[1]); G_STAGE(G_SA(0, 1), cA + hstepA, gc[1][0], gc[1][1]);
    if (wr == 1) G_BAR;
    G_WAIT_V(4); G_BAR;
    G_STAGE(G_SB(1, 0), cB + kstep, voffB[0], voffB[1]); G_STAGE(G_SA(1, 0), cA + kstep, gc[0][0], gc[0][1]); G_STAGE(G_SB(1, 1), cB + hstepB + kstep, voffB[0], voffB[1]);
    G_WAIT_V(6); G_BAR;
    for (;;) {
        const bool has_next = S.next(ui + 1, nxt);
        const char* nA = has_next ? nxt.a : cA; const char* nB = has_next ? nxt.b : cB;
        for (int t = 0; t < nt; t += 2) {
            const bool last = (t == nt - 2);
            const char* a1 = cA + (size_t)(t + 1) * kstep;
            const char* a2 = last ? nA : cA + (size_t)(t + 2) * kstep; const char* b2 = last ? nB : cB + (size_t)(t + 2) * kstep;
            const char* a3 = a2 + kstep; const char* b3 = b2 + kstep;
            unsigned g2[2][2];
            if constexpr (GATHER) { g2[0][0] = last ? gn[0][0] : gc[0][0]; g2[0][1] = last ? gn[0][1] : gc[0][1]; g2[1][0] = last ? gn[1][0] : gc[1][0]; g2[1][1] = last ? gn[1][1] : gc[1][1]; }
            else { g2[0][0] = voffA[0]; g2[0][1] = voffA[1]; g2[1][0] = voffA[0]; g2[1][1] = voffA[1]; }
            if constexpr (GATHER) { if (t == nt - 4) {
                if (has_next) { S.gather(nxt, R0, gn); gn[0][0] += voffA[0]; gn[0][1] += voffA[0]; gn[1][0] += voffA[0]; gn[1][1] += voffA[0]; }
                else { gn[0][0] = gc[0][0]; gn[0][1] = gc[0][1]; gn[1][0] = gc[1][0]; gn[1][1] = gc[1][1]; } } }
            if constexpr (Epi::MID_T > 0) { if (t == Epi::MID_T) { int tz = threadIdx.x; asm volatile("" : "+v"(tz)); const int wz = tz >> 6, lz = tz & 63; E.mid(acc, cur, wz >> 2, wz & 3, lz & 15, lz >> 4); } }
            G_LDB(B0, 0, 0); G_SCHED; G_LDA(At, 0, 0); G_STAGE(G_SA(1, 1), a1 + hstepA, gc[1][0], gc[1][1]);
            G_WAIT_L(8); G_BAR; G_WAIT_L(0); G_MMA(0, 0, At, B0); G_BAR; G_SCHED;
            G_LDB(B1, 0, 1); G_STAGE(G_SB(0, 0), b2, voffB[0], voffB[1]);
            G_BAR; G_WAIT_L(0); G_MMA(0, 1, At, B1); G_BAR;
            G_LDA(At, 0, 1); G_STAGE(G_SA(0, 0), a2, g2[0][0], g2[0][1]);
            G_BAR; G_WAIT_L(0); G_MMA(1, 0, At, B0); G_BAR; G_SCHED;
            G_STAGE(G_SB(0, 1), b2 + hstepB, voffB[0], voffB[1]);
            G_WAIT_V(6); G_BAR; G_MMA(1, 1, At, B1); G_BAR;
            G_LDB(B0, 1, 0); G_SCHED; G_LDA(At, 1, 0); G_STAGE(G_SA(0, 1), a2 + hstepA, g2[1][0], g2[1][1]);
            G_WAIT_L(8); G_BAR; G_WAIT_L(0); G_MMA(0, 0, At, B0); G_BAR; G_SCHED;
            G_LDB(B1, 1, 1); G_STAGE(G_SB(1, 0), b3, voffB[0], voffB[1]);
            G_BAR; G_WAIT_L(0); G_MMA(0, 1, At, B1); G_BAR;
            G_LDA(At, 1, 1); G_STAGE(G_SA(1, 0), a3, g2[0][0], g2[0][1]);
            G_BAR; G_WAIT_L(0); G_MMA(1, 0, At, B0); G_BAR; G_SCHED;
            G_STAGE(G_SB(1, 1), b3 + hstepB, voffB[0], voffB[1]);
            G_WAIT_V(6); G_BAR; G_MMA(1, 1, At, B1); G_BAR;
        }
        if constexpr (Sched::F8) asm volatile("s_nop 15\n\ts_nop 15\n\ts_nop 15" ::: "memory");
        { int tz = threadIdx.x; asm volatile("" : "+v"(tz)); const int wz = tz >> 6, lz = tz & 63; E(acc, cur, wz >> 2, wz & 3, lz & 15, lz >> 4, pre); }
        if (!has_next) break;
        zero_acc(acc);
        cur = nxt; cA = nA; cB = nB; ++ui;
        E.pre(cur, wr, lane, pre);
        if constexpr (GATHER) { gc[0][0] = gn[0][0]; gc[0][1] = gn[0][1]; gc[1][0] = gn[1][0]; gc[1][1] = gn[1][1]; }
    }
    G_WAIT_V(0);
    if (wr == 0) G_BAR;
    G_BAR;
}

struct EpiBf16 { static constexpr int MID_T = 0; DEVI void mid(Acc&, const GUnit&, int, int, int, int) const {}
    struct Pre {}; DEVI void pre(const GUnit&, int, int, Pre&) const {}
    DEVI void operator()(const Acc& acc, const GUnit& u, int wr, int wc, int fr, int fq, const Pre&) const {
        if (u.f0 < 0.f) {
            float* fb = (float*)u.dst; const float sn = -u.f0;
#pragma unroll
            for (int m = 0; m < 4; ++m) { const int row = wr * 64 + m * 16 + fr;
                if (row < 32) { float* rp = fb + (size_t)row * u.ldd + wc * 32 + 8 * fq;
#pragma unroll
                    for (int bj = 0; bj < 2; ++bj) { *(f32x4*)(rp + bj * 128) = acc[0][bj][m][0] * sn; *(f32x4*)(rp + bj * 128 + 4) = acc[0][bj][m][1] * sn; } } }
            return;
        }
        bf16_t* base = (bf16_t*)u.dst; const float s = u.f0; const int act = u.i0;
#pragma unroll
        for (int ai = 0; ai < 2; ++ai)
#pragma unroll
            for (int m = 0; m < 4; ++m) {
                bf16_t* rp = base + (size_t)(ai * 128 + wr * 64 + m * 16 + fr) * u.ldd + wc * 32 + 8 * fq;
#pragma unroll
                for (int bj = 0; bj < 2; ++bj) {
                    f32x4 v0 = acc[ai][bj][m][0] * s, v1 = acc[ai][bj][m][1] * s;
                    if (act) {
#pragma unroll
                        for (int j = 0; j < 4; ++j) { v0[j] = sigmoidf_(v0[j]); v1[j] = sigmoidf_(v1[j]); }
                    }
                    u32x4 w; w.x = pk_bf16(v0[0], v0[1]); w.y = pk_bf16(v0[2], v0[3]); w.z = pk_bf16(v1[0], v1[1]); w.w = pk_bf16(v1[2], v1[3]);
                    *(u32x4*)(rp + bj * 128) = w;
                }
            }
    }
};
struct EpiF32 { static constexpr int MID_T = 0; DEVI void mid(Acc&, const GUnit&, int, int, int, int) const {}
    struct Pre {}; DEVI void pre(const GUnit&, int, int, Pre&) const {}
    DEVI void operator()(const Acc& acc, const GUnit& u, int wr, int wc, int fr, int fq, const Pre&) const {
        float* base = (float*)u.dst;
#pragma unroll
        for (int ai = 0; ai < 2; ++ai)
#pragma unroll
            for (int m = 0; m < 4; ++m) {
                float* rp = base + (size_t)(ai * 128 + wr * 64 + m * 16 + fr) * u.ldd + wc * 32 + 8 * fq;
#pragma unroll
                for (int bj = 0; bj < 2; ++bj) { *(f32x4*)(rp + bj * 128) = acc[ai][bj][m][0]; *(f32x4*)(rp + bj * 128 + 4) = acc[ai][bj][m][1]; }
            }
    }
};
struct EpiBranchC {
    static constexpr int MID_T = 8;
    const bf16_t* sga; const bf16_t* sgb; bf16_t* ym;
    struct Pre {}; DEVI void pre(const GUnit&, int, int, Pre&) const {}
    DEVI void mid(Acc& acc, const GUnit& u, int wr, int wc, int fr, int fq) const {
#pragma unroll
        for (int ai = 0; ai < 2; ++ai)
#pragma unroll
            for (int m = 0; m < 4; ++m) {
                const size_t ro = (size_t)(u.i1 + ai * 128 + wr * 64 + m * 16 + fr) * 1024 + u.i2 + wc * 32 + 8 * fq;
#pragma unroll
                for (int bj = 0; bj < 2; ++bj) {
                    const u32x4 ga = *(const u32x4*)(sga + ro + bj * 128), gb = *(const u32x4*)(sgb + ro + bj * 128);
                    f32x4 r0, r1;
                    r0[0] = bflo(ga.x) * __builtin_amdgcn_rcpf(bflo(gb.x)); r0[1] = bfhi(ga.x) * __builtin_amdgcn_rcpf(bfhi(gb.x)); r0[2] = bflo(ga.y) * __builtin_amdgcn_rcpf(bflo(gb.y)); r0[3] = bfhi(ga.y) * __builtin_amdgcn_rcpf(bfhi(gb.y));
                    r1[0] = bflo(ga.z) * __builtin_amdgcn_rcpf(bflo(gb.z)); r1[1] = bfhi(ga.z) * __builtin_amdgcn_rcpf(bfhi(gb.z)); r1[2] = bflo(ga.w) * __builtin_amdgcn_rcpf(bflo(gb.w)); r1[3] = bfhi(ga.w) * __builtin_amdgcn_rcpf(bfhi(gb.w));
                    acc[ai][bj][m][0] = acc[ai][bj][m][0] * r0; acc[ai][bj][m][1] = acc[ai][bj][m][1] * r1;
                }
            }
    }
    DEVI void operator()(const Acc& acc, const GUnit& u, int wr, int wc, int fr, int fq, const Pre&) const {
#pragma unroll
        for (int ai = 0; ai < 2; ++ai)
#pragma unroll
            for (int m = 0; m < 4; ++m) {
                const size_t ro = (size_t)(u.i1 + ai * 128 + wr * 64 + m * 16 + fr) * 1024 + u.i2 + wc * 32 + 8 * fq;
#pragma unroll
                for (int bj = 0; bj < 2; ++bj) {
                    const u32x4 gb = *(const u32x4*)(sgb + ro + bj * 128);
                    const f32x4 v0 = acc[ai][bj][m][0], v1 = acc[ai][bj][m][1];
                    u32x4 w;
                    w.x = pk_bf16(bflo(gb.x) * v0[0], bfhi(gb.x) * v0[1]); w.y = pk_bf16(bflo(gb.y) * v0[2], bfhi(gb.y) * v0[3]);
                    w.z = pk_bf16(bflo(gb.z) * v1[0], bfhi(gb.z) * v1[1]); w.w = pk_bf16(bflo(gb.w) * v1[2], bfhi(gb.w) * v1[3]);
                    *(u32x4*)(ym + ro + bj * 128) = w;
                }
            }
    }
};
struct EpiGateUp { static constexpr int MID_T = 0; DEVI void mid(Acc&, const GUnit&, int, int, int, int) const {}
    unsigned char* hid;
    struct Pre {}; DEVI void pre(const GUnit&, int, int, Pre&) const {}
    DEVI void operator()(const Acc& acc, const GUnit& u, int wr, int wc, int fr, int fq, const Pre&) const {
#pragma unroll
        for (int ai = 0; ai < 2; ++ai)
#pragma unroll
            for (int m = 0; m < 4; ++m) {
                const int row = ai * 128 + wr * 64 + m * 16 + fr;
                if (row < u.i1) {
                    constexpr float si = 1.0f / (F8_X * F8_WGU), so = F8_H * si;
                    const f32x4 g0 = acc[ai][0][m][0] * si, g1 = acc[ai][0][m][1] * si, u0 = acc[ai][1][m][0] * so, u1 = acc[ai][1][m][1] * so;
                    float h[8];
#pragma unroll
                    for (int j = 0; j < 4; ++j) { h[j] = g0[j] * sigmoidf_(g0[j]) * u0[j]; h[4 + j] = g1[j] * sigmoidf_(g1[j]) * u1[j]; }
                    u32x2 w; w.x = pk4_fp8(h[0], h[1], h[2], h[3]); w.y = pk4_fp8(h[4], h[5], h[6], h[7]);
                    *(u32x2*)(hid + (size_t)(u.i0 + row) * 256 + u.i2 * 128 + wc * 32 + 8 * fq) = w;
                }
            }
    }
};
struct EpiDown {
    static constexpr int MID_T = 0; DEVI void mid(Acc&, const GUnit&, int, int, int, int) const {}
    unsigned char* ws;
    struct Pre {}; DEVI void pre(const GUnit&, int, int, Pre&) const {}
    DEVI void operator()(const Acc& acc, const GUnit& u, int wr, int wc, int fr, int fq, const Pre&) const {
#pragma unroll
        for (int ai = 0; ai < 2; ++ai)
#pragma unroll
            for (int m = 0; m < 4; ++m) {
                const int row = ai * 128 + wr * 64 + m * 16 + fr;
                if (row < u.i1) {
                    unsigned char* rp = (u.i2 == 0 ? ws + ws_ys(u.i0 + row) : ws + WS_Y8 + (size_t)(u.i0 + row) * 1024) + u.ldd + wc * 32 + 8 * fq;
#pragma unroll
                    for (int bj = 0; bj < 2; ++bj) {
                        constexpr float sd = F8_Y / (F8_H * F8_WD);
                        const f32x4 v0 = acc[ai][bj][m][0] * sd, v1 = acc[ai][bj][m][1] * sd;
                        u32x2 o; o.x = pk4_fp8(v0[0], v0[1], v0[2], v0[3]); o.y = pk4_fp8(v1[0], v1[1], v1[2], v1[3]);
                        *(u32x2*)(rp + bj * 128) = o;
                    }
                }
            }
    }
};

struct SchedInProj {
    unsigned char* ws; int G, c;
    static constexpr unsigned lda = 1024, ldb = 1024; static constexpr int nt = 8; static constexpr bool F8 = true;
    DEVI bool next(int i, GUnit& u) const {
        const int L = i * G + c; if (L >= 3544) return false;
        constexpr float us = 1.0f / (F8_HIN * F8_WIN);
        u.i0 = 0; u.i1 = 0; u.i2 = 0; u.f0 = us;
        const char* H = (const char*)(ws + WS_H); const char* BT = (const char*)(ws + WS_BT_IN);
        int pm, pn;
        if (L < 2592) {
            if (L < 2560) { const int x = L & 7, q = L >> 3, blk = q >> 5, w = q & 31; pm = 16 * x + 8 * (blk & 1) + (w & 7); pn = 4 * (blk >> 1) + (w >> 3); }
            else { const int j = L - 2560, jn = j >> 3; pm = 128 + (j & 7); pn = jn < 2 ? 2 + jn : 4 + jn; }
            u.a = H + (size_t)pm * 256 * 1024; u.b = BT + (size_t)pn * 256 * 1024;
            size_t base; int ld, col;
            if (pn < 2)       { base = WS_QA; ld = 512; col = pn * 256; u.f0 = 0.125f * us; }
            else if (pn < 4)  { base = WS_KA; ld = 512; col = (pn - 2) * 256; }
            else if (pn < 6)  { base = WS_QB; ld = 512; col = (pn - 4) * 256; }
            else if (pn < 8)  { base = WS_KB; ld = 512; col = (pn - 6) * 256; }
            else if (pn < 12) { base = WS_GB; ld = 1024; col = (pn - 8) * 256; }
            else if (pn < 16) { base = WS_SGA; ld = 1024; col = (pn - 12) * 256; u.i0 = 1; }
            else              { base = WS_SGB; ld = 1024; col = (pn - 16) * 256; u.i0 = 1; }
            u.dst = (char*)(ws + base) + ((size_t)pm * 256 * ld + col) * 2; u.ldd = ld;
        } else {
            const int j = L - 2592, x = j & 7, q = j >> 3, tn = 17 * x + q / 7, wm = q % 7;
            u.a = BT + (size_t)(5120 + wm * 256) * 1024; u.b = H + (size_t)tn * 256 * 1024;
            u.dst = (wm < 2 ? (char*)(ws + WS_VAT) + ((size_t)(wm * 256) * NROW + tn * 256) * 2 : (wm < 6 ? (char*)(ws + WS_VBT) + ((size_t)((wm - 2) * 256) * NROW + tn * 256) * 2 : (char*)(ws + WS_LRT) + (size_t)(tn * 256) * 4));
            u.ldd = NROW; if (wm == 6) u.f0 = -us;
        }
        return true;
    }
};
struct SchedDense {
    const char* A; const char* Bt; char* dst; int K; int G, c; unsigned lda, ldb; int nt; static constexpr bool F8 = false;
    DEVI bool next(int i, GUnit& u) const {
        const int L = i * G + c; if (L >= 512) return false;
        const int x = L & 7, q = L >> 3, blk = q >> 5, w = q & 31, pm = 16 * x + 8 * blk + (w & 7), pn = w >> 3;
        u.a = A + (size_t)pm * 256 * K * 2; u.b = Bt + (size_t)pn * 256 * K * 2;
        u.dst = dst + ((size_t)pm * 256 * 1024 + pn * 256) * 2; u.ldd = 1024; u.i0 = 0; u.i1 = pm * 256; u.i2 = pn * 256; u.f0 = 1.0f;
        return true;
    }
};
struct SchedRouter {
    unsigned char* ws; int G, c;
    static constexpr unsigned lda = 2048, ldb = 2048; static constexpr int nt = 16; static constexpr bool F8 = false;
    DEVI static int panel(int c) { return 16 * (c & 7) + (c >> 3); }
    DEVI bool next(int i, GUnit& u) const {
        if (i > 0 || c >= 128) return false;
        const int pm = panel(c);
        u.a = (const char*)(ws + WS_H2) + (size_t)pm * 256 * 2048; u.b = (const char*)(ws + WS_BT_RT);
        u.dst = (char*)(ws + WS_LOG0) + (size_t)pm * 256 * 256 * 4; u.ldd = 256; u.i0 = 0; u.i1 = 0; u.i2 = 0; u.f0 = 1.0f;
        return true;
    }
};
DEVI void moe_tables(const unsigned* gcnt, LAS int* T) {
    if (threadIdx.x < 64) {
        const int l = threadIdx.x; int c[4], t[4];
#pragma unroll
        for (int k = 0; k < 4; ++k) { c[k] = (int)gcnt[4 * l + k]; t[k] = (c[k] + 255) >> 8; }
        const int sc = c[0] + c[1] + c[2] + c[3], st = t[0] + t[1] + t[2] + t[3];
        int ic = sc, it = st;
#pragma unroll
        for (int o = 1; o < 64; o <<= 1) { const int a = __shfl_up(ic, o), b = __shfl_up(it, o); if (l >= o) { ic += a; it += b; } }
        int bc = ic - sc, bt = it - st;
#pragma unroll
        for (int k = 0; k < 4; ++k) { T[4 * l + k] = c[k]; T[256 + 4 * l + k] = bc; T[513 + 4 * l + k] = bt; bc += c[k]; bt += t[k]; }
        if (l == 63) { T[256 + 256] = ic; T[513 + 256] = it; }
    }
    __syncthreads();
    {
        const int TRt = T[513 + 256];
        for (int t = threadIdx.x; t < TRt; t += 512) { int lo = 0, hi = 256; while (hi - lo > 1) { const int mid = (lo + hi) >> 1; if (T[513 + mid] <= t) lo = mid; else hi = mid; } T[770 + t] = lo; }
    }
    __syncthreads();
}
DEVI int moe_find(const LAS int* toff, int t) {
    int lo = 0, hi = 256;
#pragma unroll 1
    while (hi - lo > 1) { const int mid = (lo + hi) >> 1; if (toff[mid] <= t) lo = mid; else hi = mid; }
    return __builtin_amdgcn_readfirstlane(lo);
}
struct SchedGateUp {
    unsigned char* ws; const LAS int* T; int G, c;
    static constexpr unsigned lda = 1024, ldb = 1024; static constexpr int nt = 8; static constexpr bool F8 = true;
    DEVI bool next(int i, GUnit& u) const {
        const int L = i * G + c; const int TR = __builtin_amdgcn_readfirstlane(T[513 + 256]);
        if (L >= 2 * TR + 256) return false;
        u.a = (const char*)(ws + WS_H2F8); u.dst = nullptr; u.ldd = 0; u.f0 = 1.0f;
        if (L < 2 * TR) {
            const int t = L >> 1, pn = L & 1, e = __builtin_amdgcn_readfirstlane(T[770 + t]), mt = t - __builtin_amdgcn_readfirstlane(T[513 + e]), cnt = __builtin_amdgcn_readfirstlane(T[e]);
            u.b = (const char*)(ws + WS_EXPGU) + ((size_t)e * 512 + pn * 256) * 1024;
            u.i0 = __builtin_amdgcn_readfirstlane(T[256 + e]) + mt * 256; u.i1 = min(256, cnt - mt * 256); u.i2 = pn;
        } else {
            const int j = L - 2 * TR, mt = j >> 1, pn = j & 1;
            u.b = (const char*)(ws + WS_BT_SHGU) + (size_t)(pn * 256) * 1024;
            u.i0 = 262144 + mt * 256; u.i1 = 256; u.i2 = pn;
        }
        return true;
    }
    DEVI void gather(const GUnit& u, int R0, unsigned (&g)[2][2]) const {
        const u32x2* slot = (const u32x2*)(ws + WS_SLOT);
#pragma unroll
        for (int h = 0; h < 2; ++h)
#pragma unroll
            for (int i = 0; i < 2; ++i) {
                const int s = u.i0 + h * 128 + R0 + 64 * i; int tok;
                if (u.i0 >= 262144) tok = s - 262144; else tok = (int)(slot[min(s, 262143)].x >> 3);
                g[h][i] = (unsigned)tok * 1024u;
            }
    }
};
struct SchedDown {
    unsigned char* ws; const LAS int* T; int G, c;
    static constexpr unsigned lda = 256, ldb = 256; static constexpr int nt = 2; static constexpr bool F8 = true;
    DEVI bool next(int i, GUnit& u) const {
        const int L = i * G + c; const int TR = __builtin_amdgcn_readfirstlane(T[513 + 256]);
        if (L >= 4 * TR + 512) return false;
        u.dst = nullptr; u.f0 = 1.0f;
        if (L < 4 * TR) {
            const int t = L >> 2, pn = L & 3, e = __builtin_amdgcn_readfirstlane(T[770 + t]), mt = t - __builtin_amdgcn_readfirstlane(T[513 + e]), cnt = __builtin_amdgcn_readfirstlane(T[e]);
            const int s0 = __builtin_amdgcn_readfirstlane(T[256 + e]) + mt * 256;
            u.a = (const char*)(ws + WS_HID) + (size_t)s0 * 256; u.b = (const char*)(ws + WS_EXPD) + ((size_t)e * 1024 + pn * 256) * 256;
            u.i0 = s0; u.i1 = min(256, cnt - mt * 256); u.i2 = 0; u.ldd = pn * 256;
        } else {
            const int j = L - 4 * TR, mt = j >> 2, pn = j & 3;
            u.a = (const char*)(ws + WS_HID) + (size_t)(262144 + mt * 256) * 256; u.b = (const char*)(ws + WS_BT_SHD) + (size_t)(pn * 256) * 256;
            u.i0 = mt * 256; u.i1 = 256; u.i2 = 1; u.ldd = pn * 256;
        }
        return true;
    }
};

DEVI void conv_tile(const float* src, int ldsrc, int ncols, bf16_t* dst, int ldd, int k0, int row0, int ilv, LAS float* t) {
    const int tid = threadIdx.x;
    f32x4 v[8];
#pragma unroll
    for (int i = 0; i < 8; ++i) { const int f = tid + 512 * i, row = f >> 6, c4 = (f & 63) * 4;
        v[i] = (c4 < ncols) ? *(const f32x4*)(src + (size_t)(k0 + row) * ldsrc + c4) : (f32x4){0.f, 0.f, 0.f, 0.f}; }
#pragma unroll
    for (int i = 0; i < 8; ++i) { const int f = tid + 512 * i, row = f >> 6, c4 = (f & 63) * 4; LAS float* q = t + row * 257 + c4; q[0] = v[i][0]; q[1] = v[i][1]; q[2] = v[i][2]; q[3] = v[i][3]; }
    __syncthreads();
#pragma unroll
    for (int j = 0; j < 4; ++j) {
        const int p = tid + 512 * j, kp = p & 7, n = p >> 3;
        if (n < ncols) {
            const LAS float* q = t + (kp * 8) * 257 + n;
            u32x4 w; w.x = pk_bf16(q[0], q[257]); w.y = pk_bf16(q[2 * 257], q[3 * 257]); w.z = pk_bf16(q[4 * 257], q[5 * 257]); w.w = pk_bf16(q[6 * 257], q[7 * 257]);
            const int drow = row0 + (ilv >= 0 ? ((n >> 7) * 256 + (n & 127) + ilv) : n);
            *(u32x4*)(dst + (size_t)drow * ldd + k0 + kp * 8) = w;
        }
    }
    __syncthreads();
}

DEVI void conv_tile8(const float* src, int ldsrc, unsigned char* dst, int ldd, int k0, int row0, int ilv, float scale, LAS float* t, int ncols = 256) {
    const int tid = threadIdx.x;
    f32x4 v[16];
#pragma unroll
    for (int i = 0; i < 16; ++i) { const int f = tid + 512 * i, row = f >> 6, c4 = (f & 63) * 4; v[i] = (c4 < ncols) ? *(const f32x4*)(src + (size_t)(k0 + row) * ldsrc + c4) : (f32x4){0.f, 0.f, 0.f, 0.f}; }
#pragma unroll
    for (int i = 0; i < 16; ++i) { const int f = tid + 512 * i, row = f >> 6, c4 = (f & 63) * 4; LAS float* q = t + row * 257 + c4; q[0] = v[i][0] * scale; q[1] = v[i][1] * scale; q[2] = v[i][2] * scale; q[3] = v[i][3] * scale; }
    __syncthreads();
#pragma unroll
    for (int j = 0; j < 4; ++j) {
        const int p = tid + 512 * j, kp = p & 7, n = p >> 3;
        if (n >= ncols) continue;
        const LAS float* q = t + (kp * 16) * 257 + n;
        u32x4 w;
        w.x = pk4_fp8(q[0], q[257], q[2 * 257], q[3 * 257]);             w.y = pk4_fp8(q[4 * 257], q[5 * 257], q[6 * 257], q[7 * 257]);
        w.z = pk4_fp8(q[8 * 257], q[9 * 257], q[10 * 257], q[11 * 257]); w.w = pk4_fp8(q[12 * 257], q[13 * 257], q[14 * 257], q[15 * 257]);
        const int drow = row0 + (ilv >= 0 ? ((n >> 7) * 256 + (n & 127) + ilv) : n);
        *(u32x4*)(dst + (size_t)drow * ldd + k0 + kp * 16) = w;
    }
    __syncthreads();
}

DEVI void phase0(const Params& p, LAS unsigned char* lds, int part) {
    const int tid = threadIdx.x, lane = tid & 63, wid = tid >> 6;
    unsigned char* ws = p.ws;
    const int NT_IN = 8 * (2 + 2 + 2 + 2 + 4 + 4 + 4 + 2 + 4 + 1);
    const int NT0 = NT_IN + 8 * 4 + 16 * 4 + 16 * 4 + 16 + 8 + 8 + 8;
    for (int u = (part == 0 ? (int)blockIdx.x : 192 + (int)blockIdx.x); u < (part == 0 ? 192 : 192 + NT0); u += gridDim.x) {
        if (u < 192) {
            LAS float* sc = (LAS float*)lds; LAS float* red = (LAS float*)(lds + 9 * 1024 * 4);
            for (int i = tid; i < 9216; i += 512) { const int r = i >> 10, k = i & 1023; const float v = r < 8 ? p.in[1][r * 1024 + k] : p.in[3][k]; sc[i] = v / (1.0f + __expf(-v)); }
            __syncthreads();
            const int n0 = u * 32, col = lane & 31, rsub = lane >> 5;
            float acc[9];
#pragma unroll
            for (int r = 0; r < 9; ++r) acc[r] = 0.f;
            for (int it = 0; it < 64; ++it) { const int k = it * 16 + wid * 2 + rsub; const float w = p.in[4][(size_t)k * 6144 + n0 + col];
#pragma unroll
                for (int r = 0; r < 9; ++r) acc[r] += sc[r * 1024 + k] * w; }
#pragma unroll
            for (int r = 0; r < 9; ++r) red[((wid * 2 + rsub) * 9 + r) * 32 + col] = acc[r];
            __syncthreads();
            if (tid < 288) { const int r = tid >> 5, cc = tid & 31; float s = 0.f; for (int g = 0; g < 16; ++g) s += red[(g * 9 + r) * 32 + cc];
                ((float*)(ws + WS_MOD))[r * 6144 + n0 + cc] = s + p.in[5][n0 + cc]; }
            __syncthreads();
        } else {
            int t = u - 192; LAS float* tb = (LAS float*)lds;
            if (t < NT_IN) {
                const int kt = t & 7; int jb = t >> 3;
                int c0, r0, nc = 256;
                if (jb < 2)       { c0 = 0 + jb * 256;             r0 = 0 + jb * 256; }
                else if (jb < 4)  { c0 = 512 + (jb - 2) * 256;     r0 = 512 + (jb - 2) * 256; }
                else if (jb < 6)  { c0 = 1536 + (jb - 4) * 256;    r0 = 1024 + (jb - 4) * 256; }
                else if (jb < 8)  { c0 = 2048 + (jb - 6) * 256;    r0 = 1536 + (jb - 6) * 256; }
                else if (jb < 12) { c0 = 3584 + (jb - 8) * 256;    r0 = 2048 + (jb - 8) * 256; }
                else if (jb < 16) { c0 = 4640 + (jb - 12) * 256;   r0 = 3072 + (jb - 12) * 256; }
                else if (jb < 20) { c0 = 5664 + (jb - 16) * 256;   r0 = 4096 + (jb - 16) * 256; }
                else if (jb < 22) { c0 = 1024 + (jb - 20) * 256;   r0 = 5120 + (jb - 20) * 256; }
                else if (jb < 26) { c0 = 2560 + (jb - 22) * 256;   r0 = 5632 + (jb - 22) * 256; }
                else              { c0 = 4608; r0 = 6656; nc = 32; }
                conv_tile8(p.in[6] + c0, 6688, ws + WS_BT_IN, 1024, kt * 128, r0, -1, F8_WIN, tb, nc);
            } else {
                t -= NT_IN;
                if (t < 32)        { const int kt = t & 7, nb = t >> 3;  conv_tile(p.in[13] + nb * 256, 1024, 256, (bf16_t*)(ws + WS_BT_BR), 1536, kt * 64, nb * 256, -1, tb); }
                else if (t < 96)   { t -= 32; const int kt = t & 15, nb = t >> 4; conv_tile(p.in[14] + nb * 256, 1024, 256, (bf16_t*)(ws + WS_BT_BR) + 512, 1536, kt * 64, nb * 256, -1, tb); }
                else if (t < 160)  { t -= 96; const int kt = t & 15, nb = t >> 4; conv_tile(p.in[15] + nb * 256, 1024, 256, (bf16_t*)(ws + WS_BT_OUT), 1024, kt * 64, nb * 256, -1, tb); }
                else if (t < 176)  { t -= 160; conv_tile(p.in[18], 256, 256, (bf16_t*)(ws + WS_BT_RT), 1024, t * 64, 0, -1, tb); }
                else if (t < 184)  { t -= 176; conv_tile8(p.in[23], 256, ws + WS_BT_SHGU, 1024, t * 128, 0, 0, F8_WGU, tb); }
                else if (t < 192)  { t -= 184; conv_tile8(p.in[24], 256, ws + WS_BT_SHGU, 1024, t * 128, 0, 128, F8_WGU, tb); }
                else               { t -= 192; const int kt = t & 1, nb = t >> 1; conv_tile8(p.in[25] + nb * 256, 1024, ws + WS_BT_SHD, 256, kt * 128, nb * 256, -1, F8_WD, tb); }
            }
        }
    }
}

DEVI void phase1(const Params& p) {
    const float* mod = (const float*)(p.ws + WS_MOD); unsigned char* H = p.ws + WS_H;
    for (size_t idx = (size_t)blockIdx.x * 512 + threadIdx.x; idx < (size_t)NROW * 128; idx += (size_t)gridDim.x * 512) {
        const int row = (int)(idx >> 7), k = (int)(idx & 127) * 8;
        const float* src = row < NTOK ? p.in[0] + (size_t)row * 1024 + k : p.in[2] + (size_t)(row - NTOK) * 1024 + k;
        const float* m = mod + (size_t)(row < NTOK ? (row >> 12) : 8) * 6144 + k;
        const f32x4 x0 = *(const f32x4*)src, x1 = *(const f32x4*)(src + 4), h0 = *(const f32x4*)m, h1 = *(const f32x4*)(m + 4), s0 = *(const f32x4*)(m + 1024), s1 = *(const f32x4*)(m + 1028);
        const f32x4 y0 = x0 * (s0 + 1.0f) + h0, y1 = x1 * (s1 + 1.0f) + h1;
        u32x2 w; w.x = pk4_fp8(y0[0] * F8_HIN, y0[1] * F8_HIN, y0[2] * F8_HIN, y0[3] * F8_HIN); w.y = pk4_fp8(y1[0] * F8_HIN, y1[1] * F8_HIN, y1[2] * F8_HIN, y1[3] * F8_HIN);
        *(u32x2*)(H + (size_t)row * 1024 + k) = w;
    }
}

DEVI float logsig16(float z) { return -(fmaxf(-z, 0.f) + __logf(1.0f + __expf(-fabsf(z)))) * 0.0625f; }
DEVI void phase3(const Params& p, LAS unsigned char* lds) {
    const int tid = threadIdx.x;
    unsigned char* ws = p.ws;
    LAS float* LRs = (LAS float*)lds;
    LAS float* CS = (LAS float*)(lds + 8192);
    LAS float* CUM = (LAS float*)(lds + 24576);
    LAS float* TOT = (LAS float*)(lds + 24576 + 65536);
    LAS bf16_t* KTs = (LAS bf16_t*)(lds + 24576 + 65536 + 2048);
    for (int i = tid; i < 2048; i += 512) { const int pos = i >> 5, j = i & 31; const float ang = (float)pos * powf(10000.0f, -(float)j / 32.0f); CS[2 * i] = cosf(ang); CS[2 * i + 1] = sinf(ang); }
    __syncthreads();
    const float* LRT = (const float*)(ws + WS_LRT);
    const bf16_t* QB = (const bf16_t*)(ws + WS_QB); const bf16_t* KB = (const bf16_t*)(ws + WS_KB);
    bf16_t* QTF = (bf16_t*)(ws + WS_QTF); bf16_t* QTB = (bf16_t*)(ws + WS_QTB); bf16_t* KTF = (bf16_t*)(ws + WS_KTF); bf16_t* KTB = (bf16_t*)(ws + WS_KTB);
    float* EE = (float*)(ws + WS_EE);
    for (int u = blockIdx.x; u < 8 * 68 * 4; u += gridDim.x) {
        const int h = u & 3, bs = u >> 2, b = bs / 68, slot = bs % 68; const bool isctx = slot < 4; const int chunk = slot - 4;
        const int rowbase = isctx ? NTOK + b * 256 + slot * 64 : b * 4096 + chunk * 64;
        { const int r = tid >> 4, c4 = (tid & 15) * 4; const f32x4 lv = *(const f32x4*)(LRT + (size_t)r * NROW + rowbase + c4);
          LRs[(c4 + 0) * 32 + r] = lv[0]; LRs[(c4 + 1) * 32 + r] = lv[1]; LRs[(c4 + 2) * 32 + r] = lv[2]; LRs[(c4 + 3) * 32 + r] = lv[3]; }
        __syncthreads();
        {
            const int ch = tid & 127, grp = tid >> 7, dir = grp & 1, hf = grp >> 1;
            const float* w2p = p.in[dir ? 10 : 8] + h * 128 + ch; const float b2 = p.in[dir ? 11 : 9][h * 128 + ch];
            float w2[16];
#pragma unroll
            for (int r = 0; r < 16; ++r) w2[r] = w2p[r * 512];
            float run = 0.f;
            for (int k = 0; k < 32; ++k) {
                const int i = dir ? (32 * hf + 31 - k) : (32 * hf + k);
                const LAS f32x4* lp = (const LAS f32x4*)(LRs + i * 32 + 16 * dir);
                const f32x4 l0 = lp[0], l1 = lp[1], l2 = lp[2], l3 = lp[3];
                const float z0 = (l0[0] * w2[0] + l0[1] * w2[1]) + (l0[2] * w2[2] + l0[3] * w2[3]), z1 = (l1[0] * w2[4] + l1[1] * w2[5]) + (l1[2] * w2[6] + l1[3] * w2[7]);
                const float z2 = (l2[0] * w2[8] + l2[1] * w2[9]) + (l2[2] * w2[10] + l2[3] * w2[11]), z3 = (l3[0] * w2[12] + l3[1] * w2[13]) + (l3[2] * w2[14] + l3[3] * w2[15]);
                const float z = b2 + ((z0 + z1) + (z2 + z3));
                run += logsig16(z);
                CUM[(dir * 64 + i) * 128 + ch] = run;
            }
            TOT[(dir * 2 + hf) * 128 + ch] = run;
        }
        __syncthreads();
#pragma unroll
        for (int rep = 0; rep < 2; ++rep) {
            const int q = tid + 512 * rep, i = q >> 4, c8 = q & 15, ch0 = c8 * 8;
            float cf[8], cb[8];
            {
                const f32x4 a0 = *(const LAS f32x4*)(CUM + (0 * 64 + i) * 128 + ch0), a1 = *(const LAS f32x4*)(CUM + (0 * 64 + i) * 128 + ch0 + 4);
                const f32x4 b0 = *(const LAS f32x4*)(CUM + (1 * 64 + i) * 128 + ch0), b1 = *(const LAS f32x4*)(CUM + (1 * 64 + i) * 128 + ch0 + 4);
                f32x4 tf0 = {0.f, 0.f, 0.f, 0.f}, tf1 = tf0, tb0 = tf0, tb1 = tf0;
                if (i >= 32) { tf0 = *(const LAS f32x4*)(TOT + (0 * 2 + 0) * 128 + ch0); tf1 = *(const LAS f32x4*)(TOT + (0 * 2 + 0) * 128 + ch0 + 4); }
                else         { tb0 = *(const LAS f32x4*)(TOT + (1 * 2 + 1) * 128 + ch0); tb1 = *(const LAS f32x4*)(TOT + (1 * 2 + 1) * 128 + ch0 + 4); }
#pragma unroll
                for (int e = 0; e < 4; ++e) { cf[e] = a0[e] + tf0[e]; cf[4 + e] = a1[e] + tf1[e]; cb[e] = b0[e] + tb0[e]; cb[4 + e] = b1[e] + tb1[e]; }
            }
            const size_t go = (size_t)(rowbase + i) * 512 + h * 128 + ch0;
            const u32x4 kraw = *(const u32x4*)(KB + go);
            float kv[8] = {bflo(kraw.x), bfhi(kraw.x), bflo(kraw.y), bfhi(kraw.y), bflo(kraw.z), bfhi(kraw.z), bflo(kraw.w), bfhi(kraw.w)};
            float ef[8], eb[8];
#pragma unroll
            for (int e = 0; e < 8; ++e) { ef[e] = __expf(cf[e]); eb[e] = __expf(cb[e]); }
            if (!isctx) {
                const size_t gp = (size_t)(rowbase + i) * 512 + h * 128 + ((c8 ^ 4) * 8);
                const u32x4 kpr = *(const u32x4*)(KB + gp), qraw = *(const u32x4*)(QB + go), qpr = *(const u32x4*)(QB + gp);
                const float kp[8] = {bflo(kpr.x), bfhi(kpr.x), bflo(kpr.y), bfhi(kpr.y), bflo(kpr.z), bfhi(kpr.z), bflo(kpr.w), bfhi(kpr.w)};
                const float qv[8] = {bflo(qraw.x), bfhi(qraw.x), bflo(qraw.y), bfhi(qraw.y), bflo(qraw.z), bfhi(qraw.z), bflo(qraw.w), bfhi(qraw.w)};
                const float qp[8] = {bflo(qpr.x), bfhi(qpr.x), bflo(qpr.y), bfhi(qpr.y), bflo(qpr.z), bfhi(qpr.z), bflo(qpr.w), bfhi(qpr.w)};
                const int half = c8 >> 3, isx2 = (c8 >> 2) & 1, j0 = (c8 & 3) * 8, pos = half ? i : chunk;
                float qf[8], qb[8];
                const LAS f32x4* cp = (const LAS f32x4*)(CS + (pos * 32 + j0) * 2); const f32x4 c0 = cp[0], c1 = cp[1], c2 = cp[2], c3 = cp[3];
                const float csv[8] = {c0[0], c0[2], c1[0], c1[2], c2[0], c2[2], c3[0], c3[2]}, snv[8] = {c0[1], c0[3], c1[1], c1[3], c2[1], c2[3], c3[1], c3[3]};
#pragma unroll
                for (int e = 0; e < 8; ++e) {
                    const float cs = csv[e], sn = snv[e];
                    const float rq = isx2 ? qv[e] * cs + qp[e] * sn : qv[e] * cs - qp[e] * sn;
                    kv[e] = isx2 ? kv[e] * cs + kp[e] * sn : kv[e] * cs - kp[e] * sn;
                    qf[e] = rq * 0.08838834764831845f * ef[e]; qb[e] = rq * 0.08838834764831845f * eb[e];
                }
                u32x4 wq; wq.x = pk_bf16(qf[0], qf[1]); wq.y = pk_bf16(qf[2], qf[3]); wq.z = pk_bf16(qf[4], qf[5]); wq.w = pk_bf16(qf[6], qf[7]); *(u32x4*)(QTF + go) = wq;
                wq.x = pk_bf16(qb[0], qb[1]); wq.y = pk_bf16(qb[2], qb[3]); wq.z = pk_bf16(qb[4], qb[5]); wq.w = pk_bf16(qb[6], qb[7]); *(u32x4*)(QTB + go) = wq;
            }
            float kf[8], kb[8];
#pragma unroll
            for (int e = 0; e < 8; ++e) { kf[e] = kv[e] * __builtin_amdgcn_rcpf(ef[e]); kb[e] = kv[e] * __builtin_amdgcn_rcpf(eb[e]); }
            u32x4 wf; wf.x = pk_bf16(kf[0], kf[1]); wf.y = pk_bf16(kf[2], kf[3]); wf.z = pk_bf16(kf[4], kf[5]); wf.w = pk_bf16(kf[6], kf[7]);
            u32x4 wb; wb.x = pk_bf16(kb[0], kb[1]); wb.y = pk_bf16(kb[2], kb[3]); wb.z = pk_bf16(kb[4], kb[5]); wb.w = pk_bf16(kb[6], kb[7]);
            *(u32x4*)(KTF + go) = wf; *(u32x4*)(KTB + go) = wb;
            *(LAS u32x4*)(KTs + (0 * 64 + i) * 136 + ch0) = wf; *(LAS u32x4*)(KTs + (1 * 64 + i) * 136 + ch0) = wb;
            if (i == 63) { float* ep = EE + ((size_t)(0 * 8 + b) * 68 + slot) * 512 + h * 128 + ch0; *(f32x4*)ep = (f32x4){ef[0], ef[1], ef[2], ef[3]}; *(f32x4*)(ep + 4) = (f32x4){ef[4], ef[5], ef[6], ef[7]}; }
            if (i == 0)  { float* ep = EE + ((size_t)(1 * 8 + b) * 68 + slot) * 512 + h * 128 + ch0; *(f32x4*)ep = (f32x4){eb[0], eb[1], eb[2], eb[3]}; *(f32x4*)(ep + 4) = (f32x4){eb[4], eb[5], eb[6], eb[7]}; }
        }
        __syncthreads();
#pragma unroll
        for (int rep = 0; rep < 4; ++rep) {
            const int q = tid + 512 * rep, ch = q & 127, t8 = (q >> 7) & 7, dir = q >> 10;
            const LAS bf16_t* sp = KTs + (dir * 64 + t8 * 8) * 136 + ch;
            u32x4 wv; wv.x = (unsigned)sp[0] | ((unsigned)sp[136] << 16); wv.y = (unsigned)sp[2 * 136] | ((unsigned)sp[3 * 136] << 16); wv.z = (unsigned)sp[4 * 136] | ((unsigned)sp[5 * 136] << 16); wv.w = (unsigned)sp[6 * 136] | ((unsigned)sp[7 * 136] << 16);
            *(u32x4*)((bf16_t*)(ws + (dir ? WS_KTTB : WS_KTTF)) + (size_t)(h * 128 + ch) * NROW + rowbase + t8 * 8) = wv;
        }
        __syncthreads();
    }
}

DEVI int gla_slot(int dir, int n) { return dir == 0 ? n : (n < 4 ? 3 - n : 71 - n); }
DEVI int gla_rowbase(int b, int slot) { return slot >= 4 ? b * 4096 + (slot - 4) * 64 : NTOK + b * 256 + slot * 64; }
DEVI void phase4_gla(const Params& p, LAS unsigned char* lds) {
    const int tid = threadIdx.x, lane = tid & 63, w = tid >> 6, l15 = lane & 15, fq = lane >> 4;
    unsigned char* ws = p.ws;
    LAS unsigned char* TQ = lds;
    LAS unsigned char* TK = lds + 32768;
    LAS unsigned char* TV = lds + 65536;
    LAS bf16_t* PM = (LAS bf16_t*)(lds + 81920);
    LAS bf16_t* SB = (LAS bf16_t*)(lds + 81920 + 9216);
    const bf16_t* VBT = (const bf16_t*)(ws + WS_VBT);
    const float* EE = (const float*)(ws + WS_EE);
    const int qr0 = tid >> 4, qp = tid & 15, vr = tid >> 3, vp = tid & 7;
    const int qoff0 = qr0 * 256 + ((qp ^ (qr0 & 15)) << 4), qoff1 = (qr0 + 32) * 256 + ((qp ^ ((qr0 + 32) & 15)) << 4);
    const int voff = vr * 128 + ((vp ^ ((vr >> 1) & 7)) << 4);
    struct PSet { u32x4 q0, q1, k0, k1, v; };
    struct KSet { bf16x8 a, b; f32x4 e; };
    for (int u = blockIdx.x; u < 256; u += gridDim.x) {
        const int xg = u & 7, kg = u >> 3, g = xg * 8 + (kg >> 2), dvq = kg & 3, dir = g & 1, h = (g >> 1) & 3, b = g >> 3;
        const bf16_t* QT = (const bf16_t*)(ws + (dir ? WS_QTB : WS_QTF)); const bf16_t* KT = (const bf16_t*)(ws + (dir ? WS_KTB : WS_KTF)); const bf16_t* KTT = (const bf16_t*)(ws + (dir ? WS_KTTB : WS_KTTF));
        bf16_t* OUT = (bf16_t*)(ws + (dir ? WS_OB : WS_OF));
        const int vrow0 = h * 256 + dvq * 64, krow0 = h * 128, kcol0 = h * 128;
        const float* EEu = EE + (size_t)(dir * 8 + b) * 68 * 512 + h * 128 + 16 * w + 4 * fq;
        const bf16_t* vsrc = VBT + (size_t)(vrow0 + vr) * NROW + vp * 8;
        const bf16_t* ktsrc = KTT + (size_t)(krow0 + 16 * w + l15) * NROW + 8 * fq;
        const size_t qsrc = (size_t)qr0 * 512 + kcol0 + qp * 8;
        f32x4 S[4];
#pragma unroll
        for (int i = 0; i < 4; ++i) S[i] = (f32x4){0.f, 0.f, 0.f, 0.f};
        PSet P0, P1; KSet K0, K1;
        P0.q0 = P0.q1 = P0.k0 = P0.k1 = P0.v = (u32x4){0u, 0u, 0u, 0u}; P1 = P0;
        auto load_p = [&](PSet& P, int n) {
            const int slot = gla_slot(dir, n), rb = gla_rowbase(b, slot);
            P.v = *(const u32x4*)(vsrc + rb);
            if (slot >= 4) { P.q0 = *(const u32x4*)(QT + (size_t)rb * 512 + qsrc); P.q1 = *(const u32x4*)(QT + (size_t)(rb + 32) * 512 + qsrc);
                             P.k0 = *(const u32x4*)(KT + (size_t)rb * 512 + qsrc); P.k1 = *(const u32x4*)(KT + (size_t)(rb + 32) * 512 + qsrc); }
        };
        auto store_p = [&](const PSet& P, int n) {
            const int slot = gla_slot(dir, n), bufo = n & 1;
            *(LAS u32x4*)(TV + bufo * 8192 + voff) = P.v;
            if (slot >= 4) { *(LAS u32x4*)(TQ + bufo * 16384 + qoff0) = P.q0; *(LAS u32x4*)(TQ + bufo * 16384 + qoff1) = P.q1; *(LAS u32x4*)(TK + bufo * 16384 + qoff0) = P.k0; *(LAS u32x4*)(TK + bufo * 16384 + qoff1) = P.k1; }
        };
        auto load_k = [&](KSet& K, int n) {
            const int slot = gla_slot(dir, n), rb = gla_rowbase(b, slot);
            K.a = *(const bf16x8*)(ktsrc + rb); K.b = *(const bf16x8*)(ktsrc + rb + 32); K.e = *(const f32x4*)(EEu + (size_t)slot * 512);
        };
        load_p(P0, 0); load_k(K0, 0); load_k(K1, 1); load_p(P1, 1);
        __syncthreads();
        store_p(P0, 0);
        auto step = [&](int n, PSet& Pload, const PSet& Pstore, KSet& K) {
            const int slot = gla_slot(dir, n); const bool lat = slot >= 4; const int rowbase = gla_rowbase(b, slot);
            const int cur = n & 1, nxt = cur ^ 1;
            LAS unsigned char* tq = TQ + cur * 16384; LAS unsigned char* tk = TK + cur * 16384; LAS unsigned char* tv = TV + cur * 8192;
            LAS bf16_t* sbc = SB + cur * 64 * 136; LAS bf16_t* sbn = SB + nxt * 64 * 136;
            lds_barrier();
            if (n + 2 < 68) load_p(Pload, n + 2);
            if (lat) {
                const int jt = w >> 1, it0 = 2 * (w & 1);
                f32x4 c0 = {0.f, 0.f, 0.f, 0.f}, c1 = {0.f, 0.f, 0.f, 0.f};
                const int rj = 16 * jt + l15, ri0 = 16 * it0 + l15, ri1 = ri0 + 16;
                bf16x8 fa[4], fb0[4], fb1[4];
#pragma unroll
                for (int ks = 0; ks < 4; ++ks) { const int pc = 4 * ks + fq;
                    fa[ks] = *(const LAS bf16x8*)(tk + rj * 256 + ((pc ^ l15) << 4)); fb0[ks] = *(const LAS bf16x8*)(tq + ri0 * 256 + ((pc ^ l15) << 4)); fb1[ks] = *(const LAS bf16x8*)(tq + ri1 * 256 + ((pc ^ l15) << 4)); }
                __builtin_amdgcn_sched_barrier(0);
#pragma unroll
                for (int ks = 0; ks < 4; ++ks) { c0 = __builtin_amdgcn_mfma_f32_16x16x32_bf16(fa[ks], fb0[ks], c0, 0, 0, 0); c1 = __builtin_amdgcn_mfma_f32_16x16x32_bf16(fa[ks], fb1[ks], c1, 0, 0, 0); }
#pragma unroll
                for (int r = 0; r < 4; ++r) { const int j = 16 * jt + 4 * fq + r;
                    const bool k0 = dir == 0 ? (j <= ri0) : (j >= ri0), k1 = dir == 0 ? (j <= ri1) : (j >= ri1);
                    c0[r] = k0 ? c0[r] : 0.f; c1[r] = k1 ? c1[r] : 0.f; }
                u32x2 w0; w0.x = pk_bf16(c0[0], c0[1]); w0.y = pk_bf16(c0[2], c0[3]); u32x2 w1; w1.x = pk_bf16(c1[0], c1[1]); w1.y = pk_bf16(c1[2], c1[3]);
                *(LAS u32x2*)(PM + ri0 * 72 + 16 * jt + 4 * fq) = w0; *(LAS u32x2*)(PM + ri1 * 72 + 16 * jt + 4 * fq) = w1;
            }
            lds_barrier();
            bf16x8 V[4][2];
#pragma unroll
            for (int dvt = 0; dvt < 4; ++dvt)
#pragma unroll
                for (int ks = 0; ks < 2; ++ks) { const int row = 16 * dvt + l15, pc = 4 * ks + fq; V[dvt][ks] = *(const LAS bf16x8*)(tv + row * 128 + ((pc ^ ((row >> 1) & 7)) << 4)); }
            __builtin_amdgcn_sched_barrier(0);
            if (lat) {
                const int it = w >> 1, dv0 = 2 * (w & 1), ri = 16 * it + l15;
                f32x4 o0 = {0.f, 0.f, 0.f, 0.f}, o1 = {0.f, 0.f, 0.f, 0.f};
                bf16x8 pB[2], pA0[2], pA1[2], sA0[4], sA1[4], sB[4];
                const LAS bf16_t* s0 = sbc + (16 * dv0 + l15) * 136 + 8 * fq; const LAS bf16_t* s1 = s0 + 16 * 136;
#pragma unroll
                for (int ks = 0; ks < 2; ++ks) { pB[ks] = *(const LAS bf16x8*)(PM + ri * 72 + 32 * ks + 8 * fq);
                    const int r0 = 16 * dv0 + l15, r1 = r0 + 16, pc = 4 * ks + fq;
                    pA0[ks] = *(const LAS bf16x8*)(tv + r0 * 128 + ((pc ^ ((r0 >> 1) & 7)) << 4)); pA1[ks] = *(const LAS bf16x8*)(tv + r1 * 128 + ((pc ^ ((r1 >> 1) & 7)) << 4)); }
#pragma unroll
                for (int ks = 0; ks < 4; ++ks) { const int pc = 4 * ks + fq;
                    sA0[ks] = *(const LAS bf16x8*)(s0 + 32 * ks); sA1[ks] = *(const LAS bf16x8*)(s1 + 32 * ks); sB[ks] = *(const LAS bf16x8*)(tq + ri * 256 + ((pc ^ l15) << 4)); }
                __builtin_amdgcn_sched_barrier(0);
#pragma unroll
                for (int ks = 0; ks < 2; ++ks) { o0 = __builtin_amdgcn_mfma_f32_16x16x32_bf16(pA0[ks], pB[ks], o0, 0, 0, 0); o1 = __builtin_amdgcn_mfma_f32_16x16x32_bf16(pA1[ks], pB[ks], o1, 0, 0, 0); }
#pragma unroll
                for (int ks = 0; ks < 4; ++ks) { o0 = __builtin_amdgcn_mfma_f32_16x16x32_bf16(sA0[ks], sB[ks], o0, 0, 0, 0); o1 = __builtin_amdgcn_mfma_f32_16x16x32_bf16(sA1[ks], sB[ks], o1, 0, 0, 0); }
                bf16_t* op = OUT + (size_t)(rowbase + ri) * 1024 + vrow0 + 16 * dv0 + 4 * fq;
                u32x2 w0; w0.x = pk_bf16(o0[0], o0[1]); w0.y = pk_bf16(o0[2], o0[3]); u32x2 w1; w1.x = pk_bf16(o1[0], o1[1]); w1.y = pk_bf16(o1[2], o1[3]);
                *(u32x2*)op = w0; *(u32x2*)(op + 16) = w1;
            }
#pragma unroll
            for (int dvt = 0; dvt < 4; ++dvt) { S[dvt] = __builtin_amdgcn_mfma_f32_16x16x32_bf16(K.a, V[dvt][0], S[dvt], 0, 0, 0); S[dvt] = __builtin_amdgcn_mfma_f32_16x16x32_bf16(K.b, V[dvt][1], S[dvt], 0, 0, 0); }
#pragma unroll
            for (int dvt = 0; dvt < 4; ++dvt) { S[dvt] = S[dvt] * K.e;
                u32x2 o; o.x = pk_bf16(S[dvt][0], S[dvt][1]); o.y = pk_bf16(S[dvt][2], S[dvt][3]);
                *(LAS u32x2*)(sbn + (16 * dvt + l15) * 136 + 16 * w + 4 * fq) = o; }
            if (n + 2 < 68) load_k(K, n + 2);
            if (n + 1 < 68) store_p(Pstore, n + 1);
        };
#pragma unroll 1
        for (int n = 0; n < 68; n += 2) { step(n, P0, P1, K0); step(n + 1, P1, P0, K1); }
        __syncthreads();
    }
}

DEVI void phase4_na(const Params& p, LAS unsigned char* lds) {
    const int tid = threadIdx.x; const int wsg = __builtin_amdgcn_readfirstlane(tid >> 6);
    unsigned char* ws = p.ws;
    LAS unsigned char* CK = lds;
    LAS unsigned char* CV = lds + 32768;
    LAS float* RP = (LAS float*)(lds + 65536);
    const bf16_t* QA = (const bf16_t*)(ws + WS_QA); const bf16_t* KA = (const bf16_t*)(ws + WS_KA); const bf16_t* VAT = (const bf16_t*)(ws + WS_VAT);
    bf16_t* OA = (bf16_t*)(ws + WS_AP);
    for (int u = blockIdx.x; u < 512; u += gridDim.x) {
        const int xg = u & 7, idx = u >> 3, bh = xg * 8 + (idx >> 3), rblk = idx & 7, h = bh & 7, b = bh >> 3;
        __syncthreads();
        for (int i = tid; i < 465; i += 512) RP[(i / 31) * 80 + 24 + (i % 31)] = p.in[7][h * 465 + i];
        int tz = tid; asm volatile("" : "+v"(tz));
#pragma unroll
        for (int rep = 0; rep < 4; ++rep) {
            const int q = tz + 512 * rep;
            { const int row = q >> 3, pc = q & 7; *(LAS u32x4*)(CK + row * 128 + ((pc ^ ((row >> 1) & 7)) << 4)) = *(const u32x4*)(KA + (size_t)(NTOK + b * 256 + row) * 512 + h * 64 + pc * 8); }
            { const int row = q >> 5, pc = q & 31; const u32x4 v = *(const u32x4*)(VAT + (size_t)(h * 64 + row) * NROW + NTOK + b * 256 + pc * 8);
              const int sw = (row & 15) << 1; u32x2 lo; lo.x = v.x; lo.y = v.y; u32x2 hi; hi.x = v.z; hi.y = v.w;
              *(LAS u32x2*)(CV + row * 512 + (((2 * pc) ^ sw) << 3)) = lo; *(LAS u32x2*)(CV + row * 512 + (((2 * pc + 1) ^ sw) << 3)) = hi; }
        }
        __syncthreads();
#pragma unroll 1
        for (int qt = 0; qt < 4; ++qt) {
            int lane = (int)__builtin_amdgcn_mbcnt_hi(~0u, __builtin_amdgcn_mbcnt_lo(~0u, 0u)); asm volatile("" : "+v"(lane));
            const int w = wsg, l15 = lane & 15, fq = lane >> 4, r = rblk * 8 + w, rs = min(max(r - 4, 0), 56);
            const int kc0 = min(max(16 * qt - 8, 0), 32);
            const int c = 16 * qt + l15, cs = min(max(c - 8, 0), 48);
            const bf16_t* qp = QA + (size_t)(b * 4096 + r * 64 + c) * 512 + h * 64 + 8 * fq;
            const bf16x8 Bq0 = *(const bf16x8*)qp, Bq1 = *(const bf16x8*)(qp + 32);
            const int lo = 15 + cs - c, d00 = kc0 - 16 * qt + 4 * fq - l15 + 15;
            const LAS unsigned char* rpl = (const LAS unsigned char*)RP + ((rs - r + 7) * 80 + 24 + d00) * 4;
            const char* kbase = (const char*)(KA + (size_t)(b * 4096 + rs * 64 + kc0) * 512 + h * 64); const unsigned klane = (unsigned)(l15 * 512 + 8 * fq) * 2u;
            const char* vbase = (const char*)(VAT + (size_t)(h * 64) * NROW + b * 4096 + rs * 64 + kc0); const unsigned vlane = (unsigned)(l15 * NROW + 4 * fq) * 2u;
#define NA_SB __builtin_amdgcn_sched_barrier(0)
            f32x4 sc[16];
#pragma unroll
            for (int hb = 0; hb < 4; ++hb) {
                bf16x8 kf[4][2];
#pragma unroll
                for (int tt = 0; tt < 4; ++tt) { const int t = 4 * hb + tt, kr = t >> 1, chh = t & 1; const char* kp = (kbase + (size_t)((kr * 64 + 16 * chh) * 1024)) + klane;
                    kf[tt][0] = *(const bf16x8*)kp; kf[tt][1] = *(const bf16x8*)(kp + 64); }
                NA_SB;
#pragma unroll
                for (int tt = 0; tt < 4; ++tt) { const int t = 4 * hb + tt, kr = t >> 1, chh = t & 1;
                    f32x4 a = {0.f, 0.f, 0.f, 0.f};
                    a = __builtin_amdgcn_mfma_f32_16x16x32_bf16(kf[tt][0], Bq0, a, 0, 0, 0); a = __builtin_amdgcn_mfma_f32_16x16x32_bf16(kf[tt][1], Bq1, a, 0, 0, 0);
#pragma unroll
                    for (int j = 0; j < 4; ++j) { const float bias = *(const LAS float*)(rpl + chh * 64 + kr * 320 + j * 4); a[j] = ((unsigned)(d00 + 16 * chh + j - lo) <= 15u) ? a[j] + bias : -INFINITY; }
                    sc[t] = a; }
                NA_SB;
            }
            u32x2 va0[2][4], va1[2][4];
            auto ld_vloc = [&](int uu0) {
#pragma unroll
                for (int q = 0; q < 2; ++q)
#pragma unroll
                    for (int mt = 0; mt < 4; ++mt) { const char* vp = (vbase + (size_t)((16 * mt * NROW + (uu0 + q) * 64) * 2)) + vlane; va0[q][mt] = *(const u32x2*)vp; va1[q][mt] = *(const u32x2*)(vp + 32); } };
            ld_vloc(0);
            NA_SB;
            float mA = -INFINITY;
#pragma unroll
            for (int t = 0; t < 16; ++t) mA = fmaxf(mA, fmaxf(fmaxf(sc[t][0], sc[t][1]), fmaxf(sc[t][2], sc[t][3])));
            mA = fmaxf(mA, __shfl_xor(mA, 16)); mA = fmaxf(mA, __shfl_xor(mA, 32));
            float lA = 0.f; u32x2 pp[16];
#pragma unroll
            for (int t = 0; t < 16; ++t) { const float e0 = __expf(sc[t][0] - mA), e1 = __expf(sc[t][1] - mA), e2 = __expf(sc[t][2] - mA), e3 = __expf(sc[t][3] - mA);
                lA += (e0 + e1) + (e2 + e3); pp[t].x = pk_bf16(e0, e1); pp[t].y = pk_bf16(e2, e3); }
            NA_SB;
            f32x4 o[4];
#pragma unroll
            for (int mt = 0; mt < 4; ++mt) o[mt] = (f32x4){0.f, 0.f, 0.f, 0.f};
            auto mm_vloc = [&](int uu0) {
#pragma unroll
                for (int q = 0; q < 2; ++q) { const int t0 = 2 * (uu0 + q), t1 = t0 + 1;
                    union { u32x4 w; bf16x8 v; } P; P.w.x = pp[t0].x; P.w.y = pp[t0].y; P.w.z = pp[t1].x; P.w.w = pp[t1].y;
#pragma unroll
                    for (int mt = 0; mt < 4; ++mt) { union { u32x4 w; bf16x8 v; } A; A.w.x = va0[q][mt].x; A.w.y = va0[q][mt].y; A.w.z = va1[q][mt].x; A.w.w = va1[q][mt].y; o[mt] = __builtin_amdgcn_mfma_f32_16x16x32_bf16(A.v, P.v, o[mt], 0, 0, 0); } } };
            mm_vloc(0); NA_SB; ld_vloc(2); NA_SB; mm_vloc(2); NA_SB; ld_vloc(4); NA_SB; mm_vloc(4); NA_SB; ld_vloc(6); NA_SB; mm_vloc(6); NA_SB;
            int lane2 = (int)__builtin_amdgcn_mbcnt_hi(~0u, __builtin_amdgcn_mbcnt_lo(~0u, 0u)); asm volatile("" : "+v"(lane2));
            const int l15b = lane2 & 15, fqb = lane2 >> 4, cks = (l15b >> 1) & 7, ck0 = l15b * 128 + ((fqb ^ cks) << 4), ck1 = l15b * 128 + (((4 + fqb) ^ cks) << 4);
            {
                bf16x8 kfA[2][2];
                auto ld_ctx = [&](bf16x8 (&kf)[2][2], auto G) {
#pragma unroll
                    for (int tt = 0; tt < 2; ++tt) { constexpr int tile = 0; const int to = (2 * decltype(G)::v + tt) * 2048 + tile;
                        kf[tt][0] = *(const LAS bf16x8*)(CK + to + ck0); kf[tt][1] = *(const LAS bf16x8*)(CK + to + ck1); } };
                auto mm_ctx = [&](const bf16x8 (&kf)[2][2], auto G) {
#pragma unroll
                    for (int tt = 0; tt < 2; ++tt) { f32x4 a = {0.f, 0.f, 0.f, 0.f};
                        a = __builtin_amdgcn_mfma_f32_16x16x32_bf16(kf[tt][0], Bq0, a, 0, 0, 0); a = __builtin_amdgcn_mfma_f32_16x16x32_bf16(kf[tt][1], Bq1, a, 0, 0, 0);
                        sc[2 * decltype(G)::v + tt] = a; } };
#define NA_CC(G0) ld_ctx(kfA, IC<G0>{}); NA_SB; mm_ctx(kfA, IC<G0>{}); NA_SB;
                NA_CC(0) NA_CC(1) NA_CC(2) NA_CC(3) NA_CC(4) NA_CC(5) NA_CC(6) NA_CC(7)
#undef NA_CC
            }
            float mB = -INFINITY;
#pragma unroll
            for (int t = 0; t < 16; ++t) mB = fmaxf(mB, fmaxf(fmaxf(sc[t][0], sc[t][1]), fmaxf(sc[t][2], sc[t][3])));
            mB = fmaxf(mB, __shfl_xor(mB, 16)); mB = fmaxf(mB, __shfl_xor(mB, 32));
            const float mx = fmaxf(mA, mB), fA = __expf(mA - mx);
            float lB = 0.f;
#pragma unroll
            for (int t = 0; t < 16; ++t) { const float e0 = __expf(sc[t][0] - mx), e1 = __expf(sc[t][1] - mx), e2 = __expf(sc[t][2] - mx), e3 = __expf(sc[t][3] - mx);
                lB += (e0 + e1) + (e2 + e3); pp[t].x = pk_bf16(e0, e1); pp[t].y = pk_bf16(e2, e3); }
            float sum = lA * fA + lB;
            sum += __shfl_xor(sum, 16); sum += __shfl_xor(sum, 32);
            const float inv = 1.0f / sum;
#pragma unroll
            for (int mt = 0; mt < 4; ++mt) o[mt] = o[mt] * fA;
            NA_SB;
            int cvo[4][2];
#pragma unroll
            for (int rr = 0; rr < 4; ++rr)
#pragma unroll
                for (int dd = 0; dd < 2; ++dd) cvo[rr][dd] = l15b * 512 + ((((8 * rr + fqb + 4 * dd) ^ (l15b << 1)) & 31) << 3);
            {
                u32x4 vfA[4], vfB[4];
                auto ld_v = [&](u32x4 (&vq)[4], auto U) {
                    constexpr int uu = decltype(U)::v, q4 = uu >> 2, rr = uu & 3;
#pragma unroll
                    for (int mt = 0; mt < 4; ++mt) { const u32x2 a0 = *(const LAS u32x2*)(CV + mt * 8192 + q4 * 256 + cvo[rr][0]), a1 = *(const LAS u32x2*)(CV + mt * 8192 + q4 * 256 + cvo[rr][1]); vq[mt] = (u32x4){a0.x, a0.y, a1.x, a1.y}; } };
                auto mm_v = [&](const u32x4 (&vq)[4], auto U) {
                    constexpr int uu = decltype(U)::v, t0 = 2 * uu, t1 = 2 * uu + 1;
                    union { u32x4 w; bf16x8 v; } P; P.w.x = pp[t0].x; P.w.y = pp[t0].y; P.w.z = pp[t1].x; P.w.w = pp[t1].y;
#pragma unroll
                    for (int mt = 0; mt < 4; ++mt) { union { u32x4 w; bf16x8 v; } A; A.w = vq[mt]; o[mt] = __builtin_amdgcn_mfma_f32_16x16x32_bf16(A.v, P.v, o[mt], 0, 0, 0); } };
#define NA_PV(U0, U1, U2, U3) mm_v(vfA, IC<U0>{}); NA_SB; ld_v(vfA, IC<U2>{}); NA_SB; mm_v(vfB, IC<U1>{}); NA_SB; ld_v(vfB, IC<U3>{}); NA_SB;
                ld_v(vfA, IC<0>{}); ld_v(vfB, IC<1>{}); NA_SB;
                NA_PV(0, 1, 2, 3) NA_PV(2, 3, 4, 5) NA_PV(4, 5, 6, 7)
                mm_v(vfA, IC<6>{}); NA_SB; mm_v(vfB, IC<7>{}); NA_SB;
#undef NA_PV
            }
#undef NA_SB
            bf16_t* op = OA + (size_t)(b * 4096 + r * 64 + c) * 1536 + h * 64 + 4 * fq;
#pragma unroll
            for (int mt = 0; mt < 4; ++mt) { u32x2 wv; wv.x = pk_bf16(o[mt][0] * inv, o[mt][1] * inv); wv.y = pk_bf16(o[mt][2] * inv, o[mt][3] * inv); *(u32x2*)(op + 16 * mt) = wv; }
        }
    }
}

DEVI void phase5(const Params& p) {
    const int lane = threadIdx.x & 63, gw = blockIdx.x * 8 + (threadIdx.x >> 6), nw = gridDim.x * 8;
    const bf16_t* OF = (const bf16_t*)(p.ws + WS_OF); const bf16_t* OB = (const bf16_t*)(p.ws + WS_OB); const bf16_t* GB = (const bf16_t*)(p.ws + WS_GB); bf16_t* AP = (bf16_t*)(p.ws + WS_AP);
    for (int tok = gw; tok < NTOK; tok += nw) {
#pragma unroll
        for (int hh = 0; hh < 2; ++hh) {
            const int col = hh * 512 + lane * 8;
            const size_t o = (size_t)tok * 1024 + col;
            const u32x4 a = *(const u32x4*)(OF + o), bb = *(const u32x4*)(OB + o), g = *(const u32x4*)(GB + o);
            float v[8] = {bflo(a.x) + bflo(bb.x), bfhi(a.x) + bfhi(bb.x), bflo(a.y) + bflo(bb.y), bfhi(a.y) + bfhi(bb.y), bflo(a.z) + bflo(bb.z), bfhi(a.z) + bfhi(bb.z), bflo(a.w) + bflo(bb.w), bfhi(a.w) + bfhi(bb.w)};
            float ss = 0.f;
#pragma unroll
            for (int e = 0; e < 8; ++e) ss += v[e] * v[e];
            ss += __shfl_xor(ss, 16); ss += __shfl_xor(ss, 8); ss += __shfl_xor(ss, 4); ss += __shfl_xor(ss, 2); ss += __shfl_xor(ss, 1);
            const float rs = rsqrtf(ss * (1.0f / 256.0f) + 1e-6f);
            const f32x4 n0 = *(const f32x4*)(p.in[12] + col), n1 = *(const f32x4*)(p.in[12] + col + 4);
            const float gg[8] = {bflo(g.x), bfhi(g.x), bflo(g.y), bfhi(g.y), bflo(g.z), bfhi(g.z), bflo(g.w), bfhi(g.w)};
            float r[8];
#pragma unroll
            for (int e = 0; e < 8; ++e) r[e] = v[e] * rs * (e < 4 ? n0[e & 3] : n1[e & 3]) * (gg[e] * sigmoidf_(gg[e]));
            u32x4 wv; wv.x = pk_bf16(r[0], r[1]); wv.y = pk_bf16(r[2], r[3]); wv.z = pk_bf16(r[4], r[5]); wv.w = pk_bf16(r[6], r[7]);
            *(u32x4*)(AP + (size_t)tok * 1536 + 512 + col) = wv;
        }
    }
}

DEVI void ln_row(f32x4 (&v)[4], const float* g, const float* bta, int lane) {
    float s = 0.f;
#pragma unroll
    for (int j = 0; j < 4; ++j) s += (v[j][0] + v[j][1]) + (v[j][2] + v[j][3]);
    const float mu = wave_sum(s) * (1.0f / 1024.0f);
    float q = 0.f;
#pragma unroll
    for (int j = 0; j < 4; ++j) { v[j] = v[j] - mu; q += (v[j][0] * v[j][0] + v[j][1] * v[j][1]) + (v[j][2] * v[j][2] + v[j][3] * v[j][3]); }
    const float rstd = rsqrtf(wave_sum(q) * (1.0f / 1024.0f) + 1e-6f);
#pragma unroll
    for (int j = 0; j < 4; ++j) { const f32x4 gg = *(const f32x4*)(g + lane * 4 + 256 * j), bb = *(const f32x4*)(bta + lane * 4 + 256 * j); v[j] = v[j] * rstd * gg + bb; }
}
DEVI void phase9(const Params& p) {
    const int lane = threadIdx.x & 63, gw = blockIdx.x * 8 + (threadIdx.x >> 6), nw = gridDim.x * 8;
    const float* mod = (const float*)(p.ws + WS_MOD); const bf16_t* Z = (const bf16_t*)(p.ws + WS_Z); bf16_t* X1 = (bf16_t*)(p.ws + WS_X1); bf16_t* H2 = (bf16_t*)(p.ws + WS_H2); unsigned char* H8 = p.ws + WS_H2F8;
    for (int tok = gw; tok < NTOK; tok += nw) {
        const float* m = mod + (size_t)(tok >> 12) * 6144; float v[2][8];
#pragma unroll
        for (int j = 0; j < 2; ++j) { const int cidx = lane * 8 + 512 * j;
            const f32x4 x0 = *(const f32x4*)(p.in[0] + (size_t)tok * 1024 + cidx), x1 = *(const f32x4*)(p.in[0] + (size_t)tok * 1024 + cidx + 4), g0 = *(const f32x4*)(m + 2048 + cidx), g1 = *(const f32x4*)(m + 2048 + cidx + 4);
            const u32x4 z = *(const u32x4*)(Z + (size_t)tok * 1024 + cidx);
            float zf[8] = {bflo(z.x), bfhi(z.x), bflo(z.y), bfhi(z.y), bflo(z.z), bfhi(z.z), bflo(z.w), bfhi(z.w)};
#if defined(DBG_NOMIX)
#pragma unroll
            for (int e = 0; e < 8; ++e) zf[e] = 0.f;
#endif
#pragma unroll
            for (int e = 0; e < 4; ++e) { v[j][e] = x0[e] * 1.189207115f + g0[e] * zf[e]; v[j][4 + e] = x1[e] * 1.189207115f + g1[e] * zf[4 + e]; }
        }
        float sm = 0.f;
#pragma unroll
        for (int j = 0; j < 2; ++j)
#pragma unroll
            for (int e = 0; e < 8; ++e) sm += v[j][e];
        const float mu = wave_sum(sm) * (1.0f / 1024.0f); float q = 0.f;
#pragma unroll
        for (int j = 0; j < 2; ++j)
#pragma unroll
            for (int e = 0; e < 8; ++e) { v[j][e] -= mu; q += v[j][e] * v[j][e]; }
        const float rstd = rsqrtf(wave_sum(q) * (1.0f / 1024.0f) + 1e-6f);
#pragma unroll
        for (int j = 0; j < 2; ++j) { const int cidx = lane * 8 + 512 * j;
            const f32x4 g0 = *(const f32x4*)(p.in[16] + cidx), g1 = *(const f32x4*)(p.in[16] + cidx + 4), b0 = *(const f32x4*)(p.in[17] + cidx), b1 = *(const f32x4*)(p.in[17] + cidx + 4);
            const f32x4 sh0 = *(const f32x4*)(m + 3072 + cidx), sh1 = *(const f32x4*)(m + 3072 + cidx + 4), sc0 = *(const f32x4*)(m + 4096 + cidx), sc1 = *(const f32x4*)(m + 4096 + cidx + 4);
            f32x4 o0, o1; float hv[8];
#pragma unroll
            for (int e = 0; e < 4; ++e) { o0[e] = v[j][e] * rstd * g0[e] + b0[e]; o1[e] = v[j][4 + e] * rstd * g1[e] + b1[e]; hv[e] = o0[e] * (sc0[e] + 1.0f) + sh0[e]; hv[4 + e] = o1[e] * (sc1[e] + 1.0f) + sh1[e]; }
            { u32x4 xv; xv.x = pk_bf16(o0[0], o0[1]); xv.y = pk_bf16(o0[2], o0[3]); xv.z = pk_bf16(o1[0], o1[1]); xv.w = pk_bf16(o1[2], o1[3]); *(u32x4*)(X1 + (size_t)tok * 1024 + cidx) = xv; }
            u32x4 wv; wv.x = pk_bf16(hv[0], hv[1]); wv.y = pk_bf16(hv[2], hv[3]); wv.z = pk_bf16(hv[4], hv[5]); wv.w = pk_bf16(hv[6], hv[7]);
            *(u32x4*)(H2 + (size_t)tok * 1024 + cidx) = wv;
            u32x2 w8; w8.x = pk4_fp8(hv[0] * F8_X, hv[1] * F8_X, hv[2] * F8_X, hv[3] * F8_X); w8.y = pk4_fp8(hv[4] * F8_X, hv[5] * F8_X, hv[6] * F8_X, hv[7] * F8_X);
            *(u32x2*)(H8 + (size_t)tok * 1024 + cidx) = w8; }
    }
}
DEVI void phase11(const Params& p, LAS unsigned char* lds, int tok_begin) {
    const int lane = threadIdx.x & 63, half = lane >> 5, tw0 = tok_begin + (threadIdx.x >> 6) * 32;
    LAS unsigned* LC = (LAS unsigned*)(lds + LDS_TAB); LAS unsigned* LB = LC + 256;
    if (threadIdx.x < 256) LC[threadIdx.x] = 0u;
    __syncthreads();
    const float* L0 = (const float*)(p.ws + WS_LOG0);
    int* TID = (int*)(p.ws + WS_TOPK_ID); float* TW = (float*)(p.ws + WS_TOPK_W); int* TP = (int*)(p.ws + WS_TOPK_POS); unsigned* CNT = (unsigned*)(p.ws + WS_CNT);
    float rb[4];
#pragma unroll
    for (int j = 0; j < 4; ++j) rb[j] = p.in[19][lane + 64 * j];
    for (int tok = tw0; tok < tw0 + 32; ++tok) {
        float s[4], bz[4], gs[4];
#pragma unroll
        for (int j = 0; j < 4; ++j) { const float lg = L0[(size_t)tok * 256 + lane + 64 * j]; s[j] = __builtin_amdgcn_rcpf(1.0f + __expf(-lg)); bz[j] = s[j] + rb[j]; }
#pragma unroll
        for (int j = 0; j < 4; ++j) { float m1 = bz[j], m2 = -INFINITY;
#define TOP2_STEP(P1, P2) { const float p1 = (P1), p2 = (P2); const float n1 = fmaxf(m1, p1), n2 = fmaxf(fminf(m1, p1), fmaxf(m2, p2)); m1 = n1; m2 = n2; }
            TOP2_STEP(dppf<DPP_X1>(m1), dppf<DPP_X1>(m2)) TOP2_STEP(dppf<DPP_X2>(m1), dppf<DPP_X2>(m2)) TOP2_STEP(dppf<DPP_HM>(m1), dppf<DPP_HM>(m2)) TOP2_STEP(dppf<DPP_RM>(m1), dppf<DPP_RM>(m2)) TOP2_STEP(x16f(m1, lane), x16f(m2, lane))
#undef TOP2_STEP
            gs[j] = m1 + m2; }
        float Gv[8];
#pragma unroll
        for (int j = 0; j < 4; ++j) { const float oth = x32f(gs[j], lane); Gv[2 * j] = half ? oth : gs[j]; Gv[2 * j + 1] = half ? gs[j] : oth; }
        bool keep[8];
#pragma unroll
        for (int g = 0; g < 8; ++g) { int rank = 0;
#pragma unroll
            for (int g2 = 0; g2 < 8; ++g2) rank += (Gv[g2] > Gv[g] || (Gv[g2] == Gv[g] && g2 < g)) ? 1 : 0;
            keep[g] = rank < 4; }
        unsigned key[4];
#pragma unroll
        for (int j = 0; j < 4; ++j) { const bool k = half ? keep[2 * j + 1] : keep[2 * j]; key[j] = k ? ((__float_as_uint(bz[j] + 1.0f) & 0xFFFFFF00u) | (unsigned)(255 - (lane + 64 * j))) : 0u; }
        int myE = 0;
#pragma unroll
        for (int it = 0; it < 8; ++it) {
            unsigned k = max(max(key[0], key[1]), max(key[2], key[3]));
            k = max(k, (unsigned)dppi<DPP_X1>((int)k)); k = max(k, (unsigned)dppi<DPP_X2>((int)k)); k = max(k, (unsigned)dppi<DPP_HM>((int)k)); k = max(k, (unsigned)dppi<DPP_RM>((int)k));
            k = max(k, (unsigned)x16i((int)k, lane)); k = max(k, (unsigned)x32i((int)k, lane));
#pragma unroll
            for (int j = 0; j < 4; ++j) key[j] = key[j] == k ? 0u : key[j];
            if (lane == it) myE = 255 - (int)(k & 255u);
        }
        float sv;
        { const int src = (myE & 63) << 2, jsel = myE >> 6;
          const float a0 = __builtin_bit_cast(float, __builtin_amdgcn_ds_bpermute(src, __builtin_bit_cast(int, s[0]))), a1 = __builtin_bit_cast(float, __builtin_amdgcn_ds_bpermute(src, __builtin_bit_cast(int, s[1])));
          const float a2 = __builtin_bit_cast(float, __builtin_amdgcn_ds_bpermute(src, __builtin_bit_cast(int, s[2]))), a3 = __builtin_bit_cast(float, __builtin_amdgcn_ds_bpermute(src, __builtin_bit_cast(int, s[3])));
          sv = jsel == 0 ? a0 : (jsel == 1 ? a1 : (jsel == 2 ? a2 : a3)); }
        float ssum = lane < 8 ? sv : 0.f;
        ssum += dppf<DPP_X1>(ssum); ssum += dppf<DPP_X2>(ssum); ssum += dppf<DPP_HM>(ssum);
        if (lane < 8) { const int idx = tok * 8 + lane; TID[idx] = myE; TW[idx] = sv / ssum * 2.5f; TP[idx] = (int)__hip_atomic_fetch_add(LC + myE, 1u, __ATOMIC_RELAXED, __HIP_MEMORY_SCOPE_WORKGROUP); }
    }
    __syncthreads();
    if (threadIdx.x < 256) { const unsigned cnt = LC[threadIdx.x]; LB[threadIdx.x] = cnt ? atomicAdd(&CNT[threadIdx.x], cnt) : 0u; }
    __syncthreads();
    for (int tok = tw0; tok < tw0 + 32; ++tok) if (lane < 8) { const int idx = tok * 8 + lane; TP[idx] += (int)LB[TID[idx]]; }
}
DEVI void phase12(const Params& p, LAS unsigned char* lds, int part) {
    if (part == 0) {
    LAS int* T = (LAS int*)(lds + LDS_TAB);
    moe_tables((const unsigned*)(p.ws + WS_CNT), T);
    const int* TID = (const int*)(p.ws + WS_TOPK_ID); const int* TP = (const int*)(p.ws + WS_TOPK_POS); int* TPw = (int*)(p.ws + WS_TOPK_POS); const float* TW = (const float*)(p.ws + WS_TOPK_W); u32x2* SL = (u32x2*)(p.ws + WS_SLOT);
    for (int idx = blockIdx.x * 512 + threadIdx.x; idx < NTOK * 8; idx += gridDim.x * 512) { const int slot_ = T[256 + TID[idx]] + TP[idx]; u32x2 rec; rec.x = (unsigned)idx; rec.y = __float_as_uint(TW[idx]); SL[slot_] = rec; TPw[idx] = slot_; }
    return; }
    LAS float* tb = (LAS float*)lds;
    __syncthreads();
    const bool even_split = gridDim.x == 256; const int cb = blockIdx.x;
    const int t_lo = even_split ? (cb < 128 ? cb * 18 : 2304 + (cb - 128) * 30) : cb, t_hi = even_split ? t_lo + (cb < 128 ? 18 : 30) : 256 * 24, t_st = even_split ? 1 : (int)gridDim.x;
    for (int t = t_lo; t < t_hi; t += t_st) {
        const int e = t / 24, r = t % 24;
        if (r < 8)       conv_tile8(p.in[20] + (size_t)e * 262144, 256, p.ws + WS_EXPGU + (size_t)e * 524288, 1024, r * 128, 0, 0, F8_WGU, tb);
        else if (r < 16) conv_tile8(p.in[21] + (size_t)e * 262144, 256, p.ws + WS_EXPGU + (size_t)e * 524288, 1024, (r - 8) * 128, 0, 128, F8_WGU, tb);
        else { const int kt = (r - 16) >> 2, nb = (r - 16) & 3; conv_tile8(p.in[22] + (size_t)e * 262144 + nb * 256, 1024, p.ws + WS_EXPD + (size_t)e * 262144, 256, kt * 128, nb * 256, -1, F8_WD, tb); }
    }
}
DEVI void phase15(const Params& p) {
    const int lane = threadIdx.x & 63, gw = blockIdx.x * 8 + (threadIdx.x >> 6), nw = gridDim.x * 8;
    const float* mod = (const float*)(p.ws + WS_MOD); const bf16_t* X1 = (const bf16_t*)(p.ws + WS_X1);
    for (int tok = gw; tok < NTOK; tok += nw) {
        const float* m = mod + (size_t)(tok >> 12) * 6144 + 5120; float v[2][8];
        int sl[8]; float tw[8];
        { const int* tp = (const int*)(p.ws + WS_TOPK_POS) + (size_t)tok * 8; const float* twp = (const float*)(p.ws + WS_TOPK_W) + (size_t)tok * 8;
#pragma unroll
          for (int k = 0; k < 8; ++k) { sl[k] = __builtin_amdgcn_readfirstlane(tp[k]); tw[k] = twp[k]; } }
#pragma unroll
        for (int j = 0; j < 2; ++j) { const int cidx = lane * 8 + 512 * j; float a[8];
#pragma unroll
            for (int e = 0; e < 8; ++e) a[e] = 0.f;
#pragma unroll
            for (int k = 0; k < 9; ++k) { const u32x2 y = *(const u32x2*)((k < 8 ? p.ws + ws_ys(sl[k]) : p.ws + WS_Y8 + (size_t)tok * 1024) + cidx); const float w = (k < 8 ? tw[k] : 1.0f) * (1.0f / F8_Y);
                const f32x2_t y0 = __builtin_amdgcn_cvt_pk_f32_fp8((int)y.x, false), y1 = __builtin_amdgcn_cvt_pk_f32_fp8((int)y.x, true), y2 = __builtin_amdgcn_cvt_pk_f32_fp8((int)y.y, false), y3 = __builtin_amdgcn_cvt_pk_f32_fp8((int)y.y, true);
                a[0] += w * y0[0]; a[1] += w * y0[1]; a[2] += w * y1[0]; a[3] += w * y1[1]; a[4] += w * y2[0]; a[5] += w * y2[1]; a[6] += w * y3[0]; a[7] += w * y3[1]; }
            const u32x4 xr = *(const u32x4*)(X1 + (size_t)tok * 1024 + cidx);
            const f32x4 g0 = *(const f32x4*)(m + cidx), g1 = *(const f32x4*)(m + cidx + 4), x0 = {bflo(xr.x), bfhi(xr.x), bflo(xr.y), bfhi(xr.y)}, x1 = {bflo(xr.z), bfhi(xr.z), bflo(xr.w), bfhi(xr.w)};
#if defined(DBG_NOMOE)
#pragma unroll
            for (int e = 0; e < 8; ++e) a[e] = 0.f;
#endif
#pragma unroll
            for (int e = 0; e < 4; ++e) { v[j][e] = x0[e] * 1.189207115f + g0[e] * a[e]; v[j][4 + e] = x1[e] * 1.189207115f + g1[e] * a[4 + e]; }
        }
        float sm = 0.f;
#pragma unroll
        for (int j = 0; j < 2; ++j)
#pragma unroll
            for (int e = 0; e < 8; ++e) sm += v[j][e];
        const float mu = wave_sum(sm) * (1.0f / 1024.0f); float q = 0.f;
#pragma unroll
        for (int j = 0; j < 2; ++j)
#pragma unroll
            for (int e = 0; e < 8; ++e) { v[j][e] -= mu; q += v[j][e] * v[j][e]; }
        const float rstd = rsqrtf(wave_sum(q) * (1.0f / 1024.0f) + 1e-6f);
#pragma unroll
        for (int j = 0; j < 2; ++j) { const int cidx = lane * 8 + 512 * j;
            const f32x4 g0 = *(const f32x4*)(p.in[26] + cidx), g1 = *(const f32x4*)(p.in[26] + cidx + 4), b0 = *(const f32x4*)(p.in[27] + cidx), b1 = *(const f32x4*)(p.in[27] + cidx + 4);
            f32x4 o0, o1;
#pragma unroll
            for (int e = 0; e < 4; ++e) { o0[e] = v[j][e] * rstd * g0[e] + b0[e]; o1[e] = v[j][4 + e] * rstd * g1[e] + b1[e]; }
            *(f32x4*)(p.out + (size_t)tok * 1024 + cidx) = o0; *(f32x4*)(p.out + (size_t)tok * 1024 + cidx + 4) = o1; }
    }
}

__global__ void __launch_bounds__(512, 2) mega(Params p) {
    extern __shared__ __attribute__((aligned(16))) unsigned char shm[];
    LAS unsigned char* lds = (LAS unsigned char*)shm;
    volatile LAS unsigned* xbw = (volatile LAS unsigned*)(lds + LDS_BARW);
    if (threadIdx.x == 0) { xbw[0] = 0u; xbw[1] = 0u; xbw[2] = 0u; xbw[3] = 0u; }
    __syncthreads();
    XcdBarrier bar; bar.bar = (unsigned*)(p.ws + WS_CTL); bar.x = 0; bar.st = xbw;
    const bool multi = (p.ph_hi - p.ph_lo) > 1;
    if (multi) bar = xcd_barrier_post((unsigned*)(p.ws + WS_CTL), xbw);
    unsigned char* ws = p.ws;
    const int G = gridDim.x, c = blockIdx.x;
#ifndef PHMASK
#define PHMASK 0xFFFF
#endif
#ifndef REPMASK
#define REPMASK 0
#endif
#define RUN(n) if (((PHMASK >> (n)) & 1) && p.ph_lo <= (n) && (n) < p.ph_hi)
#define SYNC(n) if (p.ph_lo <= (n) && (n) + 1 < p.ph_hi) xcd_barrier(bar); else __syncthreads()
    RUN(0) phase0(p, lds, 0);
#if (REPMASK >> 0) & 1
    __syncthreads();
    RUN(0) phase0(p, lds, 0);
#endif
    SYNC(0);
    RUN(1) { phase1(p); phase0(p, lds, 1); }
#if (REPMASK >> 1) & 1
    __syncthreads();
    RUN(1) { phase1(p); phase0(p, lds, 1); }
#endif
    SYNC(1);
    RUN(2) { SchedInProj S{ws, G, c}; EpiBf16 E; gemm_stream<SchedInProj, EpiBf16, false>(lds, S, E); }
#if (REPMASK >> 2) & 1
    __syncthreads();
    RUN(2) { SchedInProj S{ws, G, c}; EpiBf16 E; gemm_stream<SchedInProj, EpiBf16, false>(lds, S, E); }
#endif
    SYNC(2);
    RUN(3) phase3(p, lds);
#if (REPMASK >> 3) & 1
    __syncthreads();
    RUN(3) phase3(p, lds);
#endif
    SYNC(3);
    RUN(4) { if (c & 1) { phase4_na(p, lds); __syncthreads(); phase4_gla(p, lds); } else { phase4_gla(p, lds); __syncthreads(); phase4_na(p, lds); } }
    SYNC(4);
    RUN(5) phase5(p);
#if (REPMASK >> 5) & 1
    __syncthreads();
    RUN(5) phase5(p);
#endif
    SYNC(5);
#if (REPMASK >> 6) & 1
    __syncthreads();
#endif
    RUN(7) { SchedDense S{(const char*)(ws + WS_AP), (const char*)(ws + WS_BT_BR), (char*)(ws + WS_YM), 1536, G, c, 3072u, 3072u, 24}; EpiBranchC E{(const bf16_t*)(ws + WS_SGA), (const bf16_t*)(ws + WS_SGB), (bf16_t*)(ws + WS_YM)}; gemm_stream<SchedDense, EpiBranchC, false>(lds, S, E); }
#if (REPMASK >> 7) & 1
    __syncthreads();
    RUN(7) { SchedDense S{(const char*)(ws + WS_AP), (const char*)(ws + WS_BT_BR), (char*)(ws + WS_YM), 1536, G, c, 3072u, 3072u, 24}; EpiBranchC E{(const bf16_t*)(ws + WS_SGA), (const bf16_t*)(ws + WS_SGB), (bf16_t*)(ws + WS_YM)}; gemm_stream<SchedDense, EpiBranchC, false>(lds, S, E); }
#endif
    SYNC(7);
    RUN(8) { SchedDense S{(const char*)(ws + WS_YM), (const char*)(ws + WS_BT_OUT), (char*)(ws + WS_Z), 1024, G, c, 2048u, 2048u, 16}; EpiBf16 E; gemm_stream<SchedDense, EpiBf16, false>(lds, S, E); }
#if (REPMASK >> 8) & 1
    __syncthreads();
    RUN(8) { SchedDense S{(const char*)(ws + WS_YM), (const char*)(ws + WS_BT_OUT), (char*)(ws + WS_Z), 1024, G, c, 2048u, 2048u, 16}; EpiBf16 E; gemm_stream<SchedDense, EpiBf16, false>(lds, S, E); }
#endif
    SYNC(8);
    RUN(9) phase9(p);
#if (REPMASK >> 9) & 1
    __syncthreads();
    RUN(9) phase9(p);
#endif
    SYNC(9);
    RUN(10) { if (c < 128) { SchedRouter S{ws, G, c}; EpiF32 E; gemm_stream<SchedRouter, EpiF32, false>(lds, S, E); asm volatile("s_waitcnt vmcnt(0)" ::: "memory"); __syncthreads(); phase11(p, lds, SchedRouter::panel(c) * 256); }
              phase12(p, lds, 1); }
    SYNC(10);
    RUN(12) phase12(p, lds, 0);
#if (REPMASK >> 12) & 1
    __syncthreads();
    RUN(12) phase12(p, lds, 0);
#endif
    SYNC(12);
    RUN(13) { LAS int* T = (LAS int*)(lds + LDS_TAB); moe_tables((const unsigned*)(ws + WS_CNT), T); SchedGateUp S{ws, T, G, c}; EpiGateUp E{ws + WS_HID}; gemm_stream<SchedGateUp, EpiGateUp, true>(lds, S, E); }
#if (REPMASK >> 13) & 1
    __syncthreads();
    RUN(13) { LAS int* T = (LAS int*)(lds + LDS_TAB); moe_tables((const unsigned*)(ws + WS_CNT), T); SchedGateUp S{ws, T, G, c}; EpiGateUp E{ws + WS_HID}; gemm_stream<SchedGateUp, EpiGateUp, true>(lds, S, E); }
#endif
    SYNC(13);
    RUN(14) { LAS int* T = (LAS int*)(lds + LDS_TAB); moe_tables((const unsigned*)(ws + WS_CNT), T); SchedDown S{ws, T, G, c}; EpiDown E{ws}; gemm_stream<SchedDown, EpiDown, false>(lds, S, E); }
#if (REPMASK >> 14) & 1
    __syncthreads();
    RUN(14) { LAS int* T = (LAS int*)(lds + LDS_TAB); moe_tables((const unsigned*)(ws + WS_CNT), T); SchedDown S{ws, T, G, c}; EpiDown E{ws}; gemm_stream<SchedDown, EpiDown, false>(lds, S, E); }
#endif
    SYNC(14);
    RUN(15) phase15(p);
#if (REPMASK >> 15) & 1
    __syncthreads();
    RUN(15) phase15(p);
#endif
}

#ifdef DBG_STOP
__global__ void dbg_dump(const unsigned short* base, size_t nwords, float* out, int accumulate) {
    for (size_t i = (size_t)blockIdx.x * blockDim.x + threadIdx.x; i < (size_t)33554432; i += (size_t)gridDim.x * blockDim.x) {
        float s = accumulate ? out[i] : 0.f;
        for (size_t j = i; j < nwords; j += (size_t)33554432) s += (float)base[j];
        out[i] = s;
    }
}
#endif
}

extern "C" void kernel_launch(void* const* d_in, const int* in_sizes, int n_in, void* d_out, int out_size, void* d_ws, size_t ws_size, hipStream_t stream) {
    static int grid = 0;
    if (grid == 0) {
        if (n_in != 28 || out_size != NTOK * 1024 || ws_size < WS_END) { fprintf(stderr, "kernel_launch: unexpected problem (n_in %d out %d ws %zu)\n", n_in, out_size, ws_size); grid = -1; return; }
        int dev = 0, cus = 0, per_cu = 0;
        if (hipGetDevice(&dev) != hipSuccess || hipDeviceGetAttribute(&cus, hipDeviceAttributeMultiprocessorCount, dev) != hipSuccess) { grid = -1; return; }
        if (hipFuncSetAttribute((const void*)mega, hipFuncAttributeMaxDynamicSharedMemorySize, LDS_TOTAL) != hipSuccess) { fprintf(stderr, "kernel_launch: hipFuncSetAttribute failed\n"); grid = -1; return; }
        if (hipOccupancyMaxActiveBlocksPerMultiprocessor(&per_cu, (const void*)mega, 512, LDS_TOTAL) != hipSuccess || per_cu < 1) fprintf(stderr, "kernel_launch: occupancy query says %d\n", per_cu);
        (void)hipGetLastError();
        grid = cus;
    }
    if (grid < 0) return;
    (void)hipMemsetAsync((char*)d_ws + WS_CTL, 0, 32768, stream);
    Params p{};
    for (int i = 0; i < 28; ++i) p.in[i] = (const float*)d_in[i];
    p.out = (float*)d_out; p.ws = (unsigned char*)d_ws;
#ifdef DBG_STOP
    for (int ph = 0; ph <= DBG_STOP; ++ph) { p.ph_lo = ph; p.ph_hi = ph + 1; hipLaunchKernelGGL(mega, dim3(grid), dim3(512), LDS_TOTAL, stream, p); }
    { const size_t regs[][2] = { DBG_REGS }; int first = 1;
      for (auto& r : regs) { hipLaunchKernelGGL(dbg_dump, dim3(2048), dim3(256), 0, stream, (const unsigned short*)((char*)d_ws + r[0] * MiB), (size_t)(r[1] * MiB / 2), (float*)d_out, first ? 0 : 1); first = 0; } }
#elif MK_PER_PHASE
    for (int ph = 0; ph < NPH; ++ph) {
#if defined(DBG_NOMOE)
        if (ph >= 10 && ph <= 14) continue;
#endif
        p.ph_lo = ph; p.ph_hi = ph + 1; hipLaunchKernelGGL(mega, dim3(grid), dim3(512), LDS_TOTAL, stream, p); }
#else
    p.ph_lo = 0; p.ph_hi = NPH; hipLaunchKernelGGL(mega, dim3(grid), dim3(512), LDS_TOTAL, stream, p);
#endif
}
```

```cpp
#include <hip/hip_runtime.h>
#include <stdint.h>
#include <stdio.h>

#ifndef MK_PER_PHASE
#define MK_PER_PHASE 0
#endif

namespace {
typedef unsigned short bf16_t;
typedef short bf16x8 __attribute__((ext_vector_type(8)));
typedef float f32x4 __attribute__((ext_vector_type(4)));
typedef unsigned u32x4 __attribute__((ext_vector_type(4)));
typedef unsigned u32x2 __attribute__((ext_vector_type(2)));
typedef int i32x4 __attribute__((ext_vector_type(4)));
typedef int i32x8 __attribute__((ext_vector_type(8)));
#define LAS __attribute__((address_space(3)))
#define DEVI __device__ __forceinline__

constexpr int NTOK = 32768, NROW = 34816, NPH = 16;
constexpr size_t MiB = 1ull << 20;
constexpr int LDS_TOTAL = 160 * 1024;
constexpr int LDS_BARW = LDS_TOTAL - 16;
constexpr int LDS_TAB = 131072;

constexpr size_t WS_CTL = 0, WS_CNT = 16384, WS_MOD = 1 * MiB, WS_EE = 2 * MiB, WS_TOPK_ID = 5 * MiB, WS_TOPK_W = 6 * MiB, WS_TOPK_POS = 7 * MiB, WS_SLOT = 8 * MiB;
constexpr size_t WS_BT_IN = 10 * MiB, WS_BT_BR = 24 * MiB  , WS_BT_OUT = 27 * MiB, WS_BT_RT = 29 * MiB, WS_BT_SHGU = 30 * MiB, WS_BT_SHD = 31 * MiB;
constexpr size_t WS_H = 32 * MiB, WS_QA = 100 * MiB, WS_KA = 132 * MiB, WS_QB = 166 * MiB, WS_KB = 198 * MiB, WS_GB = 232 * MiB, WS_SGA = 296 * MiB, WS_SGB = 360 * MiB;
constexpr size_t WS_VAT = 424 * MiB, WS_VBT = 458 * MiB, WS_QTF = 526 * MiB, WS_QTB = 558 * MiB, WS_KTF = 590 * MiB, WS_KTB = 624 * MiB, WS_KTTF = 658 * MiB, WS_KTTB = 692 * MiB;
constexpr size_t WS_OF = 726 * MiB, WS_OB = 790 * MiB, WS_AP = 896 * MiB, WS_LRT = 888 * MiB;
constexpr size_t WS_YM = 424 * MiB, WS_Z = 488 * MiB;
constexpr size_t WS_X1 = 32 * MiB, WS_EXPD = 160 * MiB, WS_LOG0 = 288 * MiB, WS_LOG1 = 320 * MiB, WS_EXPGU = 352 * MiB, WS_H2 = 608 * MiB, WS_HID = 864 * MiB;
constexpr size_t WS_H2F8 = 96 * MiB;
constexpr size_t WS_YS = 288 * MiB;
constexpr size_t WS_Y8 = 800 * MiB, WS_END = 1009 * MiB;
DEVI size_t ws_ys(int slot) { return WS_YS + (size_t)slot * 1024; }
DEVI size_t ws_y(int k) { return (k < 2 ? 160 + 64 * (size_t)k : (k < 6 ? 416 + 64 * (size_t)(k - 2) : 817 + 64 * (size_t)(k - 6))) * MiB; }

struct Params { const float* in[28]; float* out; unsigned char* ws; int ph_lo, ph_hi; };

typedef __bf16 bf16x2_t __attribute__((ext_vector_type(2)));
typedef float f32x2_t __attribute__((ext_vector_type(2)));
DEVI unsigned pk_bf16(float lo, float hi) { const f32x2_t v = {lo, hi}; const bf16x2_t r = __builtin_convertvector(v, bf16x2_t); return __builtin_bit_cast(unsigned, r); }
DEVI float bf2f(bf16_t b) { return __uint_as_float(((unsigned)b) << 16); }
DEVI float bflo(unsigned w) { return __uint_as_float(w << 16); }
DEVI float bfhi(unsigned w) { return __uint_as_float(w & 0xffff0000u); }
DEVI float clamp8(float v) { return __builtin_amdgcn_fmed3f(v, -448.0f, 448.0f); }
DEVI unsigned pk4_fp8(float a, float b, float c, float d) { unsigned w = 0u; w = (unsigned)__builtin_amdgcn_cvt_pk_fp8_f32(clamp8(a), clamp8(b), (int)w, false); w = (unsigned)__builtin_amdgcn_cvt_pk_fp8_f32(clamp8(c), clamp8(d), (int)w, true); return w; }
DEVI i32x8 cat8(bf16x8 a, bf16x8 b) { const i32x4 x = __builtin_bit_cast(i32x4, a), y = __builtin_bit_cast(i32x4, b); return __builtin_shufflevector(x, y, 0, 1, 2, 3, 4, 5, 6, 7); }
DEVI void mfma8(f32x4& acc, i32x8 a, i32x8 b) { asm volatile("v_mfma_f32_16x16x128_f8f6f4 %0, %1, %2, %0" : "+v"(acc) : "v"(a), "v"(b)); }
constexpr float F8_X = 4.0f, F8_WGU = 256.0f, F8_H = 4.0f, F8_WD = 128.0f;
constexpr float F8_Y = 64.0f;
constexpr float F8_HIN = 4.0f, F8_WIN = 256.0f;
constexpr float F8_AP = 8.0f, F8_WBR = 256.0f, F8_YM = 64.0f, F8_WOUT = 256.0f;
DEVI bf16_t f2bf(float f) { return (bf16_t)(pk_bf16(f, 0.f) & 0xffffu); }
DEVI float sigmoidf_(float x) { return __builtin_amdgcn_rcpf(1.0f + __expf(-x)); }
template <int N> struct IC { static constexpr int v = N; };
DEVI void lds_barrier() { asm volatile("s_waitcnt lgkmcnt(0)" ::: "memory"); __builtin_amdgcn_s_barrier(); asm volatile("" ::: "memory"); }
template <int CTRL> DEVI float dppf(float v) { return __builtin_bit_cast(float, __builtin_amdgcn_update_dpp(__builtin_bit_cast(int, v), __builtin_bit_cast(int, v), CTRL, 0xF, 0xF, false)); }
template <int CTRL> DEVI int dppi(int v) { return __builtin_amdgcn_update_dpp(v, v, CTRL, 0xF, 0xF, false); }
DEVI float x16f(float v, int lane) { const auto r = __builtin_amdgcn_permlane16_swap(__builtin_bit_cast(unsigned, v), __builtin_bit_cast(unsigned, v), false, false); return __builtin_bit_cast(float, (lane & 16) ? r[0] : r[1]); }
DEVI int   x16i(int v, int lane)   { const auto r = __builtin_amdgcn_permlane16_swap((unsigned)v, (unsigned)v, false, false); return (int)((lane & 16) ? r[0] : r[1]); }
DEVI float x32f(float v, int lane) { const auto r = __builtin_amdgcn_permlane32_swap(__builtin_bit_cast(unsigned, v), __builtin_bit_cast(unsigned, v), false, false); return __builtin_bit_cast(float, (lane & 32) ? r[0] : r[1]); }
DEVI int   x32i(int v, int lane)   { const auto r = __builtin_amdgcn_permlane32_swap((unsigned)v, (unsigned)v, false, false); return (int)((lane & 32) ? r[0] : r[1]); }
#define DPP_X1 0xB1
#define DPP_X2 0x4E
#define DPP_HM 0x141
#define DPP_RM 0x140
DEVI float wave_sum(float v) { const int lane = threadIdx.x & 63; v += dppf<DPP_X1>(v); v += dppf<DPP_X2>(v); v += dppf<DPP_HM>(v); v += dppf<DPP_RM>(v); v += x16f(v, lane); v += x32f(v, lane); return v; }

#define XB_TMO      128
#define XB_XCNT(j)  (256  + 64 * (j))
#define XB_XSUB(j)  (1280 + 64 * (j))
#define XB_XGEN(j)  (2304 + 64 * (j))
#define XB_TOP      3328
#define XB_TOPGEN   3392
#define XCD_BAR_WORDS 3456
#define XB_SPIN_CAP (1u << 22)
DEVI unsigned xb_ld(unsigned* p)              { return __hip_atomic_load(p, __ATOMIC_RELAXED, __HIP_MEMORY_SCOPE_AGENT); }
DEVI unsigned xb_add(unsigned* p, unsigned v) { return __hip_atomic_fetch_add(p, v, __ATOMIC_RELAXED, __HIP_MEMORY_SCOPE_AGENT); }
DEVI unsigned xb_xcc_id() { return (unsigned)__builtin_amdgcn_s_getreg((3 << 11) | 20) & 0xFu; }
#define XB_SPIN(cond, bar) do { unsigned _sp = 0; while (cond) { __builtin_amdgcn_s_sleep(1); \
    if ((++_sp & 255u) == 0u) { if (xb_ld(&(bar)[XB_TMO])) break; if (_sp > XB_SPIN_CAP) { atomicAdd(&(bar)[XB_TMO], 1u); break; } } } } while (0)
struct XcdBarrier { unsigned* bar; unsigned x; volatile LAS unsigned* st; };
DEVI XcdBarrier xcd_barrier_post(unsigned* bar, volatile LAS unsigned* st) {
    XcdBarrier b; b.bar = bar; b.x = xb_xcc_id(); b.st = st;
    if (threadIdx.x == 0) (void)xb_add(&bar[XB_XCNT(b.x)], 1u);
    return b;
}
DEVI void xcd_barrier_complete(unsigned* bar, unsigned x, unsigned& nloc, unsigned& nx) {
    const unsigned G = gridDim.x * gridDim.y * gridDim.z;
    unsigned sum, cnt, mine, sp = 0u;
    for (;;) {
        sum = 0u; cnt = 0u; mine = 0u;
#pragma unroll
        for (unsigned j = 0; j < 16; ++j) { const unsigned c = xb_ld(&bar[XB_XCNT(j)]); sum += c; cnt += (c > 0u) ? 1u : 0u; mine = (j == x) ? c : mine; }
        if (sum == G) break;
        __builtin_amdgcn_s_sleep(1);
        if ((++sp & 255u) == 0u) { if (xb_ld(&bar[XB_TMO])) break; if (sp > XB_SPIN_CAP) { atomicAdd(&bar[XB_TMO], 1u); break; } }
    }
    nloc = mine > 0u ? mine : 1u; nx = cnt > 0u ? cnt : 1u;
}
DEVI void xcd_barrier(const XcdBarrier& b) {
    asm volatile("s_waitcnt vmcnt(0)" ::: "memory");
    __syncthreads();
    if (threadIdx.x == 0) {
        unsigned* bar = b.bar;
        __builtin_amdgcn_s_waitcnt(0);
        unsigned nloc = b.st[0], nx = b.st[1];
        if (nloc == 0u) { xcd_barrier_complete(bar, b.x, nloc, nx); b.st[0] = nloc; b.st[1] = nx; }
        const unsigned old = xb_add(&bar[XB_XSUB(b.x)], 1u);
        const unsigned gen = old / nloc;
        if (old + 1u == (gen + 1u) * nloc) {
            __builtin_amdgcn_fence(__ATOMIC_RELEASE, "agent");
            asm volatile("s_waitcnt vmcnt(0)" ::: "memory");
            const unsigned og = xb_add(&bar[XB_TOP], 1u);
            const unsigned tg = og / nx;
            if (og + 1u == (tg + 1u) * nx) xb_add(&bar[XB_TOPGEN], 1u);
            else XB_SPIN(xb_ld(&bar[XB_TOPGEN]) == tg, bar);
            __builtin_amdgcn_fence(__ATOMIC_ACQUIRE, "agent");
            xb_add(&bar[XB_XGEN(b.x)], 1u);
            asm volatile("s_waitcnt vmcnt(0)" ::: "memory");
        } else {
            XB_SPIN(xb_ld(&bar[XB_XGEN(b.x)]) == gen, bar);
            __builtin_amdgcn_fence(__ATOMIC_ACQUIRE, "agent");
            asm volatile("s_waitcnt vmcnt(0)" ::: "memory");
        }
    }
    __syncthreads();
}

constexpr int BK = 64, HALF = 128, HTB = HALF * BK * 2;
DEVI int lds_byte(int r, int c) { const int st = (r >> 4) * 2 + (c >> 5), rr = r & 15, cc = c & 31, ob = rr * 64 + cc * 2; return st * 1024 + (ob ^ (((ob >> 9) & 1) << 5)); }
DEVI void stage_rc(int b, int& R, int& C) { const int st = b / 1024, sb = b % 1024, swz = sb ^ (((sb >> 9) & 1) << 5); R = (st >> 1) * 16 + swz / 64; C = (st & 1) * 32 + (swz % 64) / 2; }
DEVI int perm32(int rho) { const int n = rho >> 4, i = rho & 15; return 8 * (i >> 2) + 4 * n + (i & 3); }

struct GUnit {
    const char* a; const char* b;
    char* dst; int ldd; int i0, i1, i2; float f0;
};
typedef f32x4 Acc[2][2][4][2];
#define ZA1(a, b, m) acc[a][b][m][0] = z; acc[a][b][m][1] = z;
#define ZA2(a, b) ZA1(a, b, 0) ZA1(a, b, 1) ZA1(a, b, 2) ZA1(a, b, 3)
DEVI void zero_acc(Acc& acc) { f32x4 z = {0.f, 0.f, 0.f, 0.f}; asm volatile("" : "+v"(z)); ZA2(0, 0) ZA2(0, 1) ZA2(1, 0) ZA2(1, 1) }

template <class Sched, class Epi, bool GATHER>
DEVI void gemm_stream(LAS unsigned char* lds, const Sched& S, const Epi& E) {
    const int tid = threadIdx.x, wid = __builtin_amdgcn_readfirstlane(tid >> 6), lane = tid & 63, wr = wid >> 2, wc = wid & 3, fr = lane & 15, fq = lane >> 4;
    const unsigned lda = S.lda, ldb = S.ldb; const int nt = S.nt;
    unsigned voffA[2], voffB[2]; int R0 = 0;
#pragma unroll
    for (int i = 0; i < 2; ++i) { int R, C; stage_rc(tid * 16 + i * 8192, R, C); const int Rb = (R & ~31) + perm32(R & 31);
        if (i == 0) R0 = R;
        voffA[i] = GATHER ? (unsigned)(C * 2) : (unsigned)R * lda + (unsigned)(C * 2); voffB[i] = (unsigned)Rb * ldb + (unsigned)(C * 2); }
    const size_t kstep = (size_t)(BK * 2);
    const size_t hstepA = GATHER ? (size_t)0 : (size_t)HALF * lda, hstepB = (size_t)HALF * ldb;
    const unsigned ldsw = (unsigned)wid * 1024u;
    const int aoff = lds_byte(wr * 64 + fr, fq * 8), boff = lds_byte(wc * 32 + fr, fq * 8);
#define G_SA(b, h) (((b) * 2 + (h)) * HTB)
#define G_SB(b, h) ((4 + (b) * 2 + (h)) * HTB)
#define G_STAGE(bufoff, gbase, o0, o1) do { \
        __builtin_amdgcn_global_load_lds((const unsigned*)((const char*)(gbase) + (o0)), (LAS unsigned*)(lds + (bufoff) + ldsw), 16, 0, 0); \
        __builtin_amdgcn_global_load_lds((const unsigned*)((const char*)(gbase) + (o1)), (LAS unsigned*)(lds + (bufoff) + ldsw + 8192), 16, 0, 0); } while (0)
#define G_LDA(dst, b, h) do { _Pragma("unroll") for (int m = 0; m < 4; ++m) _Pragma("unroll") for (int k = 0; k < 2; ++k) dst[m][k] = *(const LAS bf16x8*)(lds + G_SA(b, h) + aoff + m * 2048 + k * 1024); } while (0)
#define G_LDB(dst, b, h) do { _Pragma("unroll") for (int n = 0; n < 2; ++n) _Pragma("unroll") for (int k = 0; k < 2; ++k) dst[n][k] = *(const LAS bf16x8*)(lds + G_SB(b, h) + boff + n * 2048 + k * 1024); } while (0)
#define G_MMA(ai, bj, At, Bt) do { __builtin_amdgcn_s_setprio(1); \
        if constexpr (Sched::F8) { _Pragma("unroll") for (int m = 0; m < 4; ++m) _Pragma("unroll") for (int n = 0; n < 2; ++n) \
            mfma8(acc[ai][bj][m][n], cat8(Bt[n][0], Bt[n][1]), cat8(At[m][0], At[m][1])); } \
        else { _Pragma("unroll") for (int m = 0; m < 4; ++m) _Pragma("unroll") for (int n = 0; n < 2; ++n) _Pragma("unroll") for (int k = 0; k < 2; ++k) \
            acc[ai][bj][m][n] = __builtin_amdgcn_mfma_f32_16x16x32_bf16(Bt[n][k], At[m][k], acc[ai][bj][m][n], 0, 0, 0); } \
        __builtin_amdgcn_s_setprio(0); } while (0)
#define G_WAIT_V(n) asm volatile("s_waitcnt vmcnt(" #n ")" ::: "memory")
#define G_WAIT_L(n) asm volatile("s_waitcnt lgkmcnt(" #n ")" ::: "memory")
#define G_BAR __builtin_amdgcn_s_barrier()
#define G_SCHED __builtin_amdgcn_sched_barrier(0)
    GUnit cur, nxt; int ui = 0;
    if (!S.next(0, cur)) return;
    unsigned gc[2][2], gn[2][2];
    gc[0][0] = voffA[0]; gc[0][1] = voffA[1]; gc[1][0] = voffA[0]; gc[1][1] = voffA[1];
    gn[0][0] = voffA[0]; gn[0][1] = voffA[1]; gn[1][0] = voffA[0]; gn[1][1] = voffA[1];
    if constexpr (GATHER) { S.gather(cur, R0, gc); gc[0][0] += voffA[0]; gc[0][1] += voffA[0]; gc[1][0] += voffA[0]; gc[1][1] += voffA[0]; }
    Acc acc; zero_acc(acc);
    typename Epi::Pre pre; E.pre(cur, wr, lane, pre);
    bf16x8 At[4][2], B0[2][2], B1[2][2];
    const char* cA = cur.a; const char* cB = cur.b;
    G_STAGE(G_SB(0, 0), cB, voffB[0], voffB[1]); G_STAGE(G_SA(0, 0), cA, gc[0][0], gc[0][1]); G_STAGE(G_SB(0, 1), cB + hstepB, voffB[0], voffB[1]); G_STAGE(G_SA(0, 1), cA + hstepA, gc[1][0], gc[1][1]);
    if (wr == 1) G_BAR;
    G_WAIT_V(4); G_BAR;
    G_STAGE(G_SB(1, 0), cB + kstep, voffB[0], voffB[1]); G_STAGE(G_SA(1, 0), cA + kstep, gc[0][0], gc[0][1]); G_STAGE(G_SB(1, 1), cB + hstepB + kstep, voffB[0], voffB[1]);
    G_WAIT_V(6); G_BAR;
    for (;;) {
        const bool has_next = S.next(ui + 1, nxt);
        const char* nA = has_next ? nxt.a : cA; const char* nB = has_next ? nxt.b : cB;
        for (int t = 0; t < nt; t += 2) {
            const bool last = (t == nt - 2);
            const char* a1 = cA + (size_t)(t + 1) * kstep;
            const char* a2 = last ? nA : cA + (size_t)(t + 2) * kstep; const char* b2 = last ? nB : cB + (size_t)(t + 2) * kstep;
            const char* a3 = a2 + kstep; const char* b3 = b2 + kstep;
            unsigned g2[2][2];
            if constexpr (GATHER) { g2[0][0] = last ? gn[0][0] : gc[0][0]; g2[0][1] = last ? gn[0][1] : gc[0][1]; g2[1][0] = last ? gn[1][0] : gc[1][0]; g2[1][1] = last ? gn[1][1] : gc[1][1]; }
            else { g2[0][0] = voffA[0]; g2[0][1] = voffA[1]; g2[1][0] = voffA[0]; g2[1][1] = voffA[1]; }
            if constexpr (GATHER) { if (t == nt - 4) {
                if (has_next) { S.gather(nxt, R0, gn); gn[0][0] += voffA[0]; gn[0][1] += voffA[0]; gn[1][0] += voffA[0]; gn[1][1] += voffA[0]; }
                else { gn[0][0] = gc[0][0]; gn[0][1] = gc[0][1]; gn[1][0] = gc[1][0]; gn[1][1] = gc[1][1]; } } }
            if constexpr (Epi::MID_T > 0) { if (t == Epi::MID_T) { if constexpr (Sched::F8) asm volatile("s_nop 15\n\ts_nop 15\n\ts_nop 15" ::: "memory"); int tz = threadIdx.x; asm volatile("" : "+v"(tz)); const int wz = tz >> 6, lz = tz & 63; E.mid(acc, cur, wz >> 2, wz & 3, lz & 15, lz >> 4); } }
            G_LDB(B0, 0, 0); G_SCHED; G_LDA(At, 0, 0); G_STAGE(G_SA(1, 1), a1 + hstepA, gc[1][0], gc[1][1]);
            G_WAIT_L(8); G_BAR; G_WAIT_L(0); G_MMA(0, 0, At, B0); G_BAR; G_SCHED;
            G_LDB(B1, 0, 1); G_STAGE(G_SB(0, 0), b2, voffB[0], voffB[1]);
            G_BAR; G_WAIT_L(0); G_MMA(0, 1, At, B1); G_BAR;
            G_LDA(At, 0, 1); G_STAGE(G_SA(0, 0), a2, g2[0][0], g2[0][1]);
            G_BAR; G_WAIT_L(0); G_MMA(1, 0, At, B0); G_BAR; G_SCHED;
            G_STAGE(G_SB(0, 1), b2 + hstepB, voffB[0], voffB[1]);
            G_WAIT_V(6); G_BAR; G_MMA(1, 1, At, B1); G_BAR;
            G_LDB(B0, 1, 0); G_SCHED; G_LDA(At, 1, 0); G_STAGE(G_SA(0, 1), a2 + hstepA, g2[1][0], g2[1][1]);
            G_WAIT_L(8); G_BAR; G_WAIT_L(0); G_MMA(0, 0, At, B0); G_BAR; G_SCHED;
            G_LDB(B1, 1, 1); G_STAGE(G_SB(1, 0), b3, voffB[0], voffB[1]);
            G_BAR; G_WAIT_L(0); G_MMA(0, 1, At, B1); G_BAR;
            G_LDA(At, 1, 1); G_STAGE(G_SA(1, 0), a3, g2[0][0], g2[0][1]);
            G_BAR; G_WAIT_L(0); G_MMA(1, 0, At, B0); G_BAR; G_SCHED;
            G_STAGE(G_SB(1, 1), b3 + hstepB, voffB[0], voffB[1]);
            G_WAIT_V(6); G_BAR; G_MMA(1, 1, At, B1); G_BAR;
        }
        if constexpr (Sched::F8) asm volatile("s_nop 15\n\ts_nop 15\n\ts_nop 15" ::: "memory");
        { int tz = threadIdx.x; asm volatile("" : "+v"(tz)); const int wz = tz >> 6, lz = tz & 63; E(acc, cur, wz >> 2, wz & 3, lz & 15, lz >> 4, pre); }
        if (!has_next) break;
        zero_acc(acc);
        cur = nxt; cA = nA; cB = nB; ++ui;
        E.pre(cur, wr, lane, pre);
        if constexpr (GATHER) { gc[0][0] = gn[0][0]; gc[0][1] = gn[0][1]; gc[1][0] = gn[1][0]; gc[1][1] = gn[1][1]; }
    }
    G_WAIT_V(0);
    if (wr == 0) G_BAR;
    G_BAR;
}

struct EpiBf16 { static constexpr int MID_T = 0; DEVI void mid(Acc&, const GUnit&, int, int, int, int) const {}
    struct Pre {}; DEVI void pre(const GUnit&, int, int, Pre&) const {}
    DEVI void operator()(const Acc& acc, const GUnit& u, int wr, int wc, int fr, int fq, const Pre&) const {
        if (u.f0 < 0.f) {
            float* fb = (float*)u.dst; const float sn = -u.f0;
#pragma unroll
            for (int m = 0; m < 4; ++m) { const int row = wr * 64 + m * 16 + fr;
                if (row < 32) { float* rp = fb + (size_t)row * u.ldd + wc * 32 + 8 * fq;
#pragma unroll
                    for (int bj = 0; bj < 2; ++bj) { *(f32x4*)(rp + bj * 128) = acc[0][bj][m][0] * sn; *(f32x4*)(rp + bj * 128 + 4) = acc[0][bj][m][1] * sn; } } }
            return;
        }
        bf16_t* base = (bf16_t*)u.dst; const float s = u.f0; const int act = u.i0;
#pragma unroll
        for (int ai = 0; ai < 2; ++ai)
#pragma unroll
            for (int m = 0; m < 4; ++m) {
                bf16_t* rp = base + (size_t)(ai * 128 + wr * 64 + m * 16 + fr) * u.ldd + wc * 32 + 8 * fq;
#pragma unroll
                for (int bj = 0; bj < 2; ++bj) {
                    f32x4 v0 = acc[ai][bj][m][0] * s, v1 = acc[ai][bj][m][1] * s;
                    if (act) {
#pragma unroll
                        for (int j = 0; j < 4; ++j) { v0[j] = sigmoidf_(v0[j]); v1[j] = sigmoidf_(v1[j]); }
                    }
                    u32x4 w; w.x = pk_bf16(v0[0], v0[1]); w.y = pk_bf16(v0[2], v0[3]); w.z = pk_bf16(v1[0], v1[1]); w.w = pk_bf16(v1[2], v1[3]);
                    *(u32x4*)(rp + bj * 128) = w;
                }
            }
    }
};
struct EpiF32 { static constexpr int MID_T = 0; DEVI void mid(Acc&, const GUnit&, int, int, int, int) const {}
    struct Pre {}; DEVI void pre(const GUnit&, int, int, Pre&) const {}
    DEVI void operator()(const Acc& acc, const GUnit& u, int wr, int wc, int fr, int fq, const Pre&) const {
        float* base = (float*)u.dst;
#pragma unroll
        for (int ai = 0; ai < 2; ++ai)
#pragma unroll
            for (int m = 0; m < 4; ++m) {
                float* rp = base + (size_t)(ai * 128 + wr * 64 + m * 16 + fr) * u.ldd + wc * 32 + 8 * fq;
#pragma unroll
                for (int bj = 0; bj < 2; ++bj) { *(f32x4*)(rp + bj * 128) = acc[ai][bj][m][0]; *(f32x4*)(rp + bj * 128 + 4) = acc[ai][bj][m][1]; }
            }
    }
};
struct EpiBranchC {
    static constexpr int MID_T = 4;
    const bf16_t* sga; const bf16_t* sgb; unsigned char* ym;
    struct Pre {}; DEVI void pre(const GUnit&, int, int, Pre&) const {}
    DEVI void mid(Acc& acc, const GUnit& u, int wr, int wc, int fr, int fq) const {
#pragma unroll
        for (int ai = 0; ai < 2; ++ai)
#pragma unroll
            for (int m = 0; m < 4; ++m) {
                const size_t ro = (size_t)(u.i1 + ai * 128 + wr * 64 + m * 16 + fr) * 1024 + u.i2 + wc * 32 + 8 * fq;
#pragma unroll
                for (int bj = 0; bj < 2; ++bj) {
                    const u32x4 ga = *(const u32x4*)(sga + ro + bj * 128), gb = *(const u32x4*)(sgb + ro + bj * 128);
                    f32x4 r0, r1;
                    r0[0] = bflo(ga.x) * __builtin_amdgcn_rcpf(bflo(gb.x)); r0[1] = bfhi(ga.x) * __builtin_amdgcn_rcpf(bfhi(gb.x)); r0[2] = bflo(ga.y) * __builtin_amdgcn_rcpf(bflo(gb.y)); r0[3] = bfhi(ga.y) * __builtin_amdgcn_rcpf(bfhi(gb.y));
                    r1[0] = bflo(ga.z) * __builtin_amdgcn_rcpf(bflo(gb.z)); r1[1] = bfhi(ga.z) * __builtin_amdgcn_rcpf(bfhi(gb.z)); r1[2] = bflo(ga.w) * __builtin_amdgcn_rcpf(bflo(gb.w)); r1[3] = bfhi(ga.w) * __builtin_amdgcn_rcpf(bfhi(gb.w));
                    acc[ai][bj][m][0] = acc[ai][bj][m][0] * r0; acc[ai][bj][m][1] = acc[ai][bj][m][1] * r1;
                }
            }
    }
    DEVI void operator()(const Acc& acc, const GUnit& u, int wr, int wc, int fr, int fq, const Pre&) const {
#pragma unroll
        for (int ai = 0; ai < 2; ++ai)
#pragma unroll
            for (int m = 0; m < 4; ++m) {
                const size_t ro = (size_t)(u.i1 + ai * 128 + wr * 64 + m * 16 + fr) * 1024 + u.i2 + wc * 32 + 8 * fq;
#pragma unroll
                for (int bj = 0; bj < 2; ++bj) {
                    const u32x4 gb = *(const u32x4*)(sgb + ro + bj * 128);
                    constexpr float sy = F8_YM / (F8_AP * F8_WBR);
                    const f32x4 v0 = acc[ai][bj][m][0] * sy, v1 = acc[ai][bj][m][1] * sy;
                    u32x2 w;
                    w.x = pk4_fp8(bflo(gb.x) * v0[0], bfhi(gb.x) * v0[1], bflo(gb.y) * v0[2], bfhi(gb.y) * v0[3]);
                    w.y = pk4_fp8(bflo(gb.z) * v1[0], bfhi(gb.z) * v1[1], bflo(gb.w) * v1[2], bfhi(gb.w) * v1[3]);
                    *(u32x2*)(ym + ro + bj * 128) = w;
                }
            }
    }
};
struct EpiGateUp { static constexpr int MID_T = 0; DEVI void mid(Acc&, const GUnit&, int, int, int, int) const {}
    unsigned char* hid;
    struct Pre {}; DEVI void pre(const GUnit&, int, int, Pre&) const {}
    DEVI void operator()(const Acc& acc, const GUnit& u, int wr, int wc, int fr, int fq, const Pre&) const {
#pragma unroll
        for (int ai = 0; ai < 2; ++ai)
#pragma unroll
            for (int m = 0; m < 4; ++m) {
                const int row = ai * 128 + wr * 64 + m * 16 + fr;
                if (row < u.i1) {
                    constexpr float si = 1.0f / (F8_X * F8_WGU), so = F8_H * si;
                    const f32x4 g0 = acc[ai][0][m][0] * si, g1 = acc[ai][0][m][1] * si, u0 = acc[ai][1][m][0] * so, u1 = acc[ai][1][m][1] * so;
                    float h[8];
#pragma unroll
                    for (int j = 0; j < 4; ++j) { h[j] = g0[j] * sigmoidf_(g0[j]) * u0[j]; h[4 + j] = g1[j] * sigmoidf_(g1[j]) * u1[j]; }
                    u32x2 w; w.x = pk4_fp8(h[0], h[1], h[2], h[3]); w.y = pk4_fp8(h[4], h[5], h[6], h[7]);
                    *(u32x2*)(hid + (size_t)(u.i0 + row) * 256 + u.i2 * 128 + wc * 32 + 8 * fq) = w;
                }
            }
    }
};
struct EpiDown {
    static constexpr int MID_T = 0; DEVI void mid(Acc&, const GUnit&, int, int, int, int) const {}
    unsigned char* ws;
    struct Pre {}; DEVI void pre(const GUnit&, int, int, Pre&) const {}
    DEVI void operator()(const Acc& acc, const GUnit& u, int wr, int wc, int fr, int fq, const Pre&) const {
#pragma unroll
        for (int ai = 0; ai < 2; ++ai)
#pragma unroll
            for (int m = 0; m < 4; ++m) {
                const int row = ai * 128 + wr * 64 + m * 16 + fr;
                if (row < u.i1) {
                    unsigned char* rp = (u.i2 == 0 ? ws + ws_ys(u.i0 + row) : ws + WS_Y8 + (size_t)(u.i0 + row) * 1024) + u.ldd + wc * 32 + 8 * fq;
#pragma unroll
                    for (int bj = 0; bj < 2; ++bj) {
                        constexpr float sd = F8_Y / (F8_H * F8_WD);
                        const f32x4 v0 = acc[ai][bj][m][0] * sd, v1 = acc[ai][bj][m][1] * sd;
                        u32x2 o; o.x = pk4_fp8(v0[0], v0[1], v0[2], v0[3]); o.y = pk4_fp8(v1[0], v1[1], v1[2], v1[3]);
                        *(u32x2*)(rp + bj * 128) = o;
                    }
                }
            }
    }
};

struct SchedInProj {
    unsigned char* ws; int G, c;
    static constexpr unsigned lda = 1024, ldb = 1024; static constexpr int nt = 8; static constexpr bool F8 = true;
    DEVI bool next(int i, GUnit& u) const {
        const int L = i * G + c; if (L >= 3544) return false;
        constexpr float us = 1.0f / (F8_HIN * F8_WIN);
        u.i0 = 0; u.i1 = 0; u.i2 = 0; u.f0 = us;
        const char* H = (const char*)(ws + WS_H); const char* BT = (const char*)(ws + WS_BT_IN);
        int pm, pn;
        if (L < 2592) {
            if (L < 2560) { const int x = L & 7, q = L >> 3, blk = q >> 5, w = q & 31; pm = 16 * x + 8 * (blk & 1) + (w & 7); pn = 4 * (blk >> 1) + (w >> 3); }
            else { const int j = L - 2560, jn = j >> 3; pm = 128 + (j & 7); pn = jn < 2 ? 2 + jn : 4 + jn; }
            u.a = H + (size_t)pm * 256 * 1024; u.b = BT + (size_t)pn * 256 * 1024;
            size_t base; int ld, col;
            if (pn < 2)       { base = WS_QA; ld = 512; col = pn * 256; u.f0 = 0.125f * us; }
            else if (pn < 4)  { base = WS_KA; ld = 512; col = (pn - 2) * 256; }
            else if (pn < 6)  { base = WS_QB; ld = 512; col = (pn - 4) * 256; }
            else if (pn < 8)  { base = WS_KB; ld = 512; col = (pn - 6) * 256; }
            else if (pn < 12) { base = WS_GB; ld = 1024; col = (pn - 8) * 256; }
            else if (pn < 16) { base = WS_SGA; ld = 1024; col = (pn - 12) * 256; u.i0 = 1; }
            else              { base = WS_SGB; ld = 1024; col = (pn - 16) * 256; u.i0 = 1; }
            u.dst = (char*)(ws + base) + ((size_t)pm * 256 * ld + col) * 2; u.ldd = ld;
        } else {
            const int j = L - 2592, x = j & 7, q = j >> 3, tn = 17 * x + q / 7, wm = q % 7;
            u.a = BT + (size_t)(5120 + wm * 256) * 1024; u.b = H + (size_t)tn * 256 * 1024;
            u.dst = (wm < 2 ? (char*)(ws + WS_VAT) + ((size_t)(wm * 256) * NROW + tn * 256) * 2 : (wm < 6 ? (char*)(ws + WS_VBT) + ((size_t)((wm - 2) * 256) * NROW + tn * 256) * 2 : (char*)(ws + WS_LRT) + (size_t)(tn * 256) * 4));
            u.ldd = NROW; if (wm == 6) u.f0 = -us;
        }
        return true;
    }
};
struct SchedDense {
    const char* A; const char* Bt; char* dst; int K; int G, c; unsigned lda, ldb; int nt; float f0; static constexpr bool F8 = true;
    DEVI bool next(int i, GUnit& u) const {
        const int L = i * G + c; if (L >= 512) return false;
        const int x = L & 7, q = L >> 3, blk = q >> 5, w = q & 31, pm = 16 * x + 8 * blk + (w & 7), pn = w >> 3;
        u.a = A + (size_t)pm * 256 * K; u.b = Bt + (size_t)pn * 256 * K;
        u.dst = dst + ((size_t)pm * 256 * 1024 + pn * 256) * 2; u.ldd = 1024; u.i0 = 0; u.i1 = pm * 256; u.i2 = pn * 256; u.f0 = f0;
        return true;
    }
};
struct SchedRouter {
    unsigned char* ws; int G, c;
    static constexpr unsigned lda = 2048, ldb = 2048; static constexpr int nt = 16; static constexpr bool F8 = false;
    DEVI static int panel(int c) { return 16 * (c & 7) + (c >> 3); }
    DEVI bool next(int i, GUnit& u) const {
        if (i > 0 || c >= 128) return false;
        const int pm = panel(c);
        u.a = (const char*)(ws + WS_H2) + (size_t)pm * 256 * 2048; u.b = (const char*)(ws + WS_BT_RT);
        u.dst = (char*)(ws + WS_LOG0) + (size_t)pm * 256 * 256 * 4; u.ldd = 256; u.i0 = 0; u.i1 = 0; u.i2 = 0; u.f0 = 1.0f;
        return true;
    }
};
DEVI void moe_tables(const unsigned* gcnt, LAS int* T) {
    if (threadIdx.x < 64) {
        const int l = threadIdx.x; int c[4], t[4];
#pragma unroll
        for (int k = 0; k < 4; ++k) { c[k] = (int)gcnt[4 * l + k]; t[k] = (c[k] + 255) >> 8; }
        const int sc = c[0] + c[1] + c[2] + c[3], st = t[0] + t[1] + t[2] + t[3];
        int ic = sc, it = st;
#pragma unroll
        for (int o = 1; o < 64; o <<= 1) { const int a = __shfl_up(ic, o), b = __shfl_up(it, o); if (l >= o) { ic += a; it += b; } }
        int bc = ic - sc, bt = it - st;
#pragma unroll
        for (int k = 0; k < 4; ++k) { T[4 * l + k] = c[k]; T[256 + 4 * l + k] = bc; T[513 + 4 * l + k] = bt; bc += c[k]; bt += t[k]; }
        if (l == 63) { T[256 + 256] = ic; T[513 + 256] = it; }
    }
    __syncthreads();
    {
        const int TRt = T[513 + 256];
        for (int t = threadIdx.x; t < TRt; t += 512) { int lo = 0, hi = 256; while (hi - lo > 1) { const int mid = (lo + hi) >> 1; if (T[513 + mid] <= t) lo = mid; else hi = mid; } T[770 + t] = lo; }
    }
    __syncthreads();
}
DEVI int moe_find(const LAS int* toff, int t) {
    int lo = 0, hi = 256;
#pragma unroll 1
    while (hi - lo > 1) { const int mid = (lo + hi) >> 1; if (toff[mid] <= t) lo = mid; else hi = mid; }
    return __builtin_amdgcn_readfirstlane(lo);
}
struct SchedGateUp {
    unsigned char* ws; const LAS int* T; int G, c;
    static constexpr unsigned lda = 1024, ldb = 1024; static constexpr int nt = 8; static constexpr bool F8 = true;
    DEVI bool next(int i, GUnit& u) const {
        const int L = i * G + c; const int TR = __builtin_amdgcn_readfirstlane(T[513 + 256]);
        if (L >= 2 * TR + 256) return false;
        u.a = (const char*)(ws + WS_H2F8); u.dst = nullptr; u.ldd = 0; u.f0 = 1.0f;
        if (L < 2 * TR) {
            const int t = L >> 1, pn = L & 1, e = __builtin_amdgcn_readfirstlane(T[770 + t]), mt = t - __builtin_amdgcn_readfirstlane(T[513 + e]), cnt = __builtin_amdgcn_readfirstlane(T[e]);
            u.b = (const char*)(ws + WS_EXPGU) + ((size_t)e * 512 + pn * 256) * 1024;
            u.i0 = __builtin_amdgcn_readfirstlane(T[256 + e]) + mt * 256; u.i1 = min(256, cnt - mt * 256); u.i2 = pn;
        } else {
            const int j = L - 2 * TR, mt = j >> 1, pn = j & 1;
            u.b = (const char*)(ws + WS_BT_SHGU) + (size_t)(pn * 256) * 1024;
            u.i0 = 262144 + mt * 256; u.i1 = 256; u.i2 = pn;
        }
        return true;
    }
    DEVI void gather(const GUnit& u, int R0, unsigned (&g)[2][2]) const {
        const u32x2* slot = (const u32x2*)(ws + WS_SLOT);
#pragma unroll
        for (int h = 0; h < 2; ++h)
#pragma unroll
            for (int i = 0; i < 2; ++i) {
                const int s = u.i0 + h * 128 + R0 + 64 * i; int tok;
                if (u.i0 >= 262144) tok = s - 262144; else tok = (int)(slot[min(s, 262143)].x >> 3);
                g[h][i] = (unsigned)tok * 1024u;
            }
    }
};
struct SchedDown {
    unsigned char* ws; const LAS int* T; int G, c;
    static constexpr unsigned lda = 256, ldb = 256; static constexpr int nt = 2; static constexpr bool F8 = true;
    DEVI bool next(int i, GUnit& u) const {
        const int L = i * G + c; const int TR = __builtin_amdgcn_readfirstlane(T[513 + 256]);
        if (L >= 4 * TR + 512) return false;
        u.dst = nullptr; u.f0 = 1.0f;
        if (L < 4 * TR) {
            const int t = L >> 2, pn = L & 3, e = __builtin_amdgcn_readfirstlane(T[770 + t]), mt = t - __builtin_amdgcn_readfirstlane(T[513 + e]), cnt = __builtin_amdgcn_readfirstlane(T[e]);
            const int s0 = __builtin_amdgcn_readfirstlane(T[256 + e]) + mt * 256;
            u.a = (const char*)(ws + WS_HID) + (size_t)s0 * 256; u.b = (const char*)(ws + WS_EXPD) + ((size_t)e * 1024 + pn * 256) * 256;
            u.i0 = s0; u.i1 = min(256, cnt - mt * 256); u.i2 = 0; u.ldd = pn * 256;
        } else {
            const int j = L - 4 * TR, mt = j >> 2, pn = j & 3;
            u.a = (const char*)(ws + WS_HID) + (size_t)(262144 + mt * 256) * 256; u.b = (const char*)(ws + WS_BT_SHD) + (size_t)(pn * 256) * 256;
            u.i0 = mt * 256; u.i1 = 256; u.i2 = 1; u.ldd = pn * 256;
        }
        return true;
    }
};

DEVI void conv_tile(const float* src, int ldsrc, int ncols, bf16_t* dst, int ldd, int k0, int row0, int ilv, LAS float* t) {
    const int tid = threadIdx.x;
    f32x4 v[8];
#pragma unroll
    for (int i = 0; i < 8; ++i) { const int f = tid + 512 * i, row = f >> 6, c4 = (f & 63) * 4;
        v[i] = (c4 < ncols) ? *(const f32x4*)(src + (size_t)(k0 + row) * ldsrc + c4) : (f32x4){0.f, 0.f, 0.f, 0.f}; }
#pragma unroll
    for (int i = 0; i < 8; ++i) { const int f = tid + 512 * i, row = f >> 6, c4 = (f & 63) * 4; LAS float* q = t + row * 257 + c4; q[0] = v[i][0]; q[1] = v[i][1]; q[2] = v[i][2]; q[3] = v[i][3]; }
    __syncthreads();
#pragma unroll
    for (int j = 0; j < 4; ++j) {
        const int p = tid + 512 * j, kp = p & 7, n = p >> 3;
        if (n < ncols) {
            const LAS float* q = t + (kp * 8) * 257 + n;
            u32x4 w; w.x = pk_bf16(q[0], q[257]); w.y = pk_bf16(q[2 * 257], q[3 * 257]); w.z = pk_bf16(q[4 * 257], q[5 * 257]); w.w = pk_bf16(q[6 * 257], q[7 * 257]);
            const int drow = row0 + (ilv >= 0 ? ((n >> 7) * 256 + (n & 127) + ilv) : n);
            *(u32x4*)(dst + (size_t)drow * ldd + k0 + kp * 8) = w;
        }
    }
    __syncthreads();
}

DEVI void conv_tile8(const float* src, int ldsrc, unsigned char* dst, int ldd, int k0, int row0, int ilv, float scale, LAS float* t, int ncols = 256) {
    const int tid = threadIdx.x;
    f32x4 v[16];
#pragma unroll
    for (int i = 0; i < 16; ++i) { const int f = tid + 512 * i, row = f >> 6, c4 = (f & 63) * 4; v[i] = (c4 < ncols) ? *(const f32x4*)(src + (size_t)(k0 + row) * ldsrc + c4) : (f32x4){0.f, 0.f, 0.f, 0.f}; }
#pragma unroll
    for (int i = 0; i < 16; ++i) { const int f = tid + 512 * i, row = f >> 6, c4 = (f & 63) * 4; LAS float* q = t + row * 257 + c4; q[0] = v[i][0] * scale; q[1] = v[i][1] * scale; q[2] = v[i][2] * scale; q[3] = v[i][3] * scale; }
    __syncthreads();
#pragma unroll
    for (int j = 0; j < 4; ++j) {
        const int p = tid + 512 * j, kp = p & 7, n = p >> 3;
        if (n >= ncols) continue;
        const LAS float* q = t + (kp * 16) * 257 + n;
        u32x4 w;
        w.x = pk4_fp8(q[0], q[257], q[2 * 257], q[3 * 257]);             w.y = pk4_fp8(q[4 * 257], q[5 * 257], q[6 * 257], q[7 * 257]);
        w.z = pk4_fp8(q[8 * 257], q[9 * 257], q[10 * 257], q[11 * 257]); w.w = pk4_fp8(q[12 * 257], q[13 * 257], q[14 * 257], q[15 * 257]);
        const int drow = row0 + (ilv >= 0 ? ((n >> 7) * 256 + (n & 127) + ilv) : n);
        *(u32x4*)(dst + (size_t)drow * ldd + k0 + kp * 16) = w;
    }
    __syncthreads();
}

DEVI void phase0(const Params& p, LAS unsigned char* lds, int part) {
    const int tid = threadIdx.x, lane = tid & 63, wid = tid >> 6;
    unsigned char* ws = p.ws;
    const int NT_IN = 8 * (2 + 2 + 2 + 2 + 4 + 4 + 4 + 2 + 4 + 1);
    const int NT0 = NT_IN + 4 * 4 + 8 * 4 + 8 * 4 + 16 + 8 + 8 + 8;
    for (int u = (part == 0 ? (int)blockIdx.x : 192 + (int)blockIdx.x); u < (part == 0 ? 192 : 192 + NT0); u += gridDim.x) {
        if (u < 192) {
            LAS float* sc = (LAS float*)lds; LAS float* red = (LAS float*)(lds + 9 * 1024 * 4);
            for (int i = tid; i < 9216; i += 512) { const int r = i >> 10, k = i & 1023; const float v = r < 8 ? p.in[1][r * 1024 + k] : p.in[3][k]; sc[i] = v / (1.0f + __expf(-v)); }
            __syncthreads();
            const int n0 = u * 32, col = lane & 31, rsub = lane >> 5;
            float acc[9];
#pragma unroll
            for (int r = 0; r < 9; ++r) acc[r] = 0.f;
            for (int it = 0; it < 64; ++it) { const int k = it * 16 + wid * 2 + rsub; const float w = p.in[4][(size_t)k * 6144 + n0 + col];
#pragma unroll
                for (int r = 0; r < 9; ++r) acc[r] += sc[r * 1024 + k] * w; }
#pragma unroll
            for (int r = 0; r < 9; ++r) red[((wid * 2 + rsub) * 9 + r) * 32 + col] = acc[r];
            __syncthreads();
            if (tid < 288) { const int r = tid >> 5, cc = tid & 31; float s = 0.f; for (int g = 0; g < 16; ++g) s += red[(g * 9 + r) * 32 + cc];
                ((float*)(ws + WS_MOD))[r * 6144 + n0 + cc] = s + p.in[5][n0 + cc]; }
            __syncthreads();
        } else {
            int t = u - 192; LAS float* tb = (LAS float*)lds;
            if (t < NT_IN) {
                const int kt = t & 7; int jb = t >> 3;
                int c0, r0, nc = 256;
                if (jb < 2)       { c0 = 0 + jb * 256;             r0 = 0 + jb * 256; }
                else if (jb < 4)  { c0 = 512 + (jb - 2) * 256;     r0 = 512 + (jb - 2) * 256; }
                else if (jb < 6)  { c0 = 1536 + (jb - 4) * 256;    r0 = 1024 + (jb - 4) * 256; }
                else if (jb < 8)  { c0 = 2048 + (jb - 6) * 256;    r0 = 1536 + (jb - 6) * 256; }
                else if (jb < 12) { c0 = 3584 + (jb - 8) * 256;    r0 = 2048 + (jb - 8) * 256; }
                else if (jb < 16) { c0 = 4640 + (jb - 12) * 256;   r0 = 3072 + (jb - 12) * 256; }
                else if (jb < 20) { c0 = 5664 + (jb - 16) * 256;   r0 = 4096 + (jb - 16) * 256; }
                else if (jb < 22) { c0 = 1024 + (jb - 20) * 256;   r0 = 5120 + (jb - 20) * 256; }
                else if (jb < 26) { c0 = 2560 + (jb - 22) * 256;   r0 = 5632 + (jb - 22) * 256; }
                else              { c0 = 4608; r0 = 6656; nc = 32; }
                conv_tile8(p.in[6] + c0, 6688, ws + WS_BT_IN, 1024, kt * 128, r0, -1, F8_WIN, tb, nc);
            } else {
                t -= NT_IN;
                if (t < 16)        { const int kt = t & 3, nb = t >> 2;  conv_tile8(p.in[13] + nb * 256, 1024, ws + WS_BT_BR, 1536, kt * 128, nb * 256, -1, F8_WBR, tb); }
                else if (t < 48)   { t -= 16; const int kt = t & 7, nb = t >> 3; conv_tile8(p.in[14] + nb * 256, 1024, ws + WS_BT_BR + 512, 1536, kt * 128, nb * 256, -1, F8_WBR, tb); }
                else if (t < 80)   { t -= 48; const int kt = t & 7, nb = t >> 3; conv_tile8(p.in[15] + nb * 256, 1024, ws + WS_BT_OUT, 1024, kt * 128, nb * 256, -1, F8_WOUT, tb); }
                else if (t < 96)   { t -= 80; conv_tile(p.in[18], 256, 256, (bf16_t*)(ws + WS_BT_RT), 1024, t * 64, 0, -1, tb); }
                else if (t < 104)  { t -= 96; conv_tile8(p.in[23], 256, ws + WS_BT_SHGU, 1024, t * 128, 0, 0, F8_WGU, tb); }
                else if (t < 112)  { t -= 104; conv_tile8(p.in[24], 256, ws + WS_BT_SHGU, 1024, t * 128, 0, 128, F8_WGU, tb); }
                else               { t -= 112; const int kt = t & 1, nb = t >> 1; conv_tile8(p.in[25] + nb * 256, 1024, ws + WS_BT_SHD, 256, kt * 128, nb * 256, -1, F8_WD, tb); }
            }
        }
    }
}

DEVI void phase1(const Params& p) {
    const float* mod = (const float*)(p.ws + WS_MOD); unsigned char* H = p.ws + WS_H;
    for (size_t idx = (size_t)blockIdx.x * 512 + threadIdx.x; idx < (size_t)NROW * 128; idx += (size_t)gridDim.x * 512) {
        const int row = (int)(idx >> 7), k = (int)(idx & 127) * 8;
        const float* src = row < NTOK ? p.in[0] + (size_t)row * 1024 + k : p.in[2] + (size_t)(row - NTOK) * 1024 + k;
        const float* m = mod + (size_t)(row < NTOK ? (row >> 12) : 8) * 6144 + k;
        const f32x4 x0 = *(const f32x4*)src, x1 = *(const f32x4*)(src + 4), h0 = *(const f32x4*)m, h1 = *(const f32x4*)(m + 4), s0 = *(const f32x4*)(m + 1024), s1 = *(const f32x4*)(m + 1028);
        const f32x4 y0 = x0 * (s0 + 1.0f) + h0, y1 = x1 * (s1 + 1.0f) + h1;
        u32x2 w; w.x = pk4_fp8(y0[0] * F8_HIN, y0[1] * F8_HIN, y0[2] * F8_HIN, y0[3] * F8_HIN); w.y = pk4_fp8(y1[0] * F8_HIN, y1[1] * F8_HIN, y1[2] * F8_HIN, y1[3] * F8_HIN);
        *(u32x2*)(H + (size_t)row * 1024 + k) = w;
    }
}

DEVI float logsig16(float z) { return -(fmaxf(-z, 0.f) + __logf(1.0f + __expf(-fabsf(z)))) * 0.0625f; }
DEVI void phase3(const Params& p, LAS unsigned char* lds) {
    const int tid = threadIdx.x;
    unsigned char* ws = p.ws;
    LAS float* LRs = (LAS float*)lds;
    LAS float* CS = (LAS float*)(lds + 8192);
    LAS float* CUM = (LAS float*)(lds + 24576);
    LAS float* TOT = (LAS float*)(lds + 24576 + 65536);
    LAS bf16_t* KTs = (LAS bf16_t*)(lds + 24576 + 65536 + 2048);
    for (int i = tid; i < 2048; i += 512) { const int pos = i >> 5, j = i & 31; const float ang = (float)pos * powf(10000.0f, -(float)j / 32.0f); CS[2 * i] = cosf(ang); CS[2 * i + 1] = sinf(ang); }
    __syncthreads();
    const float* LRT = (const float*)(ws + WS_LRT);
    const bf16_t* QB = (const bf16_t*)(ws + WS_QB); const bf16_t* KB = (const bf16_t*)(ws + WS_KB);
    bf16_t* QTF = (bf16_t*)(ws + WS_QTF); bf16_t* QTB = (bf16_t*)(ws + WS_QTB); bf16_t* KTF = (bf16_t*)(ws + WS_KTF); bf16_t* KTB = (bf16_t*)(ws + WS_KTB);
    float* EE = (float*)(ws + WS_EE);
    for (int u = blockIdx.x; u < 8 * 68 * 4; u += gridDim.x) {
        const int h = u & 3, bs = u >> 2, b = bs / 68, slot = bs % 68; const bool isctx = slot < 4; const int chunk = slot - 4;
        const int rowbase = isctx ? NTOK + b * 256 + slot * 64 : b * 4096 + chunk * 64;
        { const int r = tid >> 4, c4 = (tid & 15) * 4; const f32x4 lv = *(const f32x4*)(LRT + (size_t)r * NROW + rowbase + c4);
          LRs[(c4 + 0) * 32 + r] = lv[0]; LRs[(c4 + 1) * 32 + r] = lv[1]; LRs[(c4 + 2) * 32 + r] = lv[2]; LRs[(c4 + 3) * 32 + r] = lv[3]; }
        __syncthreads();
        {
            const int ch = tid & 127, grp = tid >> 7, dir = grp & 1, hf = grp >> 1;
            const float* w2p = p.in[dir ? 10 : 8] + h * 128 + ch; const float b2 = p.in[dir ? 11 : 9][h * 128 + ch];
            float w2[16];
#pragma unroll
            for (int r = 0; r < 16; ++r) w2[r] = w2p[r * 512];
            float run = 0.f;
            for (int k = 0; k < 32; ++k) {
                const int i = dir ? (32 * hf + 31 - k) : (32 * hf + k);
                const LAS f32x4* lp = (const LAS f32x4*)(LRs + i * 32 + 16 * dir);
                const f32x4 l0 = lp[0], l1 = lp[1], l2 = lp[2], l3 = lp[3];
                const float z0 = (l0[0] * w2[0] + l0[1] * w2[1]) + (l0[2] * w2[2] + l0[3] * w2[3]), z1 = (l1[0] * w2[4] + l1[1] * w2[5]) + (l1[2] * w2[6] + l1[3] * w2[7]);
                const float z2 = (l2[0] * w2[8] + l2[1] * w2[9]) + (l2[2] * w2[10] + l2[3] * w2[11]), z3 = (l3[0] * w2[12] + l3[1] * w2[13]) + (l3[2] * w2[14] + l3[3] * w2[15]);
                const float z = b2 + ((z0 + z1) + (z2 + z3));
                run += logsig16(z);
                CUM[(dir * 64 + i) * 128 + ch] = run;
            }
            TOT[(dir * 2 + hf) * 128 + ch] = run;
        }
        __syncthreads();
#pragma unroll
        for (int rep = 0; rep < 2; ++rep) {
            const int q = tid + 512 * rep, i = q >> 4, c8 = q & 15, ch0 = c8 * 8;
            float cf[8], cb[8];
            {
                const f32x4 a0 = *(const LAS f32x4*)(CUM + (0 * 64 + i) * 128 + ch0), a1 = *(const LAS f32x4*)(CUM + (0 * 64 + i) * 128 + ch0 + 4);
                const f32x4 b0 = *(const LAS f32x4*)(CUM + (1 * 64 + i) * 128 + ch0), b1 = *(const LAS f32x4*)(CUM + (1 * 64 + i) * 128 + ch0 + 4);
                f32x4 tf0 = {0.f, 0.f, 0.f, 0.f}, tf1 = tf0, tb0 = tf0, tb1 = tf0;
                if (i >= 32) { tf0 = *(const LAS f32x4*)(TOT + (0 * 2 + 0) * 128 + ch0); tf1 = *(const LAS f32x4*)(TOT + (0 * 2 + 0) * 128 + ch0 + 4); }
                else         { tb0 = *(const LAS f32x4*)(TOT + (1 * 2 + 1) * 128 + ch0); tb1 = *(const LAS f32x4*)(TOT + (1 * 2 + 1) * 128 + ch0 + 4); }
#pragma unroll
                for (int e = 0; e < 4; ++e) { cf[e] = a0[e] + tf0[e]; cf[4 + e] = a1[e] + tf1[e]; cb[e] = b0[e] + tb0[e]; cb[4 + e] = b1[e] + tb1[e]; }
            }
            const size_t go = (size_t)(rowbase + i) * 512 + h * 128 + ch0;
            const u32x4 kraw = *(const u32x4*)(KB + go);
            float kv[8] = {bflo(kraw.x), bfhi(kraw.x), bflo(kraw.y), bfhi(kraw.y), bflo(kraw.z), bfhi(kraw.z), bflo(kraw.w), bfhi(kraw.w)};
            float ef[8], eb[8];
#pragma unroll
            for (int e = 0; e < 8; ++e) { ef[e] = __expf(cf[e]); eb[e] = __expf(cb[e]); }
            if (!isctx) {
                const size_t gp = (size_t)(rowbase + i) * 512 + h * 128 + ((c8 ^ 4) * 8);
                const u32x4 kpr = *(const u32x4*)(KB + gp), qraw = *(const u32x4*)(QB + go), qpr = *(const u32x4*)(QB + gp);
                const float kp[8] = {bflo(kpr.x), bfhi(kpr.x), bflo(kpr.y), bfhi(kpr.y), bflo(kpr.z), bfhi(kpr.z), bflo(kpr.w), bfhi(kpr.w)};
                const float qv[8] = {bflo(qraw.x), bfhi(qraw.x), bflo(qraw.y), bfhi(qraw.y), bflo(qraw.z), bfhi(qraw.z), bflo(qraw.w), bfhi(qraw.w)};
                const float qp[8] = {bflo(qpr.x), bfhi(qpr.x), bflo(qpr.y), bfhi(qpr.y), bflo(qpr.z), bfhi(qpr.z), bflo(qpr.w), bfhi(qpr.w)};
                const int half = c8 >> 3, isx2 = (c8 >> 2) & 1, j0 = (c8 & 3) * 8, pos = half ? i : chunk;
                float qf[8], qb[8];
                const LAS f32x4* cp = (const LAS f32x4*)(CS + (pos * 32 + j0) * 2); const f32x4 c0 = cp[0], c1 = cp[1], c2 = cp[2], c3 = cp[3];
                const float csv[8] = {c0[0], c0[2], c1[0], c1[2], c2[0], c2[2], c3[0], c3[2]}, snv[8] = {c0[1], c0[3], c1[1], c1[3], c2[1], c2[3], c3[1], c3[3]};
#pragma unroll
                for (int e = 0; e < 8; ++e) {
                    const float cs = csv[e], sn = snv[e];
                    const float rq = isx2 ? qv[e] * cs + qp[e] * sn : qv[e] * cs - qp[e] * sn;
                    kv[e] = isx2 ? kv[e] * cs + kp[e] * sn : kv[e] * cs - kp[e] * sn;
                    qf[e] = rq * 0.08838834764831845f * ef[e]; qb[e] = rq * 0.08838834764831845f * eb[e];
                }
                u32x4 wq; wq.x = pk_bf16(qf[0], qf[1]); wq.y = pk_bf16(qf[2], qf[3]); wq.z = pk_bf16(qf[4], qf[5]); wq.w = pk_bf16(qf[6], qf[7]); *(u32x4*)(QTF + go) = wq;
                wq.x = pk_bf16(qb[0], qb[1]); wq.y = pk_bf16(qb[2], qb[3]); wq.z = pk_bf16(qb[4], qb[5]); wq.w = pk_bf16(qb[6], qb[7]); *(u32x4*)(QTB + go) = wq;
            }
            float kf[8], kb[8];
#pragma unroll
            for (int e = 0; e < 8; ++e) { kf[e] = kv[e] * __builtin_amdgcn_rcpf(ef[e]); kb[e] = kv[e] * __builtin_amdgcn_rcpf(eb[e]); }
            u32x4 wf; wf.x = pk_bf16(kf[0], kf[1]); wf.y = pk_bf16(kf[2], kf[3]); wf.z = pk_bf16(kf[4], kf[5]); wf.w = pk_bf16(kf[6], kf[7]);
            u32x4 wb; wb.x = pk_bf16(kb[0], kb[1]); wb.y = pk_bf16(kb[2], kb[3]); wb.z = pk_bf16(kb[4], kb[5]); wb.w = pk_bf16(kb[6], kb[7]);
            *(u32x4*)(KTF + go) = wf; *(u32x4*)(KTB + go) = wb;
            *(LAS u32x4*)(KTs + (0 * 64 + i) * 136 + ch0) = wf; *(LAS u32x4*)(KTs + (1 * 64 + i) * 136 + ch0) = wb;
            if (i == 63) { float* ep = EE + ((size_t)(0 * 8 + b) * 68 + slot) * 512 + h * 128 + ch0; *(f32x4*)ep = (f32x4){ef[0], ef[1], ef[2], ef[3]}; *(f32x4*)(ep + 4) = (f32x4){ef[4], ef[5], ef[6], ef[7]}; }
            if (i == 0)  { float* ep = EE + ((size_t)(1 * 8 + b) * 68 + slot) * 512 + h * 128 + ch0; *(f32x4*)ep = (f32x4){eb[0], eb[1], eb[2], eb[3]}; *(f32x4*)(ep + 4) = (f32x4){eb[4], eb[5], eb[6], eb[7]}; }
        }
        __syncthreads();
#pragma unroll
        for (int rep = 0; rep < 4; ++rep) {
            const int q = tid + 512 * rep, ch = q & 127, t8 = (q >> 7) & 7, dir = q >> 10;
            const LAS bf16_t* sp = KTs + (dir * 64 + t8 * 8) * 136 + ch;
            u32x4 wv; wv.x = (unsigned)sp[0] | ((unsigned)sp[136] << 16); wv.y = (unsigned)sp[2 * 136] | ((unsigned)sp[3 * 136] << 16); wv.z = (unsigned)sp[4 * 136] | ((unsigned)sp[5 * 136] << 16); wv.w = (unsigned)sp[6 * 136] | ((unsigned)sp[7 * 136] << 16);
            *(u32x4*)((bf16_t*)(ws + (dir ? WS_KTTB : WS_KTTF)) + (size_t)(h * 128 + ch) * NROW + rowbase + t8 * 8) = wv;
        }
        __syncthreads();
    }
}

DEVI int gla_slot(int dir, int n) { return dir == 0 ? n : (n < 4 ? 3 - n : 71 - n); }
DEVI int gla_rowbase(int b, int slot) { return slot >= 4 ? b * 4096 + (slot - 4) * 64 : NTOK + b * 256 + slot * 64; }
DEVI void phase4_gla(const Params& p, LAS unsigned char* lds) {
    const int tid = threadIdx.x, lane = tid & 63, w = tid >> 6, l15 = lane & 15, fq = lane >> 4;
    unsigned char* ws = p.ws;
    LAS unsigned char* TQ = lds;
    LAS unsigned char* TK = lds + 32768;
    LAS unsigned char* TV = lds + 65536;
    LAS bf16_t* PM = (LAS bf16_t*)(lds + 81920);
    LAS bf16_t* SB = (LAS bf16_t*)(lds + 81920 + 9216);
    const bf16_t* VBT = (const bf16_t*)(ws + WS_VBT);
    const float* EE = (const float*)(ws + WS_EE);
    const int qr0 = tid >> 4, qp = tid & 15, vr = tid >> 3, vp = tid & 7;
    const int qoff0 = qr0 * 256 + ((qp ^ (qr0 & 15)) << 4), qoff1 = (qr0 + 32) * 256 + ((qp ^ ((qr0 + 32) & 15)) << 4);
    const int voff = vr * 128 + ((vp ^ ((vr >> 1) & 7)) << 4);
    struct PSet { u32x4 q0, q1, k0, k1, v; };
    struct KSet { bf16x8 a, b; f32x4 e; };
    for (int u = blockIdx.x; u < 256; u += gridDim.x) {
        const int xg = u & 7, kg = u >> 3, g = xg * 8 + (kg >> 2), dvq = kg & 3, dir = g & 1, h = (g >> 1) & 3, b = g >> 3;
        const bf16_t* QT = (const bf16_t*)(ws + (dir ? WS_QTB : WS_QTF)); const bf16_t* KT = (const bf16_t*)(ws + (dir ? WS_KTB : WS_KTF)); const bf16_t* KTT = (const bf16_t*)(ws + (dir ? WS_KTTB : WS_KTTF));
        bf16_t* OUT = (bf16_t*)(ws + (dir ? WS_OB : WS_OF));
        const int vrow0 = h * 256 + dvq * 64, krow0 = h * 128, kcol0 = h * 128;
        const float* EEu = EE + (size_t)(dir * 8 + b) * 68 * 512 + h * 128 + 16 * w + 4 * fq;
        const bf16_t* vsrc = VBT + (size_t)(vrow0 + vr) * NROW + vp * 8;
        const bf16_t* ktsrc = KTT + (size_t)(krow0 + 16 * w + l15) * NROW + 8 * fq;
        const size_t qsrc = (size_t)qr0 * 512 + kcol0 + qp * 8;
        f32x4 S[4];
#pragma unroll
        for (int i = 0; i < 4; ++i) S[i] = (f32x4){0.f, 0.f, 0.f, 0.f};
        PSet P0, P1; KSet K0, K1;
        P0.q0 = P0.q1 = P0.k0 = P0.k1 = P0.v = (u32x4){0u, 0u, 0u, 0u}; P1 = P0;
        auto load_p = [&](PSet& P, int n) {
            const int slot = gla_slot(dir, n), rb = gla_rowbase(b, slot);
            P.v = *(const u32x4*)(vsrc + rb);
            if (slot >= 4) { P.q0 = *(const u32x4*)(QT + (size_t)rb * 512 + qsrc); P.q1 = *(const u32x4*)(QT + (size_t)(rb + 32) * 512 + qsrc);
                             P.k0 = *(const u32x4*)(KT + (size_t)rb * 512 + qsrc); P.k1 = *(const u32x4*)(KT + (size_t)(rb + 32) * 512 + qsrc); }
        };
        auto store_p = [&](const PSet& P, int n) {
            const int slot = gla_slot(dir, n), bufo = n & 1;
            *(LAS u32x4*)(TV + bufo * 8192 + voff) = P.v;
            if (slot >= 4) { *(LAS u32x4*)(TQ + bufo * 16384 + qoff0) = P.q0; *(LAS u32x4*)(TQ + bufo * 16384 + qoff1) = P.q1; *(LAS u32x4*)(TK + bufo * 16384 + qoff0) = P.k0; *(LAS u32x4*)(TK + bufo * 16384 + qoff1) = P.k1; }
        };
        auto load_k = [&](KSet& K, int n) {
            const int slot = gla_slot(dir, n), rb = gla_rowbase(b, slot);
            K.a = *(const bf16x8*)(ktsrc + rb); K.b = *(const bf16x8*)(ktsrc + rb + 32); K.e = *(const f32x4*)(EEu + (size_t)slot * 512);
        };
        load_p(P0, 0); load_k(K0, 0); load_k(K1, 1); load_p(P1, 1);
        __syncthreads();
        store_p(P0, 0);
        auto step = [&](int n, PSet& Pload, const PSet& Pstore, KSet& K) {
            const int slot = gla_slot(dir, n); const bool lat = slot >= 4; const int rowbase = gla_rowbase(b, slot);
            const int cur = n & 1, nxt = cur ^ 1;
            LAS unsigned char* tq = TQ + cur * 16384; LAS unsigned char* tk = TK + cur * 16384; LAS unsigned char* tv = TV + cur * 8192;
            LAS bf16_t* sbc = SB + cur * 64 * 136; LAS bf16_t* sbn = SB + nxt * 64 * 136;
            lds_barrier();
            if (n + 2 < 68) load_p(Pload, n + 2);
            if (lat) {
                const int jt = w >> 1, it0 = 2 * (w & 1);
                f32x4 c0 = {0.f, 0.f, 0.f, 0.f}, c1 = {0.f, 0.f, 0.f, 0.f};
                const int rj = 16 * jt + l15, ri0 = 16 * it0 + l15, ri1 = ri0 + 16;
                bf16x8 fa[4], fb0[4], fb1[4];
#pragma unroll
                for (int ks = 0; ks < 4; ++ks) { const int pc = 4 * ks + fq;
                    fa[ks] = *(const LAS bf16x8*)(tk + rj * 256 + ((pc ^ l15) << 4)); fb0[ks] = *(const LAS bf16x8*)(tq + ri0 * 256 + ((pc ^ l15) << 4)); fb1[ks] = *(const LAS bf16x8*)(tq + ri1 * 256 + ((pc ^ l15) << 4)); }
                __builtin_amdgcn_sched_barrier(0);
#pragma unroll
                for (int ks = 0; ks < 4; ++ks) { c0 = __builtin_amdgcn_mfma_f32_16x16x32_bf16(fa[ks], fb0[ks], c0, 0, 0, 0); c1 = __builtin_amdgcn_mfma_f32_16x16x32_bf16(fa[ks], fb1[ks], c1, 0, 0, 0); }
#pragma unroll
                for (int r = 0; r < 4; ++r) { const int j = 16 * jt + 4 * fq + r;
                    const bool k0 = dir == 0 ? (j <= ri0) : (j >= ri0), k1 = dir == 0 ? (j <= ri1) : (j >= ri1);
                    c0[r] = k0 ? c0[r] : 0.f; c1[r] = k1 ? c1[r] : 0.f; }
                u32x2 w0; w0.x = pk_bf16(c0[0], c0[1]); w0.y = pk_bf16(c0[2], c0[3]); u32x2 w1; w1.x = pk_bf16(c1[0], c1[1]); w1.y = pk_bf16(c1[2], c1[3]);
                *(LAS u32x2*)(PM + ri0 * 72 + 16 * jt + 4 * fq) = w0; *(LAS u32x2*)(PM + ri1 * 72 + 16 * jt + 4 * fq) = w1;
            }
            lds_barrier();
            bf16x8 V[4][2];
#pragma unroll
            for (int dvt = 0; dvt < 4; ++dvt)
#pragma unroll
                for (int ks = 0; ks < 2; ++ks) { const int row = 16 * dvt + l15, pc = 4 * ks + fq; V[dvt][ks] = *(const LAS bf16x8*)(tv + row * 128 + ((pc ^ ((row >> 1) & 7)) << 4)); }
            __builtin_amdgcn_sched_barrier(0);
            if (lat) {
                const int it = w >> 1, dv0 = 2 * (w & 1), ri = 16 * it + l15;
                f32x4 o0 = {0.f, 0.f, 0.f, 0.f}, o1 = {0.f, 0.f, 0.f, 0.f};
                bf16x8 pB[2], pA0[2], pA1[2], sA0[4], sA1[4], sB[4];
                const LAS bf16_t* s0 = sbc + (16 * dv0 + l15) * 136 + 8 * fq; const LAS bf16_t* s1 = s0 + 16 * 136;
#pragma unroll
                for (int ks = 0; ks < 2; ++ks) { pB[ks] = *(const LAS bf16x8*)(PM + ri * 72 + 32 * ks + 8 * fq);
                    const int r0 = 16 * dv0 + l15, r1 = r0 + 16, pc = 4 * ks + fq;
                    pA0[ks] = *(const LAS bf16x8*)(tv + r0 * 128 + ((pc ^ ((r0 >> 1) & 7)) << 4)); pA1[ks] = *(const LAS bf16x8*)(tv + r1 * 128 + ((pc ^ ((r1 >> 1) & 7)) << 4)); }
#pragma unroll
                for (int ks = 0; ks < 4; ++ks) { const int pc = 4 * ks + fq;
                    sA0[ks] = *(const LAS bf16x8*)(s0 + 32 * ks); sA1[ks] = *(const LAS bf16x8*)(s1 + 32 * ks); sB[ks] = *(const LAS bf16x8*)(tq + ri * 256 + ((pc ^ l15) << 4)); }
                __builtin_amdgcn_sched_barrier(0);
#pragma unroll
                for (int ks = 0; ks < 2; ++ks) { o0 = __builtin_amdgcn_mfma_f32_16x16x32_bf16(pA0[ks], pB[ks], o0, 0, 0, 0); o1 = __builtin_amdgcn_mfma_f32_16x16x32_bf16(pA1[ks], pB[ks], o1, 0, 0, 0); }
#pragma unroll
                for (int ks = 0; ks < 4; ++ks) { o0 = __builtin_amdgcn_mfma_f32_16x16x32_bf16(sA0[ks], sB[ks], o0, 0, 0, 0); o1 = __builtin_amdgcn_mfma_f32_16x16x32_bf16(sA1[ks], sB[ks], o1, 0, 0, 0); }
                bf16_t* op = OUT + (size_t)(rowbase + ri) * 1024 + vrow0 + 16 * dv0 + 4 * fq;
                u32x2 w0; w0.x = pk_bf16(o0[0], o0[1]); w0.y = pk_bf16(o0[2], o0[3]); u32x2 w1; w1.x = pk_bf16(o1[0], o1[1]); w1.y = pk_bf16(o1[2], o1[3]);
                *(u32x2*)op = w0; *(u32x2*)(op + 16) = w1;
            }
#pragma unroll
            for (int dvt = 0; dvt < 4; ++dvt) { S[dvt] = __builtin_amdgcn_mfma_f32_16x16x32_bf16(K.a, V[dvt][0], S[dvt], 0, 0, 0); S[dvt] = __builtin_amdgcn_mfma_f32_16x16x32_bf16(K.b, V[dvt][1], S[dvt], 0, 0, 0); }
#pragma unroll
            for (int dvt = 0; dvt < 4; ++dvt) { S[dvt] = S[dvt] * K.e;
                u32x2 o; o.x = pk_bf16(S[dvt][0], S[dvt][1]); o.y = pk_bf16(S[dvt][2], S[dvt][3]);
                *(LAS u32x2*)(sbn + (16 * dvt + l15) * 136 + 16 * w + 4 * fq) = o; }
            if (n + 2 < 68) load_k(K, n + 2);
            if (n + 1 < 68) store_p(Pstore, n + 1);
        };
#pragma unroll 1
        for (int n = 0; n < 68; n += 2) { step(n, P0, P1, K0); step(n + 1, P1, P0, K1); }
        __syncthreads();
    }
}

DEVI void phase4_na(const Params& p, LAS unsigned char* lds) {
    const int tid = threadIdx.x; const int wsg = __builtin_amdgcn_readfirstlane(tid >> 6);
    unsigned char* ws = p.ws;
    LAS unsigned char* CK = lds;
    LAS unsigned char* CV = lds + 32768;
    LAS float* RP = (LAS float*)(lds + 65536);
    const bf16_t* QA = (const bf16_t*)(ws + WS_QA); const bf16_t* KA = (const bf16_t*)(ws + WS_KA); const bf16_t* VAT = (const bf16_t*)(ws + WS_VAT);
    unsigned char* OA = ws + WS_AP;
    for (int u = blockIdx.x; u < 512; u += gridDim.x) {
        const int xg = u & 7, idx = u >> 3, bh = xg * 8 + (idx >> 3), rblk = idx & 7, h = bh & 7, b = bh >> 3;
        __syncthreads();
        for (int i = tid; i < 465; i += 512) RP[(i / 31) * 80 + 24 + (i % 31)] = p.in[7][h * 465 + i];
        int tz = tid; asm volatile("" : "+v"(tz));
#pragma unroll
        for (int rep = 0; rep < 4; ++rep) {
            const int q = tz + 512 * rep;
            { const int row = q >> 3, pc = q & 7; *(LAS u32x4*)(CK + row * 128 + ((pc ^ ((row >> 1) & 7)) << 4)) = *(const u32x4*)(KA + (size_t)(NTOK + b * 256 + row) * 512 + h * 64 + pc * 8); }
            { const int row = q >> 5, pc = q & 31; const u32x4 v = *(const u32x4*)(VAT + (size_t)(h * 64 + row) * NROW + NTOK + b * 256 + pc * 8);
              const int sw = (row & 15) << 1; u32x2 lo; lo.x = v.x; lo.y = v.y; u32x2 hi; hi.x = v.z; hi.y = v.w;
              *(LAS u32x2*)(CV + row * 512 + (((2 * pc) ^ sw) << 3)) = lo; *(LAS u32x2*)(CV + row * 512 + (((2 * pc + 1) ^ sw) << 3)) = hi; }
        }
        __syncthreads();
#pragma unroll 1
        for (int qt = 0; qt < 4; ++qt) {
            int lane = (int)__builtin_amdgcn_mbcnt_hi(~0u, __builtin_amdgcn_mbcnt_lo(~0u, 0u)); asm volatile("" : "+v"(lane));
            const int w = wsg, l15 = lane & 15, fq = lane >> 4, r = rblk * 8 + w, rs = min(max(r - 4, 0), 56);
            const int kc0 = min(max(16 * qt - 8, 0), 32);
            const int c = 16 * qt + l15, cs = min(max(c - 8, 0), 48);
            const bf16_t* qp = QA + (size_t)(b * 4096 + r * 64 + c) * 512 + h * 64 + 8 * fq;
            const bf16x8 Bq0 = *(const bf16x8*)qp, Bq1 = *(const bf16x8*)(qp + 32);
            const int lo = 15 + cs - c, d00 = kc0 - 16 * qt + 4 * fq - l15 + 15;
            const LAS unsigned char* rpl = (const LAS unsigned char*)RP + ((rs - r + 7) * 80 + 24 + d00) * 4;
            const char* kbase = (const char*)(KA + (size_t)(b * 4096 + rs * 64 + kc0) * 512 + h * 64); const unsigned klane = (unsigned)(l15 * 512 + 8 * fq) * 2u;
            const char* vbase = (const char*)(VAT + (size_t)(h * 64) * NROW + b * 4096 + rs * 64 + kc0); const unsigned vlane = (unsigned)(l15 * NROW + 4 * fq) * 2u;
#define NA_SB __builtin_amdgcn_sched_barrier(0)
            f32x4 sc[16];
#pragma unroll
            for (int hb = 0; hb < 4; ++hb) {
                bf16x8 kf[4][2];
#pragma unroll
                for (int tt = 0; tt < 4; ++tt) { const int t = 4 * hb + tt, kr = t >> 1, chh = t & 1; const char* kp = (kbase + (size_t)((kr * 64 + 16 * chh) * 1024)) + klane;
                    kf[tt][0] = *(const bf16x8*)kp; kf[tt][1] = *(const bf16x8*)(kp + 64); }
                NA_SB;
#pragma unroll
                for (int tt = 0; tt < 4; ++tt) { const int t = 4 * hb + tt, kr = t >> 1, chh = t & 1;
                    f32x4 a = {0.f, 0.f, 0.f, 0.f};
                    a = __builtin_amdgcn_mfma_f32_16x16x32_bf16(kf[tt][0], Bq0, a, 0, 0, 0); a = __builtin_amdgcn_mfma_f32_16x16x32_bf16(kf[tt][1], Bq1, a, 0, 0, 0);
#pragma unroll
                    for (int j = 0; j < 4; ++j) { const float bias = *(const LAS float*)(rpl + chh * 64 + kr * 320 + j * 4); a[j] = ((unsigned)(d00 + 16 * chh + j - lo) <= 15u) ? a[j] + bias : -INFINITY; }
                    sc[t] = a; }
                NA_SB;
            }
            u32x2 va0[2][4], va1[2][4];
            auto ld_vloc = [&](int uu0) {
#pragma unroll
                for (int q = 0; q < 2; ++q)
#pragma unroll
                    for (int mt = 0; mt < 4; ++mt) { const char* vp = (vbase + (size_t)((16 * mt * NROW + (uu0 + q) * 64) * 2)) + vlane; va0[q][mt] = *(const u32x2*)vp; va1[q][mt] = *(const u32x2*)(vp + 32); } };
            ld_vloc(0);
            NA_SB;
            float mA = -INFINITY;
#pragma unroll
            for (int t = 0; t < 16; ++t) mA = fmaxf(mA, fmaxf(fmaxf(sc[t][0], sc[t][1]), fmaxf(sc[t][2], sc[t][3])));
            mA = fmaxf(mA, __shfl_xor(mA, 16)); mA = fmaxf(mA, __shfl_xor(mA, 32));
            float lA = 0.f; u32x2 pp[16];
#pragma unroll
            for (int t = 0; t < 16; ++t) { const float e0 = __expf(sc[t][0] - mA), e1 = __expf(sc[t][1] - mA), e2 = __expf(sc[t][2] - mA), e3 = __expf(sc[t][3] - mA);
                lA += (e0 + e1) + (e2 + e3); pp[t].x = pk_bf16(e0, e1); pp[t].y = pk_bf16(e2, e3); }
            NA_SB;
            f32x4 o[4];
#pragma unroll
            for (int mt = 0; mt < 4; ++mt) o[mt] = (f32x4){0.f, 0.f, 0.f, 0.f};
            auto mm_vloc = [&](int uu0) {
#pragma unroll
                for (int q = 0; q < 2; ++q) { const int t0 = 2 * (uu0 + q), t1 = t0 + 1;
                    union { u32x4 w; bf16x8 v; } P; P.w.x = pp[t0].x; P.w.y = pp[t0].y; P.w.z = pp[t1].x; P.w.w = pp[t1].y;
#pragma unroll
                    for (int mt = 0; mt < 4; ++mt) { union { u32x4 w; bf16x8 v; } A; A.w.x = va0[q][mt].x; A.w.y = va0[q][mt].y; A.w.z = va1[q][mt].x; A.w.w = va1[q][mt].y; o[mt] = __builtin_amdgcn_mfma_f32_16x16x32_bf16(A.v, P.v, o[mt], 0, 0, 0); } } };
            mm_vloc(0); NA_SB; ld_vloc(2); NA_SB; mm_vloc(2); NA_SB; ld_vloc(4); NA_SB; mm_vloc(4); NA_SB; ld_vloc(6); NA_SB; mm_vloc(6); NA_SB;
            int lane2 = (int)__builtin_amdgcn_mbcnt_hi(~0u, __builtin_amdgcn_mbcnt_lo(~0u, 0u)); asm volatile("" : "+v"(lane2));
            const int l15b = lane2 & 15, fqb = lane2 >> 4, cks = (l15b >> 1) & 7, ck0 = l15b * 128 + ((fqb ^ cks) << 4), ck1 = l15b * 128 + (((4 + fqb) ^ cks) << 4);
            {
                bf16x8 kfA[2][2];
                auto ld_ctx = [&](bf16x8 (&kf)[2][2], auto G) {
#pragma unroll
                    for (int tt = 0; tt < 2; ++tt) { constexpr int tile = 0; const int to = (2 * decltype(G)::v + tt) * 2048 + tile;
                        kf[tt][0] = *(const LAS bf16x8*)(CK + to + ck0); kf[tt][1] = *(const LAS bf16x8*)(CK + to + ck1); } };
                auto mm_ctx = [&](const bf16x8 (&kf)[2][2], auto G) {
#pragma unroll
                    for (int tt = 0; tt < 2; ++tt) { f32x4 a = {0.f, 0.f, 0.f, 0.f};
                        a = __builtin_amdgcn_mfma_f32_16x16x32_bf16(kf[tt][0], Bq0, a, 0, 0, 0); a = __builtin_amdgcn_mfma_f32_16x16x32_bf16(kf[tt][1], Bq1, a, 0, 0, 0);
                        sc[2 * decltype(G)::v + tt] = a; } };
#define NA_CC(G0) ld_ctx(kfA, IC<G0>{}); NA_SB; mm_ctx(kfA, IC<G0>{}); NA_SB;
                NA_CC(0) NA_CC(1) NA_CC(2) NA_CC(3) NA_CC(4) NA_CC(5) NA_CC(6) NA_CC(7)
#undef NA_CC
            }
            float mB = -INFINITY;
#pragma unroll
            for (int t = 0; t < 16; ++t) mB = fmaxf(mB, fmaxf(fmaxf(sc[t][0], sc[t][1]), fmaxf(sc[t][2], sc[t][3])));
            mB = fmaxf(mB, __shfl_xor(mB, 16)); mB = fmaxf(mB, __shfl_xor(mB, 32));
            const float mx = fmaxf(mA, mB), fA = __expf(mA - mx);
            float lB = 0.f;
#pragma unroll
            for (int t = 0; t < 16; ++t) { const float e0 = __expf(sc[t][0] - mx), e1 = __expf(sc[t][1] - mx), e2 = __expf(sc[t][2] - mx), e3 = __expf(sc[t][3] - mx);
                lB += (e0 + e1) + (e2 + e3); pp[t].x = pk_bf16(e0, e1); pp[t].y = pk_bf16(e2, e3); }
            float sum = lA * fA + lB;
            sum += __shfl_xor(sum, 16); sum += __shfl_xor(sum, 32);
            const float inv = 1.0f / sum;
#pragma unroll
            for (int mt = 0; mt < 4; ++mt) o[mt] = o[mt] * fA;
            NA_SB;
            int cvo[4][2];
#pragma unroll
            for (int rr = 0; rr < 4; ++rr)
#pragma unroll
                for (int dd = 0; dd < 2; ++dd) cvo[rr][dd] = l15b * 512 + ((((8 * rr + fqb + 4 * dd) ^ (l15b << 1)) & 31) << 3);
            {
                u32x4 vfA[4], vfB[4];
                auto ld_v = [&](u32x4 (&vq)[4], auto U) {
                    constexpr int uu = decltype(U)::v, q4 = uu >> 2, rr = uu & 3;
#pragma unroll
                    for (int mt = 0; mt < 4; ++mt) { const u32x2 a0 = *(const LAS u32x2*)(CV + mt * 8192 + q4 * 256 + cvo[rr][0]), a1 = *(const LAS u32x2*)(CV + mt * 8192 + q4 * 256 + cvo[rr][1]); vq[mt] = (u32x4){a0.x, a0.y, a1.x, a1.y}; } };
                auto mm_v = [&](const u32x4 (&vq)[4], auto U) {
                    constexpr int uu = decltype(U)::v, t0 = 2 * uu, t1 = 2 * uu + 1;
                    union { u32x4 w; bf16x8 v; } P; P.w.x = pp[t0].x; P.w.y = pp[t0].y; P.w.z = pp[t1].x; P.w.w = pp[t1].y;
#pragma unroll
                    for (int mt = 0; mt < 4; ++mt) { union { u32x4 w; bf16x8 v; } A; A.w = vq[mt]; o[mt] = __builtin_amdgcn_mfma_f32_16x16x32_bf16(A.v, P.v, o[mt], 0, 0, 0); } };
#define NA_PV(U0, U1, U2, U3) mm_v(vfA, IC<U0>{}); NA_SB; ld_v(vfA, IC<U2>{}); NA_SB; mm_v(vfB, IC<U1>{}); NA_SB; ld_v(vfB, IC<U3>{}); NA_SB;
                ld_v(vfA, IC<0>{}); ld_v(vfB, IC<1>{}); NA_SB;
                NA_PV(0, 1, 2, 3) NA_PV(2, 3, 4, 5) NA_PV(4, 5, 6, 7)
                mm_v(vfA, IC<6>{}); NA_SB; mm_v(vfB, IC<7>{}); NA_SB;
#undef NA_PV
            }
#undef NA_SB
            unsigned char* op = OA + (size_t)(b * 4096 + r * 64 + c) * 1536 + h * 64 + 4 * fq; const float inv8 = inv * F8_AP;
#pragma unroll
            for (int mt = 0; mt < 4; ++mt) *(unsigned*)(op + 16 * mt) = pk4_fp8(o[mt][0] * inv8, o[mt][1] * inv8, o[mt][2] * inv8, o[mt][3] * inv8);
        }
    }
}

DEVI void phase5(const Params& p) {
    const int lane = threadIdx.x & 63, gw = blockIdx.x * 8 + (threadIdx.x >> 6), nw = gridDim.x * 8;
    const bf16_t* OF = (const bf16_t*)(p.ws + WS_OF); const bf16_t* OB = (const bf16_t*)(p.ws + WS_OB); const bf16_t* GB = (const bf16_t*)(p.ws + WS_GB); unsigned char* AP = p.ws + WS_AP;
    for (int tok = gw; tok < NTOK; tok += nw) {
#pragma unroll
        for (int hh = 0; hh < 2; ++hh) {
            const int col = hh * 512 + lane * 8;
            const size_t o = (size_t)tok * 1024 + col;
            const u32x4 a = *(const u32x4*)(OF + o), bb = *(const u32x4*)(OB + o), g = *(const u32x4*)(GB + o);
            float v[8] = {bflo(a.x) + bflo(bb.x), bfhi(a.x) + bfhi(bb.x), bflo(a.y) + bflo(bb.y), bfhi(a.y) + bfhi(bb.y), bflo(a.z) + bflo(bb.z), bfhi(a.z) + bfhi(bb.z), bflo(a.w) + bflo(bb.w), bfhi(a.w) + bfhi(bb.w)};
            float ss = 0.f;
#pragma unroll
            for (int e = 0; e < 8; ++e) ss += v[e] * v[e];
            ss += __shfl_xor(ss, 16); ss += __shfl_xor(ss, 8); ss += __shfl_xor(ss, 4); ss += __shfl_xor(ss, 2); ss += __shfl_xor(ss, 1);
            const float rs = rsqrtf(ss * (1.0f / 256.0f) + 1e-6f);
            const f32x4 n0 = *(const f32x4*)(p.in[12] + col), n1 = *(const f32x4*)(p.in[12] + col + 4);
            const float gg[8] = {bflo(g.x), bfhi(g.x), bflo(g.y), bfhi(g.y), bflo(g.z), bfhi(g.z), bflo(g.w), bfhi(g.w)};
            float r[8];
#pragma unroll
            for (int e = 0; e < 8; ++e) r[e] = v[e] * (rs * F8_AP) * (e < 4 ? n0[e & 3] : n1[e & 3]) * (gg[e] * sigmoidf_(gg[e]));
            u32x2 wv; wv.x = pk4_fp8(r[0], r[1], r[2], r[3]); wv.y = pk4_fp8(r[4], r[5], r[6], r[7]);
            *(u32x2*)(AP + (size_t)tok * 1536 + 512 + col) = wv;
        }
    }
}

DEVI void ln_row(f32x4 (&v)[4], const float* g, const float* bta, int lane) {
    float s = 0.f;
#pragma unroll
    for (int j = 0; j < 4; ++j) s += (v[j][0] + v[j][1]) + (v[j][2] + v[j][3]);
    const float mu = wave_sum(s) * (1.0f / 1024.0f);
    float q = 0.f;
#pragma unroll
    for (int j = 0; j < 4; ++j) { v[j] = v[j] - mu; q += (v[j][0] * v[j][0] + v[j][1] * v[j][1]) + (v[j][2] * v[j][2] + v[j][3] * v[j][3]); }
    const float rstd = rsqrtf(wave_sum(q) * (1.0f / 1024.0f) + 1e-6f);
#pragma unroll
    for (int j = 0; j < 4; ++j) { const f32x4 gg = *(const f32x4*)(g + lane * 4 + 256 * j), bb = *(const f32x4*)(bta + lane * 4 + 256 * j); v[j] = v[j] * rstd * gg + bb; }
}
DEVI void phase9(const Params& p) {
    const int lane = threadIdx.x & 63, gw = blockIdx.x * 8 + (threadIdx.x >> 6), nw = gridDim.x * 8;
    const float* mod = (const float*)(p.ws + WS_MOD); const bf16_t* Z = (const bf16_t*)(p.ws + WS_Z); bf16_t* X1 = (bf16_t*)(p.ws + WS_X1); bf16_t* H2 = (bf16_t*)(p.ws + WS_H2); unsigned char* H8 = p.ws + WS_H2F8;
    for (int tok = gw; tok < NTOK; tok += nw) {
        const float* m = mod + (size_t)(tok >> 12) * 6144; float v[2][8];
#pragma unroll
        for (int j = 0; j < 2; ++j) { const int cidx = lane * 8 + 512 * j;
            const f32x4 x0 = *(const f32x4*)(p.in[0] + (size_t)tok * 1024 + cidx), x1 = *(const f32x4*)(p.in[0] + (size_t)tok * 1024 + cidx + 4), g0 = *(const f32x4*)(m + 2048 + cidx), g1 = *(const f32x4*)(m + 2048 + cidx + 4);
            const u32x4 z = *(const u32x4*)(Z + (size_t)tok * 1024 + cidx);
            float zf[8] = {bflo(z.x), bfhi(z.x), bflo(z.y), bfhi(z.y), bflo(z.z), bfhi(z.z), bflo(z.w), bfhi(z.w)};
#if defined(DBG_NOMIX)
#pragma unroll
            for (int e = 0; e < 8; ++e) zf[e] = 0.f;
#endif
#pragma unroll
            for (int e = 0; e < 4; ++e) { v[j][e] = x0[e] * 1.189207115f + g0[e] * zf[e]; v[j][4 + e] = x1[e] * 1.189207115f + g1[e] * zf[4 + e]; }
        }
        float sm = 0.f;
#pragma unroll
        for (int j = 0; j < 2; ++j)
#pragma unroll
            for (int e = 0; e < 8; ++e) sm += v[j][e];
        const float mu = wave_sum(sm) * (1.0f / 1024.0f); float q = 0.f;
#pragma unroll
        for (int j = 0; j < 2; ++j)
#pragma unroll
            for (int e = 0; e < 8; ++e) { v[j][e] -= mu; q += v[j][e] * v[j][e]; }
        const float rstd = rsqrtf(wave_sum(q) * (1.0f / 1024.0f) + 1e-6f);
#pragma unroll
        for (int j = 0; j < 2; ++j) { const int cidx = lane * 8 + 512 * j;
            const f32x4 g0 = *(const f32x4*)(p.in[16] + cidx), g1 = *(const f32x4*)(p.in[16] + cidx + 4), b0 = *(const f32x4*)(p.in[17] + cidx), b1 = *(const f32x4*)(p.in[17] + cidx + 4);
            const f32x4 sh0 = *(const f32x4*)(m + 3072 + cidx), sh1 = *(const f32x4*)(m + 3072 + cidx + 4), sc0 = *(const f32x4*)(m + 4096 + cidx), sc1 = *(const f32x4*)(m + 4096 + cidx + 4);
            f32x4 o0, o1; float hv[8];
#pragma unroll
            for (int e = 0; e < 4; ++e) { o0[e] = v[j][e] * rstd * g0[e] + b0[e]; o1[e] = v[j][4 + e] * rstd * g1[e] + b1[e]; hv[e] = o0[e] * (sc0[e] + 1.0f) + sh0[e]; hv[4 + e] = o1[e] * (sc1[e] + 1.0f) + sh1[e]; }
            { u32x4 xv; xv.x = pk_bf16(o0[0], o0[1]); xv.y = pk_bf16(o0[2], o0[3]); xv.z = pk_bf16(o1[0], o1[1]); xv.w = pk_bf16(o1[2], o1[3]); *(u32x4*)(X1 + (size_t)tok * 1024 + cidx) = xv; }
            u32x4 wv; wv.x = pk_bf16(hv[0], hv[1]); wv.y = pk_bf16(hv[2], hv[3]); wv.z = pk_bf16(hv[4], hv[5]); wv.w = pk_bf16(hv[6], hv[7]);
            *(u32x4*)(H2 + (size_t)tok * 1024 + cidx) = wv;
            u32x2 w8; w8.x = pk4_fp8(hv[0] * F8_X, hv[1] * F8_X, hv[2] * F8_X, hv[3] * F8_X); w8.y = pk4_fp8(hv[4] * F8_X, hv[5] * F8_X, hv[6] * F8_X, hv[7] * F8_X);
            *(u32x2*)(H8 + (size_t)tok * 1024 + cidx) = w8; }
    }
}
DEVI void phase11(const Params& p, LAS unsigned char* lds, int tok_begin) {
    const int lane = threadIdx.x & 63, half = lane >> 5, tw0 = tok_begin + (threadIdx.x >> 6) * 32;
    LAS unsigned* LC = (LAS unsigned*)(lds + LDS_TAB); LAS unsigned* LB = LC + 256;
    if (threadIdx.x < 256) LC[threadIdx.x] = 0u;
    __syncthreads();
    const float* L0 = (const float*)(p.ws + WS_LOG0);
    int* TID = (int*)(p.ws + WS_TOPK_ID); float* TW = (float*)(p.ws + WS_TOPK_W); int* TP = (int*)(p.ws + WS_TOPK_POS); unsigned* CNT = (unsigned*)(p.ws + WS_CNT);
    float rb[4];
#pragma unroll
    for (int j = 0; j < 4; ++j) rb[j] = p.in[19][lane + 64 * j];
    for (int tok = tw0; tok < tw0 + 32; ++tok) {
        float s[4], bz[4], gs[4];
#pragma unroll
        for (int j = 0; j < 4; ++j) { const float lg = L0[(size_t)tok * 256 + lane + 64 * j]; s[j] = __builtin_amdgcn_rcpf(1.0f + __expf(-lg)); bz[j] = s[j] + rb[j]; }
#pragma unroll
        for (int j = 0; j < 4; ++j) { float m1 = bz[j], m2 = -INFINITY;
#define TOP2_STEP(P1, P2) { const float p1 = (P1), p2 = (P2); const float n1 = fmaxf(m1, p1), n2 = fmaxf(fminf(m1, p1), fmaxf(m2, p2)); m1 = n1; m2 = n2; }
            TOP2_STEP(dppf<DPP_X1>(m1), dppf<DPP_X1>(m2)) TOP2_STEP(dppf<DPP_X2>(m1), dppf<DPP_X2>(m2)) TOP2_STEP(dppf<DPP_HM>(m1), dppf<DPP_HM>(m2)) TOP2_STEP(dppf<DPP_RM>(m1), dppf<DPP_RM>(m2)) TOP2_STEP(x16f(m1, lane), x16f(m2, lane))
#undef TOP2_STEP
            gs[j] = m1 + m2; }
        float Gv[8];
#pragma unroll
        for (int j = 0; j < 4; ++j) { const float oth = x32f(gs[j], lane); Gv[2 * j] = half ? oth : gs[j]; Gv[2 * j + 1] = half ? gs[j] : oth; }
        bool keep[8];
#pragma unroll
        for (int g = 0; g < 8; ++g) { int rank = 0;
#pragma unroll
            for (int g2 = 0; g2 < 8; ++g2) rank += (Gv[g2] > Gv[g] || (Gv[g2] == Gv[g] && g2 < g)) ? 1 : 0;
            keep[g] = rank < 4; }
        unsigned key[4];
#pragma unroll
        for (int j = 0; j < 4; ++j) { const bool k = half ? keep[2 * j + 1] : keep[2 * j]; key[j] = k ? ((__float_as_uint(bz[j] + 1.0f) & 0xFFFFFF00u) | (unsigned)(255 - (lane + 64 * j))) : 0u; }
        int myE = 0;
#pragma unroll
        for (int it = 0; it < 8; ++it) {
            unsigned k = max(max(key[0], key[1]), max(key[2], key[3]));
            k = max(k, (unsigned)dppi<DPP_X1>((int)k)); k = max(k, (unsigned)dppi<DPP_X2>((int)k)); k = max(k, (unsigned)dppi<DPP_HM>((int)k)); k = max(k, (unsigned)dppi<DPP_RM>((int)k));
            k = max(k, (unsigned)x16i((int)k, lane)); k = max(k, (unsigned)x32i((int)k, lane));
#pragma unroll
            for (int j = 0; j < 4; ++j) key[j] = key[j] == k ? 0u : key[j];
            if (lane == it) myE = 255 - (int)(k & 255u);
        }
        float sv;
        { const int src = (myE & 63) << 2, jsel = myE >> 6;
          const float a0 = __builtin_bit_cast(float, __builtin_amdgcn_ds_bpermute(src, __builtin_bit_cast(int, s[0]))), a1 = __builtin_bit_cast(float, __builtin_amdgcn_ds_bpermute(src, __builtin_bit_cast(int, s[1])));
          const float a2 = __builtin_bit_cast(float, __builtin_amdgcn_ds_bpermute(src, __builtin_bit_cast(int, s[2]))), a3 = __builtin_bit_cast(float, __builtin_amdgcn_ds_bpermute(src, __builtin_bit_cast(int, s[3])));
          sv = jsel == 0 ? a0 : (jsel == 1 ? a1 : (jsel == 2 ? a2 : a3)); }
        float ssum = lane < 8 ? sv : 0.f;
        ssum += dppf<DPP_X1>(ssum); ssum += dppf<DPP_X2>(ssum); ssum += dppf<DPP_HM>(ssum);
        if (lane < 8) { const int idx = tok * 8 + lane; TID[idx] = myE; TW[idx] = sv / ssum * 2.5f; TP[idx] = (int)__hip_atomic_fetch_add(LC + myE, 1u, __ATOMIC_RELAXED, __HIP_MEMORY_SCOPE_WORKGROUP); }
    }
    __syncthreads();
    if (threadIdx.x < 256) { const unsigned cnt = LC[threadIdx.x]; LB[threadIdx.x] = cnt ? atomicAdd(&CNT[threadIdx.x], cnt) : 0u; }
    __syncthreads();
    for (int tok = tw0; tok < tw0 + 32; ++tok) if (lane < 8) { const int idx = tok * 8 + lane; TP[idx] += (int)LB[TID[idx]]; }
}
DEVI void phase12(const Params& p, LAS unsigned char* lds, int part) {
    if (part == 0) {
    LAS int* T = (LAS int*)(lds + LDS_TAB);
    moe_tables((const unsigned*)(p.ws + WS_CNT), T);
    const int* TID = (const int*)(p.ws + WS_TOPK_ID); const int* TP = (const int*)(p.ws + WS_TOPK_POS); int* TPw = (int*)(p.ws + WS_TOPK_POS); const float* TW = (const float*)(p.ws + WS_TOPK_W); u32x2* SL = (u32x2*)(p.ws + WS_SLOT);
    for (int idx = blockIdx.x * 512 + threadIdx.x; idx < NTOK * 8; idx += gridDim.x * 512) { const int slot_ = T[256 + TID[idx]] + TP[idx]; u32x2 rec; rec.x = (unsigned)idx; rec.y = __float_as_uint(TW[idx]); SL[slot_] = rec; TPw[idx] = slot_; }
    return; }
    LAS float* tb = (LAS float*)lds;
    __syncthreads();
    const bool even_split = gridDim.x == 256; const int cb = blockIdx.x;
    const int t_lo = even_split ? (cb < 128 ? cb * 18 : 2304 + (cb - 128) * 30) : cb, t_hi = even_split ? t_lo + (cb < 128 ? 18 : 30) : 256 * 24, t_st = even_split ? 1 : (int)gridDim.x;
    for (int t = t_lo; t < t_hi; t += t_st) {
        const int e = t / 24, r = t % 24;
        if (r < 8)       conv_tile8(p.in[20] + (size_t)e * 262144, 256, p.ws + WS_EXPGU + (size_t)e * 524288, 1024, r * 128, 0, 0, F8_WGU, tb);
        else if (r < 16) conv_tile8(p.in[21] + (size_t)e * 262144, 256, p.ws + WS_EXPGU + (size_t)e * 524288, 1024, (r - 8) * 128, 0, 128, F8_WGU, tb);
        else { const int kt = (r - 16) >> 2, nb = (r - 16) & 3; conv_tile8(p.in[22] + (size_t)e * 262144 + nb * 256, 1024, p.ws + WS_EXPD + (size_t)e * 262144, 256, kt * 128, nb * 256, -1, F8_WD, tb); }
    }
}
DEVI void phase15(const Params& p) {
    const int lane = threadIdx.x & 63, gw = blockIdx.x * 8 + (threadIdx.x >> 6), nw = gridDim.x * 8;
    const float* mod = (const float*)(p.ws + WS_MOD); const bf16_t* X1 = (const bf16_t*)(p.ws + WS_X1);
    for (int tok = gw; tok < NTOK; tok += nw) {
        const float* m = mod + (size_t)(tok >> 12) * 6144 + 5120; float v[2][8];
        int sl[8]; float tw[8];
        { const int* tp = (const int*)(p.ws + WS_TOPK_POS) + (size_t)tok * 8; const float* twp = (const float*)(p.ws + WS_TOPK_W) + (size_t)tok * 8;
#pragma unroll
          for (int k = 0; k < 8; ++k) { sl[k] = __builtin_amdgcn_readfirstlane(tp[k]); tw[k] = twp[k]; } }
#pragma unroll
        for (int j = 0; j < 2; ++j) { const int cidx = lane * 8 + 512 * j; float a[8];
#pragma unroll
            for (int e = 0; e < 8; ++e) a[e] = 0.f;
#pragma unroll
            for (int k = 0; k < 9; ++k) { const u32x2 y = *(const u32x2*)((k < 8 ? p.ws + ws_ys(sl[k]) : p.ws + WS_Y8 + (size_t)tok * 1024) + cidx); const float w = (k < 8 ? tw[k] : 1.0f) * (1.0f / F8_Y);
                const f32x2_t y0 = __builtin_amdgcn_cvt_pk_f32_fp8((int)y.x, false), y1 = __builtin_amdgcn_cvt_pk_f32_fp8((int)y.x, true), y2 = __builtin_amdgcn_cvt_pk_f32_fp8((int)y.y, false), y3 = __builtin_amdgcn_cvt_pk_f32_fp8((int)y.y, true);
                a[0] += w * y0[0]; a[1] += w * y0[1]; a[2] += w * y1[0]; a[3] += w * y1[1]; a[4] += w * y2[0]; a[5] += w * y2[1]; a[6] += w * y3[0]; a[7] += w * y3[1]; }
            const u32x4 xr = *(const u32x4*)(X1 + (size_t)tok * 1024 + cidx);
            const f32x4 g0 = *(const f32x4*)(m + cidx), g1 = *(const f32x4*)(m + cidx + 4), x0 = {bflo(xr.x), bfhi(xr.x), bflo(xr.y), bfhi(xr.y)}, x1 = {bflo(xr.z), bfhi(xr.z), bflo(xr.w), bfhi(xr.w)};
#if defined(DBG_NOMOE)
#pragma unroll
            for (int e = 0; e < 8; ++e) a[e] = 0.f;
#endif
#pragma unroll
            for (int e = 0; e < 4; ++e) { v[j][e] = x0[e] * 1.189207115f + g0[e] * a[e]; v[j][4 + e] = x1[e] * 1.189207115f + g1[e] * a[4 + e]; }
        }
        float sm = 0.f;
#pragma unroll
        for (int j = 0; j < 2; ++j)
#pragma unroll
            for (int e = 0; e < 8; ++e) sm += v[j][e];
        const float mu = wave_sum(sm) * (1.0f / 1024.0f); float q = 0.f;
#pragma unroll
        for (int j = 0; j < 2; ++j)
#pragma unroll
            for (int e = 0; e < 8; ++e) { v[j][e] -= mu; q += v[j][e] * v[j][e]; }
        const float rstd = rsqrtf(wave_sum(q) * (1.0f / 1024.0f) + 1e-6f);
#pragma unroll
        for (int j = 0; j < 2; ++j) { const int cidx = lane * 8 + 512 * j;
            const f32x4 g0 = *(const f32x4*)(p.in[26] + cidx), g1 = *(const f32x4*)(p.in[26] + cidx + 4), b0 = *(const f32x4*)(p.in[27] + cidx), b1 = *(const f32x4*)(p.in[27] + cidx + 4);
            f32x4 o0, o1;
#pragma unroll
            for (int e = 0; e < 4; ++e) { o0[e] = v[j][e] * rstd * g0[e] + b0[e]; o1[e] = v[j][4 + e] * rstd * g1[e] + b1[e]; }
            *(f32x4*)(p.out + (size_t)tok * 1024 + cidx) = o0; *(f32x4*)(p.out + (size_t)tok * 1024 + cidx + 4) = o1; }
    }
}

__global__ void __launch_bounds__(512, 2) mega(Params p) {
    extern __shared__ __attribute__((aligned(16))) unsigned char shm[];
    LAS unsigned char* lds = (LAS unsigned char*)shm;
    volatile LAS unsigned* xbw = (volatile LAS unsigned*)(lds + LDS_BARW);
    if (threadIdx.x == 0) { xbw[0] = 0u; xbw[1] = 0u; xbw[2] = 0u; xbw[3] = 0u; }
    __syncthreads();
    XcdBarrier bar; bar.bar = (unsigned*)(p.ws + WS_CTL); bar.x = 0; bar.st = xbw;
    const bool multi = (p.ph_hi - p.ph_lo) > 1;
    if (multi) bar = xcd_barrier_post((unsigned*)(p.ws + WS_CTL), xbw);
    unsigned char* ws = p.ws;
    const int G = gridDim.x, c = blockIdx.x;
#ifndef PHMASK
#define PHMASK 0xFFFF
#endif
#ifndef REPMASK
#define REPMASK 0
#endif
#define RUN(n) if (((PHMASK >> (n)) & 1) && p.ph_lo <= (n) && (n) < p.ph_hi)
#define SYNC(n) if (p.ph_lo <= (n) && (n) + 1 < p.ph_hi) xcd_barrier(bar); else __syncthreads()
    RUN(0) phase0(p, lds, 0);
#if (REPMASK >> 0) & 1
    __syncthreads();
    RUN(0) phase0(p, lds, 0);
#endif
    SYNC(0);
    RUN(1) { phase1(p); phase0(p, lds, 1); }
#if (REPMASK >> 1) & 1
    __syncthreads();
    RUN(1) { phase1(p); phase0(p, lds, 1); }
#endif
    SYNC(1);
    RUN(2) { SchedInProj S{ws, G, c}; EpiBf16 E; gemm_stream<SchedInProj, EpiBf16, false>(lds, S, E); }
#if (REPMASK >> 2) & 1
    __syncthreads();
    RUN(2) { SchedInProj S{ws, G, c}; EpiBf16 E; gemm_stream<SchedInProj, EpiBf16, false>(lds, S, E); }
#endif
    SYNC(2);
    RUN(3) phase3(p, lds);
#if (REPMASK >> 3) & 1
    __syncthreads();
    RUN(3) phase3(p, lds);
#endif
    SYNC(3);
    RUN(4) { if (c & 1) { phase4_na(p, lds); __syncthreads(); phase4_gla(p, lds); } else { phase4_gla(p, lds); __syncthreads(); phase4_na(p, lds); } }
    SYNC(4);
    RUN(5) phase5(p);
#if (REPMASK >> 5) & 1
    __syncthreads();
    RUN(5) phase5(p);
#endif
    SYNC(5);
#if (REPMASK >> 6) & 1
    __syncthreads();
#endif
    RUN(7) { SchedDense S{(const char*)(ws + WS_AP), (const char*)(ws + WS_BT_BR), (char*)(ws + WS_YM), 1536, G, c, 1536u, 1536u, 12, 1.0f}; EpiBranchC E{(const bf16_t*)(ws + WS_SGA), (const bf16_t*)(ws + WS_SGB), ws + WS_YM}; gemm_stream<SchedDense, EpiBranchC, false>(lds, S, E); }
#if (REPMASK >> 7) & 1
    __syncthreads();
    RUN(7) { SchedDense S{(const char*)(ws + WS_AP), (const char*)(ws + WS_BT_BR), (char*)(ws + WS_YM), 1536, G, c, 1536u, 1536u, 12, 1.0f}; EpiBranchC E{(const bf16_t*)(ws + WS_SGA), (const bf16_t*)(ws + WS_SGB), ws + WS_YM}; gemm_stream<SchedDense, EpiBranchC, false>(lds, S, E); }
#endif
    SYNC(7);
    RUN(8) { SchedDense S{(const char*)(ws + WS_YM), (const char*)(ws + WS_BT_OUT), (char*)(ws + WS_Z), 1024, G, c, 1024u, 1024u, 8, 1.0f / (F8_YM * F8_WOUT)}; EpiBf16 E; gemm_stream<SchedDense, EpiBf16, false>(lds, S, E); }
#if (REPMASK >> 8) & 1
    __syncthreads();
    RUN(8) { SchedDense S{(const char*)(ws + WS_YM), (const char*)(ws + WS_BT_OUT), (char*)(ws + WS_Z), 1024, G, c, 1024u, 1024u, 8, 1.0f / (F8_YM * F8_WOUT)}; EpiBf16 E; gemm_stream<SchedDense, EpiBf16, false>(lds, S, E); }
#endif
    SYNC(8);
    RUN(9) phase9(p);
#if (REPMASK >> 9) & 1
    __syncthreads();
    RUN(9) phase9(p);
#endif
    SYNC(9);
    RUN(10) { if (c < 128) { SchedRouter S{ws, G, c}; EpiF32 E; gemm_stream<SchedRouter, EpiF32, false>(lds, S, E); asm volatile("s_waitcnt vmcnt(0)" ::: "memory"); __syncthreads(); phase11(p, lds, SchedRouter::panel(c) * 256); }
              phase12(p, lds, 1); }
    SYNC(10);
    RUN(12) phase12(p, lds, 0);
#if (REPMASK >> 12) & 1
    __syncthreads();
    RUN(12) phase12(p, lds, 0);
#endif
    SYNC(12);
    RUN(13) { LAS int* T = (LAS int*)(lds + LDS_TAB); moe_tables((const unsigned*)(ws + WS_CNT), T); SchedGateUp S{ws, T, G, c}; EpiGateUp E{ws + WS_HID}; gemm_stream<SchedGateUp, EpiGateUp, true>(lds, S, E); }
#if (REPMASK >> 13) & 1
    __syncthreads();
    RUN(13) { LAS int* T = (LAS int*)(lds + LDS_TAB); moe_tables((const unsigned*)(ws + WS_CNT), T); SchedGateUp S{ws, T, G, c}; EpiGateUp E{ws + WS_HID}; gemm_stream<SchedGateUp, EpiGateUp, true>(lds, S, E); }
#endif
    SYNC(13);
    RUN(14) { LAS int* T = (LAS int*)(lds + LDS_TAB); moe_tables((const unsigned*)(ws + WS_CNT), T); SchedDown S{ws, T, G, c}; EpiDown E{ws}; gemm_stream<SchedDown, EpiDown, false>(lds, S, E); }
#if (REPMASK >> 14) & 1
    __syncthreads();
    RUN(14) { LAS int* T = (LAS int*)(lds + LDS_TAB); moe_tables((const unsigned*)(ws + WS_CNT), T); SchedDown S{ws, T, G, c}; EpiDown E{ws}; gemm_stream<SchedDown, EpiDown, false>(lds, S, E); }
#endif
    SYNC(14);
    RUN(15) phase15(p);
#if (REPMASK >> 15) & 1
    __syncthreads();
    RUN(15) phase15(p);
#endif
}

#ifdef DBG_STOP
__global__ void dbg_dump(const unsigned short* base, size_t nwords, float* out, int accumulate) {
    for (size_t i = (size_t)blockIdx.x * blockDim.x + threadIdx.x; i < (size_t)33554432; i += (size_t)gridDim.x * blockDim.x) {
        float s = accumulate ? out[i] : 0.f;
        for (size_t j = i; j < nwords; j += (size_t)33554432) s += (float)base[j];
        out[i] = s;
    }
}
#endif
}

extern "C" void kernel_launch(void* const* d_in, const int* in_sizes, int n_in, void* d_out, int out_size, void* d_ws, size_t ws_size, hipStream_t stream) {
    static int grid = 0;
    if (grid == 0) {
        if (n_in != 28 || out_size != NTOK * 1024 || ws_size < WS_END) { fprintf(stderr, "kernel_launch: unexpected problem (n_in %d out %d ws %zu)\n", n_in, out_size, ws_size); grid = -1; return; }
        int dev = 0, cus = 0, per_cu = 0;
        if (hipGetDevice(&dev) != hipSuccess || hipDeviceGetAttribute(&cus, hipDeviceAttributeMultiprocessorCount, dev) != hipSuccess) { grid = -1; return; }
        if (hipFuncSetAttribute((const void*)mega, hipFuncAttributeMaxDynamicSharedMemorySize, LDS_TOTAL) != hipSuccess) { fprintf(stderr, "kernel_launch: hipFuncSetAttribute failed\n"); grid = -1; return; }
        if (hipOccupancyMaxActiveBlocksPerMultiprocessor(&per_cu, (const void*)mega, 512, LDS_TOTAL) != hipSuccess || per_cu < 1) fprintf(stderr, "kernel_launch: occupancy query says %d\n", per_cu);
        (void)hipGetLastError();
        grid = cus;
    }
    if (grid < 0) return;
    (void)hipMemsetAsync((char*)d_ws + WS_CTL, 0, 32768, stream);
    Params p{};
    for (int i = 0; i < 28; ++i) p.in[i] = (const float*)d_in[i];
    p.out = (float*)d_out; p.ws = (unsigned char*)d_ws;
#ifdef DBG_STOP
    for (int ph = 0; ph <= DBG_STOP; ++ph) { p.ph_lo = ph; p.ph_hi = ph + 1; hipLaunchKernelGGL(mega, dim3(grid), dim3(512), LDS_TOTAL, stream, p); }
    { const size_t regs[][2] = { DBG_REGS }; int first = 1;
      for (auto& r : regs) { hipLaunchKernelGGL(dbg_dump, dim3(2048), dim3(256), 0, stream, (const unsigned short*)((char*)d_ws + r[0] * MiB), (size_t)(r[1] * MiB / 2), (float*)d_out, first ? 0 : 1); first = 0; } }
#elif MK_PER_PHASE
    for (int ph = 0; ph < NPH; ++ph) {
#if defined(DBG_NOMOE)
        if (ph >= 10 && ph <= 14) continue;
#endif
        p.ph_lo = ph; p.ph_hi = ph + 1; hipLaunchKernelGGL(mega, dim3(grid), dim3(512), LDS_TOTAL, stream, p); }
#else
    p.ph_lo = 0; p.ph_hi = NPH; hipLaunchKernelGGL(mega, dim3(grid), dim3(512), LDS_TOTAL, stream, p);
#endif
}
```
